# Optimizing an MI355X kernel written in HIP

```python
import jax
import jax.numpy as jnp
from jax import lax
import numpy as np


D_MODEL = 1024
BATCH = 32
SEQ = 2048
DEPTH = 4

GRID_W = 64
CTX_LEN = 256
CONV_W = 256
GMLP_W = 256
GMLP_GROUPS = 4
CHUNK = 128
N_Q_HEADS = 8
N_KV_HEADS = 2
HEAD_DIM = 64
Q_PER_KV = N_Q_HEADS // N_KV_HEADS
ATTN_W = N_Q_HEADS * HEAD_DIM
KV_W = N_KV_HEADS * HEAD_DIM
WINDOW = 128
BLOCK = 128
ROPE_BASE = 10000.0
N_BRANCH = 3
D_FF = 2816
N_MOD = 9
EPS = 1e-6
NEG_INF = -1e30

OFF_CB = 0
OFF_CC = OFF_CB + CONV_W
OFF_CH = OFF_CC + CONV_W
OFF_GU = OFF_CH + CONV_W
OFF_GV = OFF_GU + GMLP_W
OFF_Q = OFF_GV + GMLP_W
OFF_K = OFF_Q + ATTN_W
OFF_V = OFF_K + KV_W
OFF_GATE = OFF_V + KV_W
PROJ_W = OFF_GATE + N_BRANCH * D_MODEL

kernel_name = 'hybrid_gated_dit_trunk'


def rmsnorm(x, g):
    xf = x.astype(jnp.float32)
    y = xf * lax.rsqrt(jnp.mean(xf * xf, axis=-1, keepdims=True) + EPS)
    return (y * g.astype(jnp.float32)).astype(x.dtype)


def layernorm(x, g, b):
    xf = x.astype(jnp.float32)
    mu = jnp.mean(xf, axis=-1, keepdims=True)
    var = jnp.mean(jnp.square(xf - mu), axis=-1, keepdims=True)
    y = (xf - mu) * lax.rsqrt(var + EPS)
    return (y * g.astype(jnp.float32) + b.astype(jnp.float32)).astype(x.dtype)


def ada_in(t, g, shift, scale):
    return rmsnorm(t, g) * (1 + scale) + shift


def swiglu(z, w_in, w_out):
    a, u = jnp.split(z @ w_in, 2, axis=-1)
    return (jax.nn.silu(a) * u) @ w_out


def short_conv(z, w):
    zp = jnp.pad(z, ((0, 0), (1, 1), (0, 0)))
    return zp[:, :-2] * w[0] + zp[:, 1:-1] * w[1] + zp[:, 2:] * w[2]


def chunk_mlp(u, v, ln_g, ln_b, ws, bs):
    b, n, _ = u.shape
    u = jax.nn.gelu(u)
    v = layernorm(jax.nn.gelu(v), ln_g, ln_b)
    vc = v.reshape(b, n // CHUNK, CHUNK, GMLP_GROUPS, GMLP_W // GMLP_GROUPS)
    s = jnp.einsum('gpq,bcqgd->bcpgd', ws, vc) + bs.T[None, None, :, :, None]
    return u * s.reshape(b, n, GMLP_W)


def axial_rope(n, dtype):
    rows = n // GRID_W
    r, col = jnp.meshgrid(jnp.arange(rows), jnp.arange(GRID_W), indexing='ij')
    r = r.reshape(-1).astype(jnp.float32)
    col = col.reshape(-1).astype(jnp.float32)
    half = HEAD_DIM // 2
    inv = ROPE_BASE ** (-jnp.arange(0, half, 2, dtype=jnp.float32) / half)
    ang_r = r[:, None] * inv[None, :]
    ang_c = col[:, None] * inv[None, :]
    ang = jnp.concatenate([ang_r, ang_r, ang_c, ang_c], axis=-1)
    return jnp.cos(ang).astype(dtype), jnp.sin(ang).astype(dtype)


def apply_rope(x, cos, sin):
    xs = x.reshape(x.shape[:-1] + (2, 2, HEAD_DIM // 4))
    rot = jnp.stack([-xs[..., 1, :], xs[..., 0, :]], axis=-2).reshape(x.shape)
    return x * cos[None, :, None, :] + rot * sin[None, :, None, :]


def head_q(proj, q_g):
    q = proj[..., OFF_Q:OFF_K].reshape(proj.shape[:2] + (N_Q_HEADS, HEAD_DIM))
    return rmsnorm(q, q_g)


def head_kv(pkv, k_g):
    shp = pkv.shape[:2] + (N_KV_HEADS, HEAD_DIM)
    k = rmsnorm(pkv[..., :KV_W].reshape(shp), k_g)
    v = pkv[..., KV_W:].reshape(shp)
    return k, v


def windowed_attention(q, k, v, kc, vc, sink):
    b, n = q.shape[:2]
    nb = n // BLOCK
    scale = HEAD_DIM ** -0.5
    qb = q.reshape(b, nb, BLOCK, N_KV_HEADS, Q_PER_KV, HEAD_DIM).transpose(1, 0, 2, 3, 4, 5)
    pad = ((0, 0), (BLOCK, BLOCK), (0, 0), (0, 0))
    kp = jnp.pad(k, pad).reshape(b, nb + 2, BLOCK, N_KV_HEADS, HEAD_DIM)
    vp = jnp.pad(v, pad).reshape(b, nb + 2, BLOCK, N_KV_HEADS, HEAD_DIM)

    def band(t):
        return jnp.concatenate([t[:, :-2], t[:, 1:-1], t[:, 2:]], axis=2).transpose(1, 0, 2, 3, 4)

    ks, vs = band(kp), band(vp)
    blk = jnp.arange(nb)[:, None, None]
    qpos = blk * BLOCK + jnp.arange(BLOCK)[None, :, None]
    kpos = blk * BLOCK - BLOCK + jnp.arange(3 * BLOCK)[None, None, :]
    mask = (jnp.abs(kpos - qpos) <= WINDOW) & (kpos >= 0) & (kpos < n)
    sink_l = sink.astype(jnp.float32).reshape(1, N_KV_HEADS, Q_PER_KV, 1, 1)
    n_band = 3 * BLOCK

    def one_block(args):
        qblk, kblk, vblk, m = args
        s_lat = jnp.einsum('bqhgd,bkhd->bhgqk', qblk, kblk).astype(jnp.float32) * scale
        s_lat = jnp.where(m[None, None, None], s_lat, NEG_INF)
        s_ctx = jnp.einsum('bqhgd,bkhd->bhgqk', qblk, kc).astype(jnp.float32) * scale
        s_snk = jnp.broadcast_to(sink_l, s_lat.shape[:-1] + (1,))
        p = jax.nn.softmax(jnp.concatenate([s_lat, s_ctx, s_snk], axis=-1), axis=-1)
        p_lat = p[..., :n_band].astype(vblk.dtype)
        p_ctx = p[..., n_band:-1].astype(vblk.dtype)
        return (jnp.einsum('bhgqk,bkhd->bqhgd', p_lat, vblk)
                + jnp.einsum('bhgqk,bkhd->bqhgd', p_ctx, vc))

    o = lax.map(one_block, (qb, ks, vs, mask))
    return o.transpose(1, 0, 2, 3, 4, 5).reshape(b, n, ATTN_W)


def context_attention(q, k, v, sink):
    b, n = q.shape[:2]
    scale = HEAD_DIM ** -0.5
    qg = q.reshape(b, n, N_KV_HEADS, Q_PER_KV, HEAD_DIM)
    s = jnp.einsum('bqhgd,bkhd->bhgqk', qg, k).astype(jnp.float32) * scale
    s_snk = jnp.broadcast_to(sink.astype(jnp.float32).reshape(1, N_KV_HEADS, Q_PER_KV, 1, 1), s.shape[:-1] + (1,))
    p = jax.nn.softmax(jnp.concatenate([s, s_snk], axis=-1), axis=-1)[..., :-1].astype(v.dtype)
    return jnp.einsum('bhgqk,bkhd->bqhgd', p, v).reshape(b, n, ATTN_W)


def mixer_merge(proj, y_attn, conv_w, ln_g, ln_b, ws, bs, b_gate, w_bc, w_bg, w_ba, w_o):
    y_conv = proj[..., OFF_CB:OFF_CC] * short_conv(proj[..., OFF_CC:OFF_CH] * proj[..., OFF_CH:OFF_GU], conv_w)
    y_gmlp = chunk_mlp(proj[..., OFF_GU:OFF_GV], proj[..., OFF_GV:OFF_Q], ln_g, ln_b, ws, bs)
    gates = jax.nn.sigmoid(proj[..., OFF_GATE:].reshape(proj.shape[:2] + (N_BRANCH, D_MODEL)) + b_gate)
    merged = (gates[..., 0, :] * (y_conv @ w_bc)
              + gates[..., 1, :] * (y_gmlp @ w_bg)
              + gates[..., 2, :] * (y_attn @ w_ba))
    return merged @ w_o


def setup_inputs(seed: int = 0) -> dict:
    key = jax.random.key(seed)
    ks = jax.random.split(key, 24)

    def nrm(k, shape, scale):
        return jax.random.normal(k, shape, jnp.float32) * scale

    L = DEPTH
    return {
        'x': nrm(ks[0], (BATCH, SEQ, D_MODEL), 1.0),
        'c': nrm(ks[1], (BATCH, D_MODEL), 1.0),
        'ctx': nrm(ks[2], (BATCH, CTX_LEN, D_MODEL), 1.0),
        'c_ctx': nrm(ks[3], (D_MODEL,), 1.0),
        'w_mod': nrm(ks[4], (L, D_MODEL, N_MOD * D_MODEL), 0.5 * D_MODEL ** -0.5),
        'b_mod': nrm(ks[5], (L, N_MOD * D_MODEL), 0.02),
        'norm_g': 1.0 + nrm(ks[6], (L, 3, D_MODEL), 0.02),
        'ffn_w_in': nrm(ks[7], (L, 2, D_MODEL, 2 * D_FF), D_MODEL ** -0.5),
        'ffn_w_out': nrm(ks[8], (L, 2, D_FF, D_MODEL), D_FF ** -0.5),
        'w_in': nrm(ks[9], (L, D_MODEL, PROJ_W), D_MODEL ** -0.5),
        'b_gate': nrm(ks[10], (L, N_BRANCH, D_MODEL), 0.02),
        'conv_w': nrm(ks[11], (L, 3, CONV_W), 3 ** -0.5),
        'gmlp_ln_g': 1.0 + nrm(ks[12], (L, GMLP_W), 0.02),
        'gmlp_ln_b': nrm(ks[13], (L, GMLP_W), 0.02),
        'gmlp_ws': nrm(ks[14], (L, GMLP_GROUPS, CHUNK, CHUNK), CHUNK ** -0.5),
        'gmlp_bs': 1.0 + nrm(ks[15], (L, GMLP_GROUPS, CHUNK), 0.02),
        'q_norm_g': 1.0 + nrm(ks[16], (L, HEAD_DIM), 0.02),
        'k_norm_g': 1.0 + nrm(ks[17], (L, HEAD_DIM), 0.02),
        'attn_sink': nrm(ks[18], (L, N_Q_HEADS), 0.5),
        'w_branch_conv': nrm(ks[19], (L, CONV_W, D_MODEL), CONV_W ** -0.5),
        'w_branch_gmlp': nrm(ks[20], (L, GMLP_W, D_MODEL), GMLP_W ** -0.5),
        'w_branch_attn': nrm(ks[21], (L, ATTN_W, D_MODEL), ATTN_W ** -0.5),
        'w_out': nrm(ks[22], (L, D_MODEL, D_MODEL), D_MODEL ** -0.5),
    }


def reference(x, c, ctx, c_ctx, w_mod, b_mod, norm_g, ffn_w_in, ffn_w_out, w_in, b_gate, conv_w,
              gmlp_ln_g, gmlp_ln_b, gmlp_ws, gmlp_bs, q_norm_g, k_norm_g, attn_sink,
              w_branch_conv, w_branch_gmlp, w_branch_attn, w_out):
    bsz, n, _ = x.shape
    cos, sin = axial_rope(n, x.dtype)
    sc = jax.nn.silu(c)
    scc = jax.nn.silu(c_ctx)
    h, hc = x, ctx
    for l in range(DEPTH):
        last = l == DEPTH - 1
        mx = (sc @ w_mod[l] + b_mod[l]).reshape(bsz, 1, N_MOD, D_MODEL)
        mc = (scc @ w_mod[l] + b_mod[l]).reshape(N_MOD, D_MODEL)
        branch = (conv_w[l], gmlp_ln_g[l], gmlp_ln_b[l], gmlp_ws[l], gmlp_bs[l], b_gate[l],
                  w_branch_conv[l], w_branch_gmlp[l], w_branch_attn[l], w_out[l])

        h = h + 0.5 * mx[:, :, 2] * swiglu(ada_in(h, norm_g[l, 0], mx[:, :, 0], mx[:, :, 1]), ffn_w_in[l, 0], ffn_w_out[l, 0])
        hc = hc + 0.5 * mc[2] * swiglu(ada_in(hc, norm_g[l, 0], mc[0], mc[1]), ffn_w_in[l, 0], ffn_w_out[l, 0])

        zx = ada_in(h, norm_g[l, 1], mx[:, :, 3], mx[:, :, 4])
        zc = ada_in(hc, norm_g[l, 1], mc[3], mc[4])
        px = zx @ w_in[l]
        qx = apply_rope(head_q(px, q_norm_g[l]), cos, sin)
        kx, vx = head_kv(px[..., OFF_K:OFF_GATE], k_norm_g[l])
        kx = apply_rope(kx, cos, sin)
        if last:
            kc, vc = head_kv(zc @ w_in[l][:, OFF_K:OFF_GATE], k_norm_g[l])
        else:
            pc = zc @ w_in[l]
            kc, vc = head_kv(pc[..., OFF_K:OFF_GATE], k_norm_g[l])
        ya = windowed_attention(qx, kx, vx, kc, vc, attn_sink[l])
        h = h + mx[:, :, 5] * mixer_merge(px, ya, *branch)
        if not last:
            yc = context_attention(head_q(pc, q_norm_g[l]), kc, vc, attn_sink[l])
            hc = hc + mc[5] * mixer_merge(pc, yc, *branch)

        h = h + 0.5 * mx[:, :, 8] * swiglu(ada_in(h, norm_g[l, 2], mx[:, :, 6], mx[:, :, 7]), ffn_w_in[l, 1], ffn_w_out[l, 1])
        if not last:
            hc = hc + 0.5 * mc[8] * swiglu(ada_in(hc, norm_g[l, 2], mc[6], mc[7]), ffn_w_in[l, 1], ffn_w_out[l, 1])
    return h
```

```cpp
#include <hip/hip_runtime.h>
#include <hip/hip_cooperative_groups.h>
#include <cstdio>
namespace cg = cooperative_groups;

#ifndef MK_SINGLE
#define MK_SINGLE 1
#endif

#define LAS __attribute__((address_space(3)))
typedef unsigned short bf16_t;
typedef short bf16x8 __attribute__((ext_vector_type(8)));
typedef short bf16x4 __attribute__((ext_vector_type(4)));
typedef float f32x4 __attribute__((ext_vector_type(4)));
typedef unsigned u32x4 __attribute__((ext_vector_type(4)));
typedef unsigned u32x2 __attribute__((ext_vector_type(2)));

constexpr int D = 1024, NB = 32, SEQ = 2048, NL = 4, CTXL = 256, DFF = 2816, PROJ = 5120, NMOD = 9;
constexpr int T_LAT = NB * SEQ, T_CTX = NB * CTXL, T_ALL = T_LAT + T_CTX;
constexpr int H_LAT = T_LAT / 2, H_CTX = T_CTX / 2, TH = H_LAT + H_CTX;
constexpr int TILES_H = TH / 256, TILES_HL = H_LAT / 256;
constexpr int OFF_CB = 0, OFF_CC = 256, OFF_CH = 512, OFF_GU = 768, OFF_GV = 1024, OFF_Q = 1280, OFF_K = 1792, OFF_V = 1920, OFF_GATE = 2048;
constexpr float EPS = 1e-6f;
constexpr float LOG2E = 1.4426950408889634f;

enum { I_X = 0, I_C, I_CTX, I_CCTX, I_WMOD, I_BMOD, I_NORMG, I_FFNIN, I_FFNOUT, I_WIN, I_BGATE, I_CONVW, I_LNG, I_LNB, I_GWS, I_GBS, I_QG, I_KG, I_SINK, I_WBC, I_WBG, I_WBA, I_WOUT, N_IN };

constexpr size_t W_FIN0 = 0, W_FIN1 = 5767168, W_FOUT0 = 11534336, W_FOUT1 = 14417920, W_WIN = 17301504, W_WB = 22544384, W_WO = 23592960, W_GWS = 24641536, W_LAYER = 24707072;
constexpr size_t WS_WT = 0;
constexpr size_t WS_MOD = WS_WT + NL * W_LAYER * 2;
constexpr size_t WS_ROPE = WS_MOD + (size_t)NL * 33 * 9216 * 4;
constexpr size_t WS_HC = WS_ROPE + 8192;
constexpr size_t WS_A = WS_HC + (size_t)T_CTX * D * 4;
constexpr size_t WS_R1 = WS_A + (size_t)T_ALL * D * 2;
constexpr size_t WS_VTL = WS_R1 + (size_t)T_ALL * DFF * 2;
constexpr size_t WS_VTC = WS_VTL + (size_t)16 * 2 * 64 * 2048 * 2;
constexpr size_t WS_END = WS_VTC + (size_t)16 * 2 * 64 * 256 * 2;

constexpr int LDS_BYTES = 143360;
constexpr int N_PHASES = 1 + 17 * NL;

struct Params {
    const float* in[N_IN];
    float* out;
    unsigned char* ws;
    int ph_lo, ph_hi;
};

__device__ __forceinline__ unsigned cvt_pk_bf16(float lo, float hi) { unsigned r; asm volatile("v_cvt_pk_bf16_f32 %0, %1, %2" : "=v"(r) : "v"(lo), "v"(hi)); return r; }
__device__ __forceinline__ int tid_opaque() { int t = threadIdx.x; asm volatile("" : "+v"(t)); return t; }
__device__ __forceinline__ int bid_opaque() { int b = blockIdx.x; asm volatile("" : "+s"(b)); return b; }
__device__ __forceinline__ float bf_lo(unsigned w) { return __uint_as_float(w << 16); }
__device__ __forceinline__ float bf_hi(unsigned w) { return __uint_as_float(w & 0xffff0000u); }
__device__ __forceinline__ float fast_rcp(float x) { return __builtin_amdgcn_rcpf(x); }
__device__ __forceinline__ float fast_exp2(float x) { return __builtin_amdgcn_exp2f(x); }
__device__ __forceinline__ float sigmoidf_(float x) { return fast_rcp(1.0f + fast_exp2(-x * LOG2E)); }
__device__ __forceinline__ float siluf_(float x) { return x * sigmoidf_(x); }
__device__ __forceinline__ float gelu_tanh(float x) { const float z = 0.7978845608028654f * (x + 0.044715f * x * x * x); return x * sigmoidf_(2.0f * z); }
__device__ __forceinline__ float wave_sum(float v) {
    v += __shfl_xor(v, 1); v += __shfl_xor(v, 2); v += __shfl_xor(v, 4); v += __shfl_xor(v, 8); v += __shfl_xor(v, 16); v += __shfl_xor(v, 32); return v;
}
__device__ __forceinline__ void unpack8(const u32x4 w, float (&f)[8]) {
    f[0] = bf_lo(w.x); f[1] = bf_hi(w.x); f[2] = bf_lo(w.y); f[3] = bf_hi(w.y); f[4] = bf_lo(w.z); f[5] = bf_hi(w.z); f[6] = bf_lo(w.w); f[7] = bf_hi(w.w);
}
__device__ __forceinline__ u32x4 pack8(const float (&f)[8]) {
    u32x4 w; w.x = cvt_pk_bf16(f[0], f[1]); w.y = cvt_pk_bf16(f[2], f[3]); w.z = cvt_pk_bf16(f[4], f[5]); w.w = cvt_pk_bf16(f[6], f[7]); return w;
}

struct RowMap { size_t row0; int is_ctx; int modrow; };
__device__ __forceinline__ RowMap map_row(int u) {
    const int s = u / TH, v = u - s * TH; RowMap r;
    if (v < H_LAT) { r.row0 = (size_t)s * H_LAT + v; r.is_ctx = 0; r.modrow = (int)(r.row0 >> 11); }
    else { r.row0 = (size_t)s * H_CTX + (v - H_LAT); r.is_ctx = 1; r.modrow = 32; }
    return r;
}

namespace pg8 {
constexpr int BM = 256, BK = 64, HALF = 128, HTB = HALF * BK * 2, STAGE_BYTES = 8 * HTB, NXCD = 8, WGM = 8;
__device__ __forceinline__ int lds_byte(int r, int c) { const int st = (r >> 4) * 2 + (c >> 5), rr = r & 15, cc = c & 31, ob = rr * 64 + cc * 2; return st * 1024 + (ob ^ (((ob >> 9) & 1) << 5)); }
__device__ __forceinline__ void stage_rc(int b, int& R, int& C) { const int st = b / 1024, sb = b % 1024, swz = sb ^ (((sb >> 9) & 1) << 5); R = (st >> 1) * 16 + swz / 64; C = (st & 1) * 32 + (swz % 64) / 2; }
__device__ __forceinline__ int perm32(int rho) { const int n = rho >> 4, i = rho & 15; return 8 * (i >> 2) + 4 * n + (i & 3); }

struct Unit { int pm, pn; };
struct Gemm { const bf16_t* A; int lda; const bf16_t* Bt; int ldb; int M, N, K; };

struct StaticOrder {
    int nM, nN, nwg, G, c;
    __device__ void init(int M, int N, int G_, int c_) { nM = M / BM; nN = N / BM; nwg = nM * nN; G = G_; c = c_; }
    __device__ bool next(int i, Unit& u) const {
        const long L = (long)i * G + c; if (L >= nwg) return false;
        int wgid = (int)L; { const int q = nwg / NXCD, r = nwg % NXCD, xcd = wgid % NXCD, off = wgid / NXCD; wgid = (xcd < r ? xcd * (q + 1) : r * (q + 1) + (xcd - r) * q) + off; }
        const int nig = WGM * nN, gid = wgid / nig, fm = gid * WGM, gsz = (nM - fm) < WGM ? (nM - fm) : WGM;
        u.pm = fm + ((wgid % nig) % gsz); u.pn = (wgid % nig) / gsz; return true;
    }
};

template <class Epi>
__device__ __forceinline__ void gemm_phase(LAS unsigned char* lds, const Gemm g, const Epi& E) {
    const int tid = tid_opaque(), wid = __builtin_amdgcn_readfirstlane(tid >> 6), lane = tid & 63, wr = wid >> 2, wc = wid & 3, fr = lane & 15, fq = lane >> 4;
    const int K = g.K, nt = K / BK;
    StaticOrder S; S.init(g.M, g.N, (int)gridDim.x, bid_opaque());
    unsigned voffA[2], voffB[2];
#pragma unroll
    for (int i = 0; i < 2; ++i) { int R, C; stage_rc(tid * 16 + i * 8192, R, C); const int Rb = Epi::PERM ? ((R & ~31) + perm32(R & 31)) : R;
        voffA[i] = (unsigned)(R * g.lda + C) * 2u; voffB[i] = (unsigned)(Rb * g.ldb + C) * 2u; }
    const size_t kstep = (size_t)(BK * 2);
    const size_t hstepA = (size_t)HALF * g.lda * 2, hstepB = (size_t)HALF * g.ldb * 2;
    const size_t tstepA = 2 * hstepA, tstepB = 2 * hstepB;
    const unsigned ldsw = (unsigned)wid * 1024u;
    const int aoff = lds_byte(wr * 64 + fr, fq * 8), boff = lds_byte(wc * 32 + fr, fq * 8);
#define PG8_SA(b, h) (((b) * 2 + (h)) * HTB)
#define PG8_SB(b, h) ((4 + (b) * 2 + (h)) * HTB)
#define PG8_STAGE(bufoff, gbase, voff) do { _Pragma("unroll") for (int _i = 0; _i < 2; ++_i) \
        __builtin_amdgcn_global_load_lds((const unsigned*)((const char*)(gbase) + (voff)[_i]), (LAS unsigned*)(lds + (bufoff) + ldsw + _i * 8192), 16, 0, 0); } while (0)
#define PG8_LDA(dst, b, h) do { _Pragma("unroll") for (int m = 0; m < 4; ++m) _Pragma("unroll") for (int k = 0; k < 2; ++k) dst[m][k] = *(const LAS bf16x8*)(lds + PG8_SA(b, h) + aoff + m * 2048 + k * 1024); } while (0)
#define PG8_LDB(dst, b, h) do { _Pragma("unroll") for (int n = 0; n < 2; ++n) _Pragma("unroll") for (int k = 0; k < 2; ++k) dst[n][k] = *(const LAS bf16x8*)(lds + PG8_SB(b, h) + boff + n * 2048 + k * 1024); } while (0)
#define PG8_MMA(ai, bj, At, Bt) do { __builtin_amdgcn_s_setprio(1); _Pragma("unroll") for (int m = 0; m < 4; ++m) _Pragma("unroll") for (int n = 0; n < 2; ++n) _Pragma("unroll") for (int k = 0; k < 2; ++k) \
        acc[ai][bj][m][n] = __builtin_amdgcn_mfma_f32_16x16x32_bf16(Bt[n][k], At[m][k], acc[ai][bj][m][n], 0, 0, 0); __builtin_amdgcn_s_setprio(0); } while (0)
#define PG8_WAIT_V(n) asm volatile("s_waitcnt vmcnt(" #n ")" ::: "memory")
#define PG8_WAIT_L(n) asm volatile("s_waitcnt lgkmcnt(" #n ")" ::: "memory")
#define PG8_BAR __builtin_amdgcn_s_barrier()
#define PG8_SCHED __builtin_amdgcn_sched_barrier(0)
#define PG8_KLOOP(TB, TE) for (int t = (TB); t < (TE); t += 2) { \
            const bool last = (t == nt - 2); \
            const char* a1 = cA + (size_t)(t + 1) * kstep; \
            const char* a2 = last ? nA : cA + (size_t)(t + 2) * kstep; const char* b2 = last ? nB : cB + (size_t)(t + 2) * kstep; \
            const char* a3 = a2 + kstep; const char* b3 = b2 + kstep; \
            PG8_LDB(B0, 0, 0); PG8_SCHED; PG8_LDA(At, 0, 0); PG8_STAGE(PG8_SA(1, 1), a1 + hstepA, voffA); \
            PG8_WAIT_L(8); PG8_BAR; PG8_WAIT_L(0); PG8_MMA(0, 0, At, B0); PG8_BAR; PG8_SCHED; \
            PG8_LDB(B1, 0, 1); PG8_STAGE(PG8_SB(0, 0), b2, voffB); \
            PG8_BAR; PG8_WAIT_L(0); PG8_MMA(0, 1, At, B1); PG8_BAR; \
            PG8_LDA(At, 0, 1); PG8_STAGE(PG8_SA(0, 0), a2, voffA); \
            PG8_BAR; PG8_WAIT_L(0); PG8_MMA(1, 0, At, B0); PG8_BAR; PG8_SCHED; \
            PG8_STAGE(PG8_SB(0, 1), b2 + hstepB, voffB); \
            PG8_WAIT_V(6); PG8_BAR; PG8_MMA(1, 1, At, B1); PG8_BAR; \
            PG8_LDB(B0, 1, 0); PG8_SCHED; PG8_LDA(At, 1, 0); PG8_STAGE(PG8_SA(0, 1), a2 + hstepA, voffA); \
            PG8_WAIT_L(8); PG8_BAR; PG8_WAIT_L(0); PG8_MMA(0, 0, At, B0); PG8_BAR; PG8_SCHED; \
            PG8_LDB(B1, 1, 1); PG8_STAGE(PG8_SB(1, 0), b3, voffB); \
            PG8_BAR; PG8_WAIT_L(0); PG8_MMA(0, 1, At, B1); PG8_BAR; \
            PG8_LDA(At, 1, 1); PG8_STAGE(PG8_SA(1, 0), a3, voffA); \
            PG8_BAR; PG8_WAIT_L(0); PG8_MMA(1, 0, At, B0); PG8_BAR; PG8_SCHED; \
            PG8_STAGE(PG8_SB(1, 1), b3 + hstepB, voffB); \
            PG8_WAIT_V(6); PG8_BAR; PG8_MMA(1, 1, At, B1); PG8_BAR; \
        }
    Unit cur, nxt; int ui = 0;
    if (!S.next(0, cur)) return;
    f32x4 acc[2][2][4][2];
#pragma unroll
    for (int a = 0; a < 2; ++a)
#pragma unroll
        for (int b = 0; b < 2; ++b)
#pragma unroll
            for (int m = 0; m < 4; ++m)
#pragma unroll
                for (int n = 0; n < 2; ++n) acc[a][b][m][n] = (f32x4){0.f, 0.f, 0.f, 0.f};
    bf16x8 At[4][2], B0[2][2], B1[2][2];
    const char* cA = (const char*)g.A + (size_t)cur.pm * tstepA; const char* cB = (const char*)g.Bt + (size_t)cur.pn * tstepB;
    PG8_STAGE(PG8_SB(0, 0), cB, voffB); PG8_STAGE(PG8_SA(0, 0), cA, voffA); PG8_STAGE(PG8_SB(0, 1), cB + hstepB, voffB); PG8_STAGE(PG8_SA(0, 1), cA + hstepA, voffA);
    if (wr == 1) PG8_BAR;
    PG8_WAIT_V(4); PG8_BAR;
    PG8_STAGE(PG8_SB(1, 0), cB + kstep, voffB); PG8_STAGE(PG8_SA(1, 0), cA + kstep, voffA); PG8_STAGE(PG8_SB(1, 1), cB + hstepB + kstep, voffB);
    PG8_WAIT_V(6); PG8_BAR;
    for (;;) {
        const bool has_next = S.next(ui + 1, nxt);
        const char* nA = has_next ? (const char*)g.A + (size_t)nxt.pm * tstepA : cA; const char* nB = has_next ? (const char*)g.Bt + (size_t)nxt.pn * tstepB : cB;
        if constexpr (Epi::MIDK) {
            PG8_KLOOP(0, 4)
            E.template mid<0>(acc, cur, wr, wc, fr, fq);
            PG8_KLOOP(4, 8)
            E.template mid<1>(acc, cur, wr, wc, fr, fq);
            PG8_KLOOP(8, nt)
        } else {
            PG8_KLOOP(0, nt)
        }
        E(acc, cur, wr, wc, fr, fq);
        if (!has_next) break;
#pragma unroll
        for (int a = 0; a < 2; ++a)
#pragma unroll
            for (int b = 0; b < 2; ++b)
#pragma unroll
                for (int m = 0; m < 4; ++m)
#pragma unroll
                    for (int n = 0; n < 2; ++n) acc[a][b][m][n] = (f32x4){0.f, 0.f, 0.f, 0.f};
        cur = nxt; cA = nA; cB = nB; ++ui;
    }
    PG8_WAIT_V(0);
    if (wr == 0) PG8_BAR;
    PG8_BAR;
#undef PG8_KLOOP
#undef PG8_SA
#undef PG8_SB
#undef PG8_STAGE
#undef PG8_LDA
#undef PG8_LDB
#undef PG8_MMA
#undef PG8_WAIT_V
#undef PG8_WAIT_L
#undef PG8_BAR
#undef PG8_SCHED
}

struct EpiSwiglu {
    static constexpr bool PERM = true, MIDK = false;
    bf16_t* O;
    __device__ __forceinline__ void operator()(const f32x4 (&acc)[2][2][4][2], const Unit& u, int wr, int wc, int fr, int fq) const {
        const int row0 = u.pm * BM + wr * 64 + fr, col0 = u.pn * 128 + wc * 32 + 8 * fq;
#pragma unroll
        for (int ai = 0; ai < 2; ++ai)
#pragma unroll
            for (int m = 0; m < 4; ++m) {
                float h[8];
#pragma unroll
                for (int n = 0; n < 2; ++n)
#pragma unroll
                    for (int j = 0; j < 4; ++j) h[n * 4 + j] = siluf_(acc[ai][0][m][n][j]) * acc[ai][1][m][n][j];
                *(u32x4*)(O + (size_t)(row0 + ai * HALF + m * 16) * DFF + col0) = pack8(h);
            }
    }
};
struct EpiBf16 {
    static constexpr bool PERM = true, MIDK = false;
    bf16_t* O; int ldc; const float* bias; int bias_col0;
    __device__ __forceinline__ void operator()(const f32x4 (&acc)[2][2][4][2], const Unit& u, int wr, int wc, int fr, int fq) const {
        const int row0 = u.pm * BM + wr * 64 + fr, col0 = u.pn * BM + wc * 32 + 8 * fq;
        const bool hb = (u.pn * BM >= bias_col0);
        f32x4 bv[2][2];
#pragma unroll
        for (int bj = 0; bj < 2; ++bj)
#pragma unroll
            for (int n = 0; n < 2; ++n) bv[bj][n] = hb ? *(const f32x4*)(bias + (col0 - bias_col0) + bj * HALF + 4 * n) : (f32x4){0.f, 0.f, 0.f, 0.f};
#pragma unroll
        for (int ai = 0; ai < 2; ++ai)
#pragma unroll
            for (int m = 0; m < 4; ++m) { bf16_t* rowp = O + (size_t)(row0 + ai * HALF + m * 16) * ldc + col0;
#pragma unroll
                for (int bj = 0; bj < 2; ++bj) { const f32x4 v0 = acc[ai][bj][m][0] + bv[bj][0], v1 = acc[ai][bj][m][1] + bv[bj][1];
                    u32x4 w; w.x = cvt_pk_bf16(v0[0], v0[1]); w.y = cvt_pk_bf16(v0[2], v0[3]); w.z = cvt_pk_bf16(v1[0], v1[1]); w.w = cvt_pk_bf16(v1[2], v1[3]);
                    *(u32x4*)(rowp + bj * HALF) = w; } }
    }
};
struct EpiResid {
    static constexpr bool PERM = false, MIDK = false;
    const float* src_lat; const float* src_ctx; float* dst_lat; float* dst_ctx; const float* mod; int gate_idx; float gscale; int tile0;
    __device__ __forceinline__ void operator()(const f32x4 (&acc)[2][2][4][2], const Unit& u, int wr, int wc, int fr, int fq) const {
        const RowMap rm = map_row((tile0 + u.pm) * BM);
        const float* src = (rm.is_ctx ? src_ctx : src_lat) + rm.row0 * D; float* dst = (rm.is_ctx ? dst_ctx : dst_lat) + rm.row0 * D;
        const float* gp = mod + (size_t)rm.modrow * (NMOD * D) + gate_idx * D;
        const int rloc = wr * 64 + fr, col0 = u.pn * BM + wc * 32 + 4 * fq;
        f32x4 gv[2][2];
#pragma unroll
        for (int bj = 0; bj < 2; ++bj)
#pragma unroll
            for (int n = 0; n < 2; ++n) gv[bj][n] = *(const f32x4*)(gp + col0 + bj * HALF + n * 16) * gscale;
#pragma unroll
        for (int ai = 0; ai < 2; ++ai)
#pragma unroll
            for (int m = 0; m < 4; ++m) { const size_t ro = (size_t)(rloc + ai * HALF + m * 16) * D + col0;
#pragma unroll
                for (int bj = 0; bj < 2; ++bj)
#pragma unroll
                    for (int n = 0; n < 2; ++n) { const f32x4 x = *(const f32x4*)(src + ro + bj * HALF + n * 16);
                        *(f32x4*)(dst + ro + bj * HALF + n * 16) = x + gv[bj][n] * acc[ai][bj][m][n]; } }
    }
};
struct EpiBranch {
    static constexpr bool PERM = true, MIDK = true;
    bf16_t* P;
    __device__ __forceinline__ void load_e(unsigned off, float (&e)[8]) const {
        const u32x4 w = *(const u32x4*)((const char*)P + (size_t)off * 2u); float x[8]; unpack8(w, x);
#pragma unroll
        for (int j = 0; j < 8; ++j) { const float v = fminf(fmaxf(x[j], -30.f), 30.f); e[j] = fast_exp2(-v * LOG2E); }
    }
    template <int WHICH> __device__ __forceinline__ void mid(f32x4 (&acc)[2][2][4][2], const Unit& u, int wr, int wc, int fr, int fq) const {
        unsigned base = (unsigned)(u.pm * BM + wr * 64 + fr) * PROJ + (unsigned)(u.pn * BM + wc * 32 + 8 * fq) + OFF_GATE + WHICH * D;
        asm volatile("" : "+v"(base));
#pragma unroll
        for (int ai = 0; ai < 2; ++ai)
#pragma unroll
            for (int m = 0; m < 4; ++m)
#pragma unroll
                for (int bj = 0; bj < 2; ++bj) { const unsigned o = base + (unsigned)(ai * HALF + m * 16) * PROJ + bj * HALF;
                    float ea[8], eb[8]; load_e(o, ea); load_e(o + D, eb);
#pragma unroll
                    for (int n = 0; n < 2; ++n)
#pragma unroll
                        for (int j = 0; j < 4; ++j) acc[ai][bj][m][n][j] *= (1.0f + eb[n * 4 + j]) * fast_rcp(1.0f + ea[n * 4 + j]);
                    __builtin_amdgcn_sched_barrier(0); }
    }
    __device__ __forceinline__ void operator()(const f32x4 (&acc)[2][2][4][2], const Unit& u, int wr, int wc, int fr, int fq) const {
        unsigned base = (unsigned)(u.pm * BM + wr * 64 + fr) * PROJ + (unsigned)(u.pn * BM + wc * 32 + 8 * fq);
        asm volatile("" : "+v"(base));
#pragma unroll
        for (int ai = 0; ai < 2; ++ai)
#pragma unroll
            for (int m = 0; m < 4; ++m)
#pragma unroll
                for (int bj = 0; bj < 2; ++bj) { const unsigned o = base + (unsigned)(ai * HALF + m * 16) * PROJ + bj * HALF;
                    float e2[8], ov[8]; load_e(o + OFF_GATE + 2 * D, e2);
#pragma unroll
                    for (int n = 0; n < 2; ++n)
#pragma unroll
                        for (int j = 0; j < 4; ++j) ov[n * 4 + j] = acc[ai][bj][m][n][j] * fast_rcp(1.0f + e2[n * 4 + j]);
                    *(u32x4*)((char*)P + (size_t)o * 2u) = pack8(ov);
                    __builtin_amdgcn_sched_barrier(0); }
    }
};
}

__device__ __forceinline__ void tr_tile(LAS float* tl, const float* src, int ld_src, int k0, int c0, bf16_t* dst, int ld_dst, int n0, int dk0) {
    const int tid = tid_opaque();
    { const int n = tid & 63, kk = tid >> 6;
#pragma unroll
      for (int i = 0; i < 8; ++i) { const int k = kk + 8 * i; tl[k * 65 + n] = src[(size_t)(k0 + k) * ld_src + c0 + n]; } }
    __syncthreads();
    { const int k2 = (tid & 31) * 2, nn = tid >> 5;
#pragma unroll
      for (int i = 0; i < 4; ++i) { const int n = nn + 16 * i; *(unsigned*)(dst + (size_t)(n0 + n) * ld_dst + dk0 + k2) = cvt_pk_bf16(tl[k2 * 65 + n], tl[(k2 + 1) * 65 + n]); } }
    __syncthreads();
}
__device__ __forceinline__ void tr_job(LAS float* tl, const float* src, int ld_src, int K, int Nout, bf16_t* dst, int ld_dst, int dkofs, int mode) {
    const int nkt = K / 64, ntl = nkt * (Nout / 64);
    for (int t = bid_opaque(); t < ntl; t += gridDim.x) {
        const int kt = t % nkt, ntile = t / nkt, n0 = ntile * 64;
        int c0 = n0;
        if (mode == 1) { const int pn = n0 >> 8, r = n0 & 255; c0 = (r < 128) ? pn * 128 + r : DFF + pn * 128 + (r - 128); }
        tr_tile(tl, src, ld_src, kt * 64, c0, dst, ld_dst, n0, dkofs + kt * 64);
    }
}

__device__ void phase_setup(const Params& p, LAS unsigned char* lds) {
    const int tid = tid_opaque(), wid = tid >> 6, lane = tid & 63;
    bf16_t* WT = (bf16_t*)(p.ws + WS_WT);
    LAS float* tl = (LAS float*)lds;
    for (int l = 0; l < NL; ++l) {
        bf16_t* W = WT + (size_t)l * W_LAYER;
        for (int j = 0; j < 2; ++j) {
            tr_job(tl, p.in[I_FFNIN] + ((size_t)l * 2 + j) * D * (2 * DFF), 2 * DFF, D, 2 * DFF, W + (j ? W_FIN1 : W_FIN0), D, 0, 1);
            tr_job(tl, p.in[I_FFNOUT] + ((size_t)l * 2 + j) * DFF * D, D, DFF, D, W + (j ? W_FOUT1 : W_FOUT0), DFF, 0, 0);
        }
        tr_job(tl, p.in[I_WIN] + (size_t)l * D * PROJ, PROJ, D, PROJ, W + W_WIN, D, 0, 0);
        tr_job(tl, p.in[I_WBC] + (size_t)l * 256 * D, D, 256, D, W + W_WB, D, 0, 0);
        tr_job(tl, p.in[I_WBG] + (size_t)l * 256 * D, D, 256, D, W + W_WB, D, 256, 0);
        tr_job(tl, p.in[I_WBA] + (size_t)l * 512 * D, D, 512, D, W + W_WB, D, 512, 0);
        tr_job(tl, p.in[I_WOUT] + (size_t)l * D * D, D, D, D, W + W_WO, D, 0, 0);
        for (int i = bid_opaque() * 512 + tid; i < 65536 / 2; i += gridDim.x * 512) {
            const float2 v = *(const float2*)(p.in[I_GWS] + (size_t)l * 65536 + 2 * i);
            *(unsigned*)(W + W_GWS + 2 * i) = cvt_pk_bf16(v.x, v.y);
        }
    }
    { const int gi = bid_opaque() * 512 + tid;
      if (gi < 1024) { const int pos = gi >> 4, i = gi & 15;
        const int i4 = i & 3, i16 = i >> 2;
        float inv = (i4 == 0) ? 1.0f : (i4 == 1) ? 0.5623413251903491f : (i4 == 2) ? 0.31622776601683794f : 0.1778279410038923f;
        inv *= (i16 == 0) ? 1.0f : (i16 == 1) ? 0.1f : (i16 == 2) ? 0.01f : 0.001f;
        const float a = (float)pos * inv;
        const float kq = __builtin_rintf(a * 0.6366197723675814f);
        float r = __builtin_fmaf(-kq, 1.5707963705062866f, a); r = __builtin_fmaf(kq, 4.371139000186241e-8f, r);
        const float r2 = r * r;
        const float sn = r * (1.0f + r2 * (-1.0f / 6 + r2 * (1.0f / 120 + r2 * (-1.0f / 5040 + r2 * (1.0f / 362880)))));
        const float cs = 1.0f + r2 * (-0.5f + r2 * (1.0f / 24 + r2 * (-1.0f / 720 + r2 * (1.0f / 40320 + r2 * (-1.0f / 3628800)))));
        const int q = ((int)kq) & 3;
        const float c = (q == 0) ? cs : (q == 1) ? -sn : (q == 2) ? -cs : sn;
        const float s = (q == 0) ? sn : (q == 1) ? cs : (q == 2) ? -sn : -cs;
        float2* rt = (float2*)(p.ws + WS_ROPE); rt[gi] = make_float2(c, s); } }
    if (bid_opaque() < NL * 36) {
        LAS float* sc = (LAS float*)lds;
        __syncthreads();
        for (int i = tid; i < 33 * D; i += 512) { const int r = i >> 10, k = i & 1023; const float v = (r < 32) ? p.in[I_C][r * D + k] : p.in[I_CCTX][k]; sc[i] = siluf_(v); }
        __syncthreads();
        float* MOD = (float*)(p.ws + WS_MOD);
        for (int it = bid_opaque(); it < NL * 36; it += gridDim.x) {
            const int l = it / 36, cgp = it % 36, n0 = cgp * 256 + lane * 4;
            const float* wp = p.in[I_WMOD] + (size_t)l * D * (NMOD * D) + n0;
            f32x4 a[5];
#pragma unroll
            for (int i = 0; i < 5; ++i) a[i] = (f32x4){0.f, 0.f, 0.f, 0.f};
            for (int k = 0; k < D; k += 4) {
                f32x4 w[4];
#pragma unroll
                for (int kk = 0; kk < 4; ++kk) w[kk] = *(const f32x4*)(wp + (size_t)(k + kk) * (NMOD * D));
#pragma unroll
                for (int i = 0; i < 5; ++i) { const int r = (i < 4) ? wid + 8 * i : 32; const f32x4 s = *(const LAS f32x4*)(sc + r * D + k);
                    a[i] += s[0] * w[0] + s[1] * w[1] + s[2] * w[2] + s[3] * w[3]; }
            }
            const f32x4 bv = *(const f32x4*)(p.in[I_BMOD] + (size_t)l * (NMOD * D) + n0);
#pragma unroll
            for (int i = 0; i < 5; ++i) { const int r = (i < 4) ? wid + 8 * i : 32; if (i < 4 || wid == 0) *(f32x4*)(MOD + ((size_t)l * 33 + r) * (NMOD * D) + n0) = a[i] + bv; }
        }
        __syncthreads();
    }
}

__device__ void phase_norm(const Params& p, int l, int j, const float* hl, const float* hc) {
    const int tid = tid_opaque(), wid = tid >> 6, lane = tid & 63;
    bf16_t* A = (bf16_t*)(p.ws + WS_A);
    const float* MOD = (const float*)(p.ws + WS_MOD) + (size_t)l * 33 * (NMOD * D);
    const float* ng = p.in[I_NORMG] + ((size_t)l * 3 + j) * D;
    for (int u = bid_opaque() * 8 + wid; u < T_ALL; u += gridDim.x * 8) {
        const RowMap rm = map_row(u);
        const float* x = (rm.is_ctx ? hc : hl) + rm.row0 * D;
        const float* sh = MOD + (size_t)rm.modrow * (NMOD * D) + (3 * j) * D; const float* sc = sh + D;
        f32x4 v[4]; float ss = 0.f;
#pragma unroll
        for (int i = 0; i < 4; ++i) { v[i] = *(const f32x4*)(x + i * 256 + lane * 4); ss += v[i][0] * v[i][0] + v[i][1] * v[i][1] + v[i][2] * v[i][2] + v[i][3] * v[i][3]; }
        ss = wave_sum(ss);
        const float rstd = rsqrtf(ss * (1.0f / D) + EPS);
#pragma unroll
        for (int i = 0; i < 4; ++i) { const int k = i * 256 + lane * 4;
            const f32x4 g = *(const f32x4*)(ng + k), s1 = *(const f32x4*)(sc + k), s0 = *(const f32x4*)(sh + k);
            const f32x4 y = v[i] * rstd * g * (s1 + 1.0f) + s0;
            u32x2 w; w.x = cvt_pk_bf16(y[0], y[1]); w.y = cvt_pk_bf16(y[2], y[3]);
            *(u32x2*)(A + (size_t)u * D + k) = w; }
    }
}

__device__ void phase_prep(const Params& p, int l, LAS unsigned char* lds) {
    const int tid = tid_opaque(), wid = tid >> 6, lane = tid & 63;
    bf16_t* P = (bf16_t*)(p.ws + WS_R1);
    bf16_t* VTL = (bf16_t*)(p.ws + WS_VTL); bf16_t* VTC = (bf16_t*)(p.ws + WS_VTC);
    const float2* rt = (const float2*)(p.ws + WS_ROPE);
    const float* qg = p.in[I_QG] + l * 64; const float* kg = p.in[I_KG] + l * 64;
    LAS bf16_t* Vs = (LAS bf16_t*)lds;
    const int c = lane & 7, seg = c >> 2, hf = (c >> 1) & 1, i0 = (c & 1) * 8;
    float gq[8], gk[8];
#pragma unroll
    for (int e = 0; e < 8; ++e) { gq[e] = qg[8 * c + e]; gk[e] = kg[8 * c + e]; }
    for (int it = bid_opaque(); it < TH / 64; it += gridDim.x) {
        const int v0 = it * 64; const bool lat = v0 < H_LAT;
        for (int i = 0; i < 8; ++i) {
            const int rl = wid * 8 + i, v = v0 + rl;
            bf16_t* rowp = P + (size_t)v * PROJ;
            const int pos = v & (SEQ - 1), pp = seg ? (pos & 63) : (pos >> 6);
            float cs[8], sn[8];
#pragma unroll
            for (int e = 0; e < 8; ++e) { const float2 t2 = rt[pp * 16 + i0 + e]; cs[e] = lat ? t2.x : 1.0f; sn[e] = lat ? t2.y : 0.0f; }
            { bf16_t* qp = rowp + OFF_Q + (lane >> 3) * 64 + 8 * c; float x[8]; unpack8(*(const u32x4*)qp, x);
              float ss = 0.f;
#pragma unroll
              for (int e = 0; e < 8; ++e) ss += x[e] * x[e];
              ss += __shfl_xor(ss, 1); ss += __shfl_xor(ss, 2); ss += __shfl_xor(ss, 4);
              const float rstd = rsqrtf(ss * (1.0f / 64) + EPS); float o[8];
#pragma unroll
              for (int e = 0; e < 8; ++e) { const float y = x[e] * rstd * gq[e]; const float yp = __shfl_xor(y, 2);
                  o[e] = (hf ? (y * cs[e] + yp * sn[e]) : (y * cs[e] - yp * sn[e])) * (0.125f * LOG2E); }
              *(u32x4*)qp = pack8(o); }
            { bf16_t* kp = rowp + OFF_K + ((lane >> 3) & 1) * 64 + 8 * c; float x[8]; unpack8(*(const u32x4*)kp, x);
              float ss = 0.f;
#pragma unroll
              for (int e = 0; e < 8; ++e) ss += x[e] * x[e];
              ss += __shfl_xor(ss, 1); ss += __shfl_xor(ss, 2); ss += __shfl_xor(ss, 4);
              const float rstd = rsqrtf(ss * (1.0f / 64) + EPS); float o[8];
#pragma unroll
              for (int e = 0; e < 8; ++e) { const float y = x[e] * rstd * gk[e]; const float yp = __shfl_xor(y, 2);
                  o[e] = hf ? (y * cs[e] + yp * sn[e]) : (y * cs[e] - yp * sn[e]); }
              if (lane < 16) *(u32x4*)kp = pack8(o); }
            { const unsigned w = *(const unsigned*)(rowp + OFF_V + 2 * lane);
              Vs[(2 * lane) * 72 + rl] = (bf16_t)(w & 0xffffu); Vs[(2 * lane + 1) * 72 + rl] = (bf16_t)(w >> 16); }
        }
        __syncthreads();
        { const int hd = tid >> 2, ch = tid & 3;
          bf16_t* dst;
          if (lat) { const int bl = v0 >> 11, pos0 = v0 & (SEQ - 1); dst = VTL + ((size_t)bl * 128 + hd) * SEQ + pos0 + ch * 16; }
          else { const int cv = v0 - H_LAT, bl = cv >> 8, pos0 = cv & 255; dst = VTC + ((size_t)bl * 128 + hd) * CTXL + pos0 + ch * 16; }
          const u32x4 a = *(const LAS u32x4*)(Vs + hd * 72 + ch * 16), b = *(const LAS u32x4*)(Vs + hd * 72 + ch * 16 + 8);
          *(u32x4*)dst = a; *(u32x4*)(dst + 8) = b; }
        __syncthreads();
    }
}

struct KeySeg { const bf16_t* K; const bf16_t* Vt; int vstride; int ntiles; int mask; };

__device__ __forceinline__ void attn_item(const Params& p, int l, int hs, int idx) {
    const int tid = tid_opaque(), wid = tid >> 6, lane = tid & 63, fr = lane & 15, fq = lane >> 4;
    const bf16_t* P = (const bf16_t*)(p.ws + WS_R1);
    const bf16_t* VTL = (const bf16_t*)(p.ws + WS_VTL); const bf16_t* VTC = (const bf16_t*)(p.ws + WS_VTC);
    bf16_t* Y = (bf16_t*)(p.ws + WS_A) + (size_t)hs * TH * D;
    int bl, qb, hk; bool lat;
    if (idx < 512) { lat = true; bl = idx >> 5; qb = (idx >> 1) & 15; hk = idx & 1; }
    else { const int j = idx - 512; lat = false; bl = j >> 2; qb = (j >> 1) & 1; hk = j & 1; }
    const int g = wid >> 1, r0 = (wid & 1) * 64, head = hk * 4 + g;
    const int qrow0 = lat ? bl * SEQ + qb * 128 : H_LAT + bl * CTXL + qb * 128;
    const int crow0 = H_LAT + bl * CTXL;
    const bf16_t* vtc = VTC + ((size_t)bl * 2 + hk) * 64 * CTXL;
    const bf16_t* vtl = VTL + ((size_t)bl * 2 + hk) * 64 * SEQ;
    bf16x8 qf[4][2];
    { const bf16_t* qp = P + (size_t)(qrow0 + r0 + fr) * PROJ + OFF_Q + head * 64 + fq * 8;
#pragma unroll
      for (int nq = 0; nq < 4; ++nq)
#pragma unroll
          for (int ks = 0; ks < 2; ++ks) qf[nq][ks] = *(const bf16x8*)(qp + (size_t)nq * 16 * PROJ + ks * 32); }
    f32x4 o[4][4];
#pragma unroll
    for (int a = 0; a < 4; ++a)
#pragma unroll
        for (int b = 0; b < 4; ++b) o[a][b] = (f32x4){0.f, 0.f, 0.f, 0.f};
    const float snk = p.in[I_SINK][l * 8 + head] * LOG2E;
    float mrun[4], lrun[4];
#pragma unroll
    for (int nq = 0; nq < 4; ++nq) { mrun[nq] = snk; lrun[nq] = (fq == 0) ? 1.0f : 0.0f; }

    for (int sg = 0; sg < 4; ++sg) {
        int ntile, mask, t_lo = 0, vstride; const bf16_t* kb_; const bf16_t* vb_;
        if (sg < 3) {
            if (!lat) continue;
            const int kb = qb + sg - 1; if (kb < 0 || kb > 15) continue;
            kb_ = P + (size_t)(bl * SEQ + kb * 128) * PROJ + OFF_K + hk * 64; vb_ = vtl + kb * 128; vstride = SEQ; ntile = 4; mask = (sg == 0) ? 1 : (sg == 2) ? 2 : 0;
            if (sg == 0) t_lo = (r0 == 64) ? 2 : 0;
            if (sg == 2) ntile = (r0 == 0) ? 2 : 4;
        } else { kb_ = P + (size_t)crow0 * PROJ + OFF_K + hk * 64; vb_ = vtc; vstride = CTXL; ntile = 8; mask = 0; }
        for (int tt = t_lo; tt < ntile; ++tt) {
            const int t0 = tt * 32;
            bf16x8 kf[2][2];
            { const bf16_t* kp = kb_ + (size_t)(t0 + fr) * PROJ + fq * 8;
#pragma unroll
              for (int kb = 0; kb < 2; ++kb)
#pragma unroll
                  for (int ks = 0; ks < 2; ++ks) kf[kb][ks] = *(const bf16x8*)(kp + (size_t)kb * 16 * PROJ + ks * 32); }
            bf16x8 vf[4];
            { const bf16_t* vp = vb_ + (size_t)fr * vstride + t0 + fq * 4;
#pragma unroll
              for (int db = 0; db < 4; ++db) { const bf16x4 lo = *(const bf16x4*)(vp + (size_t)db * 16 * vstride), hi = *(const bf16x4*)(vp + (size_t)db * 16 * vstride + 16);
                  vf[db] = (bf16x8){lo[0], lo[1], lo[2], lo[3], hi[0], hi[1], hi[2], hi[3]}; } }
            f32x4 s[2][4];
#pragma unroll
            for (int kb = 0; kb < 2; ++kb)
#pragma unroll
                for (int nq = 0; nq < 4; ++nq) {
                    s[kb][nq] = __builtin_amdgcn_mfma_f32_16x16x32_bf16(kf[kb][0], qf[nq][0], (f32x4){0.f, 0.f, 0.f, 0.f}, 0, 0, 0);
                    s[kb][nq] = __builtin_amdgcn_mfma_f32_16x16x32_bf16(kf[kb][1], qf[nq][1], s[kb][nq], 0, 0, 0);
                }
            if (mask) {
#pragma unroll
                for (int kb = 0; kb < 2; ++kb)
#pragma unroll
                    for (int nq = 0; nq < 4; ++nq)
#pragma unroll
                        for (int j = 0; j < 4; ++j) { const int t = t0 + kb * 16 + fq * 4 + j, r = r0 + nq * 16 + fr;
                            const bool ok = (mask == 1) ? (t >= r) : (t <= r); if (!ok) s[kb][nq][j] = -1e30f; }
            }
            bf16x8 pf[4];
#pragma unroll
            for (int nq = 0; nq < 4; ++nq) {
                float mx = fmaxf(fmaxf(fmaxf(s[0][nq][0], s[0][nq][1]), fmaxf(s[0][nq][2], s[0][nq][3])), fmaxf(fmaxf(s[1][nq][0], s[1][nq][1]), fmaxf(s[1][nq][2], s[1][nq][3])));
                mx = fmaxf(mx, __shfl_xor(mx, 16)); mx = fmaxf(mx, __shfl_xor(mx, 32));
                const float mn = fmaxf(mrun[nq], mx), alpha = fast_exp2(mrun[nq] - mn); mrun[nq] = mn;
                float pv[8], ps = 0.f;
#pragma unroll
                for (int j = 0; j < 4; ++j) { pv[j] = fast_exp2(s[0][nq][j] - mn); pv[4 + j] = fast_exp2(s[1][nq][j] - mn); ps += pv[j] + pv[4 + j]; }
                lrun[nq] = lrun[nq] * alpha + ps;
                const u32x4 w = pack8(pv); pf[nq] = *(const bf16x8*)&w;
#pragma unroll
                for (int db = 0; db < 4; ++db) o[db][nq] *= alpha;
            }
#pragma unroll
            for (int db = 0; db < 4; ++db)
#pragma unroll
                for (int nq = 0; nq < 4; ++nq) o[db][nq] = __builtin_amdgcn_mfma_f32_16x16x32_bf16(vf[db], pf[nq], o[db][nq], 0, 0, 0);
        }
    }
#pragma unroll
    for (int nq = 0; nq < 4; ++nq) {
        float lt = lrun[nq]; lt += __shfl_xor(lt, 16); lt += __shfl_xor(lt, 32);
        const float inv = 1.0f / lt;
        bf16_t* yp = Y + (size_t)(qrow0 + r0 + nq * 16 + fr) * D + 512 + head * 64 + fq * 4;
#pragma unroll
        for (int db = 0; db < 4; ++db) { u32x2 w; w.x = cvt_pk_bf16(o[db][nq][0] * inv, o[db][nq][1] * inv); w.y = cvt_pk_bf16(o[db][nq][2] * inv, o[db][nq][3] * inv);
            *(u32x2*)(yp + db * 16) = w; }
    }
}

__device__ __forceinline__ void gmlp_conv_item(const Params& p, int l, int hs, int chunk, LAS unsigned char* lds) {
    const int tid = tid_opaque(), wid = tid >> 6, lane = tid & 63, fr = lane & 15, fq = lane >> 4;
    const bf16_t* P = (const bf16_t*)(p.ws + WS_R1);
    bf16_t* Y = (bf16_t*)(p.ws + WS_A) + (size_t)hs * TH * D;
    const int v0 = chunk * 128;
    LAS bf16_t* vT = (LAS bf16_t*)lds;
    { const float* cw = p.in[I_CONVW] + (size_t)l * 3 * 256;
      const bool lat = v0 < H_LAT;
#pragma unroll 2
      for (int i = 0; i < 8; ++i) {
          const int id = i * 512 + tid, pt = id >> 5, cc = (id & 31) * 8, v = v0 + pt;
          const int pos = lat ? (v & (SEQ - 1)) : ((v - H_LAT) & (CTXL - 1)), n = lat ? SEQ : CTXL;
          const bf16_t* rp = P + (size_t)v * PROJ + cc;
          float bv[8], c1[8], h1[8], acc[8];
          unpack8(*(const u32x4*)(rp + OFF_CB), bv); unpack8(*(const u32x4*)(rp + OFF_CC), c1); unpack8(*(const u32x4*)(rp + OFF_CH), h1);
          { const f32x4 wa = *(const f32x4*)(cw + 256 + cc), wb = *(const f32x4*)(cw + 256 + cc + 4);
#pragma unroll
            for (int e = 0; e < 8; ++e) acc[e] = c1[e] * h1[e] * (e < 4 ? wa[e & 3] : wb[e & 3]); }
          if (pos > 0) { float c0[8], h0[8]; unpack8(*(const u32x4*)(rp - PROJ + OFF_CC), c0); unpack8(*(const u32x4*)(rp - PROJ + OFF_CH), h0);
              const f32x4 wa = *(const f32x4*)(cw + cc), wb = *(const f32x4*)(cw + cc + 4);
#pragma unroll
              for (int e = 0; e < 8; ++e) acc[e] += c0[e] * h0[e] * (e < 4 ? wa[e & 3] : wb[e & 3]); }
          if (pos < n - 1) { float c2[8], h2[8]; unpack8(*(const u32x4*)(rp + PROJ + OFF_CC), c2); unpack8(*(const u32x4*)(rp + PROJ + OFF_CH), h2);
              const f32x4 wa = *(const f32x4*)(cw + 512 + cc), wb = *(const f32x4*)(cw + 512 + cc + 4);
#pragma unroll
              for (int e = 0; e < 8; ++e) acc[e] += c2[e] * h2[e] * (e < 4 ? wa[e & 3] : wb[e & 3]); }
#pragma unroll
          for (int e = 0; e < 8; ++e) acc[e] *= bv[e];
          *(u32x4*)(Y + (size_t)v * D + cc) = pack8(acc);
      } }
    { const float* lg = p.in[I_LNG] + l * 256 + 4 * lane; const float* lb = p.in[I_LNB] + l * 256 + 4 * lane;
      const f32x4 g4 = *(const f32x4*)lg, b4 = *(const f32x4*)lb;
      for (int i = 0; i < 16; ++i) {
          const int pt = wid * 16 + i;
          const u32x2 w = *(const u32x2*)(P + (size_t)(v0 + pt) * PROJ + OFF_GV + 4 * lane);
          float x[4] = {gelu_tanh(bf_lo(w.x)), gelu_tanh(bf_hi(w.x)), gelu_tanh(bf_lo(w.y)), gelu_tanh(bf_hi(w.y))};
          const float mu = wave_sum(x[0] + x[1] + x[2] + x[3]) * (1.0f / 256);
          float q = 0.f;
#pragma unroll
          for (int e = 0; e < 4; ++e) { x[e] -= mu; q += x[e] * x[e]; }
          const float rstd = rsqrtf(wave_sum(q) * (1.0f / 256) + EPS);
#pragma unroll
          for (int e = 0; e < 4; ++e) { const float y = x[e] * rstd * g4[e] + b4[e]; vT[(4 * lane + e) * 136 + pt] = (bf16_t)(cvt_pk_bf16(y, 0.f) & 0xffffu); }
      } }
    __syncthreads();
    { const int g = wid >> 1, ph = wid & 1;
      const bf16_t* wsb = (const bf16_t*)(p.ws + WS_WT) + (size_t)l * W_LAYER + W_GWS + (size_t)g * 128 * 128;
      f32x4 acc[4][4];
#pragma unroll
      for (int a = 0; a < 4; ++a)
#pragma unroll
          for (int b = 0; b < 4; ++b) acc[a][b] = (f32x4){0.f, 0.f, 0.f, 0.f};
#pragma unroll
      for (int kk = 0; kk < 4; ++kk) {
          bf16x8 af[4], bfr[4];
#pragma unroll
          for (int db = 0; db < 4; ++db) af[db] = *(const LAS bf16x8*)(vT + (g * 64 + db * 16 + fr) * 136 + kk * 32 + fq * 8);
#pragma unroll
          for (int pb = 0; pb < 4; ++pb) bfr[pb] = *(const bf16x8*)(wsb + (size_t)((ph * 4 + pb) * 16 + fr) * 128 + kk * 32 + fq * 8);
#pragma unroll
          for (int db = 0; db < 4; ++db)
#pragma unroll
              for (int pb = 0; pb < 4; ++pb) acc[db][pb] = __builtin_amdgcn_mfma_f32_16x16x32_bf16(af[db], bfr[pb], acc[db][pb], 0, 0, 0);
      }
      const float* bs = p.in[I_GBS] + (size_t)l * 512 + g * 128;
#pragma unroll
      for (int pb = 0; pb < 4; ++pb) { const int pt = (ph * 4 + pb) * 16 + fr; const float bias = bs[pt];
          const bf16_t* up = P + (size_t)(v0 + pt) * PROJ + OFF_GU + g * 64 + fq * 4;
          bf16_t* yp = Y + (size_t)(v0 + pt) * D + 256 + g * 64 + fq * 4;
#pragma unroll
          for (int db = 0; db < 4; ++db) { const u32x2 w = *(const u32x2*)(up + db * 16);
              const float y0 = gelu_tanh(bf_lo(w.x)) * (acc[db][pb][0] + bias), y1 = gelu_tanh(bf_hi(w.x)) * (acc[db][pb][1] + bias);
              const float y2 = gelu_tanh(bf_lo(w.y)) * (acc[db][pb][2] + bias), y3 = gelu_tanh(bf_hi(w.y)) * (acc[db][pb][3] + bias);
              u32x2 ov; ov.x = cvt_pk_bf16(y0, y1); ov.y = cvt_pk_bf16(y2, y3); *(u32x2*)(yp + db * 16) = ov; } } }
    __syncthreads();
}

__device__ void phase_mixers(const Params& p, int l, int hs, LAS unsigned char* lds) {
#ifndef SKIP_ATTN
    for (int it = bid_opaque(); it < 576; it += gridDim.x) attn_item(p, l, hs, it);
#endif
    __builtin_amdgcn_sched_barrier(0);
#ifndef SKIP_GMLP
    for (int it = (bid_opaque() + (int)gridDim.x - 64) % (int)gridDim.x; it < 288; it += gridDim.x) gmlp_conv_item(p, l, hs, it, lds);
#endif
}

__device__ void run_phase(const Params& p, int ph, LAS unsigned char* lds) {
    if (ph == 0) {
#ifndef SKIP_SETUP
 phase_setup(p, lds);
#endif
 return; }
    const int q = ph - 1, l = q / 17, r = q % 17;
    const bf16_t* W = (const bf16_t*)(p.ws + WS_WT) + (size_t)l * W_LAYER;
    const float* MOD = (const float*)(p.ws + WS_MOD) + (size_t)l * 33 * (NMOD * D);
    float* hc = (float*)(p.ws + WS_HC);
    const bool first = (l == 0 && r <= 2);
    const float* hl_src = first ? p.in[I_X] : p.out; const float* hc_src = first ? p.in[I_CTX] : hc;
    bf16_t* A = (bf16_t*)(p.ws + WS_A); bf16_t* R1 = (bf16_t*)(p.ws + WS_R1);
    if (r == 0 || r == 3 || r == 14) {
#ifndef SKIP_NORM
 phase_norm(p, l, r == 0 ? 0 : (r == 3 ? 1 : 2), hl_src, hc_src);
#endif
 return; }
    if (r == 1 || r == 15) {
        const int j = (r == 1) ? 0 : 1;
        pg8::Gemm g{A, D, W + (j ? W_FIN1 : W_FIN0), D, T_ALL, 2 * DFF, D};
        pg8::EpiSwiglu E{R1};
#ifndef SKIP_UP
        pg8::gemm_phase(lds, g, E);
#endif
        return;
    }
    if (r == 2 || r == 16) {
        const int j = (r == 2) ? 0 : 1;
        pg8::Gemm g{R1, DFF, W + (j ? W_FOUT1 : W_FOUT0), DFF, T_ALL, D, DFF};
        pg8::EpiResid E{hl_src, hc_src, p.out, hc, MOD, j ? 8 : 2, 0.5f, 0};
#ifndef SKIP_DOWN
        pg8::gemm_phase(lds, g, E);
#endif
        return;
    }
    const int hs = (r - 4) / 5, rr = (r - 4) % 5;
    if (rr == 0) { pg8::Gemm g{A + (size_t)hs * TH * D, D, W + W_WIN, D, TH, PROJ, D}; pg8::EpiBf16 E{R1, PROJ, p.in[I_BGATE] + (size_t)l * 3 * D, OFF_GATE};
#ifndef SKIP_PROJ
 pg8::gemm_phase(lds, g, E);
#endif
 return; }
    if (rr == 1) {
#ifndef SKIP_PREP
 phase_prep(p, l, lds);
#endif
 return; }
    if (rr == 2) {
#ifndef SKIP_MIX
 phase_mixers(p, l, hs, lds);
#endif
 return; }
    if (rr == 3) { pg8::Gemm g{A + (size_t)hs * TH * D, D, W + W_WB, D, TH, D, D}; pg8::EpiBranch E{R1};
#ifndef SKIP_BRANCH
 pg8::gemm_phase(lds, g, E);
#endif
 return; }
    { pg8::Gemm g{R1, PROJ, W + W_WO, D, TH, D, D}; pg8::EpiResid E{p.out, hc, p.out, hc, MOD, 5, 1.0f, hs * TILES_H};
#ifndef SKIP_OUT
 pg8::gemm_phase(lds, g, E);
#endif
 }
}

__global__ __launch_bounds__(512, 2) void fwd_megakernel(Params p) {
    extern __shared__ __attribute__((aligned(16))) unsigned char shm[];
    LAS unsigned char* lds = (LAS unsigned char*)shm;
    for (int ph = p.ph_lo; ph < p.ph_hi; ++ph) {
#if defined(__HIP_DEVICE_COMPILE__)
        const __attribute__((address_space(4))) char* kp = (const __attribute__((address_space(4))) char*)__builtin_amdgcn_kernarg_segment_ptr();
        asm volatile("" : "+s"(kp));
        const Params lp = *(const Params*)(const char*)kp;
#else
        const Params lp = p;
#endif
        run_phase(lp, ph, lds);
#if MK_SINGLE
        if (ph + 1 < p.ph_hi) cg::this_grid().sync();
#endif
    }
}

extern "C" void kernel_launch(void* const* d_in, const int* in_sizes, int n_in, void* d_out, int out_size, void* d_ws, size_t ws_size, hipStream_t stream) {
    static int grid = 0;
    if (grid == 0) {
        if (n_in != N_IN || out_size != T_LAT * D || ws_size < WS_END) { fprintf(stderr, "kernel_launch: unexpected shapes (n_in %d out %d ws %zu need %zu)\n", n_in, out_size, ws_size, (size_t)WS_END); grid = -1; return; }
        int dev = 0, cus = 0, per_cu = 0;
        (void)hipGetDevice(&dev); (void)hipDeviceGetAttribute(&cus, hipDeviceAttributeMultiprocessorCount, dev);
        if (hipFuncSetAttribute((const void*)fwd_megakernel, hipFuncAttributeMaxDynamicSharedMemorySize, LDS_BYTES) != hipSuccess) { fprintf(stderr, "kernel_launch: hipFuncSetAttribute failed\n"); grid = -1; return; }
        if (hipOccupancyMaxActiveBlocksPerMultiprocessor(&per_cu, (const void*)fwd_megakernel, 512, LDS_BYTES) != hipSuccess || per_cu < 1) { fprintf(stderr, "kernel_launch: occupancy query gave %d\n", per_cu); per_cu = 1; }
        (void)hipGetLastError();
        grid = cus * per_cu;
    }
    if (grid < 0) return;
    Params p{};
    for (int i = 0; i < N_IN; ++i) p.in[i] = (const float*)d_in[i];
    p.out = (float*)d_out; p.ws = (unsigned char*)d_ws;
#if MK_SINGLE
    p.ph_lo = 0; p.ph_hi = N_PHASES;
    void* args[] = {&p};
    hipError_t e = hipLaunchCooperativeKernel((const void*)fwd_megakernel, dim3(grid), dim3(512), args, LDS_BYTES, stream);
    if (e != hipSuccess) fprintf(stderr, "cooperative launch failed: %s (grid %d)\n", hipGetErrorString(e), grid);
#else
    for (int ph = 0; ph < N_PHASES; ++ph) {
        p.ph_lo = ph; p.ph_hi = ph + 1;
        hipLaunchKernelGGL(fwd_megakernel, dim3(grid), dim3(512), LDS_BYTES, stream, p);
    }
#endif
}
```

```cpp
#include <hip/hip_runtime.h>
#include <hip/hip_cooperative_groups.h>
#include <cstdio>
namespace cg = cooperative_groups;

#ifndef MK_SINGLE
#define MK_SINGLE 1
#endif

#define LAS __attribute__((address_space(3)))
typedef unsigned short bf16_t;
typedef short bf16x8 __attribute__((ext_vector_type(8)));
typedef short bf16x4 __attribute__((ext_vector_type(4)));
typedef float f32x4 __attribute__((ext_vector_type(4)));
typedef unsigned u32x4 __attribute__((ext_vector_type(4)));
typedef unsigned u32x2 __attribute__((ext_vector_type(2)));

constexpr int D = 1024, NB = 32, SEQ = 2048, NL = 4, CTXL = 256, DFF = 2816, PROJ = 5120, NMOD = 9;
constexpr int T_LAT = NB * SEQ, T_CTX = NB * CTXL, T_ALL = T_LAT + T_CTX;
constexpr int H_LAT = T_LAT / 2, H_CTX = T_CTX / 2, TH = H_LAT + H_CTX;
constexpr int TILES_H = TH / 256, TILES_HL = H_LAT / 256;
constexpr int OFF_CB = 0, OFF_CC = 256, OFF_CH = 512, OFF_GU = 768, OFF_GV = 1024, OFF_Q = 1280, OFF_K = 1792, OFF_V = 1920, OFF_GATE = 2048;
constexpr float EPS = 1e-6f;
constexpr float LOG2E = 1.4426950408889634f;

enum { I_X = 0, I_C, I_CTX, I_CCTX, I_WMOD, I_BMOD, I_NORMG, I_FFNIN, I_FFNOUT, I_WIN, I_BGATE, I_CONVW, I_LNG, I_LNB, I_GWS, I_GBS, I_QG, I_KG, I_SINK, I_WBC, I_WBG, I_WBA, I_WOUT, N_IN };

constexpr size_t W_FIN0 = 0, W_FIN1 = 5767168, W_FOUT0 = 11534336, W_FOUT1 = 14417920, W_WIN = 17301504, W_WB = 22544384, W_WO = 23592960, W_GWS = 24641536, W_LAYER = 24707072;
constexpr size_t WS_WT = 0;
constexpr size_t WS_MOD = WS_WT + NL * W_LAYER * 2;
constexpr size_t WS_ROPE = WS_MOD + (size_t)NL * 33 * 9216 * 4;
constexpr size_t WS_HC = WS_ROPE + 8192;
constexpr size_t WS_A = WS_HC + (size_t)T_CTX * D * 4;
constexpr size_t WS_R1 = WS_A + (size_t)T_ALL * D * 2;
constexpr size_t WS_VTL = WS_R1 + (size_t)T_ALL * DFF * 2;
constexpr size_t WS_VTC = WS_VTL + (size_t)16 * 2 * 64 * 2048 * 2;
constexpr size_t WS_BAR = WS_VTC + (size_t)16 * 2 * 64 * 256 * 2;
constexpr size_t WS_END = WS_BAR + 16384;

constexpr int LDS_BYTES = 143360;
constexpr int N_PHASES = 1 + 17 * NL;

struct Params {
    const float* in[N_IN];
    float* out;
    unsigned char* ws;
    int ph_lo, ph_hi;
};

__device__ __forceinline__ unsigned cvt_pk_bf16(float lo, float hi) { unsigned r; asm volatile("v_cvt_pk_bf16_f32 %0, %1, %2" : "=v"(r) : "v"(lo), "v"(hi)); return r; }
__device__ __forceinline__ int tid_opaque() { int t = threadIdx.x; asm volatile("" : "+v"(t)); return t; }
__device__ __forceinline__ int bid_opaque() { int b = blockIdx.x; asm volatile("" : "+s"(b)); return b; }
__device__ __forceinline__ float bf_lo(unsigned w) { return __uint_as_float(w << 16); }
__device__ __forceinline__ float bf_hi(unsigned w) { return __uint_as_float(w & 0xffff0000u); }
__device__ __forceinline__ float fast_rcp(float x) { return __builtin_amdgcn_rcpf(x); }
__device__ __forceinline__ float fast_exp2(float x) { return __builtin_amdgcn_exp2f(x); }
__device__ __forceinline__ float sigmoidf_(float x) { return fast_rcp(1.0f + fast_exp2(-x * LOG2E)); }
__device__ __forceinline__ float siluf_(float x) { return x * sigmoidf_(x); }
__device__ __forceinline__ float gelu_tanh(float x) { const float z = 0.7978845608028654f * (x + 0.044715f * x * x * x); return x * sigmoidf_(2.0f * z); }
__device__ __forceinline__ float wave_sum(float v) {
    v += __shfl_xor(v, 1); v += __shfl_xor(v, 2); v += __shfl_xor(v, 4); v += __shfl_xor(v, 8); v += __shfl_xor(v, 16); v += __shfl_xor(v, 32); return v;
}
__device__ __forceinline__ void unpack8(const u32x4 w, float (&f)[8]) {
    f[0] = bf_lo(w.x); f[1] = bf_hi(w.x); f[2] = bf_lo(w.y); f[3] = bf_hi(w.y); f[4] = bf_lo(w.z); f[5] = bf_hi(w.z); f[6] = bf_lo(w.w); f[7] = bf_hi(w.w);
}
__device__ __forceinline__ u32x4 pack8(const float (&f)[8]) {
    u32x4 w; w.x = cvt_pk_bf16(f[0], f[1]); w.y = cvt_pk_bf16(f[2], f[3]); w.z = cvt_pk_bf16(f[4], f[5]); w.w = cvt_pk_bf16(f[6], f[7]); return w;
}

struct RowMap { size_t row0; int is_ctx; int modrow; };
__device__ __forceinline__ RowMap map_row(int u) {
    const int s = u / TH, v = u - s * TH; RowMap r;
    if (v < H_LAT) { r.row0 = (size_t)s * H_LAT + v; r.is_ctx = 0; r.modrow = (int)(r.row0 >> 11); }
    else { r.row0 = (size_t)s * H_CTX + (v - H_LAT); r.is_ctx = 1; r.modrow = 32; }
    return r;
}

namespace pg8 {
constexpr int BM = 256, BK = 64, HALF = 128, HTB = HALF * BK * 2, STAGE_BYTES = 8 * HTB, NXCD = 8, WGM = 8;
__device__ __forceinline__ int lds_byte(int r, int c) { const int st = (r >> 4) * 2 + (c >> 5), rr = r & 15, cc = c & 31, ob = rr * 64 + cc * 2; return st * 1024 + (ob ^ (((ob >> 9) & 1) << 5)); }
__device__ __forceinline__ void stage_rc(int b, int& R, int& C) { const int st = b / 1024, sb = b % 1024, swz = sb ^ (((sb >> 9) & 1) << 5); R = (st >> 1) * 16 + swz / 64; C = (st & 1) * 32 + (swz % 64) / 2; }
__device__ __forceinline__ int perm32(int rho) { const int n = rho >> 4, i = rho & 15; return 8 * (i >> 2) + 4 * n + (i & 3); }

struct Unit { int pm, pn; };
struct Gemm { const bf16_t* A; int lda; const bf16_t* Bt; int ldb; int M, N, K; };

struct StaticOrder {
    int nM, nN, nwg, G, c;
    __device__ void init(int M, int N, int G_, int c_) { nM = M / BM; nN = N / BM; nwg = nM * nN; G = G_; c = c_; }
    __device__ bool next(int i, Unit& u) const {
        const long L = (long)i * G + c; if (L >= nwg) return false;
        int wgid = (int)L; { const int q = nwg / NXCD, r = nwg % NXCD, xcd = wgid % NXCD, off = wgid / NXCD; wgid = (xcd < r ? xcd * (q + 1) : r * (q + 1) + (xcd - r) * q) + off; }
        const int nig = WGM * nN, gid = wgid / nig, fm = gid * WGM, gsz = (nM - fm) < WGM ? (nM - fm) : WGM;
        u.pm = fm + ((wgid % nig) % gsz); u.pn = (wgid % nig) / gsz; return true;
    }
};

template <class Epi>
__device__ __forceinline__ void gemm_phase(LAS unsigned char* lds, const Gemm g, const Epi& E) {
    const int tid = tid_opaque(), wid = __builtin_amdgcn_readfirstlane(tid >> 6), lane = tid & 63, wr = wid >> 2, wc = wid & 3, fr = lane & 15, fq = lane >> 4;
    const int K = g.K, nt = K / BK;
    StaticOrder S; S.init(g.M, g.N, (int)gridDim.x, bid_opaque());
    unsigned voffA[2], voffB[2];
#pragma unroll
    for (int i = 0; i < 2; ++i) { int R, C; stage_rc(tid * 16 + i * 8192, R, C); const int Rb = Epi::PERM ? ((R & ~31) + perm32(R & 31)) : R;
        voffA[i] = (unsigned)(R * g.lda + C) * 2u; voffB[i] = (unsigned)(Rb * g.ldb + C) * 2u; }
    const size_t kstep = (size_t)(BK * 2);
    const size_t hstepA = (size_t)HALF * g.lda * 2, hstepB = (size_t)HALF * g.ldb * 2;
    const size_t tstepA = 2 * hstepA, tstepB = 2 * hstepB;
    const unsigned ldsw = (unsigned)wid * 1024u;
    const int aoff = lds_byte(wr * 64 + fr, fq * 8), boff = lds_byte(wc * 32 + fr, fq * 8);
#define PG8_SA(b, h) (((b) * 2 + (h)) * HTB)
#define PG8_SB(b, h) ((4 + (b) * 2 + (h)) * HTB)
#define PG8_STAGE(bufoff, gbase, voff) do { _Pragma("unroll") for (int _i = 0; _i < 2; ++_i) \
        __builtin_amdgcn_global_load_lds((const unsigned*)((const char*)(gbase) + (voff)[_i]), (LAS unsigned*)(lds + (bufoff) + ldsw + _i * 8192), 16, 0, 0); } while (0)
#define PG8_LDA(dst, b, h) do { _Pragma("unroll") for (int m = 0; m < 4; ++m) _Pragma("unroll") for (int k = 0; k < 2; ++k) dst[m][k] = *(const LAS bf16x8*)(lds + PG8_SA(b, h) + aoff + m * 2048 + k * 1024); } while (0)
#define PG8_LDB(dst, b, h) do { _Pragma("unroll") for (int n = 0; n < 2; ++n) _Pragma("unroll") for (int k = 0; k < 2; ++k) dst[n][k] = *(const LAS bf16x8*)(lds + PG8_SB(b, h) + boff + n * 2048 + k * 1024); } while (0)
#define PG8_MMA(ai, bj, At, Bt) do { __builtin_amdgcn_s_setprio(1); _Pragma("unroll") for (int m = 0; m < 4; ++m) _Pragma("unroll") for (int n = 0; n < 2; ++n) _Pragma("unroll") for (int k = 0; k < 2; ++k) \
        acc[ai][bj][m][n] = __builtin_amdgcn_mfma_f32_16x16x32_bf16(Bt[n][k], At[m][k], acc[ai][bj][m][n], 0, 0, 0); __builtin_amdgcn_s_setprio(0); } while (0)
#define PG8_WAIT_V(n) asm volatile("s_waitcnt vmcnt(" #n ")" ::: "memory")
#define PG8_WAIT_L(n) asm volatile("s_waitcnt lgkmcnt(" #n ")" ::: "memory")
#define PG8_BAR __builtin_amdgcn_s_barrier()
#define PG8_SCHED __builtin_amdgcn_sched_barrier(0)
#define PG8_KLOOP(TB, TE) for (int t = (TB); t < (TE); t += 2) { \
            const bool last = (t == nt - 2); \
            const char* a1 = cA + (size_t)(t + 1) * kstep; \
            const char* a2 = last ? nA : cA + (size_t)(t + 2) * kstep; const char* b2 = last ? nB : cB + (size_t)(t + 2) * kstep; \
            const char* a3 = a2 + kstep; const char* b3 = b2 + kstep; \
            PG8_LDB(B0, 0, 0); PG8_SCHED; PG8_LDA(At, 0, 0); PG8_STAGE(PG8_SA(1, 1), a1 + hstepA, voffA); \
            PG8_WAIT_L(8); PG8_BAR; PG8_WAIT_L(0); PG8_MMA(0, 0, At, B0); PG8_BAR; PG8_SCHED; \
            PG8_LDB(B1, 0, 1); PG8_STAGE(PG8_SB(0, 0), b2, voffB); \
            PG8_BAR; PG8_WAIT_L(0); PG8_MMA(0, 1, At, B1); PG8_BAR; \
            PG8_LDA(At, 0, 1); PG8_STAGE(PG8_SA(0, 0), a2, voffA); \
            PG8_BAR; PG8_WAIT_L(0); PG8_MMA(1, 0, At, B0); PG8_BAR; PG8_SCHED; \
            PG8_STAGE(PG8_SB(0, 1), b2 + hstepB, voffB); \
            PG8_WAIT_V(6); PG8_BAR; PG8_MMA(1, 1, At, B1); PG8_BAR; \
            PG8_LDB(B0, 1, 0); PG8_SCHED; PG8_LDA(At, 1, 0); PG8_STAGE(PG8_SA(0, 1), a2 + hstepA, voffA); \
            PG8_WAIT_L(8); PG8_BAR; PG8_WAIT_L(0); PG8_MMA(0, 0, At, B0); PG8_BAR; PG8_SCHED; \
            PG8_LDB(B1, 1, 1); PG8_STAGE(PG8_SB(1, 0), b3, voffB); \
            PG8_BAR; PG8_WAIT_L(0); PG8_MMA(0, 1, At, B1); PG8_BAR; \
            PG8_LDA(At, 1, 1); PG8_STAGE(PG8_SA(1, 0), a3, voffA); \
            PG8_BAR; PG8_WAIT_L(0); PG8_MMA(1, 0, At, B0); PG8_BAR; PG8_SCHED; \
            PG8_STAGE(PG8_SB(1, 1), b3 + hstepB, voffB); \
            PG8_WAIT_V(6); PG8_BAR; PG8_MMA(1, 1, At, B1); PG8_BAR; \
        }
    Unit cur, nxt; int ui = 0;
    if (!S.next(0, cur)) return;
    f32x4 acc[2][2][4][2];
#pragma unroll
    for (int a = 0; a < 2; ++a)
#pragma unroll
        for (int b = 0; b < 2; ++b)
#pragma unroll
            for (int m = 0; m < 4; ++m)
#pragma unroll
                for (int n = 0; n < 2; ++n) acc[a][b][m][n] = (f32x4){0.f, 0.f, 0.f, 0.f};
    bf16x8 At[4][2], B0[2][2], B1[2][2];
    const char* cA = (const char*)g.A + (size_t)cur.pm * tstepA; const char* cB = (const char*)g.Bt + (size_t)cur.pn * tstepB;
    PG8_STAGE(PG8_SB(0, 0), cB, voffB); PG8_STAGE(PG8_SA(0, 0), cA, voffA); PG8_STAGE(PG8_SB(0, 1), cB + hstepB, voffB); PG8_STAGE(PG8_SA(0, 1), cA + hstepA, voffA);
    if (wr == 1) PG8_BAR;
    PG8_WAIT_V(4); PG8_BAR;
    PG8_STAGE(PG8_SB(1, 0), cB + kstep, voffB); PG8_STAGE(PG8_SA(1, 0), cA + kstep, voffA); PG8_STAGE(PG8_SB(1, 1), cB + hstepB + kstep, voffB);
    PG8_WAIT_V(6); PG8_BAR;
    for (;;) {
        const bool has_next = S.next(ui + 1, nxt);
        const char* nA = has_next ? (const char*)g.A + (size_t)nxt.pm * tstepA : cA; const char* nB = has_next ? (const char*)g.Bt + (size_t)nxt.pn * tstepB : cB;
        if constexpr (Epi::MIDK) {
            PG8_KLOOP(0, 4)
            E.template mid<0>(acc, cur, wr, wc, fr, fq);
            PG8_KLOOP(4, 8)
            E.template mid<1>(acc, cur, wr, wc, fr, fq);
            PG8_KLOOP(8, nt)
        } else {
            PG8_KLOOP(0, nt)
        }
        E(acc, cur, wr, wc, fr, fq);
        if (!has_next) break;
#pragma unroll
        for (int a = 0; a < 2; ++a)
#pragma unroll
            for (int b = 0; b < 2; ++b)
#pragma unroll
                for (int m = 0; m < 4; ++m)
#pragma unroll
                    for (int n = 0; n < 2; ++n) acc[a][b][m][n] = (f32x4){0.f, 0.f, 0.f, 0.f};
        cur = nxt; cA = nA; cB = nB; ++ui;
    }
    PG8_WAIT_V(0);
    if (wr == 0) PG8_BAR;
    PG8_BAR;
#undef PG8_KLOOP
#undef PG8_SA
#undef PG8_SB
#undef PG8_STAGE
#undef PG8_LDA
#undef PG8_LDB
#undef PG8_MMA
#undef PG8_WAIT_V
#undef PG8_WAIT_L
#undef PG8_BAR
#undef PG8_SCHED
}

struct EpiSwiglu {
    static constexpr bool PERM = true, MIDK = false;
    bf16_t* O;
    __device__ __forceinline__ void operator()(const f32x4 (&acc)[2][2][4][2], const Unit& u, int wr, int wc, int fr, int fq) const {
        const int row0 = u.pm * BM + wr * 64 + fr, col0 = u.pn * 128 + wc * 32 + 8 * fq;
#pragma unroll
        for (int ai = 0; ai < 2; ++ai)
#pragma unroll
            for (int m = 0; m < 4; ++m) {
                float h[8];
#pragma unroll
                for (int n = 0; n < 2; ++n)
#pragma unroll
                    for (int j = 0; j < 4; ++j) h[n * 4 + j] = siluf_(acc[ai][0][m][n][j]) * acc[ai][1][m][n][j];
                *(u32x4*)(O + (size_t)(row0 + ai * HALF + m * 16) * DFF + col0) = pack8(h);
            }
    }
};
struct EpiBf16 {
    static constexpr bool PERM = true, MIDK = false;
    bf16_t* O; int ldc; const float* bias; int bias_col0;
    __device__ __forceinline__ void operator()(const f32x4 (&acc)[2][2][4][2], const Unit& u, int wr, int wc, int fr, int fq) const {
        const int row0 = u.pm * BM + wr * 64 + fr, col0 = u.pn * BM + wc * 32 + 8 * fq;
        const bool hb = (u.pn * BM >= bias_col0);
        f32x4 bv[2][2];
#pragma unroll
        for (int bj = 0; bj < 2; ++bj)
#pragma unroll
            for (int n = 0; n < 2; ++n) bv[bj][n] = hb ? *(const f32x4*)(bias + (col0 - bias_col0) + bj * HALF + 4 * n) : (f32x4){0.f, 0.f, 0.f, 0.f};
#pragma unroll
        for (int ai = 0; ai < 2; ++ai)
#pragma unroll
            for (int m = 0; m < 4; ++m) { bf16_t* rowp = O + (size_t)(row0 + ai * HALF + m * 16) * ldc + col0;
#pragma unroll
                for (int bj = 0; bj < 2; ++bj) { const f32x4 v0 = acc[ai][bj][m][0] + bv[bj][0], v1 = acc[ai][bj][m][1] + bv[bj][1];
                    u32x4 w; w.x = cvt_pk_bf16(v0[0], v0[1]); w.y = cvt_pk_bf16(v0[2], v0[3]); w.z = cvt_pk_bf16(v1[0], v1[1]); w.w = cvt_pk_bf16(v1[2], v1[3]);
                    *(u32x4*)(rowp + bj * HALF) = w; } }
    }
};
struct EpiResid {
    static constexpr bool PERM = false, MIDK = false;
    const float* src_lat; const float* src_ctx; float* dst_lat; float* dst_ctx; const float* mod; int gate_idx; float gscale; int tile0;
    __device__ __forceinline__ void operator()(const f32x4 (&acc)[2][2][4][2], const Unit& u, int wr, int wc, int fr, int fq) const {
        const RowMap rm = map_row((tile0 + u.pm) * BM);
        const float* src = (rm.is_ctx ? src_ctx : src_lat) + rm.row0 * D; float* dst = (rm.is_ctx ? dst_ctx : dst_lat) + rm.row0 * D;
        const float* gp = mod + (size_t)rm.modrow * (NMOD * D) + gate_idx * D;
        const int rloc = wr * 64 + fr, col0 = u.pn * BM + wc * 32 + 4 * fq;
        f32x4 gv[2][2];
#pragma unroll
        for (int bj = 0; bj < 2; ++bj)
#pragma unroll
            for (int n = 0; n < 2; ++n) gv[bj][n] = *(const f32x4*)(gp + col0 + bj * HALF + n * 16) * gscale;
#pragma unroll
        for (int ai = 0; ai < 2; ++ai)
#pragma unroll
            for (int m = 0; m < 4; ++m) { const size_t ro = (size_t)(rloc + ai * HALF + m * 16) * D + col0;
#pragma unroll
                for (int bj = 0; bj < 2; ++bj)
#pragma unroll
                    for (int n = 0; n < 2; ++n) { const f32x4 x = *(const f32x4*)(src + ro + bj * HALF + n * 16);
                        *(f32x4*)(dst + ro + bj * HALF + n * 16) = x + gv[bj][n] * acc[ai][bj][m][n]; } }
    }
};
struct EpiBranch {
    static constexpr bool PERM = true, MIDK = true;
    bf16_t* P;
    __device__ __forceinline__ void load_e(unsigned off, float (&e)[8]) const {
        const u32x4 w = *(const u32x4*)((const char*)P + (size_t)off * 2u); float x[8]; unpack8(w, x);
#pragma unroll
        for (int j = 0; j < 8; ++j) { const float v = fminf(fmaxf(x[j], -30.f), 30.f); e[j] = fast_exp2(-v * LOG2E); }
    }
    template <int WHICH> __device__ __forceinline__ void mid(f32x4 (&acc)[2][2][4][2], const Unit& u, int wr, int wc, int fr, int fq) const {
        unsigned base = (unsigned)(u.pm * BM + wr * 64 + fr) * PROJ + (unsigned)(u.pn * BM + wc * 32 + 8 * fq) + OFF_GATE + WHICH * D;
        asm volatile("" : "+v"(base));
#pragma unroll
        for (int ai = 0; ai < 2; ++ai)
#pragma unroll
            for (int m = 0; m < 4; ++m)
#pragma unroll
                for (int bj = 0; bj < 2; ++bj) { const unsigned o = base + (unsigned)(ai * HALF + m * 16) * PROJ + bj * HALF;
                    float ea[8], eb[8]; load_e(o, ea); load_e(o + D, eb);
#pragma unroll
                    for (int n = 0; n < 2; ++n)
#pragma unroll
                        for (int j = 0; j < 4; ++j) acc[ai][bj][m][n][j] *= (1.0f + eb[n * 4 + j]) * fast_rcp(1.0f + ea[n * 4 + j]);
                    __builtin_amdgcn_sched_barrier(0); }
    }
    __device__ __forceinline__ void operator()(const f32x4 (&acc)[2][2][4][2], const Unit& u, int wr, int wc, int fr, int fq) const {
        unsigned base = (unsigned)(u.pm * BM + wr * 64 + fr) * PROJ + (unsigned)(u.pn * BM + wc * 32 + 8 * fq);
        asm volatile("" : "+v"(base));
#pragma unroll
        for (int ai = 0; ai < 2; ++ai)
#pragma unroll
            for (int m = 0; m < 4; ++m)
#pragma unroll
                for (int bj = 0; bj < 2; ++bj) { const unsigned o = base + (unsigned)(ai * HALF + m * 16) * PROJ + bj * HALF;
                    float e2[8], ov[8]; load_e(o + OFF_GATE + 2 * D, e2);
#pragma unroll
                    for (int n = 0; n < 2; ++n)
#pragma unroll
                        for (int j = 0; j < 4; ++j) ov[n * 4 + j] = acc[ai][bj][m][n][j] * fast_rcp(1.0f + e2[n * 4 + j]);
                    *(u32x4*)((char*)P + (size_t)o * 2u) = pack8(ov);
                    __builtin_amdgcn_sched_barrier(0); }
    }
};
}

__device__ __forceinline__ void tr_tile(LAS float* tl, const float* src, int ld_src, int k0, int c0, bf16_t* dst, int ld_dst, int n0, int dk0) {
    const int tid = tid_opaque();
    { const int n = tid & 63, kk = tid >> 6;
#pragma unroll
      for (int i = 0; i < 8; ++i) { const int k = kk + 8 * i; tl[k * 65 + n] = src[(size_t)(k0 + k) * ld_src + c0 + n]; } }
    __syncthreads();
    { const int k2 = (tid & 31) * 2, nn = tid >> 5;
#pragma unroll
      for (int i = 0; i < 4; ++i) { const int n = nn + 16 * i; *(unsigned*)(dst + (size_t)(n0 + n) * ld_dst + dk0 + k2) = cvt_pk_bf16(tl[k2 * 65 + n], tl[(k2 + 1) * 65 + n]); } }
    __syncthreads();
}
__device__ __forceinline__ void tr_job(LAS float* tl, const float* src, int ld_src, int K, int Nout, bf16_t* dst, int ld_dst, int dkofs, int mode) {
    const int nkt = K / 64, ntl = nkt * (Nout / 64);
    for (int t = bid_opaque(); t < ntl; t += gridDim.x) {
        const int kt = t % nkt, ntile = t / nkt, n0 = ntile * 64;
        int c0 = n0;
        if (mode == 1) { const int pn = n0 >> 8, r = n0 & 255; c0 = (r < 128) ? pn * 128 + r : DFF + pn * 128 + (r - 128); }
        tr_tile(tl, src, ld_src, kt * 64, c0, dst, ld_dst, n0, dkofs + kt * 64);
    }
}

__device__ void phase_setup(const Params& p, LAS unsigned char* lds) {
    const int tid = tid_opaque(), wid = tid >> 6, lane = tid & 63;
    bf16_t* WT = (bf16_t*)(p.ws + WS_WT);
    LAS float* tl = (LAS float*)lds;
    for (int l = 0; l < NL; ++l) {
        bf16_t* W = WT + (size_t)l * W_LAYER;
        for (int j = 0; j < 2; ++j) {
            tr_job(tl, p.in[I_FFNIN] + ((size_t)l * 2 + j) * D * (2 * DFF), 2 * DFF, D, 2 * DFF, W + (j ? W_FIN1 : W_FIN0), D, 0, 1);
            tr_job(tl, p.in[I_FFNOUT] + ((size_t)l * 2 + j) * DFF * D, D, DFF, D, W + (j ? W_FOUT1 : W_FOUT0), DFF, 0, 0);
        }
        tr_job(tl, p.in[I_WIN] + (size_t)l * D * PROJ, PROJ, D, PROJ, W + W_WIN, D, 0, 0);
        tr_job(tl, p.in[I_WBC] + (size_t)l * 256 * D, D, 256, D, W + W_WB, D, 0, 0);
        tr_job(tl, p.in[I_WBG] + (size_t)l * 256 * D, D, 256, D, W + W_WB, D, 256, 0);
        tr_job(tl, p.in[I_WBA] + (size_t)l * 512 * D, D, 512, D, W + W_WB, D, 512, 0);
        tr_job(tl, p.in[I_WOUT] + (size_t)l * D * D, D, D, D, W + W_WO, D, 0, 0);
        for (int i = bid_opaque() * 512 + tid; i < 65536 / 2; i += gridDim.x * 512) {
            const float2 v = *(const float2*)(p.in[I_GWS] + (size_t)l * 65536 + 2 * i);
            *(unsigned*)(W + W_GWS + 2 * i) = cvt_pk_bf16(v.x, v.y);
        }
    }
    { const int gi = bid_opaque() * 512 + tid;
      if (gi < 1024) { const int pos = gi >> 4, i = gi & 15;
        const int i4 = i & 3, i16 = i >> 2;
        float inv = (i4 == 0) ? 1.0f : (i4 == 1) ? 0.5623413251903491f : (i4 == 2) ? 0.31622776601683794f : 0.1778279410038923f;
        inv *= (i16 == 0) ? 1.0f : (i16 == 1) ? 0.1f : (i16 == 2) ? 0.01f : 0.001f;
        const float a = (float)pos * inv;
        const float kq = __builtin_rintf(a * 0.6366197723675814f);
        float r = __builtin_fmaf(-kq, 1.5707963705062866f, a); r = __builtin_fmaf(kq, 4.371139000186241e-8f, r);
        const float r2 = r * r;
        const float sn = r * (1.0f + r2 * (-1.0f / 6 + r2 * (1.0f / 120 + r2 * (-1.0f / 5040 + r2 * (1.0f / 362880)))));
        const float cs = 1.0f + r2 * (-0.5f + r2 * (1.0f / 24 + r2 * (-1.0f / 720 + r2 * (1.0f / 40320 + r2 * (-1.0f / 3628800)))));
        const int q = ((int)kq) & 3;
        const float c = (q == 0) ? cs : (q == 1) ? -sn : (q == 2) ? -cs : sn;
        const float s = (q == 0) ? sn : (q == 1) ? cs : (q == 2) ? -sn : -cs;
        float2* rt = (float2*)(p.ws + WS_ROPE); rt[gi] = make_float2(c, s); } }
    if (bid_opaque() < NL * 36) {
        LAS float* sc = (LAS float*)lds;
        __syncthreads();
        for (int i = tid; i < 33 * D; i += 512) { const int r = i >> 10, k = i & 1023; const float v = (r < 32) ? p.in[I_C][r * D + k] : p.in[I_CCTX][k]; sc[i] = siluf_(v); }
        __syncthreads();
        float* MOD = (float*)(p.ws + WS_MOD);
        for (int it = bid_opaque(); it < NL * 36; it += gridDim.x) {
            const int l = it / 36, cgp = it % 36, n0 = cgp * 256 + lane * 4;
            const float* wp = p.in[I_WMOD] + (size_t)l * D * (NMOD * D) + n0;
            f32x4 a[5];
#pragma unroll
            for (int i = 0; i < 5; ++i) a[i] = (f32x4){0.f, 0.f, 0.f, 0.f};
            for (int k = 0; k < D; k += 4) {
                f32x4 w[4];
#pragma unroll
                for (int kk = 0; kk < 4; ++kk) w[kk] = *(const f32x4*)(wp + (size_t)(k + kk) * (NMOD * D));
#pragma unroll
                for (int i = 0; i < 5; ++i) { const int r = (i < 4) ? wid + 8 * i : 32; const f32x4 s = *(const LAS f32x4*)(sc + r * D + k);
                    a[i] += s[0] * w[0] + s[1] * w[1] + s[2] * w[2] + s[3] * w[3]; }
            }
            const f32x4 bv = *(const f32x4*)(p.in[I_BMOD] + (size_t)l * (NMOD * D) + n0);
#pragma unroll
            for (int i = 0; i < 5; ++i) { const int r = (i < 4) ? wid + 8 * i : 32; if (i < 4 || wid == 0) *(f32x4*)(MOD + ((size_t)l * 33 + r) * (NMOD * D) + n0) = a[i] + bv; }
        }
        __syncthreads();
    }
}

__device__ void phase_norm(const Params& p, int l, int j, const float* hl, const float* hc) {
    const int tid = tid_opaque(), wid = tid >> 6, lane = tid & 63;
    bf16_t* A = (bf16_t*)(p.ws + WS_A);
    const float* MOD = (const float*)(p.ws + WS_MOD) + (size_t)l * 33 * (NMOD * D);
    const float* ng = p.in[I_NORMG] + ((size_t)l * 3 + j) * D;
    for (int u = bid_opaque() * 8 + wid; u < T_ALL; u += gridDim.x * 8) {
        const RowMap rm = map_row(u);
        const float* x = (rm.is_ctx ? hc : hl) + rm.row0 * D;
        const float* sh = MOD + (size_t)rm.modrow * (NMOD * D) + (3 * j) * D; const float* sc = sh + D;
        f32x4 v[4]; float ss = 0.f;
#pragma unroll
        for (int i = 0; i < 4; ++i) { v[i] = *(const f32x4*)(x + i * 256 + lane * 4); ss += v[i][0] * v[i][0] + v[i][1] * v[i][1] + v[i][2] * v[i][2] + v[i][3] * v[i][3]; }
        ss = wave_sum(ss);
        const float rstd = rsqrtf(ss * (1.0f / D) + EPS);
#pragma unroll
        for (int i = 0; i < 4; ++i) { const int k = i * 256 + lane * 4;
            const f32x4 g = *(const f32x4*)(ng + k), s1 = *(const f32x4*)(sc + k), s0 = *(const f32x4*)(sh + k);
            const f32x4 y = v[i] * rstd * g * (s1 + 1.0f) + s0;
            u32x2 w; w.x = cvt_pk_bf16(y[0], y[1]); w.y = cvt_pk_bf16(y[2], y[3]);
            *(u32x2*)(A + (size_t)u * D + k) = w; }
    }
}

__device__ void phase_prep(const Params& p, int l, LAS unsigned char* lds) {
    const int tid = tid_opaque(), wid = tid >> 6, lane = tid & 63;
    bf16_t* P = (bf16_t*)(p.ws + WS_R1);
    bf16_t* VTL = (bf16_t*)(p.ws + WS_VTL); bf16_t* VTC = (bf16_t*)(p.ws + WS_VTC);
    const float2* rt = (const float2*)(p.ws + WS_ROPE);
    const float* qg = p.in[I_QG] + l * 64; const float* kg = p.in[I_KG] + l * 64;
    LAS bf16_t* Vs = (LAS bf16_t*)lds;
    const int c = lane & 7, seg = c >> 2, hf = (c >> 1) & 1, i0 = (c & 1) * 8;
    float gq[8], gk[8];
#pragma unroll
    for (int e = 0; e < 8; ++e) { gq[e] = qg[8 * c + e]; gk[e] = kg[8 * c + e]; }
    for (int it = bid_opaque(); it < TH / 64; it += gridDim.x) {
        const int v0 = it * 64; const bool lat = v0 < H_LAT;
        for (int i = 0; i < 8; ++i) {
            const int rl = wid * 8 + i, v = v0 + rl;
            bf16_t* rowp = P + (size_t)v * PROJ;
            const int pos = v & (SEQ - 1), pp = seg ? (pos & 63) : (pos >> 6);
            float cs[8], sn[8];
#pragma unroll
            for (int e = 0; e < 8; ++e) { const float2 t2 = rt[pp * 16 + i0 + e]; cs[e] = lat ? t2.x : 1.0f; sn[e] = lat ? t2.y : 0.0f; }
            { bf16_t* qp = rowp + OFF_Q + (lane >> 3) * 64 + 8 * c; float x[8]; unpack8(*(const u32x4*)qp, x);
              float ss = 0.f;
#pragma unroll
              for (int e = 0; e < 8; ++e) ss += x[e] * x[e];
              ss += __shfl_xor(ss, 1); ss += __shfl_xor(ss, 2); ss += __shfl_xor(ss, 4);
              const float rstd = rsqrtf(ss * (1.0f / 64) + EPS); float o[8];
#pragma unroll
              for (int e = 0; e < 8; ++e) { const float y = x[e] * rstd * gq[e]; const float yp = __shfl_xor(y, 2);
                  o[e] = (hf ? (y * cs[e] + yp * sn[e]) : (y * cs[e] - yp * sn[e])) * (0.125f * LOG2E); }
              *(u32x4*)qp = pack8(o); }
            { bf16_t* kp = rowp + OFF_K + ((lane >> 3) & 1) * 64 + 8 * c; float x[8]; unpack8(*(const u32x4*)kp, x);
              float ss = 0.f;
#pragma unroll
              for (int e = 0; e < 8; ++e) ss += x[e] * x[e];
              ss += __shfl_xor(ss, 1); ss += __shfl_xor(ss, 2); ss += __shfl_xor(ss, 4);
              const float rstd = rsqrtf(ss * (1.0f / 64) + EPS); float o[8];
#pragma unroll
              for (int e = 0; e < 8; ++e) { const float y = x[e] * rstd * gk[e]; const float yp = __shfl_xor(y, 2);
                  o[e] = hf ? (y * cs[e] + yp * sn[e]) : (y * cs[e] - yp * sn[e]); }
              if (lane < 16) *(u32x4*)kp = pack8(o); }
            { const unsigned w = *(const unsigned*)(rowp + OFF_V + 2 * lane);
              Vs[(2 * lane) * 72 + rl] = (bf16_t)(w & 0xffffu); Vs[(2 * lane + 1) * 72 + rl] = (bf16_t)(w >> 16); }
        }
        __syncthreads();
        { const int hd = tid >> 2, ch = tid & 3;
          bf16_t* dst;
          if (lat) { const int bl = v0 >> 11, pos0 = v0 & (SEQ - 1); dst = VTL + ((size_t)bl * 128 + hd) * SEQ + pos0 + ch * 16; }
          else { const int cv = v0 - H_LAT, bl = cv >> 8, pos0 = cv & 255; dst = VTC + ((size_t)bl * 128 + hd) * CTXL + pos0 + ch * 16; }
          const u32x4 a = *(const LAS u32x4*)(Vs + hd * 72 + ch * 16), b = *(const LAS u32x4*)(Vs + hd * 72 + ch * 16 + 8);
          *(u32x4*)dst = a; *(u32x4*)(dst + 8) = b; }
        __syncthreads();
    }
}

struct KeySeg { const bf16_t* K; const bf16_t* Vt; int vstride; int ntiles; int mask; };

__device__ __forceinline__ void attn_item(const Params& p, int l, int hs, int idx) {
    const int tid = tid_opaque(), wid = tid >> 6, lane = tid & 63, fr = lane & 15, fq = lane >> 4;
    const bf16_t* P = (const bf16_t*)(p.ws + WS_R1);
    const bf16_t* VTL = (const bf16_t*)(p.ws + WS_VTL); const bf16_t* VTC = (const bf16_t*)(p.ws + WS_VTC);
    bf16_t* Y = (bf16_t*)(p.ws + WS_A) + (size_t)hs * TH * D;
    int bl, qb, hk; bool lat;
    if (idx < 512) { lat = true; bl = idx >> 5; qb = (idx >> 1) & 15; hk = idx & 1; }
    else { const int j = idx - 512; lat = false; bl = j >> 2; qb = (j >> 1) & 1; hk = j & 1; }
    const int g = wid >> 1, r0 = (wid & 1) * 64, head = hk * 4 + g;
    const int qrow0 = lat ? bl * SEQ + qb * 128 : H_LAT + bl * CTXL + qb * 128;
    const int crow0 = H_LAT + bl * CTXL;
    const bf16_t* vtc = VTC + ((size_t)bl * 2 + hk) * 64 * CTXL;
    const bf16_t* vtl = VTL + ((size_t)bl * 2 + hk) * 64 * SEQ;
    bf16x8 qf[4][2];
    { const bf16_t* qp = P + (size_t)(qrow0 + r0 + fr) * PROJ + OFF_Q + head * 64 + fq * 8;
#pragma unroll
      for (int nq = 0; nq < 4; ++nq)
#pragma unroll
          for (int ks = 0; ks < 2; ++ks) qf[nq][ks] = *(const bf16x8*)(qp + (size_t)nq * 16 * PROJ + ks * 32); }
    f32x4 o[4][4];
#pragma unroll
    for (int a = 0; a < 4; ++a)
#pragma unroll
        for (int b = 0; b < 4; ++b) o[a][b] = (f32x4){0.f, 0.f, 0.f, 0.f};
    const float snk = p.in[I_SINK][l * 8 + head] * LOG2E;
    float mrun[4], lrun[4];
#pragma unroll
    for (int nq = 0; nq < 4; ++nq) { mrun[nq] = snk; lrun[nq] = (fq == 0) ? 1.0f : 0.0f; }

    for (int sg = 0; sg < 4; ++sg) {
        int ntile, mask, t_lo = 0, vstride; const bf16_t* kb_; const bf16_t* vb_;
        if (sg < 3) {
            if (!lat) continue;
            const int kb = qb + sg - 1; if (kb < 0 || kb > 15) continue;
            kb_ = P + (size_t)(bl * SEQ + kb * 128) * PROJ + OFF_K + hk * 64; vb_ = vtl + kb * 128; vstride = SEQ; ntile = 4; mask = (sg == 0) ? 1 : (sg == 2) ? 2 : 0;
            if (sg == 0) t_lo = (r0 == 64) ? 2 : 0;
            if (sg == 2) ntile = (r0 == 0) ? 2 : 4;
        } else { kb_ = P + (size_t)crow0 * PROJ + OFF_K + hk * 64; vb_ = vtc; vstride = CTXL; ntile = 8; mask = 0; }
        for (int tt = t_lo; tt < ntile; ++tt) {
            const int t0 = tt * 32;
            bf16x8 kf[2][2];
            { const bf16_t* kp = kb_ + (size_t)(t0 + fr) * PROJ + fq * 8;
#pragma unroll
              for (int kb = 0; kb < 2; ++kb)
#pragma unroll
                  for (int ks = 0; ks < 2; ++ks) kf[kb][ks] = *(const bf16x8*)(kp + (size_t)kb * 16 * PROJ + ks * 32); }
            bf16x8 vf[4];
            { const bf16_t* vp = vb_ + (size_t)fr * vstride + t0 + fq * 4;
#pragma unroll
              for (int db = 0; db < 4; ++db) { const bf16x4 lo = *(const bf16x4*)(vp + (size_t)db * 16 * vstride), hi = *(const bf16x4*)(vp + (size_t)db * 16 * vstride + 16);
                  vf[db] = (bf16x8){lo[0], lo[1], lo[2], lo[3], hi[0], hi[1], hi[2], hi[3]}; } }
            f32x4 s[2][4];
#pragma unroll
            for (int kb = 0; kb < 2; ++kb)
#pragma unroll
                for (int nq = 0; nq < 4; ++nq) {
                    s[kb][nq] = __builtin_amdgcn_mfma_f32_16x16x32_bf16(kf[kb][0], qf[nq][0], (f32x4){0.f, 0.f, 0.f, 0.f}, 0, 0, 0);
                    s[kb][nq] = __builtin_amdgcn_mfma_f32_16x16x32_bf16(kf[kb][1], qf[nq][1], s[kb][nq], 0, 0, 0);
                }
            if (mask) {
#pragma unroll
                for (int kb = 0; kb < 2; ++kb)
#pragma unroll
                    for (int nq = 0; nq < 4; ++nq)
#pragma unroll
                        for (int j = 0; j < 4; ++j) { const int t = t0 + kb * 16 + fq * 4 + j, r = r0 + nq * 16 + fr;
                            const bool ok = (mask == 1) ? (t >= r) : (t <= r); if (!ok) s[kb][nq][j] = -1e30f; }
            }
            bf16x8 pf[4];
#pragma unroll
            for (int nq = 0; nq < 4; ++nq) {
                float mx = fmaxf(fmaxf(fmaxf(s[0][nq][0], s[0][nq][1]), fmaxf(s[0][nq][2], s[0][nq][3])), fmaxf(fmaxf(s[1][nq][0], s[1][nq][1]), fmaxf(s[1][nq][2], s[1][nq][3])));
                mx = fmaxf(mx, __shfl_xor(mx, 16)); mx = fmaxf(mx, __shfl_xor(mx, 32));
                const float mn = fmaxf(mrun[nq], mx), alpha = fast_exp2(mrun[nq] - mn); mrun[nq] = mn;
                float pv[8], ps = 0.f;
#pragma unroll
                for (int j = 0; j < 4; ++j) { pv[j] = fast_exp2(s[0][nq][j] - mn); pv[4 + j] = fast_exp2(s[1][nq][j] - mn); ps += pv[j] + pv[4 + j]; }
                lrun[nq] = lrun[nq] * alpha + ps;
                const u32x4 w = pack8(pv); pf[nq] = *(const bf16x8*)&w;
#pragma unroll
                for (int db = 0; db < 4; ++db) o[db][nq] *= alpha;
            }
#pragma unroll
            for (int db = 0; db < 4; ++db)
#pragma unroll
                for (int nq = 0; nq < 4; ++nq) o[db][nq] = __builtin_amdgcn_mfma_f32_16x16x32_bf16(vf[db], pf[nq], o[db][nq], 0, 0, 0);
        }
    }
#pragma unroll
    for (int nq = 0; nq < 4; ++nq) {
        float lt = lrun[nq]; lt += __shfl_xor(lt, 16); lt += __shfl_xor(lt, 32);
        const float inv = 1.0f / lt;
        bf16_t* yp = Y + (size_t)(qrow0 + r0 + nq * 16 + fr) * D + 512 + head * 64 + fq * 4;
#pragma unroll
        for (int db = 0; db < 4; ++db) { u32x2 w; w.x = cvt_pk_bf16(o[db][nq][0] * inv, o[db][nq][1] * inv); w.y = cvt_pk_bf16(o[db][nq][2] * inv, o[db][nq][3] * inv);
            *(u32x2*)(yp + db * 16) = w; }
    }
}

__device__ __forceinline__ void gmlp_conv_item(const Params& p, int l, int hs, int chunk, LAS unsigned char* lds) {
    const int tid = tid_opaque(), wid = tid >> 6, lane = tid & 63, fr = lane & 15, fq = lane >> 4;
    const bf16_t* P = (const bf16_t*)(p.ws + WS_R1);
    bf16_t* Y = (bf16_t*)(p.ws + WS_A) + (size_t)hs * TH * D;
    const int v0 = chunk * 128;
    LAS bf16_t* vT = (LAS bf16_t*)lds;
    { const float* cw = p.in[I_CONVW] + (size_t)l * 3 * 256;
      const bool lat = v0 < H_LAT;
#pragma unroll 2
      for (int i = 0; i < 8; ++i) {
          const int id = i * 512 + tid, pt = id >> 5, cc = (id & 31) * 8, v = v0 + pt;
          const int pos = lat ? (v & (SEQ - 1)) : ((v - H_LAT) & (CTXL - 1)), n = lat ? SEQ : CTXL;
          const bf16_t* rp = P + (size_t)v * PROJ + cc;
          float bv[8], c1[8], h1[8], acc[8];
          unpack8(*(const u32x4*)(rp + OFF_CB), bv); unpack8(*(const u32x4*)(rp + OFF_CC), c1); unpack8(*(const u32x4*)(rp + OFF_CH), h1);
          { const f32x4 wa = *(const f32x4*)(cw + 256 + cc), wb = *(const f32x4*)(cw + 256 + cc + 4);
#pragma unroll
            for (int e = 0; e < 8; ++e) acc[e] = c1[e] * h1[e] * (e < 4 ? wa[e & 3] : wb[e & 3]); }
          if (pos > 0) { float c0[8], h0[8]; unpack8(*(const u32x4*)(rp - PROJ + OFF_CC), c0); unpack8(*(const u32x4*)(rp - PROJ + OFF_CH), h0);
              const f32x4 wa = *(const f32x4*)(cw + cc), wb = *(const f32x4*)(cw + cc + 4);
#pragma unroll
              for (int e = 0; e < 8; ++e) acc[e] += c0[e] * h0[e] * (e < 4 ? wa[e & 3] : wb[e & 3]); }
          if (pos < n - 1) { float c2[8], h2[8]; unpack8(*(const u32x4*)(rp + PROJ + OFF_CC), c2); unpack8(*(const u32x4*)(rp + PROJ + OFF_CH), h2);
              const f32x4 wa = *(const f32x4*)(cw + 512 + cc), wb = *(const f32x4*)(cw + 512 + cc + 4);
#pragma unroll
              for (int e = 0; e < 8; ++e) acc[e] += c2[e] * h2[e] * (e < 4 ? wa[e & 3] : wb[e & 3]); }
#pragma unroll
          for (int e = 0; e < 8; ++e) acc[e] *= bv[e];
          *(u32x4*)(Y + (size_t)v * D + cc) = pack8(acc);
      } }
    { const float* lg = p.in[I_LNG] + l * 256 + 4 * lane; const float* lb = p.in[I_LNB] + l * 256 + 4 * lane;
      const f32x4 g4 = *(const f32x4*)lg, b4 = *(const f32x4*)lb;
      for (int i = 0; i < 16; ++i) {
          const int pt = wid * 16 + i;
          const u32x2 w = *(const u32x2*)(P + (size_t)(v0 + pt) * PROJ + OFF_GV + 4 * lane);
          float x[4] = {gelu_tanh(bf_lo(w.x)), gelu_tanh(bf_hi(w.x)), gelu_tanh(bf_lo(w.y)), gelu_tanh(bf_hi(w.y))};
          const float mu = wave_sum(x[0] + x[1] + x[2] + x[3]) * (1.0f / 256);
          float q = 0.f;
#pragma unroll
          for (int e = 0; e < 4; ++e) { x[e] -= mu; q += x[e] * x[e]; }
          const float rstd = rsqrtf(wave_sum(q) * (1.0f / 256) + EPS);
#pragma unroll
          for (int e = 0; e < 4; ++e) { const float y = x[e] * rstd * g4[e] + b4[e]; vT[(4 * lane + e) * 136 + pt] = (bf16_t)(cvt_pk_bf16(y, 0.f) & 0xffffu); }
      } }
    __syncthreads();
    { const int g = wid >> 1, ph = wid & 1;
      const bf16_t* wsb = (const bf16_t*)(p.ws + WS_WT) + (size_t)l * W_LAYER + W_GWS + (size_t)g * 128 * 128;
      f32x4 acc[4][4];
#pragma unroll
      for (int a = 0; a < 4; ++a)
#pragma unroll
          for (int b = 0; b < 4; ++b) acc[a][b] = (f32x4){0.f, 0.f, 0.f, 0.f};
#pragma unroll
      for (int kk = 0; kk < 4; ++kk) {
          bf16x8 af[4], bfr[4];
#pragma unroll
          for (int db = 0; db < 4; ++db) af[db] = *(const LAS bf16x8*)(vT + (g * 64 + db * 16 + fr) * 136 + kk * 32 + fq * 8);
#pragma unroll
          for (int pb = 0; pb < 4; ++pb) bfr[pb] = *(const bf16x8*)(wsb + (size_t)((ph * 4 + pb) * 16 + fr) * 128 + kk * 32 + fq * 8);
#pragma unroll
          for (int db = 0; db < 4; ++db)
#pragma unroll
              for (int pb = 0; pb < 4; ++pb) acc[db][pb] = __builtin_amdgcn_mfma_f32_16x16x32_bf16(af[db], bfr[pb], acc[db][pb], 0, 0, 0);
      }
      const float* bs = p.in[I_GBS] + (size_t)l * 512 + g * 128;
#pragma unroll
      for (int pb = 0; pb < 4; ++pb) { const int pt = (ph * 4 + pb) * 16 + fr; const float bias = bs[pt];
          const bf16_t* up = P + (size_t)(v0 + pt) * PROJ + OFF_GU + g * 64 + fq * 4;
          bf16_t* yp = Y + (size_t)(v0 + pt) * D + 256 + g * 64 + fq * 4;
#pragma unroll
          for (int db = 0; db < 4; ++db) { const u32x2 w = *(const u32x2*)(up + db * 16);
              const float y0 = gelu_tanh(bf_lo(w.x)) * (acc[db][pb][0] + bias), y1 = gelu_tanh(bf_hi(w.x)) * (acc[db][pb][1] + bias);
              const float y2 = gelu_tanh(bf_lo(w.y)) * (acc[db][pb][2] + bias), y3 = gelu_tanh(bf_hi(w.y)) * (acc[db][pb][3] + bias);
              u32x2 ov; ov.x = cvt_pk_bf16(y0, y1); ov.y = cvt_pk_bf16(y2, y3); *(u32x2*)(yp + db * 16) = ov; } } }
    __syncthreads();
}

__device__ void phase_mixers(const Params& p, int l, int hs, LAS unsigned char* lds) {
#ifndef SKIP_ATTN
    for (int it = bid_opaque(); it < 576; it += gridDim.x) attn_item(p, l, hs, it);
#endif
    __builtin_amdgcn_sched_barrier(0);
#ifndef SKIP_GMLP
    for (int it = (bid_opaque() + (int)gridDim.x - 64) % (int)gridDim.x; it < 288; it += gridDim.x) gmlp_conv_item(p, l, hs, it, lds);
#endif
}

#define XB_TMO      128
#define XB_XCNT(j)  (256  + 64 * (j))
#define XB_XSUB(j)  (1280 + 64 * (j))
#define XB_XGEN(j)  (2304 + 64 * (j))
#define XB_TOP      3328
#define XB_TOPGEN   3392
#define XCD_BAR_WORDS 3456
#define XB_SPIN_CAP (1u << 22)
__device__ __forceinline__ unsigned xb_ld(unsigned* p)              { return __hip_atomic_load(p, __ATOMIC_RELAXED, __HIP_MEMORY_SCOPE_AGENT); }
__device__ __forceinline__ unsigned xb_add(unsigned* p, unsigned v) { return __hip_atomic_fetch_add(p, v, __ATOMIC_RELAXED, __HIP_MEMORY_SCOPE_AGENT); }
__device__ __forceinline__ unsigned xb_xcc_id() { return (unsigned)__builtin_amdgcn_s_getreg((3 << 11) | 20) & 0xFu; }
#define XB_SPIN(cond, bar) do { unsigned _sp = 0; while (cond) { __builtin_amdgcn_s_sleep(1); \
    if ((++_sp & 255u) == 0u) { if (xb_ld(&(bar)[XB_TMO])) break; if (_sp > XB_SPIN_CAP) { atomicAdd(&(bar)[XB_TMO], 1u); break; } } } } while (0)
__device__ __forceinline__ void xcd_barrier_post(unsigned* bar) { if (threadIdx.x == 0) (void)xb_add(&bar[XB_XCNT(xb_xcc_id())], 1u); }
__device__ __forceinline__ void xcd_barrier_complete(unsigned* bar, unsigned x, unsigned& nloc, unsigned& nx) {
    const unsigned G = gridDim.x * gridDim.y * gridDim.z;
    unsigned sum, cnt, mine, sp = 0u;
    for (;;) {
        sum = 0u; cnt = 0u; mine = 0u;
#pragma unroll
        for (unsigned j = 0; j < 16; ++j) { const unsigned c = xb_ld(&bar[XB_XCNT(j)]); sum += c; cnt += (c > 0u) ? 1u : 0u; mine = (j == x) ? c : mine; }
        if (sum == G) break;
        __builtin_amdgcn_s_sleep(1);
        if ((++sp & 255u) == 0u) { if (xb_ld(&bar[XB_TMO])) break; if (sp > XB_SPIN_CAP) { atomicAdd(&bar[XB_TMO], 1u); break; } }
    }
    nloc = mine > 0u ? mine : 1u; nx = cnt > 0u ? cnt : 1u;
}
__device__ __forceinline__ void xcd_barrier(unsigned* bar, volatile LAS unsigned* st) {
    asm volatile("s_waitcnt vmcnt(0)" ::: "memory");
    __syncthreads();
    if (threadIdx.x == 0) {
        const unsigned x = xb_xcc_id();
        __builtin_amdgcn_s_waitcnt(0);
        unsigned nloc = st[0], nx = st[1];
        if (nloc == 0u) { xcd_barrier_complete(bar, x, nloc, nx); st[0] = nloc; st[1] = nx; }
        const unsigned old = xb_add(&bar[XB_XSUB(x)], 1u);
        const unsigned gen = old / nloc;
        if (old + 1u == (gen + 1u) * nloc) {
            __builtin_amdgcn_fence(__ATOMIC_RELEASE, "agent");
            asm volatile("s_waitcnt vmcnt(0)" ::: "memory");
            const unsigned og = xb_add(&bar[XB_TOP], 1u);
            const unsigned tg = og / nx;
            if (og + 1u == (tg + 1u) * nx) xb_add(&bar[XB_TOPGEN], 1u);
            else XB_SPIN(xb_ld(&bar[XB_TOPGEN]) == tg, bar);
            __builtin_amdgcn_fence(__ATOMIC_ACQUIRE, "agent");
            xb_add(&bar[XB_XGEN(x)], 1u);
            asm volatile("s_waitcnt vmcnt(0)" ::: "memory");
        } else {
            XB_SPIN(xb_ld(&bar[XB_XGEN(x)]) == gen, bar);
            __builtin_amdgcn_fence(__ATOMIC_ACQUIRE, "agent");
            asm volatile("s_waitcnt vmcnt(0)" ::: "memory");
        }
    }
    __syncthreads();
}

__device__ void run_phase(const Params& p, int ph, LAS unsigned char* lds) {
    if (ph == 0) {
#ifndef SKIP_SETUP
 phase_setup(p, lds);
#endif
 return; }
    const int q = ph - 1, l = q / 17, r = q % 17;
    const bf16_t* W = (const bf16_t*)(p.ws + WS_WT) + (size_t)l * W_LAYER;
    const float* MOD = (const float*)(p.ws + WS_MOD) + (size_t)l * 33 * (NMOD * D);
    float* hc = (float*)(p.ws + WS_HC);
    const bool first = (l == 0 && r <= 2);
    const float* hl_src = first ? p.in[I_X] : p.out; const float* hc_src = first ? p.in[I_CTX] : hc;
    bf16_t* A = (bf16_t*)(p.ws + WS_A); bf16_t* R1 = (bf16_t*)(p.ws + WS_R1);
    if (r == 0 || r == 3 || r == 14) {
#ifndef SKIP_NORM
 phase_norm(p, l, r == 0 ? 0 : (r == 3 ? 1 : 2), hl_src, hc_src);
#endif
 return; }
    if (r == 1 || r == 15) {
        const int j = (r == 1) ? 0 : 1;
        pg8::Gemm g{A, D, W + (j ? W_FIN1 : W_FIN0), D, T_ALL, 2 * DFF, D};
        pg8::EpiSwiglu E{R1};
#ifndef SKIP_UP
        pg8::gemm_phase(lds, g, E);
#endif
        return;
    }
    if (r == 2 || r == 16) {
        const int j = (r == 2) ? 0 : 1;
        pg8::Gemm g{R1, DFF, W + (j ? W_FOUT1 : W_FOUT0), DFF, T_ALL, D, DFF};
        pg8::EpiResid E{hl_src, hc_src, p.out, hc, MOD, j ? 8 : 2, 0.5f, 0};
#ifndef SKIP_DOWN
        pg8::gemm_phase(lds, g, E);
#endif
        return;
    }
    const int hs = (r - 4) / 5, rr = (r - 4) % 5;
    if (rr == 0) { pg8::Gemm g{A + (size_t)hs * TH * D, D, W + W_WIN, D, TH, PROJ, D}; pg8::EpiBf16 E{R1, PROJ, p.in[I_BGATE] + (size_t)l * 3 * D, OFF_GATE};
#ifndef SKIP_PROJ
 pg8::gemm_phase(lds, g, E);
#endif
 return; }
    if (rr == 1) {
#ifndef SKIP_PREP
 phase_prep(p, l, lds);
#endif
 return; }
    if (rr == 2) {
#ifndef SKIP_MIX
 phase_mixers(p, l, hs, lds);
#endif
 return; }
    if (rr == 3) { pg8::Gemm g{A + (size_t)hs * TH * D, D, W + W_WB, D, TH, D, D}; pg8::EpiBranch E{R1};
#ifndef SKIP_BRANCH
 pg8::gemm_phase(lds, g, E);
#endif
 return; }
    { pg8::Gemm g{R1, PROJ, W + W_WO, D, TH, D, D}; pg8::EpiResid E{p.out, hc, p.out, hc, MOD, 5, 1.0f, hs * TILES_H};
#ifndef SKIP_OUT
 pg8::gemm_phase(lds, g, E);
#endif
 }
}

__global__ __launch_bounds__(512, 2) void fwd_megakernel(Params p) {
    extern __shared__ __attribute__((aligned(16))) unsigned char shm[];
    LAS unsigned char* lds = (LAS unsigned char*)shm;
#if MK_SINGLE
    volatile LAS unsigned* bst = (volatile LAS unsigned*)(lds + LDS_BYTES - 16);
    if (threadIdx.x == 0) { bst[0] = 0u; bst[1] = 0u; }
    __syncthreads();
    xcd_barrier_post((unsigned*)(p.ws + WS_BAR));
#endif
    for (int ph = p.ph_lo; ph < p.ph_hi; ++ph) {
#if defined(__HIP_DEVICE_COMPILE__)
        const __attribute__((address_space(4))) char* kp = (const __attribute__((address_space(4))) char*)__builtin_amdgcn_kernarg_segment_ptr();
        asm volatile("" : "+s"(kp));
        const Params lp = *(const Params*)(const char*)kp;
#else
        const Params lp = p;
#endif
        run_phase(lp, ph, lds);
#if MK_SINGLE
        if (ph + 1 < lp.ph_hi) {
            if (ph == 0) cg::this_grid().sync();
            else xcd_barrier((unsigned*)(lp.ws + WS_BAR), (volatile LAS unsigned*)(lds + LDS_BYTES - 16));
        }
#endif
    }
}

extern "C" void kernel_launch(void* const* d_in, const int* in_sizes, int n_in, void* d_out, int out_size, void* d_ws, size_t ws_size, hipStream_t stream) {
    static int grid = 0;
    if (grid == 0) {
        if (n_in != N_IN || out_size != T_LAT * D || ws_size < WS_END) { fprintf(stderr, "kernel_launch: unexpected shapes (n_in %d out %d ws %zu need %zu)\n", n_in, out_size, ws_size, (size_t)WS_END); grid = -1; return; }
        int dev = 0, cus = 0, per_cu = 0;
        (void)hipGetDevice(&dev); (void)hipDeviceGetAttribute(&cus, hipDeviceAttributeMultiprocessorCount, dev);
        if (hipFuncSetAttribute((const void*)fwd_megakernel, hipFuncAttributeMaxDynamicSharedMemorySize, LDS_BYTES) != hipSuccess) { fprintf(stderr, "kernel_launch: hipFuncSetAttribute failed\n"); grid = -1; return; }
        if (hipOccupancyMaxActiveBlocksPerMultiprocessor(&per_cu, (const void*)fwd_megakernel, 512, LDS_BYTES) != hipSuccess || per_cu < 1) { fprintf(stderr, "kernel_launch: occupancy query gave %d\n", per_cu); per_cu = 1; }
        (void)hipGetLastError();
        grid = cus * per_cu;
    }
    if (grid < 0) return;
    Params p{};
    for (int i = 0; i < N_IN; ++i) p.in[i] = (const float*)d_in[i];
    p.out = (float*)d_out; p.ws = (unsigned char*)d_ws;
#if MK_SINGLE
    p.ph_lo = 0; p.ph_hi = N_PHASES;
    if (hipMemsetAsync((char*)d_ws + WS_BAR, 0, 16384, stream) != hipSuccess) { fprintf(stderr, "kernel_launch: memset of the barrier words failed\n"); return; }
    void* args[] = {&p};
    hipError_t e = hipLaunchCooperativeKernel((const void*)fwd_megakernel, dim3(grid), dim3(512), args, LDS_BYTES, stream);
    if (e != hipSuccess) fprintf(stderr, "cooperative launch failed: %s (grid %d)\n", hipGetErrorString(e), grid);
#else
    for (int ph = 0; ph < N_PHASES; ++ph) {
        p.ph_lo = ph; p.ph_hi = ph + 1;
        hipLaunchKernelGGL(fwd_megakernel, dim3(grid), dim3(512), LDS_BYTES, stream, p);
    }
#endif
}
```

```cpp
#include <hip/hip_runtime.h>
#include <hip/hip_cooperative_groups.h>
#include <cstdio>
namespace cg = cooperative_groups;

#ifndef MK_SINGLE
#define MK_SINGLE 1
#endif

#define LAS __attribute__((address_space(3)))
typedef unsigned short bf16_t;
typedef short bf16x8 __attribute__((ext_vector_type(8)));
typedef short bf16x4 __attribute__((ext_vector_type(4)));
typedef float f32x4 __attribute__((ext_vector_type(4)));
typedef unsigned u32x4 __attribute__((ext_vector_type(4)));
typedef unsigned u32x2 __attribute__((ext_vector_type(2)));
typedef float f32x2 __attribute__((ext_vector_type(2)));

constexpr int D = 1024, NB = 32, SEQ = 2048, NL = 4, CTXL = 256, DFF = 2816, PROJ = 5120, NMOD = 9;
constexpr int T_LAT = NB * SEQ, T_CTX = NB * CTXL, T_ALL = T_LAT + T_CTX;
constexpr int H_LAT = T_LAT / 2, H_CTX = T_CTX / 2, TH = H_LAT + H_CTX;
constexpr int TILES_H = TH / 256, TILES_HL = H_LAT / 256;
constexpr int OFF_CB = 0, OFF_CC = 256, OFF_CH = 512, OFF_GU = 768, OFF_GV = 1024, OFF_Q = 1280, OFF_K = 1792, OFF_V = 1920, OFF_GATE = 2048;
constexpr float EPS = 1e-6f;
constexpr float LOG2E = 1.4426950408889634f;

enum { I_X = 0, I_C, I_CTX, I_CCTX, I_WMOD, I_BMOD, I_NORMG, I_FFNIN, I_FFNOUT, I_WIN, I_BGATE, I_CONVW, I_LNG, I_LNB, I_GWS, I_GBS, I_QG, I_KG, I_SINK, I_WBC, I_WBG, I_WBA, I_WOUT, N_IN };

constexpr size_t W_FIN0 = 0, W_FIN1 = 5767168, W_FOUT0 = 11534336, W_FOUT1 = 14417920, W_WIN = 17301504, W_WB = 22544384, W_WO = 23592960, W_GWS = 24641536, W_LAYER = 24707072;
constexpr size_t WS_WT = 0;
constexpr size_t WS_MOD = WS_WT + NL * W_LAYER * 2;
constexpr size_t WS_ROPE = WS_MOD + (size_t)NL * 33 * 9216 * 4;
constexpr size_t WS_HC = WS_ROPE + 8192;
constexpr size_t WS_A = WS_HC + (size_t)T_CTX * D * 4;
constexpr size_t WS_R1 = WS_A + (size_t)T_ALL * D * 2;
constexpr size_t WS_VTL = WS_R1 + (size_t)T_ALL * DFF * 2;
constexpr size_t WS_VTC = WS_VTL + (size_t)16 * 2 * 64 * 2048 * 2;
constexpr size_t WS_BAR = WS_VTC + (size_t)16 * 2 * 64 * 256 * 2;
constexpr size_t WS_END = WS_BAR + 16384;

constexpr int LDS_BYTES = 143360;
constexpr int N_PHASES = 1 + 17 * NL;

struct Params {
    const float* in[N_IN];
    float* out;
    unsigned char* ws;
    int ph_lo, ph_hi;
};

__device__ __forceinline__ unsigned cvt_pk_bf16(float lo, float hi) { unsigned r; asm volatile("v_cvt_pk_bf16_f32 %0, %1, %2" : "=v"(r) : "v"(lo), "v"(hi)); return r; }
__device__ __forceinline__ int tid_opaque() { int t = threadIdx.x; asm volatile("" : "+v"(t)); return t; }
__device__ __forceinline__ int bid_opaque() { int b = blockIdx.x; asm volatile("" : "+s"(b)); return b; }
__device__ __forceinline__ float bf_lo(unsigned w) { return __uint_as_float(w << 16); }
__device__ __forceinline__ float bf_hi(unsigned w) { return __uint_as_float(w & 0xffff0000u); }
__device__ __forceinline__ float fast_rcp(float x) { return __builtin_amdgcn_rcpf(x); }
__device__ __forceinline__ float fast_exp2(float x) { return __builtin_amdgcn_exp2f(x); }
__device__ __forceinline__ float sigmoidf_(float x) { return fast_rcp(1.0f + fast_exp2(-x * LOG2E)); }
__device__ __forceinline__ float siluf_(float x) { return x * sigmoidf_(x); }
__device__ __forceinline__ float gelu_tanh(float x) { const float z = 0.7978845608028654f * (x + 0.044715f * x * x * x); return x * sigmoidf_(2.0f * z); }
__device__ __forceinline__ float wave_sum(float v) {
    v += __shfl_xor(v, 1); v += __shfl_xor(v, 2); v += __shfl_xor(v, 4); v += __shfl_xor(v, 8); v += __shfl_xor(v, 16); v += __shfl_xor(v, 32); return v;
}
__device__ __forceinline__ void unpack8(const u32x4 w, float (&f)[8]) {
    f[0] = bf_lo(w.x); f[1] = bf_hi(w.x); f[2] = bf_lo(w.y); f[3] = bf_hi(w.y); f[4] = bf_lo(w.z); f[5] = bf_hi(w.z); f[6] = bf_lo(w.w); f[7] = bf_hi(w.w);
}
__device__ __forceinline__ u32x4 pack8(const float (&f)[8]) {
    u32x4 w; w.x = cvt_pk_bf16(f[0], f[1]); w.y = cvt_pk_bf16(f[2], f[3]); w.z = cvt_pk_bf16(f[4], f[5]); w.w = cvt_pk_bf16(f[6], f[7]); return w;
}

struct RowMap { size_t row0; int is_ctx; int modrow; };
__device__ __forceinline__ RowMap map_row(int u) {
    const int s = u / TH, v = u - s * TH; RowMap r;
    if (v < H_LAT) { r.row0 = (size_t)s * H_LAT + v; r.is_ctx = 0; r.modrow = (int)(r.row0 >> 11); }
    else { r.row0 = (size_t)s * H_CTX + (v - H_LAT); r.is_ctx = 1; r.modrow = 32; }
    return r;
}

namespace pg8 {
constexpr int BM = 256, BK = 64, HALF = 128, HTB = HALF * BK * 2, STAGE_BYTES = 8 * HTB, NXCD = 8, WGM = 8;
__device__ __forceinline__ int lds_byte(int r, int c) { const int st = (r >> 4) * 2 + (c >> 5), rr = r & 15, cc = c & 31, ob = rr * 64 + cc * 2; return st * 1024 + (ob ^ (((ob >> 9) & 1) << 5)); }
__device__ __forceinline__ void stage_rc(int b, int& R, int& C) { const int st = b / 1024, sb = b % 1024, swz = sb ^ (((sb >> 9) & 1) << 5); R = (st >> 1) * 16 + swz / 64; C = (st & 1) * 32 + (swz % 64) / 2; }
__device__ __forceinline__ int perm32(int rho) { const int n = rho >> 4, i = rho & 15; return 8 * (i >> 2) + 4 * n + (i & 3); }

struct Unit { int pm, pn; };
struct Gemm { const bf16_t* A; int lda; const bf16_t* Bt; int ldb; int M, N, K; };

struct StaticOrder {
    int nM, nN, nwg, G, c;
    __device__ void init(int M, int N, int G_, int c_) { nM = M / BM; nN = N / BM; nwg = nM * nN; G = G_; c = c_; }
    __device__ bool next(int i, Unit& u) const {
        const long L = (long)i * G + c; if (L >= nwg) return false;
        int wgid = (int)L; { const int q = nwg / NXCD, r = nwg % NXCD, xcd = wgid % NXCD, off = wgid / NXCD; wgid = (xcd < r ? xcd * (q + 1) : r * (q + 1) + (xcd - r) * q) + off; }
        const int nig = WGM * nN, gid = wgid / nig, fm = gid * WGM, gsz = (nM - fm) < WGM ? (nM - fm) : WGM;
        u.pm = fm + ((wgid % nig) % gsz); u.pn = (wgid % nig) / gsz; return true;
    }
};

template <class Epi>
__device__ __forceinline__ void gemm_phase(LAS unsigned char* lds, const Gemm g, const Epi& E) {
    const int tid = tid_opaque(), wid = __builtin_amdgcn_readfirstlane(tid >> 6), lane = tid & 63, wr = wid >> 2, wc = wid & 3, fr = lane & 15, fq = lane >> 4;
    const int K = g.K, nt = K / BK;
    StaticOrder S; S.init(g.M, g.N, (int)gridDim.x, bid_opaque());
    unsigned voffA[2], voffB[2];
#pragma unroll
    for (int i = 0; i < 2; ++i) { int R, C; stage_rc(tid * 16 + i * 8192, R, C); const int Rb = Epi::PERM ? ((R & ~31) + perm32(R & 31)) : R;
        voffA[i] = (unsigned)(R * g.lda + C) * 2u; voffB[i] = (unsigned)(Rb * g.ldb + C) * 2u; }
    const size_t kstep = (size_t)(BK * 2);
    const size_t hstepA = (size_t)HALF * g.lda * 2, hstepB = (size_t)HALF * g.ldb * 2;
    const size_t tstepA = 2 * hstepA, tstepB = 2 * hstepB;
    const unsigned ldsw = (unsigned)wid * 1024u;
    const int aoff = lds_byte(wr * 64 + fr, fq * 8), boff = lds_byte(wc * 32 + fr, fq * 8);
#define PG8_SA(b, h) (((b) * 2 + (h)) * HTB)
#define PG8_SB(b, h) ((4 + (b) * 2 + (h)) * HTB)
#define PG8_STAGE(bufoff, gbase, voff) do { _Pragma("unroll") for (int _i = 0; _i < 2; ++_i) \
        __builtin_amdgcn_global_load_lds((const unsigned*)((const char*)(gbase) + (voff)[_i]), (LAS unsigned*)(lds + (bufoff) + ldsw + _i * 8192), 16, 0, 0); } while (0)
#define PG8_LDA(dst, b, h) do { _Pragma("unroll") for (int m = 0; m < 4; ++m) _Pragma("unroll") for (int k = 0; k < 2; ++k) dst[m][k] = *(const LAS bf16x8*)(lds + PG8_SA(b, h) + aoff + m * 2048 + k * 1024); } while (0)
#define PG8_LDB(dst, b, h) do { _Pragma("unroll") for (int n = 0; n < 2; ++n) _Pragma("unroll") for (int k = 0; k < 2; ++k) dst[n][k] = *(const LAS bf16x8*)(lds + PG8_SB(b, h) + boff + n * 2048 + k * 1024); } while (0)
#define PG8_MMA(ai, bj, At, Bt) do { __builtin_amdgcn_s_setprio(1); _Pragma("unroll") for (int m = 0; m < 4; ++m) _Pragma("unroll") for (int n = 0; n < 2; ++n) _Pragma("unroll") for (int k = 0; k < 2; ++k) \
        acc[ai][bj][m][n] = __builtin_amdgcn_mfma_f32_16x16x32_bf16(Bt[n][k], At[m][k], acc[ai][bj][m][n], 0, 0, 0); __builtin_amdgcn_s_setprio(0); } while (0)
#define PG8_WAIT_V(n) asm volatile("s_waitcnt vmcnt(" #n ")" ::: "memory")
#define PG8_WAIT_L(n) asm volatile("s_waitcnt lgkmcnt(" #n ")" ::: "memory")
#define PG8_BAR __builtin_amdgcn_s_barrier()
#define PG8_SCHED __builtin_amdgcn_sched_barrier(0)
#define PG8_KLOOP(TB, TE) for (int t = (TB); t < (TE); t += 2) { \
            const bool last = (t == nt - 2); \
            const char* a1 = cA + (size_t)(t + 1) * kstep; \
            const char* a2 = last ? nA : cA + (size_t)(t + 2) * kstep; const char* b2 = last ? nB : cB + (size_t)(t + 2) * kstep; \
            const char* a3 = a2 + kstep; const char* b3 = b2 + kstep; \
            PG8_LDB(B0, 0, 0); PG8_SCHED; PG8_LDA(At, 0, 0); PG8_STAGE(PG8_SA(1, 1), a1 + hstepA, voffA); \
            PG8_WAIT_L(8); PG8_BAR; PG8_WAIT_L(0); PG8_MMA(0, 0, At, B0); PG8_BAR; PG8_SCHED; \
            PG8_LDB(B1, 0, 1); PG8_STAGE(PG8_SB(0, 0), b2, voffB); \
            PG8_BAR; PG8_WAIT_L(0); PG8_MMA(0, 1, At, B1); PG8_BAR; \
            PG8_LDA(At, 0, 1); PG8_STAGE(PG8_SA(0, 0), a2, voffA); \
            PG8_BAR; PG8_WAIT_L(0); PG8_MMA(1, 0, At, B0); PG8_BAR; PG8_SCHED; \
            PG8_STAGE(PG8_SB(0, 1), b2 + hstepB, voffB); \
            PG8_WAIT_V(6); PG8_BAR; PG8_MMA(1, 1, At, B1); PG8_BAR; \
            PG8_LDB(B0, 1, 0); PG8_SCHED; PG8_LDA(At, 1, 0); PG8_STAGE(PG8_SA(0, 1), a2 + hstepA, voffA); \
            PG8_WAIT_L(8); PG8_BAR; PG8_WAIT_L(0); PG8_MMA(0, 0, At, B0); PG8_BAR; PG8_SCHED; \
            PG8_LDB(B1, 1, 1); PG8_STAGE(PG8_SB(1, 0), b3, voffB); \
            PG8_BAR; PG8_WAIT_L(0); PG8_MMA(0, 1, At, B1); PG8_BAR; \
            PG8_LDA(At, 1, 1); PG8_STAGE(PG8_SA(1, 0), a3, voffA); \
            PG8_BAR; PG8_WAIT_L(0); PG8_MMA(1, 0, At, B0); PG8_BAR; PG8_SCHED; \
            PG8_STAGE(PG8_SB(1, 1), b3 + hstepB, voffB); \
            PG8_WAIT_V(6); PG8_BAR; PG8_MMA(1, 1, At, B1); PG8_BAR; \
        }
    Unit cur, nxt; int ui = 0;
    if (!S.next(0, cur)) return;
    f32x4 acc[2][2][4][2];
#pragma unroll
    for (int a = 0; a < 2; ++a)
#pragma unroll
        for (int b = 0; b < 2; ++b)
#pragma unroll
            for (int m = 0; m < 4; ++m)
#pragma unroll
                for (int n = 0; n < 2; ++n) acc[a][b][m][n] = (f32x4){0.f, 0.f, 0.f, 0.f};
    bf16x8 At[4][2], B0[2][2], B1[2][2];
    const char* cA = (const char*)g.A + (size_t)cur.pm * tstepA; const char* cB = (const char*)g.Bt + (size_t)cur.pn * tstepB;
    PG8_STAGE(PG8_SB(0, 0), cB, voffB); PG8_STAGE(PG8_SA(0, 0), cA, voffA); PG8_STAGE(PG8_SB(0, 1), cB + hstepB, voffB); PG8_STAGE(PG8_SA(0, 1), cA + hstepA, voffA);
    if (wr == 1) PG8_BAR;
    PG8_WAIT_V(4); PG8_BAR;
    PG8_STAGE(PG8_SB(1, 0), cB + kstep, voffB); PG8_STAGE(PG8_SA(1, 0), cA + kstep, voffA); PG8_STAGE(PG8_SB(1, 1), cB + hstepB + kstep, voffB);
    PG8_WAIT_V(6); PG8_BAR;
    for (;;) {
        const bool has_next = S.next(ui + 1, nxt);
        const char* nA = has_next ? (const char*)g.A + (size_t)nxt.pm * tstepA : cA; const char* nB = has_next ? (const char*)g.Bt + (size_t)nxt.pn * tstepB : cB;
        if constexpr (Epi::MIDK) {
            PG8_KLOOP(0, 4)
            E.template mid<0>(acc, cur, wr, wc, fr, fq);
            PG8_KLOOP(4, 8)
            E.template mid<1>(acc, cur, wr, wc, fr, fq);
            PG8_KLOOP(8, nt)
        } else {
            PG8_KLOOP(0, nt)
        }
        E(acc, cur, wr, wc, fr, fq);
        if (!has_next) break;
#pragma unroll
        for (int a = 0; a < 2; ++a)
#pragma unroll
            for (int b = 0; b < 2; ++b)
#pragma unroll
                for (int m = 0; m < 4; ++m)
#pragma unroll
                    for (int n = 0; n < 2; ++n) acc[a][b][m][n] = (f32x4){0.f, 0.f, 0.f, 0.f};
        cur = nxt; cA = nA; cB = nB; ++ui;
    }
    PG8_WAIT_V(0);
    if (wr == 0) PG8_BAR;
    PG8_BAR;
#undef PG8_KLOOP
#undef PG8_SA
#undef PG8_SB
#undef PG8_STAGE
#undef PG8_LDA
#undef PG8_LDB
#undef PG8_MMA
#undef PG8_WAIT_V
#undef PG8_WAIT_L
#undef PG8_BAR
#undef PG8_SCHED
}

struct EpiSwiglu {
    static constexpr bool PERM = true, MIDK = false;
    bf16_t* O;
    __device__ __forceinline__ void operator()(const f32x4 (&acc)[2][2][4][2], const Unit& u, int wr, int wc, int fr, int fq) const {
        const int row0 = u.pm * BM + wr * 64 + fr, col0 = u.pn * 128 + wc * 32 + 8 * fq;
#pragma unroll
        for (int ai = 0; ai < 2; ++ai)
#pragma unroll
            for (int m = 0; m < 4; ++m) {
                float h[8];
#pragma unroll
                for (int n = 0; n < 2; ++n)
#pragma unroll
                    for (int j = 0; j < 4; ++j) h[n * 4 + j] = siluf_(acc[ai][0][m][n][j]) * acc[ai][1][m][n][j];
                *(u32x4*)(O + (size_t)(row0 + ai * HALF + m * 16) * DFF + col0) = pack8(h);
            }
    }
};
struct EpiBf16 {
    static constexpr bool PERM = true, MIDK = false;
    bf16_t* O; int ldc; const float* bias; int bias_col0;
    __device__ __forceinline__ void operator()(const f32x4 (&acc)[2][2][4][2], const Unit& u, int wr, int wc, int fr, int fq) const {
        const int row0 = u.pm * BM + wr * 64 + fr, col0 = u.pn * BM + wc * 32 + 8 * fq;
        const bool hb = (u.pn * BM >= bias_col0);
        f32x4 bv[2][2];
#pragma unroll
        for (int bj = 0; bj < 2; ++bj)
#pragma unroll
            for (int n = 0; n < 2; ++n) bv[bj][n] = hb ? *(const f32x4*)(bias + (col0 - bias_col0) + bj * HALF + 4 * n) : (f32x4){0.f, 0.f, 0.f, 0.f};
#pragma unroll
        for (int ai = 0; ai < 2; ++ai)
#pragma unroll
            for (int m = 0; m < 4; ++m) { bf16_t* rowp = O + (size_t)(row0 + ai * HALF + m * 16) * ldc + col0;
#pragma unroll
                for (int bj = 0; bj < 2; ++bj) { const f32x4 v0 = acc[ai][bj][m][0] + bv[bj][0], v1 = acc[ai][bj][m][1] + bv[bj][1];
                    u32x4 w; w.x = cvt_pk_bf16(v0[0], v0[1]); w.y = cvt_pk_bf16(v0[2], v0[3]); w.z = cvt_pk_bf16(v1[0], v1[1]); w.w = cvt_pk_bf16(v1[2], v1[3]);
                    *(u32x4*)(rowp + bj * HALF) = w; } }
    }
};
struct EpiResid {
    static constexpr bool PERM = false, MIDK = false;
    const float* src_lat; const float* src_ctx; float* dst_lat; float* dst_ctx; const float* mod; int gate_idx; float gscale; int tile0;
    __device__ __forceinline__ void operator()(const f32x4 (&acc)[2][2][4][2], const Unit& u, int wr, int wc, int fr, int fq) const {
        const RowMap rm = map_row((tile0 + u.pm) * BM);
        const float* src = (rm.is_ctx ? src_ctx : src_lat) + rm.row0 * D; float* dst = (rm.is_ctx ? dst_ctx : dst_lat) + rm.row0 * D;
        const float* gp = mod + (size_t)rm.modrow * (NMOD * D) + gate_idx * D;
        const int rloc = wr * 64 + fr, col0 = u.pn * BM + wc * 32 + 4 * fq;
        f32x4 gv[2][2];
#pragma unroll
        for (int bj = 0; bj < 2; ++bj)
#pragma unroll
            for (int n = 0; n < 2; ++n) gv[bj][n] = *(const f32x4*)(gp + col0 + bj * HALF + n * 16) * gscale;
#pragma unroll
        for (int ai = 0; ai < 2; ++ai)
#pragma unroll
            for (int m = 0; m < 4; ++m) { const size_t ro = (size_t)(rloc + ai * HALF + m * 16) * D + col0;
#pragma unroll
                for (int bj = 0; bj < 2; ++bj)
#pragma unroll
                    for (int n = 0; n < 2; ++n) { const f32x4 x = *(const f32x4*)(src + ro + bj * HALF + n * 16);
                        *(f32x4*)(dst + ro + bj * HALF + n * 16) = x + gv[bj][n] * acc[ai][bj][m][n]; } }
    }
};
struct EpiBranch {
    static constexpr bool PERM = true, MIDK = true;
    bf16_t* P;
    __device__ __forceinline__ u32x4 ld_raw(unsigned off) const { return *(const u32x4*)((const char*)P + (size_t)off * 2u); }
    __device__ __forceinline__ void to_e(const u32x4 w, float (&e)[8]) const {
        float x[8]; unpack8(w, x);
#pragma unroll
        for (int j = 0; j < 8; ++j) { const float v = fminf(fmaxf(x[j], -30.f), 30.f); e[j] = fast_exp2(-v * LOG2E); }
    }
    template <int WHICH> __device__ __forceinline__ void mid(f32x4 (&acc)[2][2][4][2], const Unit& u, int wr, int wc, int fr, int fq) const {
        unsigned base = (unsigned)(u.pm * BM + wr * 64 + fr) * PROJ + (unsigned)(u.pn * BM + wc * 32 + 8 * fq) + OFF_GATE + WHICH * D;
        asm volatile("" : "+v"(base));
#pragma unroll
        for (int ai = 0; ai < 2; ++ai)
#pragma unroll
            for (int mp = 0; mp < 2; ++mp) {
                u32x4 wa[2][2], wb[2][2];
#pragma unroll
                for (int mm = 0; mm < 2; ++mm)
#pragma unroll
                    for (int bj = 0; bj < 2; ++bj) { const unsigned o = base + (unsigned)(ai * HALF + (mp * 2 + mm) * 16) * PROJ + bj * HALF; wa[mm][bj] = ld_raw(o); wb[mm][bj] = ld_raw(o + D); }
                __builtin_amdgcn_sched_barrier(0);
#pragma unroll
                for (int mm = 0; mm < 2; ++mm)
#pragma unroll
                    for (int bj = 0; bj < 2; ++bj) { float ea[8], eb[8]; to_e(wa[mm][bj], ea); to_e(wb[mm][bj], eb);
#pragma unroll
                        for (int n = 0; n < 2; ++n)
#pragma unroll
                            for (int j = 0; j < 4; ++j) acc[ai][bj][mp * 2 + mm][n][j] *= (1.0f + eb[n * 4 + j]) * fast_rcp(1.0f + ea[n * 4 + j]); }
                __builtin_amdgcn_sched_barrier(0);
            }
    }
    __device__ __forceinline__ void operator()(const f32x4 (&acc)[2][2][4][2], const Unit& u, int wr, int wc, int fr, int fq) const {
        unsigned base = (unsigned)(u.pm * BM + wr * 64 + fr) * PROJ + (unsigned)(u.pn * BM + wc * 32 + 8 * fq);
        asm volatile("" : "+v"(base));
#pragma unroll
        for (int ai = 0; ai < 2; ++ai) {
            u32x4 w2[4][2];
#pragma unroll
            for (int m = 0; m < 4; ++m)
#pragma unroll
                for (int bj = 0; bj < 2; ++bj) w2[m][bj] = ld_raw(base + (unsigned)(ai * HALF + m * 16) * PROJ + bj * HALF + OFF_GATE + 2 * D);
            __builtin_amdgcn_sched_barrier(0);
#pragma unroll
            for (int m = 0; m < 4; ++m)
#pragma unroll
                for (int bj = 0; bj < 2; ++bj) { const unsigned o = base + (unsigned)(ai * HALF + m * 16) * PROJ + bj * HALF;
                    float e2[8], ov[8]; to_e(w2[m][bj], e2);
#pragma unroll
                    for (int n = 0; n < 2; ++n)
#pragma unroll
                        for (int j = 0; j < 4; ++j) ov[n * 4 + j] = acc[ai][bj][m][n][j] * fast_rcp(1.0f + e2[n * 4 + j]);
                    *(u32x4*)((char*)P + (size_t)o * 2u) = pack8(ov); }
            __builtin_amdgcn_sched_barrier(0);
        }
    }
};
}

__device__ __forceinline__ void tr_tile(LAS float* tl, const float* src, int ld_src, int k0, int c0, bf16_t* dst, int ld_dst, int n0, int dk0) {
    const int tid = tid_opaque();
    { const int n = tid & 63, kk = tid >> 6;
#pragma unroll
      for (int i = 0; i < 8; ++i) { const int k = kk + 8 * i; tl[k * 65 + n] = src[(size_t)(k0 + k) * ld_src + c0 + n]; } }
    __syncthreads();
    { const int k2 = (tid & 31) * 2, nn = tid >> 5;
#pragma unroll
      for (int i = 0; i < 4; ++i) { const int n = nn + 16 * i; *(unsigned*)(dst + (size_t)(n0 + n) * ld_dst + dk0 + k2) = cvt_pk_bf16(tl[k2 * 65 + n], tl[(k2 + 1) * 65 + n]); } }
    __syncthreads();
}
__device__ __forceinline__ void tr_job(LAS float* tl, const float* src, int ld_src, int K, int Nout, bf16_t* dst, int ld_dst, int dkofs, int mode) {
    const int nkt = K / 64, ntl = nkt * (Nout / 64);
    for (int t = bid_opaque(); t < ntl; t += gridDim.x) {
        const int kt = t % nkt, ntile = t / nkt, n0 = ntile * 64;
        int c0 = n0;
        if (mode == 1) { const int pn = n0 >> 8, r = n0 & 255; c0 = (r < 128) ? pn * 128 + r : DFF + pn * 128 + (r - 128); }
        tr_tile(tl, src, ld_src, kt * 64, c0, dst, ld_dst, n0, dkofs + kt * 64);
    }
}

__device__ void phase_setup(const Params& p, LAS unsigned char* lds) {
    const int tid = tid_opaque(), wid = tid >> 6, lane = tid & 63;
    bf16_t* WT = (bf16_t*)(p.ws + WS_WT);
    LAS float* tl = (LAS float*)lds;
    for (int l = 0; l < NL; ++l) {
        bf16_t* W = WT + (size_t)l * W_LAYER;
        for (int j = 0; j < 2; ++j) {
            tr_job(tl, p.in[I_FFNIN] + ((size_t)l * 2 + j) * D * (2 * DFF), 2 * DFF, D, 2 * DFF, W + (j ? W_FIN1 : W_FIN0), D, 0, 1);
            tr_job(tl, p.in[I_FFNOUT] + ((size_t)l * 2 + j) * DFF * D, D, DFF, D, W + (j ? W_FOUT1 : W_FOUT0), DFF, 0, 0);
        }
        tr_job(tl, p.in[I_WIN] + (size_t)l * D * PROJ, PROJ, D, PROJ, W + W_WIN, D, 0, 0);
        tr_job(tl, p.in[I_WBC] + (size_t)l * 256 * D, D, 256, D, W + W_WB, D, 0, 0);
        tr_job(tl, p.in[I_WBG] + (size_t)l * 256 * D, D, 256, D, W + W_WB, D, 256, 0);
        tr_job(tl, p.in[I_WBA] + (size_t)l * 512 * D, D, 512, D, W + W_WB, D, 512, 0);
        tr_job(tl, p.in[I_WOUT] + (size_t)l * D * D, D, D, D, W + W_WO, D, 0, 0);
        for (int i = bid_opaque() * 512 + tid; i < 65536 / 2; i += gridDim.x * 512) {
            const float2 v = *(const float2*)(p.in[I_GWS] + (size_t)l * 65536 + 2 * i);
            *(unsigned*)(W + W_GWS + 2 * i) = cvt_pk_bf16(v.x, v.y);
        }
    }
    { const int gi = bid_opaque() * 512 + tid;
      if (gi < 1024) { const int pos = gi >> 4, i = gi & 15;
        const int i4 = i & 3, i16 = i >> 2;
        float inv = (i4 == 0) ? 1.0f : (i4 == 1) ? 0.5623413251903491f : (i4 == 2) ? 0.31622776601683794f : 0.1778279410038923f;
        inv *= (i16 == 0) ? 1.0f : (i16 == 1) ? 0.1f : (i16 == 2) ? 0.01f : 0.001f;
        const float a = (float)pos * inv;
        const float kq = __builtin_rintf(a * 0.6366197723675814f);
        float r = __builtin_fmaf(-kq, 1.5707963705062866f, a); r = __builtin_fmaf(kq, 4.371139000186241e-8f, r);
        const float r2 = r * r;
        const float sn = r * (1.0f + r2 * (-1.0f / 6 + r2 * (1.0f / 120 + r2 * (-1.0f / 5040 + r2 * (1.0f / 362880)))));
        const float cs = 1.0f + r2 * (-0.5f + r2 * (1.0f / 24 + r2 * (-1.0f / 720 + r2 * (1.0f / 40320 + r2 * (-1.0f / 3628800)))));
        const int q = ((int)kq) & 3;
        const float c = (q == 0) ? cs : (q == 1) ? -sn : (q == 2) ? -cs : sn;
        const float s = (q == 0) ? sn : (q == 1) ? cs : (q == 2) ? -sn : -cs;
        float2* rt = (float2*)(p.ws + WS_ROPE); rt[gi] = make_float2(c, s); } }
    if (bid_opaque() < NL * 36) {
        LAS float* sc = (LAS float*)lds;
        __syncthreads();
        for (int i = tid; i < 33 * D; i += 512) { const int r = i >> 10, k = i & 1023; const float v = (r < 32) ? p.in[I_C][r * D + k] : p.in[I_CCTX][k]; sc[i] = siluf_(v); }
        __syncthreads();
        float* MOD = (float*)(p.ws + WS_MOD);
        for (int it = bid_opaque(); it < NL * 36; it += gridDim.x) {
            const int l = it / 36, cgp = it % 36, n0 = cgp * 256 + lane * 4;
            const float* wp = p.in[I_WMOD] + (size_t)l * D * (NMOD * D) + n0;
            f32x4 a[5];
#pragma unroll
            for (int i = 0; i < 5; ++i) a[i] = (f32x4){0.f, 0.f, 0.f, 0.f};
            for (int k = 0; k < D; k += 4) {
                f32x4 w[4];
#pragma unroll
                for (int kk = 0; kk < 4; ++kk) w[kk] = *(const f32x4*)(wp + (size_t)(k + kk) * (NMOD * D));
#pragma unroll
                for (int i = 0; i < 5; ++i) { const int r = (i < 4) ? wid + 8 * i : 32; const f32x4 s = *(const LAS f32x4*)(sc + r * D + k);
                    a[i] += s[0] * w[0] + s[1] * w[1] + s[2] * w[2] + s[3] * w[3]; }
            }
            const f32x4 bv = *(const f32x4*)(p.in[I_BMOD] + (size_t)l * (NMOD * D) + n0);
#pragma unroll
            for (int i = 0; i < 5; ++i) { const int r = (i < 4) ? wid + 8 * i : 32; if (i < 4 || wid == 0) *(f32x4*)(MOD + ((size_t)l * 33 + r) * (NMOD * D) + n0) = a[i] + bv; }
        }
        __syncthreads();
    }
}

__device__ void phase_norm(const Params& p, int l, int j, const float* hl, const float* hc) {
    const int tid = tid_opaque(), wid = tid >> 6, lane = tid & 63;
    bf16_t* A = (bf16_t*)(p.ws + WS_A);
    const float* MOD = (const float*)(p.ws + WS_MOD) + (size_t)l * 33 * (NMOD * D);
    const float* ng = p.in[I_NORMG] + ((size_t)l * 3 + j) * D;
    for (int u = bid_opaque() * 8 + wid; u < T_ALL; u += gridDim.x * 8) {
        const RowMap rm = map_row(u);
        const float* x = (rm.is_ctx ? hc : hl) + rm.row0 * D;
        const float* sh = MOD + (size_t)rm.modrow * (NMOD * D) + (3 * j) * D; const float* sc = sh + D;
        f32x4 v[4]; float ss = 0.f;
#pragma unroll
        for (int i = 0; i < 4; ++i) { v[i] = *(const f32x4*)(x + i * 256 + lane * 4); ss += v[i][0] * v[i][0] + v[i][1] * v[i][1] + v[i][2] * v[i][2] + v[i][3] * v[i][3]; }
        ss = wave_sum(ss);
        const float rstd = rsqrtf(ss * (1.0f / D) + EPS);
#pragma unroll
        for (int i = 0; i < 4; ++i) { const int k = i * 256 + lane * 4;
            const f32x4 g = *(const f32x4*)(ng + k), s1 = *(const f32x4*)(sc + k), s0 = *(const f32x4*)(sh + k);
            const f32x4 y = v[i] * rstd * g * (s1 + 1.0f) + s0;
            u32x2 w; w.x = cvt_pk_bf16(y[0], y[1]); w.y = cvt_pk_bf16(y[2], y[3]);
            *(u32x2*)(A + (size_t)u * D + k) = w; }
    }
}

__device__ void phase_prep(const Params& p, int l, LAS unsigned char* lds) {
    const int tid = tid_opaque(), wid = tid >> 6, lane = tid & 63;
    bf16_t* P = (bf16_t*)(p.ws + WS_R1);
    bf16_t* VTL = (bf16_t*)(p.ws + WS_VTL); bf16_t* VTC = (bf16_t*)(p.ws + WS_VTC);
    const float* qg = p.in[I_QG] + l * 64; const float* kg = p.in[I_KG] + l * 64;
    LAS bf16_t* Vs = (LAS bf16_t*)lds;
    const LAS f32x2* rts = (const LAS f32x2*)(lds + 20480);
    __syncthreads();
    *(LAS u32x4*)(lds + 20480 + tid * 16) = *(const u32x4*)(p.ws + WS_ROPE + tid * 16);
    __syncthreads();
    const int c = lane & 7, seg = c >> 2, hf = (c >> 1) & 1, i0 = (c & 1) * 8;
    float gq[8], gk[8];
#pragma unroll
    for (int e = 0; e < 8; ++e) { gq[e] = qg[8 * c + e]; gk[e] = kg[8 * c + e]; }
    for (int it = bid_opaque(); it < TH / 64; it += gridDim.x) {
        const int v0 = it * 64; const bool lat = v0 < H_LAT;
        const int prow = (v0 & (SEQ - 1)) >> 6;
        bf16_t* rowb = P + (size_t)(v0 + wid * 8) * PROJ;
        const int qoff = OFF_Q + (lane >> 3) * 64 + 8 * c, koff = OFF_K + ((lane >> 3) & 1) * 64 + 8 * c;
        u32x4 qr[8], kr[8]; unsigned vr[8];
#pragma unroll
        for (int i = 0; i < 8; ++i) { const bf16_t* rp = rowb + (size_t)i * PROJ; qr[i] = *(const u32x4*)(rp + qoff); kr[i] = *(const u32x4*)(rp + koff); vr[i] = *(const unsigned*)(rp + OFF_V + 2 * lane); }
#pragma unroll
        for (int i = 0; i < 8; ++i) {
            const int rl = wid * 8 + i;
            bf16_t* rowp = rowb + (size_t)i * PROJ;
            const int pp = seg ? rl : prow;
            float cs[8], sn[8];
#pragma unroll
            for (int e = 0; e < 8; ++e) { const f32x2 t2 = rts[pp * 16 + i0 + e]; cs[e] = lat ? t2[0] : 1.0f; sn[e] = lat ? t2[1] : 0.0f; }
            { float x[8]; unpack8(qr[i], x);
              float ss = 0.f;
#pragma unroll
              for (int e = 0; e < 8; ++e) ss += x[e] * x[e];
              ss += __shfl_xor(ss, 1); ss += __shfl_xor(ss, 2); ss += __shfl_xor(ss, 4);
              const float rstd = rsqrtf(ss * (1.0f / 64) + EPS); float o[8];
#pragma unroll
              for (int e = 0; e < 8; ++e) { const float y = x[e] * rstd * gq[e]; const float yp = __shfl_xor(y, 2);
                  o[e] = (hf ? (y * cs[e] + yp * sn[e]) : (y * cs[e] - yp * sn[e])) * (0.125f * LOG2E); }
              *(u32x4*)(rowp + qoff) = pack8(o); }
            { float x[8]; unpack8(kr[i], x);
              float ss = 0.f;
#pragma unroll
              for (int e = 0; e < 8; ++e) ss += x[e] * x[e];
              ss += __shfl_xor(ss, 1); ss += __shfl_xor(ss, 2); ss += __shfl_xor(ss, 4);
              const float rstd = rsqrtf(ss * (1.0f / 64) + EPS); float o[8];
#pragma unroll
              for (int e = 0; e < 8; ++e) { const float y = x[e] * rstd * gk[e]; const float yp = __shfl_xor(y, 2);
                  o[e] = hf ? (y * cs[e] + yp * sn[e]) : (y * cs[e] - yp * sn[e]); }
              if (lane < 16) *(u32x4*)(rowp + koff) = pack8(o); }
            { const unsigned w = vr[i];
              Vs[(2 * lane) * 72 + rl] = (bf16_t)(w & 0xffffu); Vs[(2 * lane + 1) * 72 + rl] = (bf16_t)(w >> 16); }
        }
        __syncthreads();
        { const int hd = tid >> 2, ch = tid & 3;
          bf16_t* dst;
          if (lat) { const int bl = v0 >> 11, pos0 = v0 & (SEQ - 1); dst = VTL + ((size_t)bl * 128 + hd) * SEQ + pos0 + ch * 16; }
          else { const int cv = v0 - H_LAT, bl = cv >> 8, pos0 = cv & 255; dst = VTC + ((size_t)bl * 128 + hd) * CTXL + pos0 + ch * 16; }
          const u32x4 a = *(const LAS u32x4*)(Vs + hd * 72 + ch * 16), b = *(const LAS u32x4*)(Vs + hd * 72 + ch * 16 + 8);
          *(u32x4*)dst = a; *(u32x4*)(dst + 8) = b; }
        __syncthreads();
    }
}

struct KeySeg { const bf16_t* K; const bf16_t* Vt; int vstride; int ntiles; int mask; };

__device__ __forceinline__ void attn_item(const Params& p, int l, int hs, int idx) {
    const int tid = tid_opaque(), wid = tid >> 6, lane = tid & 63, fr = lane & 15, fq = lane >> 4;
    const bf16_t* P = (const bf16_t*)(p.ws + WS_R1);
    const bf16_t* VTL = (const bf16_t*)(p.ws + WS_VTL); const bf16_t* VTC = (const bf16_t*)(p.ws + WS_VTC);
    bf16_t* Y = (bf16_t*)(p.ws + WS_A) + (size_t)hs * TH * D;
    int bl, qb, hk; bool lat;
    if (idx < 512) { lat = true; bl = idx >> 5; qb = (idx >> 1) & 15; hk = idx & 1; }
    else { const int j = idx - 512; lat = false; bl = j >> 2; qb = (j >> 1) & 1; hk = j & 1; }
    const int g = wid >> 1, r0 = (wid & 1) * 64, head = hk * 4 + g;
    const int qrow0 = lat ? bl * SEQ + qb * 128 : H_LAT + bl * CTXL + qb * 128;
    const int crow0 = H_LAT + bl * CTXL;
    const bf16_t* vtc = VTC + ((size_t)bl * 2 + hk) * 64 * CTXL;
    const bf16_t* vtl = VTL + ((size_t)bl * 2 + hk) * 64 * SEQ;
    bf16x8 qf[4][2];
    { const bf16_t* qp = P + (size_t)(qrow0 + r0 + fr) * PROJ + OFF_Q + head * 64 + fq * 8;
#pragma unroll
      for (int nq = 0; nq < 4; ++nq)
#pragma unroll
          for (int ks = 0; ks < 2; ++ks) qf[nq][ks] = *(const bf16x8*)(qp + (size_t)nq * 16 * PROJ + ks * 32); }
    f32x4 o[4][4];
#pragma unroll
    for (int a = 0; a < 4; ++a)
#pragma unroll
        for (int b = 0; b < 4; ++b) o[a][b] = (f32x4){0.f, 0.f, 0.f, 0.f};
    const float snk = p.in[I_SINK][l * 8 + head] * LOG2E;
    float mrun[4], lrun[4];
#pragma unroll
    for (int nq = 0; nq < 4; ++nq) { mrun[nq] = snk; lrun[nq] = (fq == 0) ? 1.0f : 0.0f; }

    for (int sg = 0; sg < 4; ++sg) {
        int ntile, mask, t_lo = 0, vstride; const bf16_t* kb_; const bf16_t* vb_;
        if (sg < 3) {
            if (!lat) continue;
            const int kb = qb + sg - 1; if (kb < 0 || kb > 15) continue;
            kb_ = P + (size_t)(bl * SEQ + kb * 128) * PROJ + OFF_K + hk * 64; vb_ = vtl + kb * 128; vstride = SEQ; ntile = 4; mask = (sg == 0) ? 1 : (sg == 2) ? 2 : 0;
            if (sg == 0) t_lo = (r0 == 64) ? 2 : 0;
            if (sg == 2) ntile = (r0 == 0) ? 2 : 4;
        } else { kb_ = P + (size_t)crow0 * PROJ + OFF_K + hk * 64; vb_ = vtc; vstride = CTXL; ntile = 8; mask = 0; }
        for (int tt = t_lo; tt < ntile; ++tt) {
            const int t0 = tt * 32;
            bf16x8 kf[2][2];
            { const bf16_t* kp = kb_ + (size_t)(t0 + fr) * PROJ + fq * 8;
#pragma unroll
              for (int kb = 0; kb < 2; ++kb)
#pragma unroll
                  for (int ks = 0; ks < 2; ++ks) kf[kb][ks] = *(const bf16x8*)(kp + (size_t)kb * 16 * PROJ + ks * 32); }
            bf16x8 vf[4];
            { const bf16_t* vp = vb_ + (size_t)fr * vstride + t0 + fq * 4;
#pragma unroll
              for (int db = 0; db < 4; ++db) { const bf16x4 lo = *(const bf16x4*)(vp + (size_t)db * 16 * vstride), hi = *(const bf16x4*)(vp + (size_t)db * 16 * vstride + 16);
                  vf[db] = (bf16x8){lo[0], lo[1], lo[2], lo[3], hi[0], hi[1], hi[2], hi[3]}; } }
            f32x4 s[2][4];
#pragma unroll
            for (int kb = 0; kb < 2; ++kb)
#pragma unroll
                for (int nq = 0; nq < 4; ++nq) {
                    s[kb][nq] = __builtin_amdgcn_mfma_f32_16x16x32_bf16(kf[kb][0], qf[nq][0], (f32x4){0.f, 0.f, 0.f, 0.f}, 0, 0, 0);
                    s[kb][nq] = __builtin_amdgcn_mfma_f32_16x16x32_bf16(kf[kb][1], qf[nq][1], s[kb][nq], 0, 0, 0);
                }
            if (mask) {
#pragma unroll
                for (int kb = 0; kb < 2; ++kb)
#pragma unroll
                    for (int nq = 0; nq < 4; ++nq)
#pragma unroll
                        for (int j = 0; j < 4; ++j) { const int t = t0 + kb * 16 + fq * 4 + j, r = r0 + nq * 16 + fr;
                            const bool ok = (mask == 1) ? (t >= r) : (t <= r); if (!ok) s[kb][nq][j] = -1e30f; }
            }
            bf16x8 pf[4];
#pragma unroll
            for (int nq = 0; nq < 4; ++nq) {
                float mx = fmaxf(fmaxf(fmaxf(s[0][nq][0], s[0][nq][1]), fmaxf(s[0][nq][2], s[0][nq][3])), fmaxf(fmaxf(s[1][nq][0], s[1][nq][1]), fmaxf(s[1][nq][2], s[1][nq][3])));
                mx = fmaxf(mx, __shfl_xor(mx, 16)); mx = fmaxf(mx, __shfl_xor(mx, 32));
                const float mn = fmaxf(mrun[nq], mx), alpha = fast_exp2(mrun[nq] - mn); mrun[nq] = mn;
                float pv[8], ps = 0.f;
#pragma unroll
                for (int j = 0; j < 4; ++j) { pv[j] = fast_exp2(s[0][nq][j] - mn); pv[4 + j] = fast_exp2(s[1][nq][j] - mn); ps += pv[j] + pv[4 + j]; }
                lrun[nq] = lrun[nq] * alpha + ps;
                const u32x4 w = pack8(pv); pf[nq] = *(const bf16x8*)&w;
#pragma unroll
                for (int db = 0; db < 4; ++db) o[db][nq] *= alpha;
            }
#pragma unroll
            for (int db = 0; db < 4; ++db)
#pragma unroll
                for (int nq = 0; nq < 4; ++nq) o[db][nq] = __builtin_amdgcn_mfma_f32_16x16x32_bf16(vf[db], pf[nq], o[db][nq], 0, 0, 0);
        }
    }
#pragma unroll
    for (int nq = 0; nq < 4; ++nq) {
        float lt = lrun[nq]; lt += __shfl_xor(lt, 16); lt += __shfl_xor(lt, 32);
        const float inv = 1.0f / lt;
        bf16_t* yp = Y + (size_t)(qrow0 + r0 + nq * 16 + fr) * D + 512 + head * 64 + fq * 4;
#pragma unroll
        for (int db = 0; db < 4; ++db) { u32x2 w; w.x = cvt_pk_bf16(o[db][nq][0] * inv, o[db][nq][1] * inv); w.y = cvt_pk_bf16(o[db][nq][2] * inv, o[db][nq][3] * inv);
            *(u32x2*)(yp + db * 16) = w; }
    }
}

__device__ __forceinline__ void gmlp_conv_item(const Params& p, int l, int hs, int chunk, LAS unsigned char* lds) {
    const int tid = tid_opaque(), wid = tid >> 6, lane = tid & 63, fr = lane & 15, fq = lane >> 4;
    const bf16_t* P = (const bf16_t*)(p.ws + WS_R1);
    bf16_t* Y = (bf16_t*)(p.ws + WS_A) + (size_t)hs * TH * D;
    const int v0 = chunk * 128;
    LAS bf16_t* vT = (LAS bf16_t*)lds;
    { const float* cw = p.in[I_CONVW] + (size_t)l * 3 * 256;
      const bool lat = v0 < H_LAT;
#pragma unroll 2
      for (int i = 0; i < 8; ++i) {
          const int id = i * 512 + tid, pt = id >> 5, cc = (id & 31) * 8, v = v0 + pt;
          const int pos = lat ? (v & (SEQ - 1)) : ((v - H_LAT) & (CTXL - 1)), n = lat ? SEQ : CTXL;
          const bf16_t* rp = P + (size_t)v * PROJ + cc;
          float bv[8], c1[8], h1[8], acc[8];
          unpack8(*(const u32x4*)(rp + OFF_CB), bv); unpack8(*(const u32x4*)(rp + OFF_CC), c1); unpack8(*(const u32x4*)(rp + OFF_CH), h1);
          { const f32x4 wa = *(const f32x4*)(cw + 256 + cc), wb = *(const f32x4*)(cw + 256 + cc + 4);
#pragma unroll
            for (int e = 0; e < 8; ++e) acc[e] = c1[e] * h1[e] * (e < 4 ? wa[e & 3] : wb[e & 3]); }
          if (pos > 0) { float c0[8], h0[8]; unpack8(*(const u32x4*)(rp - PROJ + OFF_CC), c0); unpack8(*(const u32x4*)(rp - PROJ + OFF_CH), h0);
              const f32x4 wa = *(const f32x4*)(cw + cc), wb = *(const f32x4*)(cw + cc + 4);
#pragma unroll
              for (int e = 0; e < 8; ++e) acc[e] += c0[e] * h0[e] * (e < 4 ? wa[e & 3] : wb[e & 3]); }
          if (pos < n - 1) { float c2[8], h2[8]; unpack8(*(const u32x4*)(rp + PROJ + OFF_CC), c2); unpack8(*(const u32x4*)(rp + PROJ + OFF_CH), h2);
              const f32x4 wa = *(const f32x4*)(cw + 512 + cc), wb = *(const f32x4*)(cw + 512 + cc + 4);
#pragma unroll
              for (int e = 0; e < 8; ++e) acc[e] += c2[e] * h2[e] * (e < 4 ? wa[e & 3] : wb[e & 3]); }
#pragma unroll
          for (int e = 0; e < 8; ++e) acc[e] *= bv[e];
          *(u32x4*)(Y + (size_t)v * D + cc) = pack8(acc);
      } }
    { const float* lg = p.in[I_LNG] + l * 256 + 4 * lane; const float* lb = p.in[I_LNB] + l * 256 + 4 * lane;
      const f32x4 g4 = *(const f32x4*)lg, b4 = *(const f32x4*)lb;
      for (int i = 0; i < 16; ++i) {
          const int pt = wid * 16 + i;
          const u32x2 w = *(const u32x2*)(P + (size_t)(v0 + pt) * PROJ + OFF_GV + 4 * lane);
          float x[4] = {gelu_tanh(bf_lo(w.x)), gelu_tanh(bf_hi(w.x)), gelu_tanh(bf_lo(w.y)), gelu_tanh(bf_hi(w.y))};
          const float mu = wave_sum(x[0] + x[1] + x[2] + x[3]) * (1.0f / 256);
          float q = 0.f;
#pragma unroll
          for (int e = 0; e < 4; ++e) { x[e] -= mu; q += x[e] * x[e]; }
          const float rstd = rsqrtf(wave_sum(q) * (1.0f / 256) + EPS);
#pragma unroll
          for (int e = 0; e < 4; ++e) { const float y = x[e] * rstd * g4[e] + b4[e]; vT[(4 * lane + e) * 136 + pt] = (bf16_t)(cvt_pk_bf16(y, 0.f) & 0xffffu); }
      } }
    __syncthreads();
    { const int g = wid >> 1, ph = wid & 1;
      const bf16_t* wsb = (const bf16_t*)(p.ws + WS_WT) + (size_t)l * W_LAYER + W_GWS + (size_t)g * 128 * 128;
      f32x4 acc[4][4];
#pragma unroll
      for (int a = 0; a < 4; ++a)
#pragma unroll
          for (int b = 0; b < 4; ++b) acc[a][b] = (f32x4){0.f, 0.f, 0.f, 0.f};
#pragma unroll
      for (int kk = 0; kk < 4; ++kk) {
          bf16x8 af[4], bfr[4];
#pragma unroll
          for (int db = 0; db < 4; ++db) af[db] = *(const LAS bf16x8*)(vT + (g * 64 + db * 16 + fr) * 136 + kk * 32 + fq * 8);
#pragma unroll
          for (int pb = 0; pb < 4; ++pb) bfr[pb] = *(const bf16x8*)(wsb + (size_t)((ph * 4 + pb) * 16 + fr) * 128 + kk * 32 + fq * 8);
#pragma unroll
          for (int db = 0; db < 4; ++db)
#pragma unroll
              for (int pb = 0; pb < 4; ++pb) acc[db][pb] = __builtin_amdgcn_mfma_f32_16x16x32_bf16(af[db], bfr[pb], acc[db][pb], 0, 0, 0);
      }
      const float* bs = p.in[I_GBS] + (size_t)l * 512 + g * 128;
#pragma unroll
      for (int pb = 0; pb < 4; ++pb) { const int pt = (ph * 4 + pb) * 16 + fr; const float bias = bs[pt];
          const bf16_t* up = P + (size_t)(v0 + pt) * PROJ + OFF_GU + g * 64 + fq * 4;
          bf16_t* yp = Y + (size_t)(v0 + pt) * D + 256 + g * 64 + fq * 4;
#pragma unroll
          for (int db = 0; db < 4; ++db) { const u32x2 w = *(const u32x2*)(up + db * 16);
              const float y0 = gelu_tanh(bf_lo(w.x)) * (acc[db][pb][0] + bias), y1 = gelu_tanh(bf_hi(w.x)) * (acc[db][pb][1] + bias);
              const float y2 = gelu_tanh(bf_lo(w.y)) * (acc[db][pb][2] + bias), y3 = gelu_tanh(bf_hi(w.y)) * (acc[db][pb][3] + bias);
              u32x2 ov; ov.x = cvt_pk_bf16(y0, y1); ov.y = cvt_pk_bf16(y2, y3); *(u32x2*)(yp + db * 16) = ov; } } }
    __syncthreads();
}

__device__ void phase_mixers(const Params& p, int l, int hs, LAS unsigned char* lds) {
#ifndef SKIP_ATTN
    for (int it = bid_opaque(); it < 576; it += gridDim.x) attn_item(p, l, hs, it);
#endif
    __builtin_amdgcn_sched_barrier(0);
#ifndef SKIP_GMLP
    for (int it = (bid_opaque() + (int)gridDim.x - 64) % (int)gridDim.x; it < 288; it += gridDim.x) gmlp_conv_item(p, l, hs, it, lds);
#endif
}

#define XB_TMO      128
#define XB_XCNT(j)  (256  + 64 * (j))
#define XB_XSUB(j)  (1280 + 64 * (j))
#define XB_XGEN(j)  (2304 + 64 * (j))
#define XB_TOP      3328
#define XB_TOPGEN   3392
#define XCD_BAR_WORDS 3456
#define XB_SPIN_CAP (1u << 22)
__device__ __forceinline__ unsigned xb_ld(unsigned* p)              { return __hip_atomic_load(p, __ATOMIC_RELAXED, __HIP_MEMORY_SCOPE_AGENT); }
__device__ __forceinline__ unsigned xb_add(unsigned* p, unsigned v) { return __hip_atomic_fetch_add(p, v, __ATOMIC_RELAXED, __HIP_MEMORY_SCOPE_AGENT); }
__device__ __forceinline__ unsigned xb_xcc_id() { return (unsigned)__builtin_amdgcn_s_getreg((3 << 11) | 20) & 0xFu; }
#define XB_SPIN(cond, bar) do { unsigned _sp = 0; while (cond) { __builtin_amdgcn_s_sleep(1); \
    if ((++_sp & 255u) == 0u) { if (xb_ld(&(bar)[XB_TMO])) break; if (_sp > XB_SPIN_CAP) { atomicAdd(&(bar)[XB_TMO], 1u); break; } } } } while (0)
__device__ __forceinline__ void xcd_barrier_post(unsigned* bar) { if (threadIdx.x == 0) (void)xb_add(&bar[XB_XCNT(xb_xcc_id())], 1u); }
__device__ __forceinline__ void xcd_barrier_complete(unsigned* bar, unsigned x, unsigned& nloc, unsigned& nx) {
    const unsigned G = gridDim.x * gridDim.y * gridDim.z;
    unsigned sum, cnt, mine, sp = 0u;
    for (;;) {
        sum = 0u; cnt = 0u; mine = 0u;
#pragma unroll
        for (unsigned j = 0; j < 16; ++j) { const unsigned c = xb_ld(&bar[XB_XCNT(j)]); sum += c; cnt += (c > 0u) ? 1u : 0u; mine = (j == x) ? c : mine; }
        if (sum == G) break;
        __builtin_amdgcn_s_sleep(1);
        if ((++sp & 255u) == 0u) { if (xb_ld(&bar[XB_TMO])) break; if (sp > XB_SPIN_CAP) { atomicAdd(&bar[XB_TMO], 1u); break; } }
    }
    nloc = mine > 0u ? mine : 1u; nx = cnt > 0u ? cnt : 1u;
}
__device__ __forceinline__ void xcd_barrier(unsigned* bar, volatile LAS unsigned* st) {
    asm volatile("s_waitcnt vmcnt(0)" ::: "memory");
    __syncthreads();
    if (threadIdx.x == 0) {
        const unsigned x = xb_xcc_id();
        __builtin_amdgcn_s_waitcnt(0);
        unsigned nloc = st[0], nx = st[1];
        if (nloc == 0u) { xcd_barrier_complete(bar, x, nloc, nx); st[0] = nloc; st[1] = nx; }
        const unsigned old = xb_add(&bar[XB_XSUB(x)], 1u);
        const unsigned gen = old / nloc;
        if (old + 1u == (gen + 1u) * nloc) {
            __builtin_amdgcn_fence(__ATOMIC_RELEASE, "agent");
            asm volatile("s_waitcnt vmcnt(0)" ::: "memory");
            const unsigned og = xb_add(&bar[XB_TOP], 1u);
            const unsigned tg = og / nx;
            if (og + 1u == (tg + 1u) * nx) xb_add(&bar[XB_TOPGEN], 1u);
            else XB_SPIN(xb_ld(&bar[XB_TOPGEN]) == tg, bar);
            __builtin_amdgcn_fence(__ATOMIC_ACQUIRE, "agent");
            xb_add(&bar[XB_XGEN(x)], 1u);
            asm volatile("s_waitcnt vmcnt(0)" ::: "memory");
        } else {
            XB_SPIN(xb_ld(&bar[XB_XGEN(x)]) == gen, bar);
            __builtin_amdgcn_fence(__ATOMIC_ACQUIRE, "agent");
            asm volatile("s_waitcnt vmcnt(0)" ::: "memory");
        }
    }
    __syncthreads();
}

__device__ void run_phase(const Params& p, int ph, LAS unsigned char* lds) {
    if (ph == 0) {
#ifndef SKIP_SETUP
 phase_setup(p, lds);
#endif
 return; }
    const int q = ph - 1, l = q / 17, r = q % 17;
    const bf16_t* W = (const bf16_t*)(p.ws + WS_WT) + (size_t)l * W_LAYER;
    const float* MOD = (const float*)(p.ws + WS_MOD) + (size_t)l * 33 * (NMOD * D);
    float* hc = (float*)(p.ws + WS_HC);
    const bool first = (l == 0 && r <= 2);
    const float* hl_src = first ? p.in[I_X] : p.out; const float* hc_src = first ? p.in[I_CTX] : hc;
    bf16_t* A = (bf16_t*)(p.ws + WS_A); bf16_t* R1 = (bf16_t*)(p.ws + WS_R1);
    if (r == 0 || r == 3 || r == 14) {
#ifndef SKIP_NORM
 phase_norm(p, l, r == 0 ? 0 : (r == 3 ? 1 : 2), hl_src, hc_src);
#endif
 return; }
    if (r == 1 || r == 15) {
        const int j = (r == 1) ? 0 : 1;
        pg8::Gemm g{A, D, W + (j ? W_FIN1 : W_FIN0), D, T_ALL, 2 * DFF, D};
        pg8::EpiSwiglu E{R1};
#ifndef SKIP_UP
        pg8::gemm_phase(lds, g, E);
#endif
        return;
    }
    if (r == 2 || r == 16) {
        const int j = (r == 2) ? 0 : 1;
        pg8::Gemm g{R1, DFF, W + (j ? W_FOUT1 : W_FOUT0), DFF, T_ALL, D, DFF};
        pg8::EpiResid E{hl_src, hc_src, p.out, hc, MOD, j ? 8 : 2, 0.5f, 0};
#ifndef SKIP_DOWN
        pg8::gemm_phase(lds, g, E);
#endif
        return;
    }
    const int hs = (r - 4) / 5, rr = (r - 4) % 5;
    if (rr == 0) { pg8::Gemm g{A + (size_t)hs * TH * D, D, W + W_WIN, D, TH, PROJ, D}; pg8::EpiBf16 E{R1, PROJ, p.in[I_BGATE] + (size_t)l * 3 * D, OFF_GATE};
#ifndef SKIP_PROJ
 pg8::gemm_phase(lds, g, E);
#endif
 return; }
    if (rr == 1) {
#ifndef SKIP_PREP
 phase_prep(p, l, lds);
#endif
 return; }
    if (rr == 2) {
#ifndef SKIP_MIX
 phase_mixers(p, l, hs, lds);
#endif
 return; }
    if (rr == 3) { pg8::Gemm g{A + (size_t)hs * TH * D, D, W + W_WB, D, TH, D, D}; pg8::EpiBranch E{R1};
#ifndef SKIP_BRANCH
 pg8::gemm_phase(lds, g, E);
#endif
 return; }
    { pg8::Gemm g{R1, PROJ, W + W_WO, D, TH, D, D}; pg8::EpiResid E{p.out, hc, p.out, hc, MOD, 5, 1.0f, hs * TILES_H};
#ifndef SKIP_OUT
 pg8::gemm_phase(lds, g, E);
#endif
 }
}

__global__ __launch_bounds__(512, 2) void fwd_megakernel(Params p) {
    extern __shared__ __attribute__((aligned(16))) unsigned char shm[];
    LAS unsigned char* lds = (LAS unsigned char*)shm;
#if MK_SINGLE
    volatile LAS unsigned* bst = (volatile LAS unsigned*)(lds + LDS_BYTES - 16);
    if (threadIdx.x == 0) { bst[0] = 0u; bst[1] = 0u; }
    __syncthreads();
    xcd_barrier_post((unsigned*)(p.ws + WS_BAR));
#endif
    for (int ph = p.ph_lo; ph < p.ph_hi; ++ph) {
#if defined(__HIP_DEVICE_COMPILE__)
        const __attribute__((address_space(4))) char* kp = (const __attribute__((address_space(4))) char*)__builtin_amdgcn_kernarg_segment_ptr();
        asm volatile("" : "+s"(kp));
        const Params lp = *(const Params*)(const char*)kp;
#else
        const Params lp = p;
#endif
        run_phase(lp, ph, lds);
#if MK_SINGLE
        if (ph + 1 < lp.ph_hi) {
            if (ph == 0) cg::this_grid().sync();
            else xcd_barrier((unsigned*)(lp.ws + WS_BAR), (volatile LAS unsigned*)(lds + LDS_BYTES - 16));
        }
#endif
    }
}

extern "C" void kernel_launch(void* const* d_in, const int* in_sizes, int n_in, void* d_out, int out_size, void* d_ws, size_t ws_size, hipStream_t stream) {
    static int grid = 0;
    if (grid == 0) {
        if (n_in != N_IN || out_size != T_LAT * D || ws_size < WS_END) { fprintf(stderr, "kernel_launch: unexpected shapes (n_in %d out %d ws %zu need %zu)\n", n_in, out_size, ws_size, (size_t)WS_END); grid = -1; return; }
        int dev = 0, cus = 0, per_cu = 0;
        (void)hipGetDevice(&dev); (void)hipDeviceGetAttribute(&cus, hipDeviceAttributeMultiprocessorCount, dev);
        if (hipFuncSetAttribute((const void*)fwd_megakernel, hipFuncAttributeMaxDynamicSharedMemorySize, LDS_BYTES) != hipSuccess) { fprintf(stderr, "kernel_launch: hipFuncSetAttribute failed\n"); grid = -1; return; }
        if (hipOccupancyMaxActiveBlocksPerMultiprocessor(&per_cu, (const void*)fwd_megakernel, 512, LDS_BYTES) != hipSuccess || per_cu < 1) { fprintf(stderr, "kernel_launch: occupancy query gave %d\n", per_cu); per_cu = 1; }
        (void)hipGetLastError();
        grid = cus * per_cu;
    }
    if (grid < 0) return;
    Params p{};
    for (int i = 0; i < N_IN; ++i) p.in[i] = (const float*)d_in[i];
    p.out = (float*)d_out; p.ws = (unsigned char*)d_ws;
#if MK_SINGLE
    p.ph_lo = 0; p.ph_hi = N_PHASES;
    if (hipMemsetAsync((char*)d_ws + WS_BAR, 0, 16384, stream) != hipSuccess) { fprintf(stderr, "kernel_launch: memset of the barrier words failed\n"); return; }
    void* args[] = {&p};
    hipError_t e = hipLaunchCooperativeKernel((const void*)fwd_megakernel, dim3(grid), dim3(512), args, LDS_BYTES, stream);
    if (e != hipSuccess) fprintf(stderr, "cooperative launch failed: %s (grid %d)\n", hipGetErrorString(e), grid);
#else
    for (int ph = 0; ph < N_PHASES; ++ph) {
        p.ph_lo = ph; p.ph_hi = ph + 1;
        hipLaunchKernelGGL(fwd_megakernel, dim3(grid), dim3(512), LDS_BYTES, stream, p);
    }
#endif
}
```

```cpp
#include <hip/hip_runtime.h>
#include <hip/hip_cooperative_groups.h>
#include <cstdio>
namespace cg = cooperative_groups;

#ifndef MK_SINGLE
#define MK_SINGLE 1
#endif

#define LAS __attribute__((address_space(3)))
typedef unsigned short bf16_t;
typedef short bf16x8 __attribute__((ext_vector_type(8)));
typedef short bf16x4 __attribute__((ext_vector_type(4)));
typedef float f32x4 __attribute__((ext_vector_type(4)));
typedef unsigned u32x4 __attribute__((ext_vector_type(4)));
typedef unsigned u32x2 __attribute__((ext_vector_type(2)));
typedef float f32x2 __attribute__((ext_vector_type(2)));

constexpr int D = 1024, NB = 32, SEQ = 2048, NL = 4, CTXL = 256, DFF = 2816, PROJ = 5120, NMOD = 9;
constexpr int T_LAT = NB * SEQ, T_CTX = NB * CTXL, T_ALL = T_LAT + T_CTX;
constexpr int H_LAT = T_LAT / 2, H_CTX = T_CTX / 2, TH = H_LAT + H_CTX;
constexpr int TILES_H = TH / 256, TILES_HL = H_LAT / 256;
constexpr int OFF_CB = 0, OFF_CC = 256, OFF_CH = 512, OFF_GU = 768, OFF_GV = 1024, OFF_Q = 1280, OFF_K = 1792, OFF_V = 1920, OFF_GATE = 2048;
constexpr float EPS = 1e-6f;
constexpr float LOG2E = 1.4426950408889634f;

enum { I_X = 0, I_C, I_CTX, I_CCTX, I_WMOD, I_BMOD, I_NORMG, I_FFNIN, I_FFNOUT, I_WIN, I_BGATE, I_CONVW, I_LNG, I_LNB, I_GWS, I_GBS, I_QG, I_KG, I_SINK, I_WBC, I_WBG, I_WBA, I_WOUT, N_IN };

constexpr size_t W_FIN0 = 0, W_FIN1 = 5767168, W_FOUT0 = 11534336, W_FOUT1 = 14417920, W_WIN = 17301504, W_WB = 22544384, W_WO = 23592960, W_GWS = 24641536, W_LAYER = 24707072;
constexpr size_t WS_WT = 0;
constexpr size_t WS_MOD = WS_WT + NL * W_LAYER * 2;
constexpr size_t WS_ROPE = WS_MOD + (size_t)NL * 33 * 9216 * 4;
constexpr size_t WS_HC = WS_ROPE + 8192;
constexpr size_t WS_A = WS_HC + (size_t)T_CTX * D * 4;
constexpr size_t WS_R1 = WS_A + (size_t)T_ALL * D * 2;
constexpr size_t WS_VTL = WS_R1 + (size_t)T_ALL * DFF * 2;
constexpr size_t WS_VTC = WS_VTL + (size_t)16 * 2 * 64 * 2048 * 2;
constexpr size_t WS_BAR = WS_VTC + (size_t)16 * 2 * 64 * 256 * 2;
constexpr size_t WS_H = WS_BAR + 16384;
constexpr size_t WS_END = WS_H + (size_t)T_ALL * D * 2;

constexpr int LDS_BYTES = 143360;
constexpr int N_PHASES = 1 + 17 * NL;

struct Params {
    const float* in[N_IN];
    float* out;
    unsigned char* ws;
    int ph_lo, ph_hi;
};

__device__ __forceinline__ unsigned cvt_pk_bf16(float lo, float hi) { unsigned r; asm volatile("v_cvt_pk_bf16_f32 %0, %1, %2" : "=v"(r) : "v"(lo), "v"(hi)); return r; }
__device__ __forceinline__ int tid_opaque() { int t = threadIdx.x; asm volatile("" : "+v"(t)); return t; }
__device__ __forceinline__ int bid_opaque() { int b = blockIdx.x; asm volatile("" : "+s"(b)); return b; }
__device__ __forceinline__ float bf_lo(unsigned w) { return __uint_as_float(w << 16); }
__device__ __forceinline__ float bf_hi(unsigned w) { return __uint_as_float(w & 0xffff0000u); }
__device__ __forceinline__ float fast_rcp(float x) { return __builtin_amdgcn_rcpf(x); }
__device__ __forceinline__ float fast_exp2(float x) { return __builtin_amdgcn_exp2f(x); }
__device__ __forceinline__ float sigmoidf_(float x) { return fast_rcp(1.0f + fast_exp2(-x * LOG2E)); }
__device__ __forceinline__ float siluf_(float x) { return x * sigmoidf_(x); }
__device__ __forceinline__ float gelu_tanh(float x) { const float z = 0.7978845608028654f * (x + 0.044715f * x * x * x); return x * sigmoidf_(2.0f * z); }
__device__ __forceinline__ float shx(float v, int m, int lane) { return __int_as_float(__builtin_amdgcn_ds_bpermute((lane ^ m) << 2, __float_as_int(v))); }
__device__ __forceinline__ float wave_sum(float v, int lane) {
    v += shx(v, 1, lane); v += shx(v, 2, lane); v += shx(v, 4, lane); v += shx(v, 8, lane); v += shx(v, 16, lane); v += shx(v, 32, lane); return v;
}
__device__ __forceinline__ void unpack8(const u32x4 w, float (&f)[8]) {
    f[0] = bf_lo(w.x); f[1] = bf_hi(w.x); f[2] = bf_lo(w.y); f[3] = bf_hi(w.y); f[4] = bf_lo(w.z); f[5] = bf_hi(w.z); f[6] = bf_lo(w.w); f[7] = bf_hi(w.w);
}
__device__ __forceinline__ u32x4 pack8(const float (&f)[8]) {
    u32x4 w; w.x = cvt_pk_bf16(f[0], f[1]); w.y = cvt_pk_bf16(f[2], f[3]); w.z = cvt_pk_bf16(f[4], f[5]); w.w = cvt_pk_bf16(f[6], f[7]); return w;
}

struct RowMap { size_t row0; int is_ctx; int modrow; };
__device__ __forceinline__ RowMap map_row(int u) {
    const int s = u / TH, v = u - s * TH; RowMap r;
    if (v < H_LAT) { r.row0 = (size_t)s * H_LAT + v; r.is_ctx = 0; r.modrow = (int)(r.row0 >> 11); }
    else { r.row0 = (size_t)s * H_CTX + (v - H_LAT); r.is_ctx = 1; r.modrow = 32; }
    return r;
}

namespace pg8 {
constexpr int BM = 256, BK = 64, HALF = 128, HTB = HALF * BK * 2, STAGE_BYTES = 8 * HTB, NXCD = 8, WGM = 8;
__device__ __forceinline__ int lds_byte(int r, int c) { const int st = (r >> 4) * 2 + (c >> 5), rr = r & 15, cc = c & 31, ob = rr * 64 + cc * 2; return st * 1024 + (ob ^ (((ob >> 9) & 1) << 5)); }
__device__ __forceinline__ void stage_rc(int b, int& R, int& C) { const int st = b / 1024, sb = b % 1024, swz = sb ^ (((sb >> 9) & 1) << 5); R = (st >> 1) * 16 + swz / 64; C = (st & 1) * 32 + (swz % 64) / 2; }
__device__ __forceinline__ int perm32(int rho) { const int n = rho >> 4, i = rho & 15; return 8 * (i >> 2) + 4 * n + (i & 3); }

struct Unit { int pm, pn; };
struct Gemm { const bf16_t* A; int lda; const bf16_t* Bt; int ldb; int M, N, K; };

struct StaticOrder {
    int nM, nN, nwg, G, c;
    __device__ void init(int M, int N, int G_, int c_) { nM = M / BM; nN = N / BM; nwg = nM * nN; G = G_; c = c_; }
    __device__ bool next(int i, Unit& u) const {
        const long L = (long)i * G + c; if (L >= nwg) return false;
        int wgid = (int)L; { const int q = nwg / NXCD, r = nwg % NXCD, xcd = wgid % NXCD, off = wgid / NXCD; wgid = (xcd < r ? xcd * (q + 1) : r * (q + 1) + (xcd - r) * q) + off; }
        const int nig = WGM * nN, gid = wgid / nig, fm = gid * WGM, gsz = (nM - fm) < WGM ? (nM - fm) : WGM;
        u.pm = fm + ((wgid % nig) % gsz); u.pn = (wgid % nig) / gsz; return true;
    }
};

template <class Epi>
__device__ __forceinline__ void gemm_phase(LAS unsigned char* lds, const Gemm g, const Epi& E) {
    const int tid = tid_opaque(), wid = __builtin_amdgcn_readfirstlane(tid >> 6), lane = tid & 63, wr = wid >> 2, wc = wid & 3, fr = lane & 15, fq = lane >> 4;
    const int K = g.K, nt = K / BK;
    StaticOrder S; S.init(g.M, g.N, (int)gridDim.x, bid_opaque());
    unsigned voffA[2], voffB[2];
#pragma unroll
    for (int i = 0; i < 2; ++i) { int R, C; stage_rc(tid * 16 + i * 8192, R, C); const int Rb = Epi::PERM ? ((R & ~31) + perm32(R & 31)) : R;
        voffA[i] = (unsigned)(R * g.lda + C) * 2u; voffB[i] = (unsigned)(Rb * g.ldb + C) * 2u; }
    const size_t kstep = (size_t)(BK * 2);
    const size_t hstepA = (size_t)HALF * g.lda * 2, hstepB = (size_t)HALF * g.ldb * 2;
    const size_t tstepA = 2 * hstepA, tstepB = 2 * hstepB;
    const unsigned ldsw = (unsigned)wid * 1024u;
    const int aoff = lds_byte(wr * 64 + fr, fq * 8), boff = lds_byte(wc * 32 + fr, fq * 8);
#define PG8_SA(b, h) (((b) * 2 + (h)) * HTB)
#define PG8_SB(b, h) ((4 + (b) * 2 + (h)) * HTB)
#define PG8_STAGE(bufoff, gbase, voff) do { _Pragma("unroll") for (int _i = 0; _i < 2; ++_i) \
        __builtin_amdgcn_global_load_lds((const unsigned*)((const char*)(gbase) + (voff)[_i]), (LAS unsigned*)(lds + (bufoff) + ldsw + _i * 8192), 16, 0, 0); } while (0)
#define PG8_LDA(dst, b, h) do { _Pragma("unroll") for (int m = 0; m < 4; ++m) _Pragma("unroll") for (int k = 0; k < 2; ++k) dst[m][k] = *(const LAS bf16x8*)(lds + PG8_SA(b, h) + aoff + m * 2048 + k * 1024); } while (0)
#define PG8_LDB(dst, b, h) do { _Pragma("unroll") for (int n = 0; n < 2; ++n) _Pragma("unroll") for (int k = 0; k < 2; ++k) dst[n][k] = *(const LAS bf16x8*)(lds + PG8_SB(b, h) + boff + n * 2048 + k * 1024); } while (0)
#define PG8_MMA(ai, bj, At, Bt) do { __builtin_amdgcn_s_setprio(1); _Pragma("unroll") for (int m = 0; m < 4; ++m) _Pragma("unroll") for (int n = 0; n < 2; ++n) _Pragma("unroll") for (int k = 0; k < 2; ++k) \
        acc[ai][bj][m][n] = __builtin_amdgcn_mfma_f32_16x16x32_bf16(Bt[n][k], At[m][k], acc[ai][bj][m][n], 0, 0, 0); __builtin_amdgcn_s_setprio(0); } while (0)
#define PG8_WAIT_V(n) asm volatile("s_waitcnt vmcnt(" #n ")" ::: "memory")
#define PG8_WAIT_L(n) asm volatile("s_waitcnt lgkmcnt(" #n ")" ::: "memory")
#define PG8_BAR __builtin_amdgcn_s_barrier()
#define PG8_SCHED __builtin_amdgcn_sched_barrier(0)
#define PG8_KLOOP(TB, TE) for (int t = (TB); t < (TE); t += 2) { \
            const bool last = (t == nt - 2); \
            const char* a1 = cA + (size_t)(t + 1) * kstep; \
            const char* a2 = last ? nA : cA + (size_t)(t + 2) * kstep; const char* b2 = last ? nB : cB + (size_t)(t + 2) * kstep; \
            const char* a3 = a2 + kstep; const char* b3 = b2 + kstep; \
            PG8_LDB(B0, 0, 0); PG8_SCHED; PG8_LDA(At, 0, 0); PG8_STAGE(PG8_SA(1, 1), a1 + hstepA, voffA); \
            PG8_WAIT_L(8); PG8_BAR; PG8_WAIT_L(0); PG8_MMA(0, 0, At, B0); PG8_BAR; PG8_SCHED; \
            PG8_LDB(B1, 0, 1); PG8_STAGE(PG8_SB(0, 0), b2, voffB); \
            PG8_BAR; PG8_WAIT_L(0); PG8_MMA(0, 1, At, B1); PG8_BAR; \
            PG8_LDA(At, 0, 1); PG8_STAGE(PG8_SA(0, 0), a2, voffA); \
            PG8_BAR; PG8_WAIT_L(0); PG8_MMA(1, 0, At, B0); PG8_BAR; PG8_SCHED; \
            PG8_STAGE(PG8_SB(0, 1), b2 + hstepB, voffB); \
            PG8_WAIT_V(6); PG8_BAR; PG8_MMA(1, 1, At, B1); PG8_BAR; \
            PG8_LDB(B0, 1, 0); PG8_SCHED; PG8_LDA(At, 1, 0); PG8_STAGE(PG8_SA(0, 1), a2 + hstepA, voffA); \
            PG8_WAIT_L(8); PG8_BAR; PG8_WAIT_L(0); PG8_MMA(0, 0, At, B0); PG8_BAR; PG8_SCHED; \
            PG8_LDB(B1, 1, 1); PG8_STAGE(PG8_SB(1, 0), b3, voffB); \
            PG8_BAR; PG8_WAIT_L(0); PG8_MMA(0, 1, At, B1); PG8_BAR; \
            PG8_LDA(At, 1, 1); PG8_STAGE(PG8_SA(1, 0), a3, voffA); \
            PG8_BAR; PG8_WAIT_L(0); PG8_MMA(1, 0, At, B0); PG8_BAR; PG8_SCHED; \
            PG8_STAGE(PG8_SB(1, 1), b3 + hstepB, voffB); \
            PG8_WAIT_V(6); PG8_BAR; PG8_MMA(1, 1, At, B1); PG8_BAR; \
        }
    Unit cur, nxt; int ui = 0;
    if (!S.next(0, cur)) return;
    f32x4 acc[2][2][4][2];
#pragma unroll
    for (int a = 0; a < 2; ++a)
#pragma unroll
        for (int b = 0; b < 2; ++b)
#pragma unroll
            for (int m = 0; m < 4; ++m)
#pragma unroll
                for (int n = 0; n < 2; ++n) acc[a][b][m][n] = (f32x4){0.f, 0.f, 0.f, 0.f};
    bf16x8 At[4][2], B0[2][2], B1[2][2];
    const char* cA = (const char*)g.A + (size_t)cur.pm * tstepA; const char* cB = (const char*)g.Bt + (size_t)cur.pn * tstepB;
    PG8_STAGE(PG8_SB(0, 0), cB, voffB); PG8_STAGE(PG8_SA(0, 0), cA, voffA); PG8_STAGE(PG8_SB(0, 1), cB + hstepB, voffB); PG8_STAGE(PG8_SA(0, 1), cA + hstepA, voffA);
    if (wr == 1) PG8_BAR;
    PG8_WAIT_V(4); PG8_BAR;
    PG8_STAGE(PG8_SB(1, 0), cB + kstep, voffB); PG8_STAGE(PG8_SA(1, 0), cA + kstep, voffA); PG8_STAGE(PG8_SB(1, 1), cB + hstepB + kstep, voffB);
    PG8_WAIT_V(6); PG8_BAR;
    for (;;) {
        const bool has_next = S.next(ui + 1, nxt);
        const char* nA = has_next ? (const char*)g.A + (size_t)nxt.pm * tstepA : cA; const char* nB = has_next ? (const char*)g.Bt + (size_t)nxt.pn * tstepB : cB;
        if constexpr (Epi::MIDK) {
            PG8_KLOOP(0, 4)
            E.template mid<0>(acc, cur, wr, wc, fr, fq);
            PG8_KLOOP(4, 8)
            E.template mid<1>(acc, cur, wr, wc, fr, fq);
            PG8_KLOOP(8, nt)
        } else {
            PG8_KLOOP(0, nt)
        }
        E(acc, cur, wr, wc, fr, fq);
        if (!has_next) break;
#pragma unroll
        for (int a = 0; a < 2; ++a)
#pragma unroll
            for (int b = 0; b < 2; ++b)
#pragma unroll
                for (int m = 0; m < 4; ++m)
#pragma unroll
                    for (int n = 0; n < 2; ++n) acc[a][b][m][n] = (f32x4){0.f, 0.f, 0.f, 0.f};
        cur = nxt; cA = nA; cB = nB; ++ui;
    }
    PG8_WAIT_V(0);
    if (wr == 0) PG8_BAR;
    PG8_BAR;
#undef PG8_KLOOP
#undef PG8_SA
#undef PG8_SB
#undef PG8_STAGE
#undef PG8_LDA
#undef PG8_LDB
#undef PG8_MMA
#undef PG8_WAIT_V
#undef PG8_WAIT_L
#undef PG8_BAR
#undef PG8_SCHED
}

struct EpiSwiglu {
    static constexpr bool PERM = true, MIDK = false;
    bf16_t* O;
    __device__ __forceinline__ void operator()(const f32x4 (&acc)[2][2][4][2], const Unit& u, int wr, int wc, int fr, int fq) const {
        const int row0 = u.pm * BM + wr * 64 + fr, col0 = u.pn * 128 + wc * 32 + 8 * fq;
#pragma unroll
        for (int ai = 0; ai < 2; ++ai)
#pragma unroll
            for (int m = 0; m < 4; ++m) {
                float h[8];
#pragma unroll
                for (int n = 0; n < 2; ++n)
#pragma unroll
                    for (int j = 0; j < 4; ++j) h[n * 4 + j] = siluf_(acc[ai][0][m][n][j]) * acc[ai][1][m][n][j];
                *(u32x4*)(O + (size_t)(row0 + ai * HALF + m * 16) * DFF + col0) = pack8(h);
            }
    }
};
struct EpiBf16 {
    static constexpr bool PERM = true, MIDK = false;
    bf16_t* O; int ldc; const float* bias; int bias_col0;
    __device__ __forceinline__ void operator()(const f32x4 (&acc)[2][2][4][2], const Unit& u, int wr, int wc, int fr, int fq) const {
        const int row0 = u.pm * BM + wr * 64 + fr, col0 = u.pn * BM + wc * 32 + 8 * fq;
        const bool hb = (u.pn * BM >= bias_col0);
        f32x4 bv[2][2];
#pragma unroll
        for (int bj = 0; bj < 2; ++bj)
#pragma unroll
            for (int n = 0; n < 2; ++n) bv[bj][n] = hb ? *(const f32x4*)(bias + (col0 - bias_col0) + bj * HALF + 4 * n) : (f32x4){0.f, 0.f, 0.f, 0.f};
#pragma unroll
        for (int ai = 0; ai < 2; ++ai)
#pragma unroll
            for (int m = 0; m < 4; ++m) { bf16_t* rowp = O + (size_t)(row0 + ai * HALF + m * 16) * ldc + col0;
#pragma unroll
                for (int bj = 0; bj < 2; ++bj) { const f32x4 v0 = acc[ai][bj][m][0] + bv[bj][0], v1 = acc[ai][bj][m][1] + bv[bj][1];
                    u32x4 w; w.x = cvt_pk_bf16(v0[0], v0[1]); w.y = cvt_pk_bf16(v0[2], v0[3]); w.z = cvt_pk_bf16(v1[0], v1[1]); w.w = cvt_pk_bf16(v1[2], v1[3]);
                    *(u32x4*)(rowp + bj * HALF) = w; } }
    }
};
struct EpiResid {
    static constexpr bool PERM = true, MIDK = false;
    const float* x_lat; const float* x_ctx; bf16_t* hbuf; float* out; const float* mod; int gate_idx; float gscale; int tile0; int mode;
    template <int MODE> __device__ __forceinline__ void body(const f32x4 (&acc)[2][2][4][2], const Unit& u, int wr, int wc, int fr, int fq) const {
        const int urow0 = (tile0 + u.pm) * BM;
        const RowMap rm = map_row(urow0);
        const float* gp = mod + (size_t)rm.modrow * (NMOD * D) + gate_idx * D;
        const int rloc = wr * 64 + fr, col0 = u.pn * BM + wc * 32 + 8 * fq;
        const float* xs = (rm.is_ctx ? x_ctx : x_lat) + rm.row0 * D + col0;
        bf16_t* hb = hbuf + (size_t)urow0 * D + col0;
        float* ob = out + rm.row0 * D + col0;
        const bool st_ok = (MODE != 2) || !rm.is_ctx;
        constexpr int MG = (MODE == 0) ? 2 : 4;
#pragma unroll
        for (int bj = 0; bj < 2; ++bj) {
            const f32x4 g0 = *(const f32x4*)(gp + col0 + bj * HALF) * gscale, g1 = *(const f32x4*)(gp + col0 + bj * HALF + 4) * gscale;
#pragma unroll
            for (int ai = 0; ai < 2; ++ai)
#pragma unroll
                for (int mg = 0; mg < 4; mg += MG) {
                    f32x4 xf[MODE == 0 ? MG : 1][2]; u32x4 xw[MODE == 0 ? 1 : MG];
#pragma unroll
                    for (int mm = 0; mm < MG; ++mm) { const size_t ro = (size_t)(rloc + ai * HALF + (mg + mm) * 16) * D + bj * HALF;
                        if constexpr (MODE == 0) { xf[mm][0] = *(const f32x4*)(xs + ro); xf[mm][1] = *(const f32x4*)(xs + ro + 4); }
                        else xw[mm] = *(const u32x4*)(hb + ro); }
                    __builtin_amdgcn_sched_barrier(0);
#pragma unroll
                    for (int mm = 0; mm < MG; ++mm) { const int m = mg + mm; const size_t ro = (size_t)(rloc + ai * HALF + m * 16) * D + bj * HALF;
                        f32x4 x0, x1;
                        if constexpr (MODE == 0) { x0 = xf[mm][0]; x1 = xf[mm][1]; }
                        else { const u32x4 w = xw[mm]; x0 = (f32x4){bf_lo(w.x), bf_hi(w.x), bf_lo(w.y), bf_hi(w.y)}; x1 = (f32x4){bf_lo(w.z), bf_hi(w.z), bf_lo(w.w), bf_hi(w.w)}; }
                        const f32x4 y0 = x0 + g0 * acc[ai][bj][m][0], y1 = x1 + g1 * acc[ai][bj][m][1];
                        if constexpr (MODE == 2) { if (st_ok) { *(f32x4*)(ob + ro) = y0; *(f32x4*)(ob + ro + 4) = y1; } }
                        else { u32x4 w; w.x = cvt_pk_bf16(y0[0], y0[1]); w.y = cvt_pk_bf16(y0[2], y0[3]); w.z = cvt_pk_bf16(y1[0], y1[1]); w.w = cvt_pk_bf16(y1[2], y1[3]); *(u32x4*)(hb + ro) = w; }
                    }
                    __builtin_amdgcn_sched_barrier(0);
                }
        }
    }
    __device__ __forceinline__ void operator()(const f32x4 (&acc)[2][2][4][2], const Unit& u, int wr, int wc, int fr, int fq) const {
        if (mode == 1) body<1>(acc, u, wr, wc, fr, fq);
        else if (mode == 0) body<0>(acc, u, wr, wc, fr, fq);
        else body<2>(acc, u, wr, wc, fr, fq);
    }
};
struct EpiBranch {
    static constexpr bool PERM = true, MIDK = true;
    bf16_t* P;
    __device__ __forceinline__ u32x4 ld_raw(unsigned off) const { return *(const u32x4*)((const char*)P + (size_t)off * 2u); }
    __device__ __forceinline__ void to_e(const u32x4 w, float (&e)[8]) const {
        float x[8]; unpack8(w, x);
#pragma unroll
        for (int j = 0; j < 8; ++j) { const float v = fminf(fmaxf(x[j], -30.f), 30.f); e[j] = fast_exp2(-v * LOG2E); }
    }
    template <int WHICH> __device__ __forceinline__ void mid(f32x4 (&acc)[2][2][4][2], const Unit& u, int wr, int wc, int fr, int fq) const {
        unsigned base = (unsigned)(u.pm * BM + wr * 64 + fr) * PROJ + (unsigned)(u.pn * BM + wc * 32 + 8 * fq) + OFF_GATE + WHICH * D;
        asm volatile("" : "+v"(base));
#pragma unroll
        for (int ai = 0; ai < 2; ++ai)
#pragma unroll
            for (int mp = 0; mp < 2; ++mp) {
                u32x4 wa[2][2], wb[2][2];
#pragma unroll
                for (int mm = 0; mm < 2; ++mm)
#pragma unroll
                    for (int bj = 0; bj < 2; ++bj) { const unsigned o = base + (unsigned)(ai * HALF + (mp * 2 + mm) * 16) * PROJ + bj * HALF; wa[mm][bj] = ld_raw(o); wb[mm][bj] = ld_raw(o + D); }
                __builtin_amdgcn_sched_barrier(0);
#pragma unroll
                for (int mm = 0; mm < 2; ++mm)
#pragma unroll
                    for (int bj = 0; bj < 2; ++bj) { float ea[8], eb[8]; to_e(wa[mm][bj], ea); to_e(wb[mm][bj], eb);
#pragma unroll
                        for (int n = 0; n < 2; ++n)
#pragma unroll
                            for (int j = 0; j < 4; ++j) acc[ai][bj][mp * 2 + mm][n][j] *= (1.0f + eb[n * 4 + j]) * fast_rcp(1.0f + ea[n * 4 + j]); }
                __builtin_amdgcn_sched_barrier(0);
            }
    }
    __device__ __forceinline__ void operator()(const f32x4 (&acc)[2][2][4][2], const Unit& u, int wr, int wc, int fr, int fq) const {
        unsigned base = (unsigned)(u.pm * BM + wr * 64 + fr) * PROJ + (unsigned)(u.pn * BM + wc * 32 + 8 * fq);
        asm volatile("" : "+v"(base));
#pragma unroll
        for (int ai = 0; ai < 2; ++ai) {
            u32x4 w2[4][2];
#pragma unroll
            for (int m = 0; m < 4; ++m)
#pragma unroll
                for (int bj = 0; bj < 2; ++bj) w2[m][bj] = ld_raw(base + (unsigned)(ai * HALF + m * 16) * PROJ + bj * HALF + OFF_GATE + 2 * D);
            __builtin_amdgcn_sched_barrier(0);
#pragma unroll
            for (int m = 0; m < 4; ++m)
#pragma unroll
                for (int bj = 0; bj < 2; ++bj) { const unsigned o = base + (unsigned)(ai * HALF + m * 16) * PROJ + bj * HALF;
                    float e2[8], ov[8]; to_e(w2[m][bj], e2);
#pragma unroll
                    for (int n = 0; n < 2; ++n)
#pragma unroll
                        for (int j = 0; j < 4; ++j) ov[n * 4 + j] = acc[ai][bj][m][n][j] * fast_rcp(1.0f + e2[n * 4 + j]);
                    *(u32x4*)((char*)P + (size_t)o * 2u) = pack8(ov); }
            __builtin_amdgcn_sched_barrier(0);
        }
    }
};
}

__device__ __forceinline__ void tr_tile(LAS float* tl, const float* src, int ld_src, int k0, int c0, bf16_t* dst, int ld_dst, int n0, int dk0) {
    const int tid = tid_opaque();
    { const int n = tid & 63, kk = tid >> 6;
#pragma unroll
      for (int i = 0; i < 8; ++i) { const int k = kk + 8 * i; tl[k * 65 + n] = src[(size_t)(k0 + k) * ld_src + c0 + n]; } }
    __syncthreads();
    { const int k2 = (tid & 31) * 2, nn = tid >> 5;
#pragma unroll
      for (int i = 0; i < 4; ++i) { const int n = nn + 16 * i; *(unsigned*)(dst + (size_t)(n0 + n) * ld_dst + dk0 + k2) = cvt_pk_bf16(tl[k2 * 65 + n], tl[(k2 + 1) * 65 + n]); } }
    __syncthreads();
}
__device__ __forceinline__ void tr_job(LAS float* tl, const float* src, int ld_src, int K, int Nout, bf16_t* dst, int ld_dst, int dkofs, int mode) {
    const int nkt = K / 64, ntl = nkt * (Nout / 64);
    for (int t = bid_opaque(); t < ntl; t += gridDim.x) {
        const int kt = t % nkt, ntile = t / nkt, n0 = ntile * 64;
        int c0 = n0;
        if (mode == 1) { const int pn = n0 >> 8, r = n0 & 255; c0 = (r < 128) ? pn * 128 + r : DFF + pn * 128 + (r - 128); }
        tr_tile(tl, src, ld_src, kt * 64, c0, dst, ld_dst, n0, dkofs + kt * 64);
    }
}

__device__ void phase_setup(const Params& p, LAS unsigned char* lds) {
    const int tid = tid_opaque(), wid = tid >> 6, lane = tid & 63;
    bf16_t* WT = (bf16_t*)(p.ws + WS_WT);
    LAS float* tl = (LAS float*)lds;
    for (int l = 0; l < NL; ++l) {
        bf16_t* W = WT + (size_t)l * W_LAYER;
        for (int j = 0; j < 2; ++j) {
            tr_job(tl, p.in[I_FFNIN] + ((size_t)l * 2 + j) * D * (2 * DFF), 2 * DFF, D, 2 * DFF, W + (j ? W_FIN1 : W_FIN0), D, 0, 1);
            tr_job(tl, p.in[I_FFNOUT] + ((size_t)l * 2 + j) * DFF * D, D, DFF, D, W + (j ? W_FOUT1 : W_FOUT0), DFF, 0, 0);
        }
        tr_job(tl, p.in[I_WIN] + (size_t)l * D * PROJ, PROJ, D, PROJ, W + W_WIN, D, 0, 0);
        tr_job(tl, p.in[I_WBC] + (size_t)l * 256 * D, D, 256, D, W + W_WB, D, 0, 0);
        tr_job(tl, p.in[I_WBG] + (size_t)l * 256 * D, D, 256, D, W + W_WB, D, 256, 0);
        tr_job(tl, p.in[I_WBA] + (size_t)l * 512 * D, D, 512, D, W + W_WB, D, 512, 0);
        tr_job(tl, p.in[I_WOUT] + (size_t)l * D * D, D, D, D, W + W_WO, D, 0, 0);
        for (int i = bid_opaque() * 512 + tid; i < 65536 / 2; i += gridDim.x * 512) {
            const float2 v = *(const float2*)(p.in[I_GWS] + (size_t)l * 65536 + 2 * i);
            *(unsigned*)(W + W_GWS + 2 * i) = cvt_pk_bf16(v.x, v.y);
        }
    }
    { const int gi = bid_opaque() * 512 + tid;
      if (gi < 1024) { const int pos = gi >> 4, i = gi & 15;
        const int i4 = i & 3, i16 = i >> 2;
        float inv = (i4 == 0) ? 1.0f : (i4 == 1) ? 0.5623413251903491f : (i4 == 2) ? 0.31622776601683794f : 0.1778279410038923f;
        inv *= (i16 == 0) ? 1.0f : (i16 == 1) ? 0.1f : (i16 == 2) ? 0.01f : 0.001f;
        const float a = (float)pos * inv;
        const float kq = __builtin_rintf(a * 0.6366197723675814f);
        float r = __builtin_fmaf(-kq, 1.5707963705062866f, a); r = __builtin_fmaf(kq, 4.371139000186241e-8f, r);
        const float r2 = r * r;
        const float sn = r * (1.0f + r2 * (-1.0f / 6 + r2 * (1.0f / 120 + r2 * (-1.0f / 5040 + r2 * (1.0f / 362880)))));
        const float cs = 1.0f + r2 * (-0.5f + r2 * (1.0f / 24 + r2 * (-1.0f / 720 + r2 * (1.0f / 40320 + r2 * (-1.0f / 3628800)))));
        const int q = ((int)kq) & 3;
        const float c = (q == 0) ? cs : (q == 1) ? -sn : (q == 2) ? -cs : sn;
        const float s = (q == 0) ? sn : (q == 1) ? cs : (q == 2) ? -sn : -cs;
        float2* rt = (float2*)(p.ws + WS_ROPE); rt[gi] = make_float2(c, s); } }
    if (bid_opaque() < NL * 36) {
        LAS float* sc = (LAS float*)lds;
        __syncthreads();
        for (int i = tid; i < 33 * D; i += 512) { const int r = i >> 10, k = i & 1023; const float v = (r < 32) ? p.in[I_C][r * D + k] : p.in[I_CCTX][k]; sc[i] = siluf_(v); }
        __syncthreads();
        float* MOD = (float*)(p.ws + WS_MOD);
        for (int it = bid_opaque(); it < NL * 36; it += gridDim.x) {
            const int l = it / 36, cgp = it % 36, n0 = cgp * 256 + lane * 4;
            const float* wp = p.in[I_WMOD] + (size_t)l * D * (NMOD * D) + n0;
            f32x4 a[5];
#pragma unroll
            for (int i = 0; i < 5; ++i) a[i] = (f32x4){0.f, 0.f, 0.f, 0.f};
            for (int k = 0; k < D; k += 4) {
                f32x4 w[4];
#pragma unroll
                for (int kk = 0; kk < 4; ++kk) w[kk] = *(const f32x4*)(wp + (size_t)(k + kk) * (NMOD * D));
#pragma unroll
                for (int i = 0; i < 5; ++i) { const int r = (i < 4) ? wid + 8 * i : 32; const f32x4 s = *(const LAS f32x4*)(sc + r * D + k);
                    a[i] += s[0] * w[0] + s[1] * w[1] + s[2] * w[2] + s[3] * w[3]; }
            }
            const f32x4 bv = *(const f32x4*)(p.in[I_BMOD] + (size_t)l * (NMOD * D) + n0);
#pragma unroll
            for (int i = 0; i < 5; ++i) { const int r = (i < 4) ? wid + 8 * i : 32; if (i < 4 || wid == 0) *(f32x4*)(MOD + ((size_t)l * 33 + r) * (NMOD * D) + n0) = a[i] + bv; }
        }
        __syncthreads();
    }
}

__device__ void phase_norm(const Params& p, int l, int j, bool from_inputs) {
    const int tid = tid_opaque(), wid = tid >> 6, lane = tid & 63;
    bf16_t* A = (bf16_t*)(p.ws + WS_A);
    const bf16_t* hbuf = (const bf16_t*)(p.ws + WS_H);
    const float* MOD = (const float*)(p.ws + WS_MOD) + (size_t)l * 33 * (NMOD * D);
    const float* ng = p.in[I_NORMG] + ((size_t)l * 3 + j) * D;
    for (int u = bid_opaque() * 8 + wid; u < T_ALL; u += gridDim.x * 8) {
        const RowMap rm = map_row(u);
        const float* sh = MOD + (size_t)rm.modrow * (NMOD * D) + (3 * j) * D; const float* sc = sh + D;
        f32x4 v[4]; float ss = 0.f;
        if (from_inputs) { const float* x = (rm.is_ctx ? p.in[I_CTX] : p.in[I_X]) + rm.row0 * D;
#pragma unroll
            for (int i = 0; i < 4; ++i) v[i] = *(const f32x4*)(x + i * 256 + lane * 4);
        } else { const bf16_t* x = hbuf + (size_t)u * D;
#pragma unroll
            for (int i = 0; i < 4; ++i) { const u32x2 w = *(const u32x2*)(x + i * 256 + lane * 4); v[i] = (f32x4){bf_lo(w.x), bf_hi(w.x), bf_lo(w.y), bf_hi(w.y)}; }
        }
#pragma unroll
        for (int i = 0; i < 4; ++i) ss += v[i][0] * v[i][0] + v[i][1] * v[i][1] + v[i][2] * v[i][2] + v[i][3] * v[i][3];
        ss = wave_sum(ss, lane);
        const float rstd = rsqrtf(ss * (1.0f / D) + EPS);
#pragma unroll
        for (int i = 0; i < 4; ++i) { const int k = i * 256 + lane * 4;
            const f32x4 g = *(const f32x4*)(ng + k), s1 = *(const f32x4*)(sc + k), s0 = *(const f32x4*)(sh + k);
            const f32x4 y = v[i] * rstd * g * (s1 + 1.0f) + s0;
            u32x2 w; w.x = cvt_pk_bf16(y[0], y[1]); w.y = cvt_pk_bf16(y[2], y[3]);
            *(u32x2*)(A + (size_t)u * D + k) = w; }
    }
}

__device__ void phase_prep(const Params& p, int l, LAS unsigned char* lds) {
    const int tid = tid_opaque(), wid = tid >> 6, lane = tid & 63;
    bf16_t* P = (bf16_t*)(p.ws + WS_R1);
    bf16_t* VTL = (bf16_t*)(p.ws + WS_VTL); bf16_t* VTC = (bf16_t*)(p.ws + WS_VTC);
    const float* qg = p.in[I_QG] + l * 64; const float* kg = p.in[I_KG] + l * 64;
    LAS bf16_t* Vs = (LAS bf16_t*)lds;
    const LAS f32x2* rts = (const LAS f32x2*)(lds + 20480);
    __syncthreads();
    *(LAS u32x4*)(lds + 20480 + tid * 16) = *(const u32x4*)(p.ws + WS_ROPE + tid * 16);
    __syncthreads();
    const int c = lane & 7, seg = c >> 2, hf = (c >> 1) & 1, i0 = (c & 1) * 8;
    float gq[8], gk[8];
#pragma unroll
    for (int e = 0; e < 8; ++e) { gq[e] = qg[8 * c + e]; gk[e] = kg[8 * c + e]; }
    for (int it = bid_opaque(); it < TH / 64; it += gridDim.x) {
        const int v0 = it * 64; const bool lat = v0 < H_LAT;
        const int prow = (v0 & (SEQ - 1)) >> 6;
        bf16_t* rowb = P + (size_t)(v0 + wid * 8) * PROJ;
        const int qoff = OFF_Q + (lane >> 3) * 64 + 8 * c, koff = OFF_K + ((lane >> 3) & 1) * 64 + 8 * c;
        u32x4 qr[8], kr[8]; unsigned vr[8];
#pragma unroll
        for (int i = 0; i < 8; ++i) { const bf16_t* rp = rowb + (size_t)i * PROJ; qr[i] = *(const u32x4*)(rp + qoff); kr[i] = *(const u32x4*)(rp + koff); vr[i] = *(const unsigned*)(rp + OFF_V + 2 * lane); }
#pragma unroll
        for (int i = 0; i < 8; ++i) {
            const int rl = wid * 8 + i;
            bf16_t* rowp = rowb + (size_t)i * PROJ;
            const int pp = seg ? rl : prow;
            float cs[8], sn[8];
#pragma unroll
            for (int e = 0; e < 8; ++e) { const f32x2 t2 = rts[pp * 16 + i0 + e]; cs[e] = lat ? t2[0] : 1.0f; sn[e] = lat ? t2[1] : 0.0f; }
            { float x[8]; unpack8(qr[i], x);
              float ss = 0.f;
#pragma unroll
              for (int e = 0; e < 8; ++e) ss += x[e] * x[e];
              ss += shx(ss, 1, lane); ss += shx(ss, 2, lane); ss += shx(ss, 4, lane);
              const float rstd = rsqrtf(ss * (1.0f / 64) + EPS); float o[8];
#pragma unroll
              for (int e = 0; e < 8; ++e) { const float y = x[e] * rstd * gq[e]; const float yp = shx(y, 2, lane);
                  o[e] = (hf ? (y * cs[e] + yp * sn[e]) : (y * cs[e] - yp * sn[e])) * (0.125f * LOG2E); }
              *(u32x4*)(rowp + qoff) = pack8(o); }
            { float x[8]; unpack8(kr[i], x);
              float ss = 0.f;
#pragma unroll
              for (int e = 0; e < 8; ++e) ss += x[e] * x[e];
              ss += shx(ss, 1, lane); ss += shx(ss, 2, lane); ss += shx(ss, 4, lane);
              const float rstd = rsqrtf(ss * (1.0f / 64) + EPS); float o[8];
#pragma unroll
              for (int e = 0; e < 8; ++e) { const float y = x[e] * rstd * gk[e]; const float yp = shx(y, 2, lane);
                  o[e] = hf ? (y * cs[e] + yp * sn[e]) : (y * cs[e] - yp * sn[e]); }
              if (lane < 16) *(u32x4*)(rowp + koff) = pack8(o); }
            { const unsigned w = vr[i];
              Vs[(2 * lane) * 72 + rl] = (bf16_t)(w & 0xffffu); Vs[(2 * lane + 1) * 72 + rl] = (bf16_t)(w >> 16); }
        }
        __syncthreads();
        { const int hd = tid >> 2, ch = tid & 3;
          bf16_t* dst;
          if (lat) { const int bl = v0 >> 11, pos0 = v0 & (SEQ - 1); dst = VTL + ((size_t)bl * 128 + hd) * SEQ + pos0 + ch * 16; }
          else { const int cv = v0 - H_LAT, bl = cv >> 8, pos0 = cv & 255; dst = VTC + ((size_t)bl * 128 + hd) * CTXL + pos0 + ch * 16; }
          const u32x4 a = *(const LAS u32x4*)(Vs + hd * 72 + ch * 16), b = *(const LAS u32x4*)(Vs + hd * 72 + ch * 16 + 8);
          *(u32x4*)dst = a; *(u32x4*)(dst + 8) = b; }
        __syncthreads();
    }
}

struct KeySeg { const bf16_t* K; const bf16_t* Vt; int vstride; int ntiles; int mask; };

__device__ __forceinline__ void attn_item(const Params& p, int l, int hs, int idx) {
    const int tid = tid_opaque(), wid = tid >> 6, lane = tid & 63, fr = lane & 15, fq = lane >> 4;
    const bf16_t* P = (const bf16_t*)(p.ws + WS_R1);
    const bf16_t* VTL = (const bf16_t*)(p.ws + WS_VTL); const bf16_t* VTC = (const bf16_t*)(p.ws + WS_VTC);
    bf16_t* Y = (bf16_t*)(p.ws + WS_A) + (size_t)hs * TH * D;
    int bl, qb, hk; bool lat;
    if (idx < 512) { lat = true; bl = idx >> 5; qb = (idx >> 1) & 15; hk = idx & 1; }
    else { const int j = idx - 512; lat = false; bl = j >> 2; qb = (j >> 1) & 1; hk = j & 1; }
    const int g = wid >> 1, r0 = (wid & 1) * 64, head = hk * 4 + g;
    const int qrow0 = lat ? bl * SEQ + qb * 128 : H_LAT + bl * CTXL + qb * 128;
    const int crow0 = H_LAT + bl * CTXL;
    const bf16_t* vtc = VTC + ((size_t)bl * 2 + hk) * 64 * CTXL;
    const bf16_t* vtl = VTL + ((size_t)bl * 2 + hk) * 64 * SEQ;
    bf16x8 qf[4][2];
    { const bf16_t* qp = P + (size_t)(qrow0 + r0 + fr) * PROJ + OFF_Q + head * 64 + fq * 8;
#pragma unroll
      for (int nq = 0; nq < 4; ++nq)
#pragma unroll
          for (int ks = 0; ks < 2; ++ks) qf[nq][ks] = *(const bf16x8*)(qp + (size_t)nq * 16 * PROJ + ks * 32); }
    f32x4 o[4][4];
#pragma unroll
    for (int a = 0; a < 4; ++a)
#pragma unroll
        for (int b = 0; b < 4; ++b) o[a][b] = (f32x4){0.f, 0.f, 0.f, 0.f};
    const float snk = p.in[I_SINK][l * 8 + head] * LOG2E;
    float mrun[4], lrun[4];
#pragma unroll
    for (int nq = 0; nq < 4; ++nq) { mrun[nq] = snk; lrun[nq] = (fq == 0) ? 1.0f : 0.0f; }

    for (int sg = 0; sg < 4; ++sg) {
        int ntile, mask, t_lo = 0, vstride; const bf16_t* kb_; const bf16_t* vb_;
        if (sg < 3) {
            if (!lat) continue;
            const int kb = qb + sg - 1; if (kb < 0 || kb > 15) continue;
            kb_ = P + (size_t)(bl * SEQ + kb * 128) * PROJ + OFF_K + hk * 64; vb_ = vtl + kb * 128; vstride = SEQ; ntile = 4; mask = (sg == 0) ? 1 : (sg == 2) ? 2 : 0;
            if (sg == 0) t_lo = (r0 == 64) ? 2 : 0;
            if (sg == 2) ntile = (r0 == 0) ? 2 : 4;
        } else { kb_ = P + (size_t)crow0 * PROJ + OFF_K + hk * 64; vb_ = vtc; vstride = CTXL; ntile = 8; mask = 0; }
        for (int tt = t_lo; tt < ntile; ++tt) {
            const int t0 = tt * 32;
            bf16x8 kf[2][2];
            { const bf16_t* kp = kb_ + (size_t)(t0 + fr) * PROJ + fq * 8;
#pragma unroll
              for (int kb = 0; kb < 2; ++kb)
#pragma unroll
                  for (int ks = 0; ks < 2; ++ks) kf[kb][ks] = *(const bf16x8*)(kp + (size_t)kb * 16 * PROJ + ks * 32); }
            bf16x8 vf[4];
            { const bf16_t* vp = vb_ + (size_t)fr * vstride + t0 + fq * 4;
#pragma unroll
              for (int db = 0; db < 4; ++db) { const bf16x4 lo = *(const bf16x4*)(vp + (size_t)db * 16 * vstride), hi = *(const bf16x4*)(vp + (size_t)db * 16 * vstride + 16);
                  vf[db] = (bf16x8){lo[0], lo[1], lo[2], lo[3], hi[0], hi[1], hi[2], hi[3]}; } }
            f32x4 s[2][4];
#pragma unroll
            for (int kb = 0; kb < 2; ++kb)
#pragma unroll
                for (int nq = 0; nq < 4; ++nq) {
                    s[kb][nq] = __builtin_amdgcn_mfma_f32_16x16x32_bf16(kf[kb][0], qf[nq][0], (f32x4){0.f, 0.f, 0.f, 0.f}, 0, 0, 0);
                    s[kb][nq] = __builtin_amdgcn_mfma_f32_16x16x32_bf16(kf[kb][1], qf[nq][1], s[kb][nq], 0, 0, 0);
                }
            if (mask) {
#pragma unroll
                for (int kb = 0; kb < 2; ++kb)
#pragma unroll
                    for (int nq = 0; nq < 4; ++nq)
#pragma unroll
                        for (int j = 0; j < 4; ++j) { const int t = t0 + kb * 16 + fq * 4 + j, r = r0 + nq * 16 + fr;
                            const bool ok = (mask == 1) ? (t >= r) : (t <= r); if (!ok) s[kb][nq][j] = -1e30f; }
            }
            bf16x8 pf[4];
#pragma unroll
            for (int nq = 0; nq < 4; ++nq) {
                float mx = fmaxf(fmaxf(fmaxf(s[0][nq][0], s[0][nq][1]), fmaxf(s[0][nq][2], s[0][nq][3])), fmaxf(fmaxf(s[1][nq][0], s[1][nq][1]), fmaxf(s[1][nq][2], s[1][nq][3])));
                mx = fmaxf(mx, shx(mx, 16, lane)); mx = fmaxf(mx, shx(mx, 32, lane));
                const float mn = fmaxf(mrun[nq], mx), alpha = fast_exp2(mrun[nq] - mn); mrun[nq] = mn;
                float pv[8], ps = 0.f;
#pragma unroll
                for (int j = 0; j < 4; ++j) { pv[j] = fast_exp2(s[0][nq][j] - mn); pv[4 + j] = fast_exp2(s[1][nq][j] - mn); ps += pv[j] + pv[4 + j]; }
                lrun[nq] = lrun[nq] * alpha + ps;
                const u32x4 w = pack8(pv); pf[nq] = *(const bf16x8*)&w;
#pragma unroll
                for (int db = 0; db < 4; ++db) o[db][nq] *= alpha;
            }
#pragma unroll
            for (int db = 0; db < 4; ++db)
#pragma unroll
                for (int nq = 0; nq < 4; ++nq) o[db][nq] = __builtin_amdgcn_mfma_f32_16x16x32_bf16(vf[db], pf[nq], o[db][nq], 0, 0, 0);
        }
    }
#pragma unroll
    for (int nq = 0; nq < 4; ++nq) {
        float lt = lrun[nq]; lt += shx(lt, 16, lane); lt += shx(lt, 32, lane);
        const float inv = 1.0f / lt;
        bf16_t* yp = Y + (size_t)(qrow0 + r0 + nq * 16 + fr) * D + 512 + head * 64 + fq * 4;
#pragma unroll
        for (int db = 0; db < 4; ++db) { u32x2 w; w.x = cvt_pk_bf16(o[db][nq][0] * inv, o[db][nq][1] * inv); w.y = cvt_pk_bf16(o[db][nq][2] * inv, o[db][nq][3] * inv);
            *(u32x2*)(yp + db * 16) = w; }
    }
}

__device__ __forceinline__ void gmlp_conv_item(const Params& p, int l, int hs, int chunk, LAS unsigned char* lds) {
    const int tid = tid_opaque(), wid = tid >> 6, lane = tid & 63, fr = lane & 15, fq = lane >> 4;
    const bf16_t* P = (const bf16_t*)(p.ws + WS_R1);
    bf16_t* Y = (bf16_t*)(p.ws + WS_A) + (size_t)hs * TH * D;
    const int v0 = chunk * 128;
    LAS bf16_t* vT = (LAS bf16_t*)lds;
    { const float* cw = p.in[I_CONVW] + (size_t)l * 3 * 256;
      const bool lat = v0 < H_LAT;
#pragma unroll 2
      for (int i = 0; i < 8; ++i) {
          const int id = i * 512 + tid, pt = id >> 5, cc = (id & 31) * 8, v = v0 + pt;
          const int pos = lat ? (v & (SEQ - 1)) : ((v - H_LAT) & (CTXL - 1)), n = lat ? SEQ : CTXL;
          const bf16_t* rp = P + (size_t)v * PROJ + cc;
          float bv[8], c1[8], h1[8], acc[8];
          unpack8(*(const u32x4*)(rp + OFF_CB), bv); unpack8(*(const u32x4*)(rp + OFF_CC), c1); unpack8(*(const u32x4*)(rp + OFF_CH), h1);
          { const f32x4 wa = *(const f32x4*)(cw + 256 + cc), wb = *(const f32x4*)(cw + 256 + cc + 4);
#pragma unroll
            for (int e = 0; e < 8; ++e) acc[e] = c1[e] * h1[e] * (e < 4 ? wa[e & 3] : wb[e & 3]); }
          if (pos > 0) { float c0[8], h0[8]; unpack8(*(const u32x4*)(rp - PROJ + OFF_CC), c0); unpack8(*(const u32x4*)(rp - PROJ + OFF_CH), h0);
              const f32x4 wa = *(const f32x4*)(cw + cc), wb = *(const f32x4*)(cw + cc + 4);
#pragma unroll
              for (int e = 0; e < 8; ++e) acc[e] += c0[e] * h0[e] * (e < 4 ? wa[e & 3] : wb[e & 3]); }
          if (pos < n - 1) { float c2[8], h2[8]; unpack8(*(const u32x4*)(rp + PROJ + OFF_CC), c2); unpack8(*(const u32x4*)(rp + PROJ + OFF_CH), h2);
              const f32x4 wa = *(const f32x4*)(cw + 512 + cc), wb = *(const f32x4*)(cw + 512 + cc + 4);
#pragma unroll
              for (int e = 0; e < 8; ++e) acc[e] += c2[e] * h2[e] * (e < 4 ? wa[e & 3] : wb[e & 3]); }
#pragma unroll
          for (int e = 0; e < 8; ++e) acc[e] *= bv[e];
          *(u32x4*)(Y + (size_t)v * D + cc) = pack8(acc);
      } }
    { const float* lg = p.in[I_LNG] + l * 256 + 4 * lane; const float* lb = p.in[I_LNB] + l * 256 + 4 * lane;
      const f32x4 g4 = *(const f32x4*)lg, b4 = *(const f32x4*)lb;
      for (int i = 0; i < 16; ++i) {
          const int pt = wid * 16 + i;
          const u32x2 w = *(const u32x2*)(P + (size_t)(v0 + pt) * PROJ + OFF_GV + 4 * lane);
          float x[4] = {gelu_tanh(bf_lo(w.x)), gelu_tanh(bf_hi(w.x)), gelu_tanh(bf_lo(w.y)), gelu_tanh(bf_hi(w.y))};
          const float mu = wave_sum(x[0] + x[1] + x[2] + x[3], lane) * (1.0f / 256);
          float q = 0.f;
#pragma unroll
          for (int e = 0; e < 4; ++e) { x[e] -= mu; q += x[e] * x[e]; }
          const float rstd = rsqrtf(wave_sum(q, lane) * (1.0f / 256) + EPS);
#pragma unroll
          for (int e = 0; e < 4; ++e) { const float y = x[e] * rstd * g4[e] + b4[e]; vT[(4 * lane + e) * 136 + pt] = (bf16_t)(cvt_pk_bf16(y, 0.f) & 0xffffu); }
      } }
    __syncthreads();
    { const int g = wid >> 1, ph = wid & 1;
      const bf16_t* wsb = (const bf16_t*)(p.ws + WS_WT) + (size_t)l * W_LAYER + W_GWS + (size_t)g * 128 * 128;
      f32x4 acc[4][4];
#pragma unroll
      for (int a = 0; a < 4; ++a)
#pragma unroll
          for (int b = 0; b < 4; ++b) acc[a][b] = (f32x4){0.f, 0.f, 0.f, 0.f};
#pragma unroll
      for (int kk = 0; kk < 4; ++kk) {
          bf16x8 af[4], bfr[4];
#pragma unroll
          for (int db = 0; db < 4; ++db) af[db] = *(const LAS bf16x8*)(vT + (g * 64 + db * 16 + fr) * 136 + kk * 32 + fq * 8);
#pragma unroll
          for (int pb = 0; pb < 4; ++pb) bfr[pb] = *(const bf16x8*)(wsb + (size_t)((ph * 4 + pb) * 16 + fr) * 128 + kk * 32 + fq * 8);
#pragma unroll
          for (int db = 0; db < 4; ++db)
#pragma unroll
              for (int pb = 0; pb < 4; ++pb) acc[db][pb] = __builtin_amdgcn_mfma_f32_16x16x32_bf16(af[db], bfr[pb], acc[db][pb], 0, 0, 0);
      }
      const float* bs = p.in[I_GBS] + (size_t)l * 512 + g * 128;
#pragma unroll
      for (int pb = 0; pb < 4; ++pb) { const int pt = (ph * 4 + pb) * 16 + fr; const float bias = bs[pt];
          const bf16_t* up = P + (size_t)(v0 + pt) * PROJ + OFF_GU + g * 64 + fq * 4;
          bf16_t* yp = Y + (size_t)(v0 + pt) * D + 256 + g * 64 + fq * 4;
#pragma unroll
          for (int db = 0; db < 4; ++db) { const u32x2 w = *(const u32x2*)(up + db * 16);
              const float y0 = gelu_tanh(bf_lo(w.x)) * (acc[db][pb][0] + bias), y1 = gelu_tanh(bf_hi(w.x)) * (acc[db][pb][1] + bias);
              const float y2 = gelu_tanh(bf_lo(w.y)) * (acc[db][pb][2] + bias), y3 = gelu_tanh(bf_hi(w.y)) * (acc[db][pb][3] + bias);
              u32x2 ov; ov.x = cvt_pk_bf16(y0, y1); ov.y = cvt_pk_bf16(y2, y3); *(u32x2*)(yp + db * 16) = ov; } } }
    __syncthreads();
}

__device__ void phase_mixers(const Params& p, int l, int hs, LAS unsigned char* lds) {
#ifndef SKIP_ATTN
    for (int it = bid_opaque(); it < 576; it += gridDim.x) attn_item(p, l, hs, it);
#endif
    __builtin_amdgcn_sched_barrier(0);
#ifndef SKIP_GMLP
    for (int it = (bid_opaque() + (int)gridDim.x - 64) % (int)gridDim.x; it < 288; it += gridDim.x) gmlp_conv_item(p, l, hs, it, lds);
#endif
}

#define XB_TMO      128
#define XB_XCNT(j)  (256  + 64 * (j))
#define XB_XSUB(j)  (1280 + 64 * (j))
#define XB_XGEN(j)  (2304 + 64 * (j))
#define XB_TOP      3328
#define XB_TOPGEN   3392
#define XCD_BAR_WORDS 3456
#define XB_SPIN_CAP (1u << 22)
__device__ __forceinline__ unsigned xb_ld(unsigned* p)              { return __hip_atomic_load(p, __ATOMIC_RELAXED, __HIP_MEMORY_SCOPE_AGENT); }
__device__ __forceinline__ unsigned xb_add(unsigned* p, unsigned v) { return __hip_atomic_fetch_add(p, v, __ATOMIC_RELAXED, __HIP_MEMORY_SCOPE_AGENT); }
__device__ __forceinline__ unsigned xb_xcc_id() { return (unsigned)__builtin_amdgcn_s_getreg((3 << 11) | 20) & 0xFu; }
#define XB_SPIN(cond, bar) do { unsigned _sp = 0; while (cond) { __builtin_amdgcn_s_sleep(1); \
    if ((++_sp & 255u) == 0u) { if (xb_ld(&(bar)[XB_TMO])) break; if (_sp > XB_SPIN_CAP) { atomicAdd(&(bar)[XB_TMO], 1u); break; } } } } while (0)
__device__ __forceinline__ void xcd_barrier_post(unsigned* bar) { if (threadIdx.x == 0) (void)xb_add(&bar[XB_XCNT(xb_xcc_id())], 1u); }
__device__ __forceinline__ void xcd_barrier_complete(unsigned* bar, unsigned x, unsigned& nloc, unsigned& nx) {
    const unsigned G = gridDim.x * gridDim.y * gridDim.z;
    unsigned sum, cnt, mine, sp = 0u;
    for (;;) {
        sum = 0u; cnt = 0u; mine = 0u;
#pragma unroll
        for (unsigned j = 0; j < 16; ++j) { const unsigned c = xb_ld(&bar[XB_XCNT(j)]); sum += c; cnt += (c > 0u) ? 1u : 0u; mine = (j == x) ? c : mine; }
        if (sum == G) break;
        __builtin_amdgcn_s_sleep(1);
        if ((++sp & 255u) == 0u) { if (xb_ld(&bar[XB_TMO])) break; if (sp > XB_SPIN_CAP) { atomicAdd(&bar[XB_TMO], 1u); break; } }
    }
    nloc = mine > 0u ? mine : 1u; nx = cnt > 0u ? cnt : 1u;
}
__device__ __forceinline__ void xcd_barrier(unsigned* bar, volatile LAS unsigned* st) {
    asm volatile("s_waitcnt vmcnt(0)" ::: "memory");
    __syncthreads();
    if (threadIdx.x == 0) {
        const unsigned x = xb_xcc_id();
        __builtin_amdgcn_s_waitcnt(0);
        unsigned nloc = st[0], nx = st[1];
        if (nloc == 0u) { xcd_barrier_complete(bar, x, nloc, nx); st[0] = nloc; st[1] = nx; }
        const unsigned old = xb_add(&bar[XB_XSUB(x)], 1u);
        const unsigned gen = old / nloc;
        if (old + 1u == (gen + 1u) * nloc) {
            __builtin_amdgcn_fence(__ATOMIC_RELEASE, "agent");
            asm volatile("s_waitcnt vmcnt(0)" ::: "memory");
            const unsigned og = xb_add(&bar[XB_TOP], 1u);
            const unsigned tg = og / nx;
            if (og + 1u == (tg + 1u) * nx) xb_add(&bar[XB_TOPGEN], 1u);
            else XB_SPIN(xb_ld(&bar[XB_TOPGEN]) == tg, bar);
            __builtin_amdgcn_fence(__ATOMIC_ACQUIRE, "agent");
            xb_add(&bar[XB_XGEN(x)], 1u);
            asm volatile("s_waitcnt vmcnt(0)" ::: "memory");
        } else {
            XB_SPIN(xb_ld(&bar[XB_XGEN(x)]) == gen, bar);
            __builtin_amdgcn_fence(__ATOMIC_ACQUIRE, "agent");
            asm volatile("s_waitcnt vmcnt(0)" ::: "memory");
        }
    }
    __syncthreads();
}

__device__ void run_phase(const Params& p, int ph, LAS unsigned char* lds) {
    if (ph == 0) {
#ifndef SKIP_SETUP
 phase_setup(p, lds);
#endif
 return; }
    const int q = ph - 1, l = q / 17, r = q % 17;
    const bf16_t* W = (const bf16_t*)(p.ws + WS_WT) + (size_t)l * W_LAYER;
    const float* MOD = (const float*)(p.ws + WS_MOD) + (size_t)l * 33 * (NMOD * D);
    bf16_t* HB = (bf16_t*)(p.ws + WS_H);
    const bool first = (l == 0 && r <= 2);
    bf16_t* A = (bf16_t*)(p.ws + WS_A); bf16_t* R1 = (bf16_t*)(p.ws + WS_R1);
    if (r == 0 || r == 3 || r == 14) {
#ifndef SKIP_NORM
 phase_norm(p, l, r == 0 ? 0 : (r == 3 ? 1 : 2), first);
#endif
 return; }
    if (r == 1 || r == 15) {
        const int j = (r == 1) ? 0 : 1;
        pg8::Gemm g{A, D, W + (j ? W_FIN1 : W_FIN0), D, T_ALL, 2 * DFF, D};
        pg8::EpiSwiglu E{R1};
#ifndef SKIP_UP
        pg8::gemm_phase(lds, g, E);
#endif
        return;
    }
    if (r == 2 || r == 16) {
        const int j = (r == 2) ? 0 : 1;
        pg8::Gemm g{R1, DFF, W + (j ? W_FOUT1 : W_FOUT0), DFF, T_ALL, D, DFF};
        pg8::EpiResid E{p.in[I_X], p.in[I_CTX], HB, p.out, MOD, j ? 8 : 2, 0.5f, 0, first ? 0 : ((l == NL - 1 && r == 16) ? 2 : 1)};
#ifndef SKIP_DOWN
        pg8::gemm_phase(lds, g, E);
#endif
        return;
    }
    const int hs = (r - 4) / 5, rr = (r - 4) % 5;
    if (rr == 0) { pg8::Gemm g{A + (size_t)hs * TH * D, D, W + W_WIN, D, TH, PROJ, D}; pg8::EpiBf16 E{R1, PROJ, p.in[I_BGATE] + (size_t)l * 3 * D, OFF_GATE};
#ifndef SKIP_PROJ
 pg8::gemm_phase(lds, g, E);
#endif
 return; }
    if (rr == 1) {
#ifndef SKIP_PREP
 phase_prep(p, l, lds);
#endif
 return; }
    if (rr == 2) {
#ifndef SKIP_MIX
 phase_mixers(p, l, hs, lds);
#endif
 return; }
    if (rr == 3) { pg8::Gemm g{A + (size_t)hs * TH * D, D, W + W_WB, D, TH, D, D}; pg8::EpiBranch E{R1};
#ifndef SKIP_BRANCH
 pg8::gemm_phase(lds, g, E);
#endif
 return; }
    { pg8::Gemm g{R1, PROJ, W + W_WO, D, TH, D, D}; pg8::EpiResid E{p.in[I_X], p.in[I_CTX], HB, p.out, MOD, 5, 1.0f, hs * TILES_H, 1};
#ifndef SKIP_OUT
 pg8::gemm_phase(lds, g, E);
#endif
 }
}

__global__ __launch_bounds__(512, 2) void fwd_megakernel(Params p) {
    extern __shared__ __attribute__((aligned(16))) unsigned char shm[];
    LAS unsigned char* lds = (LAS unsigned char*)shm;
#if MK_SINGLE
    volatile LAS unsigned* bst = (volatile LAS unsigned*)(lds + LDS_BYTES - 16);
    if (threadIdx.x == 0) { bst[0] = 0u; bst[1] = 0u; }
    __syncthreads();
    xcd_barrier_post((unsigned*)(p.ws + WS_BAR));
#endif
    for (int ph = p.ph_lo; ph < p.ph_hi; ++ph) {
#if defined(__HIP_DEVICE_COMPILE__)
        const __attribute__((address_space(4))) char* kp = (const __attribute__((address_space(4))) char*)__builtin_amdgcn_kernarg_segment_ptr();
        asm volatile("" : "+s"(kp));
        const Params lp = *(const Params*)(const char*)kp;
#else
        const Params lp = p;
#endif
        run_phase(lp, ph, lds);
#if MK_SINGLE
        if (ph + 1 < lp.ph_hi) {
            if (ph == 0) cg::this_grid().sync();
            else xcd_barrier((unsigned*)(lp.ws + WS_BAR), (volatile LAS unsigned*)(lds + LDS_BYTES - 16));
        }
#endif
    }
}

extern "C" void kernel_launch(void* const* d_in, const int* in_sizes, int n_in, void* d_out, int out_size, void* d_ws, size_t ws_size, hipStream_t stream) {
    static int grid = 0;
    if (grid == 0) {
        if (n_in != N_IN || out_size != T_LAT * D || ws_size < WS_END) { fprintf(stderr, "kernel_launch: unexpected shapes (n_in %d out %d ws %zu need %zu)\n", n_in, out_size, ws_size, (size_t)WS_END); grid = -1; return; }
        int dev = 0, cus = 0, per_cu = 0;
        (void)hipGetDevice(&dev); (void)hipDeviceGetAttribute(&cus, hipDeviceAttributeMultiprocessorCount, dev);
        if (hipFuncSetAttribute((const void*)fwd_megakernel, hipFuncAttributeMaxDynamicSharedMemorySize, LDS_BYTES) != hipSuccess) { fprintf(stderr, "kernel_launch: hipFuncSetAttribute failed\n"); grid = -1; return; }
        if (hipOccupancyMaxActiveBlocksPerMultiprocessor(&per_cu, (const void*)fwd_megakernel, 512, LDS_BYTES) != hipSuccess || per_cu < 1) { fprintf(stderr, "kernel_launch: occupancy query gave %d\n", per_cu); per_cu = 1; }
        (void)hipGetLastError();
        grid = cus * per_cu;
    }
    if (grid < 0) return;
    Params p{};
    for (int i = 0; i < N_IN; ++i) p.in[i] = (const float*)d_in[i];
    p.out = (float*)d_out; p.ws = (unsigned char*)d_ws;
#if MK_SINGLE
    p.ph_lo = 0; p.ph_hi = N_PHASES;
    if (hipMemsetAsync((char*)d_ws + WS_BAR, 0, 16384, stream) != hipSuccess) { fprintf(stderr, "kernel_launch: memset of the barrier words failed\n"); return; }
    void* args[] = {&p};
    hipError_t e = hipLaunchCooperativeKernel((const void*)fwd_megakernel, dim3(grid), dim3(512), args, LDS_BYTES, stream);
    if (e != hipSuccess) fprintf(stderr, "cooperative launch failed: %s (grid %d)\n", hipGetErrorString(e), grid);
#else
    for (int ph = 0; ph < N_PHASES; ++ph) {
        p.ph_lo = ph; p.ph_hi = ph + 1;
        hipLaunchKernelGGL(fwd_megakernel, dim3(grid), dim3(512), LDS_BYTES, stream, p);
    }
#endif
}
```

```cpp
#include <hip/hip_runtime.h>
#include <hip/hip_cooperative_groups.h>
#include <cstdio>
namespace cg = cooperative_groups;

#ifndef MK_SINGLE
#define MK_SINGLE 1
#endif

#define LAS __attribute__((address_space(3)))
typedef unsigned short bf16_t;
typedef short bf16x8 __attribute__((ext_vector_type(8)));
typedef short bf16x4 __attribute__((ext_vector_type(4)));
typedef float f32x4 __attribute__((ext_vector_type(4)));
typedef unsigned u32x4 __attribute__((ext_vector_type(4)));
typedef unsigned u32x2 __attribute__((ext_vector_type(2)));
typedef float f32x2 __attribute__((ext_vector_type(2)));

constexpr int D = 1024, NB = 32, SEQ = 2048, NL = 4, CTXL = 256, DFF = 2816, PROJ = 5120, NMOD = 9;
constexpr int T_LAT = NB * SEQ, T_CTX = NB * CTXL, T_ALL = T_LAT + T_CTX;
constexpr int H_LAT = T_LAT / 2, H_CTX = T_CTX / 2, TH = H_LAT + H_CTX;
constexpr int TILES_H = TH / 256, TILES_HL = H_LAT / 256;
constexpr int OFF_CB = 0, OFF_CC = 256, OFF_CH = 512, OFF_GU = 768, OFF_GV = 1024, OFF_Q = 1280, OFF_K = 1792, OFF_V = 1920, OFF_GATE = 2048;
constexpr float EPS = 1e-6f;
constexpr float LOG2E = 1.4426950408889634f;

enum { I_X = 0, I_C, I_CTX, I_CCTX, I_WMOD, I_BMOD, I_NORMG, I_FFNIN, I_FFNOUT, I_WIN, I_BGATE, I_CONVW, I_LNG, I_LNB, I_GWS, I_GBS, I_QG, I_KG, I_SINK, I_WBC, I_WBG, I_WBA, I_WOUT, N_IN };

constexpr size_t W_FIN0 = 0, W_FIN1 = 5767168, W_FOUT0 = 11534336, W_FOUT1 = 14417920, W_WIN = 17301504, W_WB = 22544384, W_WO = 23592960, W_GWS = 24641536, W_LAYER = 24707072;
constexpr size_t WS_WT = 0;
constexpr size_t WS_MOD = WS_WT + NL * W_LAYER * 2;
constexpr size_t WS_ROPE = WS_MOD + (size_t)NL * 33 * 9216 * 4;
constexpr size_t WS_HC = WS_ROPE + 8192;
constexpr size_t WS_A = WS_HC + (size_t)T_CTX * D * 4;
constexpr size_t WS_R1 = WS_A + (size_t)T_ALL * D * 2;
constexpr size_t WS_VTL = WS_R1 + (size_t)T_ALL * DFF * 2;
constexpr size_t WS_VTC = WS_VTL + (size_t)16 * 2 * 64 * 2048 * 2;
constexpr size_t WS_BAR = WS_VTC + (size_t)16 * 2 * 64 * 256 * 2;
constexpr size_t WS_H = WS_BAR + 16384;
constexpr size_t WS_END = WS_H + (size_t)T_ALL * D * 2;

constexpr int LDS_BYTES = 143360;
constexpr int N_PHASES = 1 + 17 * NL;

struct Params {
    const float* in[N_IN];
    float* out;
    unsigned char* ws;
    int ph_lo, ph_hi;
};

__device__ __forceinline__ unsigned cvt_pk_bf16(float lo, float hi) { unsigned r; asm volatile("v_cvt_pk_bf16_f32 %0, %1, %2" : "=v"(r) : "v"(lo), "v"(hi)); return r; }
__device__ __forceinline__ int tid_opaque() { int t = threadIdx.x; asm volatile("" : "+v"(t)); return t; }
__device__ __forceinline__ int bid_opaque() { int b = blockIdx.x; asm volatile("" : "+s"(b)); return b; }
__device__ __forceinline__ float bf_lo(unsigned w) { return __uint_as_float(w << 16); }
__device__ __forceinline__ float bf_hi(unsigned w) { return __uint_as_float(w & 0xffff0000u); }
__device__ __forceinline__ float fast_rcp(float x) { return __builtin_amdgcn_rcpf(x); }
__device__ __forceinline__ float fast_exp2(float x) { return __builtin_amdgcn_exp2f(x); }
__device__ __forceinline__ float sigmoidf_(float x) { return fast_rcp(1.0f + fast_exp2(-x * LOG2E)); }
__device__ __forceinline__ float siluf_(float x) { return x * sigmoidf_(x); }
__device__ __forceinline__ float gelu_tanh(float x) { const float z = 0.7978845608028654f * (x + 0.044715f * x * x * x); return x * sigmoidf_(2.0f * z); }
__device__ __forceinline__ float shx(float v, int m, int lane) { return __int_as_float(__builtin_amdgcn_ds_bpermute((lane ^ m) << 2, __float_as_int(v))); }
__device__ __forceinline__ float wave_sum(float v, int lane) {
    v += shx(v, 1, lane); v += shx(v, 2, lane); v += shx(v, 4, lane); v += shx(v, 8, lane); v += shx(v, 16, lane); v += shx(v, 32, lane); return v;
}
__device__ __forceinline__ void unpack8(const u32x4 w, float (&f)[8]) {
    f[0] = bf_lo(w.x); f[1] = bf_hi(w.x); f[2] = bf_lo(w.y); f[3] = bf_hi(w.y); f[4] = bf_lo(w.z); f[5] = bf_hi(w.z); f[6] = bf_lo(w.w); f[7] = bf_hi(w.w);
}
__device__ __forceinline__ u32x4 pack8(const float (&f)[8]) {
    u32x4 w; w.x = cvt_pk_bf16(f[0], f[1]); w.y = cvt_pk_bf16(f[2], f[3]); w.z = cvt_pk_bf16(f[4], f[5]); w.w = cvt_pk_bf16(f[6], f[7]); return w;
}

struct RowMap { size_t row0; int is_ctx; int modrow; };
__device__ __forceinline__ RowMap map_row(int u) {
    const int s = u / TH, v = u - s * TH; RowMap r;
    if (v < H_LAT) { r.row0 = (size_t)s * H_LAT + v; r.is_ctx = 0; r.modrow = (int)(r.row0 >> 11); }
    else { r.row0 = (size_t)s * H_CTX + (v - H_LAT); r.is_ctx = 1; r.modrow = 32; }
    return r;
}

namespace pg8 {
constexpr int BM = 256, BK = 64, HALF = 128, HTB = HALF * BK * 2, STAGE_BYTES = 8 * HTB, NXCD = 8, WGM = 8;
__device__ __forceinline__ int lds_byte(int r, int c) { const int st = (r >> 4) * 2 + (c >> 5), rr = r & 15, cc = c & 31, ob = rr * 64 + cc * 2; return st * 1024 + (ob ^ (((ob >> 9) & 1) << 5)); }
__device__ __forceinline__ void stage_rc(int b, int& R, int& C) { const int st = b / 1024, sb = b % 1024, swz = sb ^ (((sb >> 9) & 1) << 5); R = (st >> 1) * 16 + swz / 64; C = (st & 1) * 32 + (swz % 64) / 2; }
__device__ __forceinline__ int perm32(int rho) { const int n = rho >> 4, i = rho & 15; return 8 * (i >> 2) + 4 * n + (i & 3); }

struct Unit { int pm, pn; };
struct Gemm { const bf16_t* A; int lda; const bf16_t* Bt; int ldb; int M, N, K; int skip_ctx; };

struct StaticOrder {
    int nM, nN, nwg, G, c, skip;
    __device__ void init(int M, int N, int G_, int c_, int skip_) { nM = M / BM; nN = N / BM; nwg = nM * nN; G = G_; c = c_; skip = skip_; }
    __device__ bool next(int i, Unit& u) const {
        const long L = (long)i * G + c; if (L >= nwg) return false;
        int wgid = (int)L; { const int q = nwg / NXCD, r = nwg % NXCD, xcd = wgid % NXCD, off = wgid / NXCD; wgid = (xcd < r ? xcd * (q + 1) : r * (q + 1) + (xcd - r) * q) + off; }
        const int nig = WGM * nN, gid = wgid / nig, fm = gid * WGM, gsz = (nM - fm) < WGM ? (nM - fm) : WGM;
        u.pm = fm + ((wgid % nig) % gsz); u.pn = (wgid % nig) / gsz; if (skip && u.pm >= TILES_HL) u.pm += TILES_H - TILES_HL; return true;
    }
};

template <class Epi>
__device__ __forceinline__ void gemm_phase(LAS unsigned char* lds, const Gemm g, const Epi& E) {
    const int tid = tid_opaque(), wid = __builtin_amdgcn_readfirstlane(tid >> 6), lane = tid & 63, wr = wid >> 2, wc = wid & 3, fr = lane & 15, fq = lane >> 4;
    const int K = g.K, nt = K / BK;
    StaticOrder S; S.init(g.M, g.N, (int)gridDim.x, bid_opaque(), g.skip_ctx);
    unsigned voffA[2], voffB[2];
#pragma unroll
    for (int i = 0; i < 2; ++i) { int R, C; stage_rc(tid * 16 + i * 8192, R, C); const int Rb = Epi::PERM ? ((R & ~31) + perm32(R & 31)) : R;
        voffA[i] = (unsigned)(R * g.lda + C) * 2u; voffB[i] = (unsigned)(Rb * g.ldb + C) * 2u; }
    const size_t kstep = (size_t)(BK * 2);
    const size_t hstepA = (size_t)HALF * g.lda * 2, hstepB = (size_t)HALF * g.ldb * 2;
    const size_t tstepA = 2 * hstepA, tstepB = 2 * hstepB;
    const unsigned ldsw = (unsigned)wid * 1024u;
    const int aoff = lds_byte(wr * 64 + fr, fq * 8), boff = lds_byte(wc * 32 + fr, fq * 8);
#define PG8_SA(b, h) (((b) * 2 + (h)) * HTB)
#define PG8_SB(b, h) ((4 + (b) * 2 + (h)) * HTB)
#define PG8_STAGE(bufoff, gbase, voff) do { _Pragma("unroll") for (int _i = 0; _i < 2; ++_i) \
        __builtin_amdgcn_global_load_lds((const unsigned*)((const char*)(gbase) + (voff)[_i]), (LAS unsigned*)(lds + (bufoff) + ldsw + _i * 8192), 16, 0, 0); } while (0)
#define PG8_LDA(dst, b, h) do { _Pragma("unroll") for (int m = 0; m < 4; ++m) _Pragma("unroll") for (int k = 0; k < 2; ++k) dst[m][k] = *(const LAS bf16x8*)(lds + PG8_SA(b, h) + aoff + m * 2048 + k * 1024); } while (0)
#define PG8_LDB(dst, b, h) do { _Pragma("unroll") for (int n = 0; n < 2; ++n) _Pragma("unroll") for (int k = 0; k < 2; ++k) dst[n][k] = *(const LAS bf16x8*)(lds + PG8_SB(b, h) + boff + n * 2048 + k * 1024); } while (0)
#define PG8_MMA(ai, bj, At, Bt) do { __builtin_amdgcn_s_setprio(1); _Pragma("unroll") for (int m = 0; m < 4; ++m) _Pragma("unroll") for (int n = 0; n < 2; ++n) _Pragma("unroll") for (int k = 0; k < 2; ++k) \
        acc[ai][bj][m][n] = __builtin_amdgcn_mfma_f32_16x16x32_bf16(Bt[n][k], At[m][k], acc[ai][bj][m][n], 0, 0, 0); __builtin_amdgcn_s_setprio(0); } while (0)
#define PG8_WAIT_V(n) asm volatile("s_waitcnt vmcnt(" #n ")" ::: "memory")
#define PG8_WAIT_L(n) asm volatile("s_waitcnt lgkmcnt(" #n ")" ::: "memory")
#define PG8_BAR __builtin_amdgcn_s_barrier()
#define PG8_SCHED __builtin_amdgcn_sched_barrier(0)
#define PG8_KLOOP(TB, TE) for (int t = (TB); t < (TE); t += 2) { \
            const bool last = (t == nt - 2); \
            const char* a1 = cA + (size_t)(t + 1) * kstep; \
            const char* a2 = last ? nA : cA + (size_t)(t + 2) * kstep; const char* b2 = last ? nB : cB + (size_t)(t + 2) * kstep; \
            const char* a3 = a2 + kstep; const char* b3 = b2 + kstep; \
            PG8_LDB(B0, 0, 0); PG8_SCHED; PG8_LDA(At, 0, 0); PG8_STAGE(PG8_SA(1, 1), a1 + hstepA, voffA); \
            PG8_WAIT_L(8); PG8_BAR; PG8_WAIT_L(0); PG8_MMA(0, 0, At, B0); PG8_BAR; PG8_SCHED; \
            PG8_LDB(B1, 0, 1); PG8_STAGE(PG8_SB(0, 0), b2, voffB); \
            PG8_BAR; PG8_WAIT_L(0); PG8_MMA(0, 1, At, B1); PG8_BAR; \
            PG8_LDA(At, 0, 1); PG8_STAGE(PG8_SA(0, 0), a2, voffA); \
            PG8_BAR; PG8_WAIT_L(0); PG8_MMA(1, 0, At, B0); PG8_BAR; PG8_SCHED; \
            PG8_STAGE(PG8_SB(0, 1), b2 + hstepB, voffB); \
            PG8_WAIT_V(6); PG8_BAR; PG8_MMA(1, 1, At, B1); PG8_BAR; \
            PG8_LDB(B0, 1, 0); PG8_SCHED; PG8_LDA(At, 1, 0); PG8_STAGE(PG8_SA(0, 1), a2 + hstepA, voffA); \
            PG8_WAIT_L(8); PG8_BAR; PG8_WAIT_L(0); PG8_MMA(0, 0, At, B0); PG8_BAR; PG8_SCHED; \
            PG8_LDB(B1, 1, 1); PG8_STAGE(PG8_SB(1, 0), b3, voffB); \
            PG8_BAR; PG8_WAIT_L(0); PG8_MMA(0, 1, At, B1); PG8_BAR; \
            PG8_LDA(At, 1, 1); PG8_STAGE(PG8_SA(1, 0), a3, voffA); \
            PG8_BAR; PG8_WAIT_L(0); PG8_MMA(1, 0, At, B0); PG8_BAR; PG8_SCHED; \
            PG8_STAGE(PG8_SB(1, 1), b3 + hstepB, voffB); \
            PG8_WAIT_V(6); PG8_BAR; PG8_MMA(1, 1, At, B1); PG8_BAR; \
        }
    Unit cur, nxt; int ui = 0;
    if (!S.next(0, cur)) return;
    f32x4 acc[2][2][4][2];
#pragma unroll
    for (int a = 0; a < 2; ++a)
#pragma unroll
        for (int b = 0; b < 2; ++b)
#pragma unroll
            for (int m = 0; m < 4; ++m)
#pragma unroll
                for (int n = 0; n < 2; ++n) acc[a][b][m][n] = (f32x4){0.f, 0.f, 0.f, 0.f};
    bf16x8 At[4][2], B0[2][2], B1[2][2];
    const char* cA = (const char*)g.A + (size_t)cur.pm * tstepA; const char* cB = (const char*)g.Bt + (size_t)cur.pn * tstepB;
    PG8_STAGE(PG8_SB(0, 0), cB, voffB); PG8_STAGE(PG8_SA(0, 0), cA, voffA); PG8_STAGE(PG8_SB(0, 1), cB + hstepB, voffB); PG8_STAGE(PG8_SA(0, 1), cA + hstepA, voffA);
    if (wr == 1) PG8_BAR;
    PG8_WAIT_V(4); PG8_BAR;
    PG8_STAGE(PG8_SB(1, 0), cB + kstep, voffB); PG8_STAGE(PG8_SA(1, 0), cA + kstep, voffA); PG8_STAGE(PG8_SB(1, 1), cB + hstepB + kstep, voffB);
    PG8_WAIT_V(6); PG8_BAR;
    for (;;) {
        const bool has_next = S.next(ui + 1, nxt);
        const char* nA = has_next ? (const char*)g.A + (size_t)nxt.pm * tstepA : cA; const char* nB = has_next ? (const char*)g.Bt + (size_t)nxt.pn * tstepB : cB;
        if constexpr (Epi::MIDK) {
            PG8_KLOOP(0, 4)
            E.template mid<0>(acc, cur, wr, wc, fr, fq);
            PG8_KLOOP(4, 8)
            E.template mid<1>(acc, cur, wr, wc, fr, fq);
            PG8_KLOOP(8, nt)
        } else {
            PG8_KLOOP(0, nt)
        }
        E(acc, cur, wr, wc, fr, fq);
        if (!has_next) break;
#pragma unroll
        for (int a = 0; a < 2; ++a)
#pragma unroll
            for (int b = 0; b < 2; ++b)
#pragma unroll
                for (int m = 0; m < 4; ++m)
#pragma unroll
                    for (int n = 0; n < 2; ++n) acc[a][b][m][n] = (f32x4){0.f, 0.f, 0.f, 0.f};
        cur = nxt; cA = nA; cB = nB; ++ui;
    }
    PG8_WAIT_V(0);
    if (wr == 0) PG8_BAR;
    PG8_BAR;
#undef PG8_KLOOP
#undef PG8_SA
#undef PG8_SB
#undef PG8_STAGE
#undef PG8_LDA
#undef PG8_LDB
#undef PG8_MMA
#undef PG8_WAIT_V
#undef PG8_WAIT_L
#undef PG8_BAR
#undef PG8_SCHED
}

struct EpiSwiglu {
    static constexpr bool PERM = true, MIDK = false;
    bf16_t* O;
    __device__ __forceinline__ void operator()(const f32x4 (&acc)[2][2][4][2], const Unit& u, int wr, int wc, int fr, int fq) const {
        const int row0 = u.pm * BM + wr * 64 + fr, col0 = u.pn * 128 + wc * 32 + 8 * fq;
#pragma unroll
        for (int ai = 0; ai < 2; ++ai)
#pragma unroll
            for (int m = 0; m < 4; ++m) {
                float h[8];
#pragma unroll
                for (int n = 0; n < 2; ++n)
#pragma unroll
                    for (int j = 0; j < 4; ++j) h[n * 4 + j] = siluf_(acc[ai][0][m][n][j]) * acc[ai][1][m][n][j];
                *(u32x4*)(O + (size_t)(row0 + ai * HALF + m * 16) * DFF + col0) = pack8(h);
            }
    }
};
struct EpiBf16 {
    static constexpr bool PERM = true, MIDK = false;
    bf16_t* O; int ldc; const float* bias; int bias_col0;
    __device__ __forceinline__ void operator()(const f32x4 (&acc)[2][2][4][2], const Unit& u, int wr, int wc, int fr, int fq) const {
        const int row0 = u.pm * BM + wr * 64 + fr, col0 = u.pn * BM + wc * 32 + 8 * fq;
        const bool hb = (u.pn * BM >= bias_col0);
        f32x4 bv[2][2];
#pragma unroll
        for (int bj = 0; bj < 2; ++bj)
#pragma unroll
            for (int n = 0; n < 2; ++n) bv[bj][n] = hb ? *(const f32x4*)(bias + (col0 - bias_col0) + bj * HALF + 4 * n) : (f32x4){0.f, 0.f, 0.f, 0.f};
#pragma unroll
        for (int ai = 0; ai < 2; ++ai)
#pragma unroll
            for (int m = 0; m < 4; ++m) { bf16_t* rowp = O + (size_t)(row0 + ai * HALF + m * 16) * ldc + col0;
#pragma unroll
                for (int bj = 0; bj < 2; ++bj) { f32x4 v0 = acc[ai][bj][m][0] + bv[bj][0], v1 = acc[ai][bj][m][1] + bv[bj][1];
                    if (hb) {
#pragma unroll
                        for (int j = 0; j < 4; ++j) { v0[j] = 1.0f + fast_exp2(-fminf(fmaxf(v0[j], -30.f), 30.f) * LOG2E); v1[j] = 1.0f + fast_exp2(-fminf(fmaxf(v1[j], -30.f), 30.f) * LOG2E); } }
                    u32x4 w; w.x = cvt_pk_bf16(v0[0], v0[1]); w.y = cvt_pk_bf16(v0[2], v0[3]); w.z = cvt_pk_bf16(v1[0], v1[1]); w.w = cvt_pk_bf16(v1[2], v1[3]);
                    *(u32x4*)(rowp + bj * HALF) = w; } }
    }
};
struct EpiResid {
    static constexpr bool PERM = true, MIDK = false;
    const float* x_lat; const float* x_ctx; bf16_t* hbuf; float* out; const float* mod; int gate_idx; float gscale; int tile0; int mode;
    template <int MODE> __device__ __forceinline__ void body(const f32x4 (&acc)[2][2][4][2], const Unit& u, int wr, int wc, int fr, int fq) const {
        const int urow0 = (tile0 + u.pm) * BM;
        const RowMap rm = map_row(urow0);
        const float* gp = mod + (size_t)rm.modrow * (NMOD * D) + gate_idx * D;
        const int rloc = wr * 64 + fr, col0 = u.pn * BM + wc * 32 + 8 * fq;
        const float* xs = (rm.is_ctx ? x_ctx : x_lat) + rm.row0 * D + col0;
        bf16_t* hb = hbuf + (size_t)urow0 * D + col0;
        float* ob = out + rm.row0 * D + col0;
        const bool st_ok = (MODE != 2) || !rm.is_ctx;
        constexpr int MG = (MODE == 0) ? 2 : 4;
#pragma unroll
        for (int bj = 0; bj < 2; ++bj) {
            const f32x4 g0 = *(const f32x4*)(gp + col0 + bj * HALF) * gscale, g1 = *(const f32x4*)(gp + col0 + bj * HALF + 4) * gscale;
#pragma unroll
            for (int ai = 0; ai < 2; ++ai)
#pragma unroll
                for (int mg = 0; mg < 4; mg += MG) {
                    f32x4 xf[MODE == 0 ? MG : 1][2]; u32x4 xw[MODE == 0 ? 1 : MG];
#pragma unroll
                    for (int mm = 0; mm < MG; ++mm) { const size_t ro = (size_t)(rloc + ai * HALF + (mg + mm) * 16) * D + bj * HALF;
                        if constexpr (MODE == 0) { xf[mm][0] = *(const f32x4*)(xs + ro); xf[mm][1] = *(const f32x4*)(xs + ro + 4); }
                        else xw[mm] = *(const u32x4*)(hb + ro); }
                    __builtin_amdgcn_sched_barrier(0);
#pragma unroll
                    for (int mm = 0; mm < MG; ++mm) { const int m = mg + mm; const size_t ro = (size_t)(rloc + ai * HALF + m * 16) * D + bj * HALF;
                        f32x4 x0, x1;
                        if constexpr (MODE == 0) { x0 = xf[mm][0]; x1 = xf[mm][1]; }
                        else { const u32x4 w = xw[mm]; x0 = (f32x4){bf_lo(w.x), bf_hi(w.x), bf_lo(w.y), bf_hi(w.y)}; x1 = (f32x4){bf_lo(w.z), bf_hi(w.z), bf_lo(w.w), bf_hi(w.w)}; }
                        const f32x4 y0 = x0 + g0 * acc[ai][bj][m][0], y1 = x1 + g1 * acc[ai][bj][m][1];
                        if constexpr (MODE == 2) { if (st_ok) { *(f32x4*)(ob + ro) = y0; *(f32x4*)(ob + ro + 4) = y1; } }
                        else { u32x4 w; w.x = cvt_pk_bf16(y0[0], y0[1]); w.y = cvt_pk_bf16(y0[2], y0[3]); w.z = cvt_pk_bf16(y1[0], y1[1]); w.w = cvt_pk_bf16(y1[2], y1[3]); *(u32x4*)(hb + ro) = w; }
                    }
                    __builtin_amdgcn_sched_barrier(0);
                }
        }
    }
    __device__ __forceinline__ void operator()(const f32x4 (&acc)[2][2][4][2], const Unit& u, int wr, int wc, int fr, int fq) const {
        if (mode == 1) body<1>(acc, u, wr, wc, fr, fq);
        else if (mode == 0) body<0>(acc, u, wr, wc, fr, fq);
        else body<2>(acc, u, wr, wc, fr, fq);
    }
};
struct EpiBranch {
    static constexpr bool PERM = true, MIDK = true;
    bf16_t* P;
    __device__ __forceinline__ u32x4 ld_raw(unsigned off) const { return *(const u32x4*)((const char*)P + (size_t)off * 2u); }
    __device__ __forceinline__ void to_e(const u32x4 w, float (&e)[8]) const { unpack8(w, e); }
    template <int WHICH> __device__ __forceinline__ void mid(f32x4 (&acc)[2][2][4][2], const Unit& u, int wr, int wc, int fr, int fq) const {
        unsigned base = (unsigned)(u.pm * BM + wr * 64 + fr) * PROJ + (unsigned)(u.pn * BM + wc * 32 + 8 * fq) + OFF_GATE + WHICH * D;
        asm volatile("" : "+v"(base));
#pragma unroll
        for (int ai = 0; ai < 2; ++ai)
#pragma unroll
            for (int mp = 0; mp < 2; ++mp) {
                u32x4 wa[2][2], wb[2][2];
#pragma unroll
                for (int mm = 0; mm < 2; ++mm)
#pragma unroll
                    for (int bj = 0; bj < 2; ++bj) { const unsigned o = base + (unsigned)(ai * HALF + (mp * 2 + mm) * 16) * PROJ + bj * HALF; wa[mm][bj] = ld_raw(o); wb[mm][bj] = ld_raw(o + D); }
                __builtin_amdgcn_sched_barrier(0);
#pragma unroll
                for (int mm = 0; mm < 2; ++mm)
#pragma unroll
                    for (int bj = 0; bj < 2; ++bj) { float ea[8], eb[8]; to_e(wa[mm][bj], ea); to_e(wb[mm][bj], eb);
#pragma unroll
                        for (int n = 0; n < 2; ++n)
#pragma unroll
                            for (int j = 0; j < 4; ++j) acc[ai][bj][mp * 2 + mm][n][j] *= eb[n * 4 + j] * fast_rcp(ea[n * 4 + j]); }
                __builtin_amdgcn_sched_barrier(0);
            }
    }
    __device__ __forceinline__ void operator()(const f32x4 (&acc)[2][2][4][2], const Unit& u, int wr, int wc, int fr, int fq) const {
        unsigned base = (unsigned)(u.pm * BM + wr * 64 + fr) * PROJ + (unsigned)(u.pn * BM + wc * 32 + 8 * fq);
        asm volatile("" : "+v"(base));
#pragma unroll
        for (int ai = 0; ai < 2; ++ai) {
            u32x4 w2[4][2];
#pragma unroll
            for (int m = 0; m < 4; ++m)
#pragma unroll
                for (int bj = 0; bj < 2; ++bj) w2[m][bj] = ld_raw(base + (unsigned)(ai * HALF + m * 16) * PROJ + bj * HALF + OFF_GATE + 2 * D);
            __builtin_amdgcn_sched_barrier(0);
#pragma unroll
            for (int m = 0; m < 4; ++m)
#pragma unroll
                for (int bj = 0; bj < 2; ++bj) { const unsigned o = base + (unsigned)(ai * HALF + m * 16) * PROJ + bj * HALF;
                    float e2[8], ov[8]; to_e(w2[m][bj], e2);
#pragma unroll
                    for (int n = 0; n < 2; ++n)
#pragma unroll
                        for (int j = 0; j < 4; ++j) ov[n * 4 + j] = acc[ai][bj][m][n][j] * fast_rcp(e2[n * 4 + j]);
                    *(u32x4*)((char*)P + (size_t)o * 2u) = pack8(ov); }
            __builtin_amdgcn_sched_barrier(0);
        }
    }
};
}

__device__ __forceinline__ void tr_tile(LAS float* tl, const float* src, int ld_src, int k0, int c0, bf16_t* dst, int ld_dst, int n0, int dk0) {
    const int tid = tid_opaque();
    { const int n = tid & 63, kk = tid >> 6;
#pragma unroll
      for (int i = 0; i < 8; ++i) { const int k = kk + 8 * i; tl[k * 65 + n] = src[(size_t)(k0 + k) * ld_src + c0 + n]; } }
    __syncthreads();
    { const int k2 = (tid & 31) * 2, nn = tid >> 5;
#pragma unroll
      for (int i = 0; i < 4; ++i) { const int n = nn + 16 * i; *(unsigned*)(dst + (size_t)(n0 + n) * ld_dst + dk0 + k2) = cvt_pk_bf16(tl[k2 * 65 + n], tl[(k2 + 1) * 65 + n]); } }
    __syncthreads();
}
__device__ __forceinline__ void tr_job(LAS float* tl, const float* src, int ld_src, int K, int Nout, bf16_t* dst, int ld_dst, int dkofs, int mode) {
    const int nkt = K / 64, ntl = nkt * (Nout / 64);
    for (int t = bid_opaque(); t < ntl; t += gridDim.x) {
        const int kt = t % nkt, ntile = t / nkt, n0 = ntile * 64;
        int c0 = n0;
        if (mode == 1) { const int pn = n0 >> 8, r = n0 & 255; c0 = (r < 128) ? pn * 128 + r : DFF + pn * 128 + (r - 128); }
        tr_tile(tl, src, ld_src, kt * 64, c0, dst, ld_dst, n0, dkofs + kt * 64);
    }
}

__device__ void phase_setup(const Params& p, LAS unsigned char* lds) {
    const int tid = tid_opaque(), wid = tid >> 6, lane = tid & 63;
    bf16_t* WT = (bf16_t*)(p.ws + WS_WT);
    LAS float* tl = (LAS float*)lds;
    for (int l = 0; l < NL; ++l) {
        bf16_t* W = WT + (size_t)l * W_LAYER;
        for (int j = 0; j < 2; ++j) {
            tr_job(tl, p.in[I_FFNIN] + ((size_t)l * 2 + j) * D * (2 * DFF), 2 * DFF, D, 2 * DFF, W + (j ? W_FIN1 : W_FIN0), D, 0, 1);
            tr_job(tl, p.in[I_FFNOUT] + ((size_t)l * 2 + j) * DFF * D, D, DFF, D, W + (j ? W_FOUT1 : W_FOUT0), DFF, 0, 0);
        }
        tr_job(tl, p.in[I_WIN] + (size_t)l * D * PROJ, PROJ, D, PROJ, W + W_WIN, D, 0, 0);
        tr_job(tl, p.in[I_WBC] + (size_t)l * 256 * D, D, 256, D, W + W_WB, D, 0, 0);
        tr_job(tl, p.in[I_WBG] + (size_t)l * 256 * D, D, 256, D, W + W_WB, D, 256, 0);
        tr_job(tl, p.in[I_WBA] + (size_t)l * 512 * D, D, 512, D, W + W_WB, D, 512, 0);
        tr_job(tl, p.in[I_WOUT] + (size_t)l * D * D, D, D, D, W + W_WO, D, 0, 0);
        for (int i = bid_opaque() * 512 + tid; i < 65536 / 2; i += gridDim.x * 512) {
            const float2 v = *(const float2*)(p.in[I_GWS] + (size_t)l * 65536 + 2 * i);
            *(unsigned*)(W + W_GWS + 2 * i) = cvt_pk_bf16(v.x, v.y);
        }
    }
    { const int gi = bid_opaque() * 512 + tid;
      if (gi < 1024) { const int pos = gi >> 4, i = gi & 15;
        const int i4 = i & 3, i16 = i >> 2;
        float inv = (i4 == 0) ? 1.0f : (i4 == 1) ? 0.5623413251903491f : (i4 == 2) ? 0.31622776601683794f : 0.1778279410038923f;
        inv *= (i16 == 0) ? 1.0f : (i16 == 1) ? 0.1f : (i16 == 2) ? 0.01f : 0.001f;
        const float a = (float)pos * inv;
        const float kq = __builtin_rintf(a * 0.6366197723675814f);
        float r = __builtin_fmaf(-kq, 1.5707963705062866f, a); r = __builtin_fmaf(kq, 4.371139000186241e-8f, r);
        const float r2 = r * r;
        const float sn = r * (1.0f + r2 * (-1.0f / 6 + r2 * (1.0f / 120 + r2 * (-1.0f / 5040 + r2 * (1.0f / 362880)))));
        const float cs = 1.0f + r2 * (-0.5f + r2 * (1.0f / 24 + r2 * (-1.0f / 720 + r2 * (1.0f / 40320 + r2 * (-1.0f / 3628800)))));
        const int q = ((int)kq) & 3;
        const float c = (q == 0) ? cs : (q == 1) ? -sn : (q == 2) ? -cs : sn;
        const float s = (q == 0) ? sn : (q == 1) ? cs : (q == 2) ? -sn : -cs;
        float2* rt = (float2*)(p.ws + WS_ROPE); rt[gi] = make_float2(c, s); } }
    if (bid_opaque() < NL * 36) {
        LAS float* sc = (LAS float*)lds;
        __syncthreads();
        for (int i = tid; i < 33 * D; i += 512) { const int r = i >> 10, k = i & 1023; const float v = (r < 32) ? p.in[I_C][r * D + k] : p.in[I_CCTX][k]; sc[i] = siluf_(v); }
        __syncthreads();
        float* MOD = (float*)(p.ws + WS_MOD);
        for (int it = bid_opaque(); it < NL * 36; it += gridDim.x) {
            const int l = it / 36, cgp = it % 36, n0 = cgp * 256 + lane * 4;
            const float* wp = p.in[I_WMOD] + (size_t)l * D * (NMOD * D) + n0;
            f32x4 a[5];
#pragma unroll
            for (int i = 0; i < 5; ++i) a[i] = (f32x4){0.f, 0.f, 0.f, 0.f};
            for (int k = 0; k < D; k += 4) {
                f32x4 w[4];
#pragma unroll
                for (int kk = 0; kk < 4; ++kk) w[kk] = *(const f32x4*)(wp + (size_t)(k + kk) * (NMOD * D));
#pragma unroll
                for (int i = 0; i < 5; ++i) { const int r = (i < 4) ? wid + 8 * i : 32; const f32x4 s = *(const LAS f32x4*)(sc + r * D + k);
                    a[i] += s[0] * w[0] + s[1] * w[1] + s[2] * w[2] + s[3] * w[3]; }
            }
            const f32x4 bv = *(const f32x4*)(p.in[I_BMOD] + (size_t)l * (NMOD * D) + n0);
#pragma unroll
            for (int i = 0; i < 5; ++i) { const int r = (i < 4) ? wid + 8 * i : 32; if (i < 4 || wid == 0) *(f32x4*)(MOD + ((size_t)l * 33 + r) * (NMOD * D) + n0) = a[i] + bv; }
        }
        __syncthreads();
    }
}

__device__ void phase_norm(const Params& p, int l, int j, bool from_inputs, bool skip_ctx) {
    const int tid = tid_opaque(), wid = tid >> 6, lane = tid & 63;
    bf16_t* A = (bf16_t*)(p.ws + WS_A);
    const bf16_t* hbuf = (const bf16_t*)(p.ws + WS_H);
    const float* MOD = (const float*)(p.ws + WS_MOD) + (size_t)l * 33 * (NMOD * D);
    const float* ng = p.in[I_NORMG] + ((size_t)l * 3 + j) * D;
    for (int u = bid_opaque() * 8 + wid; u < T_ALL; u += gridDim.x * 8) {
        const RowMap rm = map_row(u);
        if (skip_ctx && rm.is_ctx) continue;
        const float* sh = MOD + (size_t)rm.modrow * (NMOD * D) + (3 * j) * D; const float* sc = sh + D;
        f32x4 v[4]; float ss = 0.f;
        if (from_inputs) { const float* x = (rm.is_ctx ? p.in[I_CTX] : p.in[I_X]) + rm.row0 * D;
#pragma unroll
            for (int i = 0; i < 4; ++i) v[i] = *(const f32x4*)(x + i * 256 + lane * 4);
        } else { const bf16_t* x = hbuf + (size_t)u * D;
#pragma unroll
            for (int i = 0; i < 4; ++i) { const u32x2 w = *(const u32x2*)(x + i * 256 + lane * 4); v[i] = (f32x4){bf_lo(w.x), bf_hi(w.x), bf_lo(w.y), bf_hi(w.y)}; }
        }
#pragma unroll
        for (int i = 0; i < 4; ++i) ss += v[i][0] * v[i][0] + v[i][1] * v[i][1] + v[i][2] * v[i][2] + v[i][3] * v[i][3];
        ss = wave_sum(ss, lane);
        const float rstd = rsqrtf(ss * (1.0f / D) + EPS);
#pragma unroll
        for (int i = 0; i < 4; ++i) { const int k = i * 256 + lane * 4;
            const f32x4 g = *(const f32x4*)(ng + k), s1 = *(const f32x4*)(sc + k), s0 = *(const f32x4*)(sh + k);
            const f32x4 y = v[i] * rstd * g * (s1 + 1.0f) + s0;
            u32x2 w; w.x = cvt_pk_bf16(y[0], y[1]); w.y = cvt_pk_bf16(y[2], y[3]);
            *(u32x2*)(A + (size_t)u * D + k) = w; }
    }
}

__device__ void phase_prep(const Params& p, int l, LAS unsigned char* lds) {
    const int tid = tid_opaque(), wid = tid >> 6, lane = tid & 63;
    bf16_t* P = (bf16_t*)(p.ws + WS_R1);
    bf16_t* VTL = (bf16_t*)(p.ws + WS_VTL); bf16_t* VTC = (bf16_t*)(p.ws + WS_VTC);
    const float* qg = p.in[I_QG] + l * 64; const float* kg = p.in[I_KG] + l * 64;
    LAS bf16_t* Vs = (LAS bf16_t*)lds;
    const LAS f32x2* rts = (const LAS f32x2*)(lds + 20480);
    __syncthreads();
    *(LAS u32x4*)(lds + 20480 + tid * 16) = *(const u32x4*)(p.ws + WS_ROPE + tid * 16);
    __syncthreads();
    const int c = lane & 7, seg = c >> 2, hf = (c >> 1) & 1, i0 = (c & 1) * 8;
    float gq[8], gk[8];
#pragma unroll
    for (int e = 0; e < 8; ++e) { gq[e] = qg[8 * c + e]; gk[e] = kg[8 * c + e]; }
    for (int it = bid_opaque(); it < TH / 64; it += gridDim.x) {
        const int v0 = it * 64; const bool lat = v0 < H_LAT;
        const int prow = (v0 & (SEQ - 1)) >> 6;
        bf16_t* rowb = P + (size_t)(v0 + wid * 8) * PROJ;
        const int qoff = OFF_Q + (lane >> 3) * 64 + 8 * c, koff = OFF_K + ((lane >> 3) & 1) * 64 + 8 * c;
        u32x4 qr[8], kr[8]; unsigned vr[8];
#pragma unroll
        for (int i = 0; i < 8; ++i) { const bf16_t* rp = rowb + (size_t)i * PROJ; qr[i] = *(const u32x4*)(rp + qoff); kr[i] = *(const u32x4*)(rp + koff); vr[i] = *(const unsigned*)(rp + OFF_V + 2 * lane); }
#pragma unroll
        for (int i = 0; i < 8; ++i) {
            const int rl = wid * 8 + i;
            bf16_t* rowp = rowb + (size_t)i * PROJ;
            const int pp = seg ? rl : prow;
            float cs[8], sn[8];
#pragma unroll
            for (int e = 0; e < 8; ++e) { const f32x2 t2 = rts[pp * 16 + i0 + e]; cs[e] = lat ? t2[0] : 1.0f; sn[e] = lat ? t2[1] : 0.0f; }
            { float x[8]; unpack8(qr[i], x);
              float ss = 0.f;
#pragma unroll
              for (int e = 0; e < 8; ++e) ss += x[e] * x[e];
              ss += shx(ss, 1, lane); ss += shx(ss, 2, lane); ss += shx(ss, 4, lane);
              const float rstd = rsqrtf(ss * (1.0f / 64) + EPS); float o[8];
#pragma unroll
              for (int e = 0; e < 8; ++e) { const float y = x[e] * rstd * gq[e]; const float yp = shx(y, 2, lane);
                  o[e] = (hf ? (y * cs[e] + yp * sn[e]) : (y * cs[e] - yp * sn[e])) * (0.125f * LOG2E); }
              *(u32x4*)(rowp + qoff) = pack8(o); }
            { float x[8]; unpack8(kr[i], x);
              float ss = 0.f;
#pragma unroll
              for (int e = 0; e < 8; ++e) ss += x[e] * x[e];
              ss += shx(ss, 1, lane); ss += shx(ss, 2, lane); ss += shx(ss, 4, lane);
              const float rstd = rsqrtf(ss * (1.0f / 64) + EPS); float o[8];
#pragma unroll
              for (int e = 0; e < 8; ++e) { const float y = x[e] * rstd * gk[e]; const float yp = shx(y, 2, lane);
                  o[e] = hf ? (y * cs[e] + yp * sn[e]) : (y * cs[e] - yp * sn[e]); }
              if (lane < 16) *(u32x4*)(rowp + koff) = pack8(o); }
            { const unsigned w = vr[i];
              Vs[(2 * lane) * 72 + rl] = (bf16_t)(w & 0xffffu); Vs[(2 * lane + 1) * 72 + rl] = (bf16_t)(w >> 16); }
        }
        __syncthreads();
        { const int hd = tid >> 2, ch = tid & 3;
          bf16_t* dst;
          if (lat) { const int bl = v0 >> 11, pos0 = v0 & (SEQ - 1); dst = VTL + ((size_t)bl * 128 + hd) * SEQ + pos0 + ch * 16; }
          else { const int cv = v0 - H_LAT, bl = cv >> 8, pos0 = cv & 255; dst = VTC + ((size_t)bl * 128 + hd) * CTXL + pos0 + ch * 16; }
          const u32x4 a = *(const LAS u32x4*)(Vs + hd * 72 + ch * 16), b = *(const LAS u32x4*)(Vs + hd * 72 + ch * 16 + 8);
          *(u32x4*)dst = a; *(u32x4*)(dst + 8) = b; }
        __syncthreads();
    }
}

struct KeySeg { const bf16_t* K; const bf16_t* Vt; int vstride; int ntiles; int mask; };

__device__ __forceinline__ void attn_item(const Params& p, int l, int hs, int idx) {
    const int tid = tid_opaque(), wid = tid >> 6, lane = tid & 63, fr = lane & 15, fq = lane >> 4;
    const bf16_t* P = (const bf16_t*)(p.ws + WS_R1);
    const bf16_t* VTL = (const bf16_t*)(p.ws + WS_VTL); const bf16_t* VTC = (const bf16_t*)(p.ws + WS_VTC);
    bf16_t* Y = (bf16_t*)(p.ws + WS_A) + (size_t)hs * TH * D;
    int bl, qb, hk; bool lat;
    if (idx < 512) { lat = true; bl = idx >> 5; qb = (idx >> 1) & 15; hk = idx & 1; }
    else { const int j = idx - 512; lat = false; bl = j >> 2; qb = (j >> 1) & 1; hk = j & 1; }
    const int g = wid >> 1, r0 = (wid & 1) * 64, head = hk * 4 + g;
    const int qrow0 = lat ? bl * SEQ + qb * 128 : H_LAT + bl * CTXL + qb * 128;
    const int crow0 = H_LAT + bl * CTXL;
    const bf16_t* vtc = VTC + ((size_t)bl * 2 + hk) * 64 * CTXL;
    const bf16_t* vtl = VTL + ((size_t)bl * 2 + hk) * 64 * SEQ;
    bf16x8 qf[4][2];
    { const bf16_t* qp = P + (size_t)(qrow0 + r0 + fr) * PROJ + OFF_Q + head * 64 + fq * 8;
#pragma unroll
      for (int nq = 0; nq < 4; ++nq)
#pragma unroll
          for (int ks = 0; ks < 2; ++ks) qf[nq][ks] = *(const bf16x8*)(qp + (size_t)nq * 16 * PROJ + ks * 32); }
    f32x4 o[4][4];
#pragma unroll
    for (int a = 0; a < 4; ++a)
#pragma unroll
        for (int b = 0; b < 4; ++b) o[a][b] = (f32x4){0.f, 0.f, 0.f, 0.f};
    const float snk = p.in[I_SINK][l * 8 + head] * LOG2E;
    float mrun[4], lrun[4];
#pragma unroll
    for (int nq = 0; nq < 4; ++nq) { mrun[nq] = snk; lrun[nq] = (fq == 0) ? 1.0f : 0.0f; }

    int lo = 0, nb = 0;
    if (lat) { lo = (qb == 0) ? 4 : (r0 >> 5); const int hi = (qb == 15) ? 8 : (r0 == 0 ? 10 : 12); nb = hi - lo; }
    const int ntot = nb + 8;
    const bf16_t* kband = P + (ptrdiff_t)(bl * SEQ + (qb - 1) * 128) * PROJ + OFF_K + hk * 64 + (size_t)fr * PROJ + fq * 8;
    const bf16_t* kctx = P + (size_t)crow0 * PROJ + OFF_K + hk * 64 + (size_t)fr * PROJ + fq * 8;
    const bf16_t* vband = vtl + (ptrdiff_t)((qb - 1) * 128) + (size_t)fr * SEQ + fq * 4;
    const bf16_t* vctx = vtc + (size_t)fr * CTXL + fq * 4;
    bf16x8 kf[2][2]; bf16x4 vlo[4], vhi[4];
#define ATT_LOAD(i_, KF, VLO, VHI) do { const int _i = (i_); const bool _b = _i < nb; \
        const bf16_t* _kp = _b ? kband + (size_t)(lo + _i) * 32 * PROJ : kctx + (size_t)(_i - nb) * 32 * PROJ; \
        const bf16_t* _vp = _b ? vband + (lo + _i) * 32 : vctx + (_i - nb) * 32; const int _vs = _b ? SEQ : CTXL; \
        _Pragma("unroll") for (int kb = 0; kb < 2; ++kb) _Pragma("unroll") for (int ks = 0; ks < 2; ++ks) KF[kb][ks] = *(const bf16x8*)(_kp + (size_t)kb * 16 * PROJ + ks * 32); \
        _Pragma("unroll") for (int db = 0; db < 4; ++db) { VLO[db] = *(const bf16x4*)(_vp + (size_t)db * 16 * _vs); VHI[db] = *(const bf16x4*)(_vp + (size_t)db * 16 * _vs + 16); } } while (0)
    ATT_LOAD(0, kf, vlo, vhi);
    for (int i = 0; i < ntot; ++i) {
        bf16x8 kfn[2][2]; bf16x4 vlon[4], vhin[4];
        const int inx = (i + 1 < ntot) ? i + 1 : i;
        ATT_LOAD(inx, kfn, vlon, vhin);
        {
            const int bt = lo + i;
            const bool mask = (i < nb) && (bt < 4 || bt >= 8);
            f32x4 s[2][4];
#pragma unroll
            for (int kb = 0; kb < 2; ++kb)
#pragma unroll
                for (int nq = 0; nq < 4; ++nq) {
                    s[kb][nq] = __builtin_amdgcn_mfma_f32_16x16x32_bf16(kf[kb][0], qf[nq][0], (f32x4){0.f, 0.f, 0.f, 0.f}, 0, 0, 0);
                    s[kb][nq] = __builtin_amdgcn_mfma_f32_16x16x32_bf16(kf[kb][1], qf[nq][1], s[kb][nq], 0, 0, 0);
                }
            if (mask) {
#pragma unroll
                for (int kb = 0; kb < 2; ++kb)
#pragma unroll
                    for (int nq = 0; nq < 4; ++nq)
#pragma unroll
                        for (int j = 0; j < 4; ++j) { const int dlt = (bt * 32 - 128 + kb * 16 + fq * 4 + j) - (r0 + nq * 16 + fr);
                            if (dlt > 128 || dlt < -128) s[kb][nq][j] = -1e30f; }
            }
            bf16x8 pf[4];
#pragma unroll
            for (int nq = 0; nq < 4; ++nq) {
                float mx = fmaxf(fmaxf(fmaxf(s[0][nq][0], s[0][nq][1]), fmaxf(s[0][nq][2], s[0][nq][3])), fmaxf(fmaxf(s[1][nq][0], s[1][nq][1]), fmaxf(s[1][nq][2], s[1][nq][3])));
                mx = fmaxf(mx, shx(mx, 16, lane)); mx = fmaxf(mx, shx(mx, 32, lane));
                const float mn = fmaxf(mrun[nq], mx), alpha = fast_exp2(mrun[nq] - mn); mrun[nq] = mn;
                float pv[8], ps = 0.f;
#pragma unroll
                for (int j = 0; j < 4; ++j) { pv[j] = fast_exp2(s[0][nq][j] - mn); pv[4 + j] = fast_exp2(s[1][nq][j] - mn); ps += pv[j] + pv[4 + j]; }
                lrun[nq] = lrun[nq] * alpha + ps;
                const u32x4 w = pack8(pv); pf[nq] = *(const bf16x8*)&w;
#pragma unroll
                for (int db = 0; db < 4; ++db) o[db][nq] *= alpha;
            }
#pragma unroll
            for (int db = 0; db < 4; ++db) { const bf16x8 vf = (bf16x8){vlo[db][0], vlo[db][1], vlo[db][2], vlo[db][3], vhi[db][0], vhi[db][1], vhi[db][2], vhi[db][3]};
#pragma unroll
                for (int nq = 0; nq < 4; ++nq) o[db][nq] = __builtin_amdgcn_mfma_f32_16x16x32_bf16(vf, pf[nq], o[db][nq], 0, 0, 0); }
        }
#pragma unroll
        for (int kb = 0; kb < 2; ++kb)
#pragma unroll
            for (int ks = 0; ks < 2; ++ks) kf[kb][ks] = kfn[kb][ks];
#pragma unroll
        for (int db = 0; db < 4; ++db) { vlo[db] = vlon[db]; vhi[db] = vhin[db]; }
    }
#undef ATT_LOAD
#pragma unroll
    for (int nq = 0; nq < 4; ++nq) {
        float lt = lrun[nq]; lt += shx(lt, 16, lane); lt += shx(lt, 32, lane);
        const float inv = 1.0f / lt;
        bf16_t* yp = Y + (size_t)(qrow0 + r0 + nq * 16 + fr) * D + 512 + head * 64 + fq * 4;
#pragma unroll
        for (int db = 0; db < 4; ++db) { u32x2 w; w.x = cvt_pk_bf16(o[db][nq][0] * inv, o[db][nq][1] * inv); w.y = cvt_pk_bf16(o[db][nq][2] * inv, o[db][nq][3] * inv);
            *(u32x2*)(yp + db * 16) = w; }
    }
}

__device__ __forceinline__ void gmlp_conv_item(const Params& p, int l, int hs, int chunk, LAS unsigned char* lds) {
    const int tid = tid_opaque(), wid = tid >> 6, lane = tid & 63, fr = lane & 15, fq = lane >> 4;
    const bf16_t* P = (const bf16_t*)(p.ws + WS_R1);
    bf16_t* Y = (bf16_t*)(p.ws + WS_A) + (size_t)hs * TH * D;
    const int v0 = chunk * 128;
    LAS bf16_t* vT = (LAS bf16_t*)lds;
    { const float* cw = p.in[I_CONVW] + (size_t)l * 3 * 256;
      const bool lat = v0 < H_LAT;
#pragma unroll 2
      for (int i = 0; i < 8; ++i) {
          const int id = i * 512 + tid, pt = id >> 5, cc = (id & 31) * 8, v = v0 + pt;
          const int pos = lat ? (v & (SEQ - 1)) : ((v - H_LAT) & (CTXL - 1)), n = lat ? SEQ : CTXL;
          const bf16_t* rp = P + (size_t)v * PROJ + cc;
          float bv[8], c1[8], h1[8], acc[8];
          unpack8(*(const u32x4*)(rp + OFF_CB), bv); unpack8(*(const u32x4*)(rp + OFF_CC), c1); unpack8(*(const u32x4*)(rp + OFF_CH), h1);
          { const f32x4 wa = *(const f32x4*)(cw + 256 + cc), wb = *(const f32x4*)(cw + 256 + cc + 4);
#pragma unroll
            for (int e = 0; e < 8; ++e) acc[e] = c1[e] * h1[e] * (e < 4 ? wa[e & 3] : wb[e & 3]); }
          if (pos > 0) { float c0[8], h0[8]; unpack8(*(const u32x4*)(rp - PROJ + OFF_CC), c0); unpack8(*(const u32x4*)(rp - PROJ + OFF_CH), h0);
              const f32x4 wa = *(const f32x4*)(cw + cc), wb = *(const f32x4*)(cw + cc + 4);
#pragma unroll
              for (int e = 0; e < 8; ++e) acc[e] += c0[e] * h0[e] * (e < 4 ? wa[e & 3] : wb[e & 3]); }
          if (pos < n - 1) { float c2[8], h2[8]; unpack8(*(const u32x4*)(rp + PROJ + OFF_CC), c2); unpack8(*(const u32x4*)(rp + PROJ + OFF_CH), h2);
              const f32x4 wa = *(const f32x4*)(cw + 512 + cc), wb = *(const f32x4*)(cw + 512 + cc + 4);
#pragma unroll
              for (int e = 0; e < 8; ++e) acc[e] += c2[e] * h2[e] * (e < 4 ? wa[e & 3] : wb[e & 3]); }
#pragma unroll
          for (int e = 0; e < 8; ++e) acc[e] *= bv[e];
          *(u32x4*)(Y + (size_t)v * D + cc) = pack8(acc);
      } }
    { const float* lg = p.in[I_LNG] + l * 256 + 4 * lane; const float* lb = p.in[I_LNB] + l * 256 + 4 * lane;
      const f32x4 g4 = *(const f32x4*)lg, b4 = *(const f32x4*)lb;
#pragma unroll
      for (int hb = 0; hb < 2; ++hb) {
          u32x2 w[8]; float x[8][4], sm[8], qv[8];
#pragma unroll
          for (int i = 0; i < 8; ++i) w[i] = *(const u32x2*)(P + (size_t)(v0 + wid * 16 + hb * 8 + i) * PROJ + OFF_GV + 4 * lane);
#pragma unroll
          for (int i = 0; i < 8; ++i) { x[i][0] = gelu_tanh(bf_lo(w[i].x)); x[i][1] = gelu_tanh(bf_hi(w[i].x)); x[i][2] = gelu_tanh(bf_lo(w[i].y)); x[i][3] = gelu_tanh(bf_hi(w[i].y));
              sm[i] = (x[i][0] + x[i][1]) + (x[i][2] + x[i][3]); }
#pragma unroll
          for (int st = 1; st < 64; st <<= 1)
#pragma unroll
              for (int i = 0; i < 8; ++i) sm[i] += shx(sm[i], st, lane);
#pragma unroll
          for (int i = 0; i < 8; ++i) { const float mu = sm[i] * (1.0f / 256); float q = 0.f;
#pragma unroll
              for (int e = 0; e < 4; ++e) { x[i][e] -= mu; q += x[i][e] * x[i][e]; }
              qv[i] = q; }
#pragma unroll
          for (int st = 1; st < 64; st <<= 1)
#pragma unroll
              for (int i = 0; i < 8; ++i) qv[i] += shx(qv[i], st, lane);
#pragma unroll
          for (int i = 0; i < 8; ++i) { const float rstd = rsqrtf(qv[i] * (1.0f / 256) + EPS); const int pt = wid * 16 + hb * 8 + i;
#pragma unroll
              for (int e = 0; e < 4; ++e) { const float y = x[i][e] * rstd * g4[e] + b4[e]; vT[(4 * lane + e) * 136 + pt] = (bf16_t)(cvt_pk_bf16(y, 0.f) & 0xffffu); } }
      } }
    __syncthreads();
    { const int g = wid >> 1, ph = wid & 1;
      const bf16_t* wsb = (const bf16_t*)(p.ws + WS_WT) + (size_t)l * W_LAYER + W_GWS + (size_t)g * 128 * 128;
      f32x4 acc[4][4];
#pragma unroll
      for (int a = 0; a < 4; ++a)
#pragma unroll
          for (int b = 0; b < 4; ++b) acc[a][b] = (f32x4){0.f, 0.f, 0.f, 0.f};
#pragma unroll
      for (int kk = 0; kk < 4; ++kk) {
          bf16x8 af[4], bfr[4];
#pragma unroll
          for (int db = 0; db < 4; ++db) af[db] = *(const LAS bf16x8*)(vT + (g * 64 + db * 16 + fr) * 136 + kk * 32 + fq * 8);
#pragma unroll
          for (int pb = 0; pb < 4; ++pb) bfr[pb] = *(const bf16x8*)(wsb + (size_t)((ph * 4 + pb) * 16 + fr) * 128 + kk * 32 + fq * 8);
#pragma unroll
          for (int db = 0; db < 4; ++db)
#pragma unroll
              for (int pb = 0; pb < 4; ++pb) acc[db][pb] = __builtin_amdgcn_mfma_f32_16x16x32_bf16(af[db], bfr[pb], acc[db][pb], 0, 0, 0);
      }
      const float* bs = p.in[I_GBS] + (size_t)l * 512 + g * 128;
      u32x2 uw[4][4]; float bias[4];
#pragma unroll
      for (int pb = 0; pb < 4; ++pb) { const int pt = (ph * 4 + pb) * 16 + fr; bias[pb] = bs[pt];
          const bf16_t* up = P + (size_t)(v0 + pt) * PROJ + OFF_GU + g * 64 + fq * 4;
#pragma unroll
          for (int db = 0; db < 4; ++db) uw[pb][db] = *(const u32x2*)(up + db * 16); }
#pragma unroll
      for (int pb = 0; pb < 4; ++pb) { const int pt = (ph * 4 + pb) * 16 + fr;
          bf16_t* yp = Y + (size_t)(v0 + pt) * D + 256 + g * 64 + fq * 4;
#pragma unroll
          for (int db = 0; db < 4; ++db) { const u32x2 w = uw[pb][db];
              const float y0 = gelu_tanh(bf_lo(w.x)) * (acc[db][pb][0] + bias[pb]), y1 = gelu_tanh(bf_hi(w.x)) * (acc[db][pb][1] + bias[pb]);
              const float y2 = gelu_tanh(bf_lo(w.y)) * (acc[db][pb][2] + bias[pb]), y3 = gelu_tanh(bf_hi(w.y)) * (acc[db][pb][3] + bias[pb]);
              u32x2 ov; ov.x = cvt_pk_bf16(y0, y1); ov.y = cvt_pk_bf16(y2, y3); *(u32x2*)(yp + db * 16) = ov; } } }
    __syncthreads();
}

__device__ void phase_mixers(const Params& p, int l, int hs, LAS unsigned char* lds, bool skip_ctx) {
    const int n_attn = skip_ctx ? 512 : 576, n_gmlp = skip_ctx ? 256 : 288;
#ifndef SKIP_ATTN
    for (int it = bid_opaque(); it < n_attn; it += gridDim.x) attn_item(p, l, hs, it);
#endif
    __builtin_amdgcn_sched_barrier(0);
#ifndef SKIP_GMLP
    { const int G = (int)gridDim.x; int n3 = n_attn - 2 * G; n3 = n3 < 0 ? 0 : (n3 > G / 2 ? G / 2 : n3);
      const int b = bid_opaque();
      if (b >= n3) for (int it = b - n3; it < n_gmlp; it += G - n3) gmlp_conv_item(p, l, hs, it, lds); }
#endif
}

#define XB_TMO      128
#define XB_XCNT(j)  (256  + 64 * (j))
#define XB_XSUB(j)  (1280 + 64 * (j))
#define XB_XGEN(j)  (2304 + 64 * (j))
#define XB_TOP      3328
#define XB_TOPGEN   3392
#define XCD_BAR_WORDS 3456
#define XB_SPIN_CAP (1u << 22)
__device__ __forceinline__ unsigned xb_ld(unsigned* p)              { return __hip_atomic_load(p, __ATOMIC_RELAXED, __HIP_MEMORY_SCOPE_AGENT); }
__device__ __forceinline__ unsigned xb_add(unsigned* p, unsigned v) { return __hip_atomic_fetch_add(p, v, __ATOMIC_RELAXED, __HIP_MEMORY_SCOPE_AGENT); }
__device__ __forceinline__ unsigned xb_xcc_id() { return (unsigned)__builtin_amdgcn_s_getreg((3 << 11) | 20) & 0xFu; }
#define XB_SPIN(cond, bar) do { unsigned _sp = 0; while (cond) { __builtin_amdgcn_s_sleep(1); \
    if ((++_sp & 255u) == 0u) { if (xb_ld(&(bar)[XB_TMO])) break; if (_sp > XB_SPIN_CAP) { atomicAdd(&(bar)[XB_TMO], 1u); break; } } } } while (0)
__device__ __forceinline__ void xcd_barrier_post(unsigned* bar) { if (threadIdx.x == 0) (void)xb_add(&bar[XB_XCNT(xb_xcc_id())], 1u); }
__device__ __forceinline__ void xcd_barrier_complete(unsigned* bar, unsigned x, unsigned& nloc, unsigned& nx) {
    const unsigned G = gridDim.x * gridDim.y * gridDim.z;
    unsigned sum, cnt, mine, sp = 0u;
    for (;;) {
        sum = 0u; cnt = 0u; mine = 0u;
#pragma unroll
        for (unsigned j = 0; j < 16; ++j) { const unsigned c = xb_ld(&bar[XB_XCNT(j)]); sum += c; cnt += (c > 0u) ? 1u : 0u; mine = (j == x) ? c : mine; }
        if (sum == G) break;
        __builtin_amdgcn_s_sleep(1);
        if ((++sp & 255u) == 0u) { if (xb_ld(&bar[XB_TMO])) break; if (sp > XB_SPIN_CAP) { atomicAdd(&bar[XB_TMO], 1u); break; } }
    }
    nloc = mine > 0u ? mine : 1u; nx = cnt > 0u ? cnt : 1u;
}
__device__ __forceinline__ void xcd_barrier(unsigned* bar, volatile LAS unsigned* st) {
    asm volatile("s_waitcnt vmcnt(0)" ::: "memory");
    __syncthreads();
    if (threadIdx.x == 0) {
        const unsigned x = xb_xcc_id();
        __builtin_amdgcn_s_waitcnt(0);
        unsigned nloc = st[0], nx = st[1];
        if (nloc == 0u) { xcd_barrier_complete(bar, x, nloc, nx); st[0] = nloc; st[1] = nx; }
        const unsigned old = xb_add(&bar[XB_XSUB(x)], 1u);
        const unsigned gen = old / nloc;
        if (old + 1u == (gen + 1u) * nloc) {
            __builtin_amdgcn_fence(__ATOMIC_RELEASE, "agent");
            asm volatile("s_waitcnt vmcnt(0)" ::: "memory");
            const unsigned og = xb_add(&bar[XB_TOP], 1u);
            const unsigned tg = og / nx;
            if (og + 1u == (tg + 1u) * nx) xb_add(&bar[XB_TOPGEN], 1u);
            else XB_SPIN(xb_ld(&bar[XB_TOPGEN]) == tg, bar);
            __builtin_amdgcn_fence(__ATOMIC_ACQUIRE, "agent");
            xb_add(&bar[XB_XGEN(x)], 1u);
            asm volatile("s_waitcnt vmcnt(0)" ::: "memory");
        } else {
            XB_SPIN(xb_ld(&bar[XB_XGEN(x)]) == gen, bar);
            __builtin_amdgcn_fence(__ATOMIC_ACQUIRE, "agent");
            asm volatile("s_waitcnt vmcnt(0)" ::: "memory");
        }
    }
    __syncthreads();
}

__device__ void run_phase(const Params& p, int ph, LAS unsigned char* lds) {
    if (ph == 0) {
#ifndef SKIP_SETUP
 phase_setup(p, lds);
#endif
 return; }
    const int q = ph - 1, l = q / 17, r = q % 17;
    const bf16_t* W = (const bf16_t*)(p.ws + WS_WT) + (size_t)l * W_LAYER;
    const float* MOD = (const float*)(p.ws + WS_MOD) + (size_t)l * 33 * (NMOD * D);
    bf16_t* HB = (bf16_t*)(p.ws + WS_H);
    const bool first = (l == 0 && r <= 2);
    const bool lastl = (l == NL - 1);
    bf16_t* A = (bf16_t*)(p.ws + WS_A); bf16_t* R1 = (bf16_t*)(p.ws + WS_R1);
    if (r == 0 || r == 3 || r == 14) {
#ifndef SKIP_NORM
 phase_norm(p, l, r == 0 ? 0 : (r == 3 ? 1 : 2), first, lastl && r == 14);
#endif
 return; }
    if (r == 1 || r == 15) {
        const int j = (r == 1) ? 0 : 1;
        const int sk = (lastl && j == 1) ? 1 : 0;
        pg8::Gemm g{A, D, W + (j ? W_FIN1 : W_FIN0), D, sk ? T_LAT : T_ALL, 2 * DFF, D, sk};
        pg8::EpiSwiglu E{R1};
#ifndef SKIP_UP
        pg8::gemm_phase(lds, g, E);
#endif
        return;
    }
    if (r == 2 || r == 16) {
        const int j = (r == 2) ? 0 : 1;
        const int sk = (lastl && j == 1) ? 1 : 0;
        pg8::Gemm g{R1, DFF, W + (j ? W_FOUT1 : W_FOUT0), DFF, sk ? T_LAT : T_ALL, D, DFF, sk};
        pg8::EpiResid E{p.in[I_X], p.in[I_CTX], HB, p.out, MOD, j ? 8 : 2, 0.5f, 0, first ? 0 : ((l == NL - 1 && r == 16) ? 2 : 1)};
#ifndef SKIP_DOWN
        pg8::gemm_phase(lds, g, E);
#endif
        return;
    }
    const int hs = (r - 4) / 5, rr = (r - 4) % 5;
    if (rr == 0) { pg8::Gemm g{A + (size_t)hs * TH * D, D, W + W_WIN, D, TH, PROJ, D, 0}; pg8::EpiBf16 E{R1, PROJ, p.in[I_BGATE] + (size_t)l * 3 * D, OFF_GATE};
#ifndef SKIP_PROJ
 pg8::gemm_phase(lds, g, E);
#endif
 return; }
    if (rr == 1) {
#ifndef SKIP_PREP
 phase_prep(p, l, lds);
#endif
 return; }
    if (rr == 2) {
#ifndef SKIP_MIX
 phase_mixers(p, l, hs, lds, lastl);
#endif
 return; }
    if (rr == 3) { pg8::Gemm g{A + (size_t)hs * TH * D, D, W + W_WB, D, lastl ? H_LAT : TH, D, D, 0}; pg8::EpiBranch E{R1};
#ifndef SKIP_BRANCH
 pg8::gemm_phase(lds, g, E);
#endif
 return; }
    { pg8::Gemm g{R1, PROJ, W + W_WO, D, lastl ? H_LAT : TH, D, D, 0}; pg8::EpiResid E{p.in[I_X], p.in[I_CTX], HB, p.out, MOD, 5, 1.0f, hs * TILES_H, 1};
#ifndef SKIP_OUT
 pg8::gemm_phase(lds, g, E);
#endif
 }
}

__global__ __launch_bounds__(512, 2) void fwd_megakernel(Params p) {
    extern __shared__ __attribute__((aligned(16))) unsigned char shm[];
    LAS unsigned char* lds = (LAS unsigned char*)shm;
#if MK_SINGLE
    volatile LAS unsigned* bst = (volatile LAS unsigned*)(lds + LDS_BYTES - 16);
    if (threadIdx.x == 0) { bst[0] = 0u; bst[1] = 0u; }
    __syncthreads();
    xcd_barrier_post((unsigned*)(p.ws + WS_BAR));
#endif
    for (int ph = p.ph_lo; ph < p.ph_hi; ++ph) {
#if defined(__HIP_DEVICE_COMPILE__)
        const __attribute__((address_space(4))) char* kp = (const __attribute__((address_space(4))) char*)__builtin_amdgcn_kernarg_segment_ptr();
        asm volatile("" : "+s"(kp));
        const Params lp = *(const Params*)(const char*)kp;
#else
        const Params lp = p;
#endif
        run_phase(lp, ph, lds);
#if MK_SINGLE
        if (ph + 1 < lp.ph_hi) {
            if (ph == 0) cg::this_grid().sync();
            else xcd_barrier((unsigned*)(lp.ws + WS_BAR), (volatile LAS unsigned*)(lds + LDS_BYTES - 16));
        }
#endif
    }
}

extern "C" void kernel_launch(void* const* d_in, const int* in_sizes, int n_in, void* d_out, int out_size, void* d_ws, size_t ws_size, hipStream_t stream) {
    static int grid = 0;
    if (grid == 0) {
        if (n_in != N_IN || out_size != T_LAT * D || ws_size < WS_END) { fprintf(stderr, "kernel_launch: unexpected shapes (n_in %d out %d ws %zu need %zu)\n", n_in, out_size, ws_size, (size_t)WS_END); grid = -1; return; }
        int dev = 0, cus = 0, per_cu = 0;
        (void)hipGetDevice(&dev); (void)hipDeviceGetAttribute(&cus, hipDeviceAttributeMultiprocessorCount, dev);
        if (hipFuncSetAttribute((const void*)fwd_megakernel, hipFuncAttributeMaxDynamicSharedMemorySize, LDS_BYTES) != hipSuccess) { fprintf(stderr, "kernel_launch: hipFuncSetAttribute failed\n"); grid = -1; return; }
        if (hipOccupancyMaxActiveBlocksPerMultiprocessor(&per_cu, (const void*)fwd_megakernel, 512, LDS_BYTES) != hipSuccess || per_cu < 1) { fprintf(stderr, "kernel_launch: occupancy query gave %d\n", per_cu); per_cu = 1; }
        (void)hipGetLastError();
        grid = cus * per_cu;
    }
    if (grid < 0) return;
    Params p{};
    for (int i = 0; i < N_IN; ++i) p.in[i] = (const float*)d_in[i];
    p.out = (float*)d_out; p.ws = (unsigned char*)d_ws;
#if MK_SINGLE
    p.ph_lo = 0; p.ph_hi = N_PHASES;
    if (hipMemsetAsync((char*)d_ws + WS_BAR, 0, 16384, stream) != hipSuccess) { fprintf(stderr, "kernel_launch: memset of the barrier words failed\n"); return; }
    void* args[] = {&p};
    hipError_t e = hipLaunchCooperativeKernel((const void*)fwd_megakernel, dim3(grid), dim3(512), args, LDS_BYTES, stream);
    if (e != hipSuccess) fprintf(stderr, "cooperative launch failed: %s (grid %d)\n", hipGetErrorString(e), grid);
#else
    for (int ph = 0; ph < N_PHASES; ++ph) {
        p.ph_lo = ph; p.ph_hi = ph + 1;
        hipLaunchKernelGGL(fwd_megakernel, dim3(grid), dim3(512), LDS_BYTES, stream, p);
    }
#endif
}
```

```cpp
#include <hip/hip_runtime.h>
#include <hip/hip_cooperative_groups.h>
#include <cstdio>
namespace cg = cooperative_groups;

#ifndef MK_SINGLE
#define MK_SINGLE 1
#endif

#define LAS __attribute__((address_space(3)))
typedef unsigned short bf16_t;
typedef short bf16x8 __attribute__((ext_vector_type(8)));
typedef short bf16x4 __attribute__((ext_vector_type(4)));
typedef float f32x4 __attribute__((ext_vector_type(4)));
typedef unsigned u32x4 __attribute__((ext_vector_type(4)));
typedef unsigned u32x2 __attribute__((ext_vector_type(2)));
typedef float f32x2 __attribute__((ext_vector_type(2)));

constexpr int D = 1024, NB = 32, SEQ = 2048, NL = 4, CTXL = 256, DFF = 2816, PROJ = 5120, NMOD = 9;
constexpr int T_LAT = NB * SEQ, T_CTX = NB * CTXL, T_ALL = T_LAT + T_CTX;
constexpr int H_LAT = T_LAT / 2, H_CTX = T_CTX / 2, TH = H_LAT + H_CTX;
constexpr int TILES_H = TH / 256, TILES_HL = H_LAT / 256;
constexpr int OFF_CB = 0, OFF_CC = 256, OFF_CH = 512, OFF_GU = 768, OFF_GV = 1024, OFF_Q = 1280, OFF_K = 1792, OFF_V = 1920, OFF_GATE = 2048;
constexpr float EPS = 1e-6f;
constexpr float LOG2E = 1.4426950408889634f;

enum { I_X = 0, I_C, I_CTX, I_CCTX, I_WMOD, I_BMOD, I_NORMG, I_FFNIN, I_FFNOUT, I_WIN, I_BGATE, I_CONVW, I_LNG, I_LNB, I_GWS, I_GBS, I_QG, I_KG, I_SINK, I_WBC, I_WBG, I_WBA, I_WOUT, N_IN };

constexpr size_t W_FIN0 = 0, W_FIN1 = 5767168, W_FOUT0 = 11534336, W_FOUT1 = 14417920, W_WIN = 17301504, W_WB = 22544384, W_WO = 23592960, W_GWS = 24641536, W_LAYER = 24707072;
constexpr size_t WS_WT = 0;
constexpr size_t WS_MOD = WS_WT + NL * W_LAYER * 2;
constexpr size_t WS_ROPE = WS_MOD + (size_t)NL * 33 * 9216 * 4;
constexpr size_t WS_HC = WS_ROPE + 8192;
constexpr size_t WS_A = WS_HC + (size_t)T_CTX * D * 4;
constexpr size_t WS_R1 = WS_A + (size_t)T_ALL * D * 2;
constexpr size_t WS_VTL = WS_R1 + (size_t)T_ALL * DFF * 2;
constexpr size_t WS_VTC = WS_VTL + (size_t)16 * 2 * 64 * 2048 * 2;
constexpr size_t WS_BAR = WS_VTC + (size_t)16 * 2 * 64 * 256 * 2;
constexpr size_t WS_H = WS_BAR + 16384;
constexpr size_t WS_END = WS_H + (size_t)T_ALL * D * 2;

constexpr int LDS_BYTES = 143360;
constexpr int N_PHASES = 1 + 17 * NL;

struct Params {
    const float* in[N_IN];
    float* out;
    unsigned char* ws;
    int ph_lo, ph_hi;
};

__device__ __forceinline__ unsigned cvt_pk_bf16(float lo, float hi) { unsigned r; asm volatile("v_cvt_pk_bf16_f32 %0, %1, %2" : "=v"(r) : "v"(lo), "v"(hi)); return r; }
__device__ __forceinline__ int tid_opaque() { int t = threadIdx.x; asm volatile("" : "+v"(t)); return t; }
__device__ __forceinline__ int bid_opaque() { int b = blockIdx.x; asm volatile("" : "+s"(b)); return b; }
__device__ __forceinline__ float bf_lo(unsigned w) { return __uint_as_float(w << 16); }
__device__ __forceinline__ float bf_hi(unsigned w) { return __uint_as_float(w & 0xffff0000u); }
__device__ __forceinline__ float fast_rcp(float x) { return __builtin_amdgcn_rcpf(x); }
__device__ __forceinline__ float fast_exp2(float x) { return __builtin_amdgcn_exp2f(x); }
__device__ __forceinline__ float sigmoidf_(float x) { return fast_rcp(1.0f + fast_exp2(-x * LOG2E)); }
__device__ __forceinline__ float siluf_(float x) { return x * sigmoidf_(x); }
__device__ __forceinline__ float gelu_tanh(float x) { const float z = 0.7978845608028654f * (x + 0.044715f * x * x * x); return x * sigmoidf_(2.0f * z); }
__device__ __forceinline__ float shx(float v, int m, int lane) { return __int_as_float(__builtin_amdgcn_ds_bpermute((lane ^ m) << 2, __float_as_int(v))); }
__device__ __forceinline__ float wave_sum(float v, int lane) {
    v += shx(v, 1, lane); v += shx(v, 2, lane); v += shx(v, 4, lane); v += shx(v, 8, lane); v += shx(v, 16, lane); v += shx(v, 32, lane); return v;
}
__device__ __forceinline__ void unpack8(const u32x4 w, float (&f)[8]) {
    f[0] = bf_lo(w.x); f[1] = bf_hi(w.x); f[2] = bf_lo(w.y); f[3] = bf_hi(w.y); f[4] = bf_lo(w.z); f[5] = bf_hi(w.z); f[6] = bf_lo(w.w); f[7] = bf_hi(w.w);
}
__device__ __forceinline__ u32x4 pack8(const float (&f)[8]) {
    u32x4 w; w.x = cvt_pk_bf16(f[0], f[1]); w.y = cvt_pk_bf16(f[2], f[3]); w.z = cvt_pk_bf16(f[4], f[5]); w.w = cvt_pk_bf16(f[6], f[7]); return w;
}

struct RowMap { size_t row0; int is_ctx; int modrow; };
__device__ __forceinline__ RowMap map_row(int u) {
    const int s = u / TH, v = u - s * TH; RowMap r;
    if (v < H_LAT) { r.row0 = (size_t)s * H_LAT + v; r.is_ctx = 0; r.modrow = (int)(r.row0 >> 11); }
    else { r.row0 = (size_t)s * H_CTX + (v - H_LAT); r.is_ctx = 1; r.modrow = 32; }
    return r;
}

namespace pg8 {
constexpr int BM = 256, BK = 64, HALF = 128, HTB = HALF * BK * 2, STAGE_BYTES = 8 * HTB, NXCD = 8, WGM = 8;
__device__ __forceinline__ int lds_byte(int r, int c) { const int st = (r >> 4) * 2 + (c >> 5), rr = r & 15, cc = c & 31, ob = rr * 64 + cc * 2; return st * 1024 + (ob ^ (((ob >> 9) & 1) << 5)); }
__device__ __forceinline__ void stage_rc(int b, int& R, int& C) { const int st = b / 1024, sb = b % 1024, swz = sb ^ (((sb >> 9) & 1) << 5); R = (st >> 1) * 16 + swz / 64; C = (st & 1) * 32 + (swz % 64) / 2; }
__device__ __forceinline__ int perm32(int rho) { const int n = rho >> 4, i = rho & 15; return 8 * (i >> 2) + 4 * n + (i & 3); }

struct Unit { int pm, pn; };
struct Gemm { const bf16_t* A; int lda; const bf16_t* Bt; int ldb; int M, N, K; int skip_ctx; };

struct StaticOrder {
    int nM, nN, nwg, G, c, skip;
    __device__ void init(int M, int N, int G_, int c_, int skip_) { nM = M / BM; nN = N / BM; nwg = nM * nN; G = G_; c = c_; skip = skip_; }
    __device__ bool next(int i, Unit& u) const {
        const long L = (long)i * G + c; if (L >= nwg) return false;
        int wgid = (int)L; { const int q = nwg / NXCD, r = nwg % NXCD, xcd = wgid % NXCD, off = wgid / NXCD; wgid = (xcd < r ? xcd * (q + 1) : r * (q + 1) + (xcd - r) * q) + off; }
        const int nig = WGM * nN, gid = wgid / nig, fm = gid * WGM, gsz = (nM - fm) < WGM ? (nM - fm) : WGM;
        u.pm = fm + ((wgid % nig) % gsz); u.pn = (wgid % nig) / gsz; if (skip && u.pm >= TILES_HL) u.pm += TILES_H - TILES_HL; return true;
    }
};

template <class Epi>
__device__ __forceinline__ void gemm_phase(LAS unsigned char* lds, const Gemm g, const Epi& E) {
    const int tid = tid_opaque(), wid = __builtin_amdgcn_readfirstlane(tid >> 6), lane = tid & 63, wr = wid >> 2, wc = wid & 3, fr = lane & 15, fq = lane >> 4;
    const int K = g.K, nt = K / BK;
    StaticOrder S; S.init(g.M, g.N, (int)gridDim.x, bid_opaque(), g.skip_ctx);
    unsigned voffA[2], voffB[2];
#pragma unroll
    for (int i = 0; i < 2; ++i) { int R, C; stage_rc(tid * 16 + i * 8192, R, C); const int Rb = Epi::PERM ? ((R & ~31) + perm32(R & 31)) : R;
        voffA[i] = (unsigned)(R * g.lda + C) * 2u; voffB[i] = (unsigned)(Rb * g.ldb + C) * 2u; }
    const size_t kstep = (size_t)(BK * 2);
    const size_t hstepA = (size_t)HALF * g.lda * 2, hstepB = (size_t)HALF * g.ldb * 2;
    const size_t tstepA = 2 * hstepA, tstepB = 2 * hstepB;
    const unsigned ldsw = (unsigned)wid * 1024u;
    const int aoff = lds_byte(wr * 64 + fr, fq * 8), boff = lds_byte(wc * 32 + fr, fq * 8);
#define PG8_SA(b, h) (((b) * 2 + (h)) * HTB)
#define PG8_SB(b, h) ((4 + (b) * 2 + (h)) * HTB)
#define PG8_STAGE(bufoff, gbase, voff) do { _Pragma("unroll") for (int _i = 0; _i < 2; ++_i) \
        __builtin_amdgcn_global_load_lds((const unsigned*)((const char*)(gbase) + (voff)[_i]), (LAS unsigned*)(lds + (bufoff) + ldsw + _i * 8192), 16, 0, 0); } while (0)
#define PG8_LDA(dst, b, h) do { _Pragma("unroll") for (int m = 0; m < 4; ++m) _Pragma("unroll") for (int k = 0; k < 2; ++k) dst[m][k] = *(const LAS bf16x8*)(lds + PG8_SA(b, h) + aoff + m * 2048 + k * 1024); } while (0)
#define PG8_LDB(dst, b, h) do { _Pragma("unroll") for (int n = 0; n < 2; ++n) _Pragma("unroll") for (int k = 0; k < 2; ++k) dst[n][k] = *(const LAS bf16x8*)(lds + PG8_SB(b, h) + boff + n * 2048 + k * 1024); } while (0)
#define PG8_MMA(ai, bj, At, Bt) do { __builtin_amdgcn_s_setprio(1); _Pragma("unroll") for (int m = 0; m < 4; ++m) _Pragma("unroll") for (int n = 0; n < 2; ++n) _Pragma("unroll") for (int k = 0; k < 2; ++k) \
        acc[ai][bj][m][n] = __builtin_amdgcn_mfma_f32_16x16x32_bf16(Bt[n][k], At[m][k], acc[ai][bj][m][n], 0, 0, 0); __builtin_amdgcn_s_setprio(0); } while (0)
#define PG8_WAIT_V(n) asm volatile("s_waitcnt vmcnt(" #n ")" ::: "memory")
#define PG8_WAIT_L(n) asm volatile("s_waitcnt lgkmcnt(" #n ")" ::: "memory")
#define PG8_BAR __builtin_amdgcn_s_barrier()
#define PG8_SCHED __builtin_amdgcn_sched_barrier(0)
#define PG8_KLOOP(TB, TE) for (int t = (TB); t < (TE); t += 2) { \
            const bool last = (t == nt - 2); \
            const char* a1 = cA + (size_t)(t + 1) * kstep; \
            const char* a2 = last ? nA : cA + (size_t)(t + 2) * kstep; const char* b2 = last ? nB : cB + (size_t)(t + 2) * kstep; \
            const char* a3 = a2 + kstep; const char* b3 = b2 + kstep; \
            PG8_LDB(B0, 0, 0); PG8_SCHED; PG8_LDA(At, 0, 0); PG8_STAGE(PG8_SA(1, 1), a1 + hstepA, voffA); \
            PG8_WAIT_L(8); PG8_BAR; PG8_WAIT_L(0); PG8_MMA(0, 0, At, B0); PG8_BAR; PG8_SCHED; \
            PG8_LDB(B1, 0, 1); PG8_STAGE(PG8_SB(0, 0), b2, voffB); \
            PG8_BAR; PG8_WAIT_L(0); PG8_MMA(0, 1, At, B1); PG8_BAR; \
            PG8_LDA(At, 0, 1); PG8_STAGE(PG8_SA(0, 0), a2, voffA); \
            PG8_BAR; PG8_WAIT_L(0); PG8_MMA(1, 0, At, B0); PG8_BAR; PG8_SCHED; \
            PG8_STAGE(PG8_SB(0, 1), b2 + hstepB, voffB); \
            PG8_WAIT_V(6); PG8_BAR; PG8_MMA(1, 1, At, B1); PG8_BAR; \
            PG8_LDB(B0, 1, 0); PG8_SCHED; PG8_LDA(At, 1, 0); PG8_STAGE(PG8_SA(0, 1), a2 + hstepA, voffA); \
            PG8_WAIT_L(8); PG8_BAR; PG8_WAIT_L(0); PG8_MMA(0, 0, At, B0); PG8_BAR; PG8_SCHED; \
            PG8_LDB(B1, 1, 1); PG8_STAGE(PG8_SB(1, 0), b3, voffB); \
            PG8_BAR; PG8_WAIT_L(0); PG8_MMA(0, 1, At, B1); PG8_BAR; \
            PG8_LDA(At, 1, 1); PG8_STAGE(PG8_SA(1, 0), a3, voffA); \
            PG8_BAR; PG8_WAIT_L(0); PG8_MMA(1, 0, At, B0); PG8_BAR; PG8_SCHED; \
            PG8_STAGE(PG8_SB(1, 1), b3 + hstepB, voffB); \
            PG8_WAIT_V(6); PG8_BAR; PG8_MMA(1, 1, At, B1); PG8_BAR; \
        }
    Unit cur, nxt; int ui = 0;
    if (!S.next(0, cur)) return;
    f32x4 acc[2][2][4][2];
#pragma unroll
    for (int a = 0; a < 2; ++a)
#pragma unroll
        for (int b = 0; b < 2; ++b)
#pragma unroll
            for (int m = 0; m < 4; ++m)
#pragma unroll
                for (int n = 0; n < 2; ++n) acc[a][b][m][n] = (f32x4){0.f, 0.f, 0.f, 0.f};
    bf16x8 At[4][2], B0[2][2], B1[2][2];
    const char* cA = (const char*)g.A + (size_t)cur.pm * tstepA; const char* cB = (const char*)g.Bt + (size_t)cur.pn * tstepB;
    PG8_STAGE(PG8_SB(0, 0), cB, voffB); PG8_STAGE(PG8_SA(0, 0), cA, voffA); PG8_STAGE(PG8_SB(0, 1), cB + hstepB, voffB); PG8_STAGE(PG8_SA(0, 1), cA + hstepA, voffA);
    if (wr == 1) PG8_BAR;
    PG8_WAIT_V(4); PG8_BAR;
    PG8_STAGE(PG8_SB(1, 0), cB + kstep, voffB); PG8_STAGE(PG8_SA(1, 0), cA + kstep, voffA); PG8_STAGE(PG8_SB(1, 1), cB + hstepB + kstep, voffB);
    PG8_WAIT_V(6); PG8_BAR;
    for (;;) {
        const bool has_next = S.next(ui + 1, nxt);
        const char* nA = has_next ? (const char*)g.A + (size_t)nxt.pm * tstepA : cA; const char* nB = has_next ? (const char*)g.Bt + (size_t)nxt.pn * tstepB : cB;
        if constexpr (Epi::MIDK) {
            PG8_KLOOP(0, 4)
            E.template mid<0>(acc, cur, wr, wc, fr, fq);
            PG8_KLOOP(4, 8)
            E.template mid<1>(acc, cur, wr, wc, fr, fq);
            PG8_KLOOP(8, nt)
        } else {
            PG8_KLOOP(0, nt)
        }
        E(acc, cur, wr, wc, fr, fq);
        if (!has_next) break;
#pragma unroll
        for (int a = 0; a < 2; ++a)
#pragma unroll
            for (int b = 0; b < 2; ++b)
#pragma unroll
                for (int m = 0; m < 4; ++m)
#pragma unroll
                    for (int n = 0; n < 2; ++n) acc[a][b][m][n] = (f32x4){0.f, 0.f, 0.f, 0.f};
        cur = nxt; cA = nA; cB = nB; ++ui;
    }
    PG8_WAIT_V(0);
    if (wr == 0) PG8_BAR;
    PG8_BAR;
#undef PG8_KLOOP
#undef PG8_SA
#undef PG8_SB
#undef PG8_STAGE
#undef PG8_LDA
#undef PG8_LDB
#undef PG8_MMA
#undef PG8_WAIT_V
#undef PG8_WAIT_L
#undef PG8_BAR
#undef PG8_SCHED
}

struct EpiSwiglu {
    static constexpr bool PERM = true, MIDK = false;
    bf16_t* O;
    __device__ __forceinline__ void operator()(const f32x4 (&acc)[2][2][4][2], const Unit& u, int wr, int wc, int fr, int fq) const {
        const int row0 = u.pm * BM + wr * 64 + fr, col0 = u.pn * 128 + wc * 32 + 8 * fq;
#pragma unroll
        for (int ai = 0; ai < 2; ++ai)
#pragma unroll
            for (int m = 0; m < 4; ++m) {
                float h[8];
#pragma unroll
                for (int n = 0; n < 2; ++n)
#pragma unroll
                    for (int j = 0; j < 4; ++j) h[n * 4 + j] = siluf_(acc[ai][0][m][n][j]) * acc[ai][1][m][n][j];
                *(u32x4*)(O + (size_t)(row0 + ai * HALF + m * 16) * DFF + col0) = pack8(h);
            }
    }
};
struct EpiBf16 {
    static constexpr bool PERM = true, MIDK = false;
    bf16_t* O; int ldc; const float* bias; int bias_col0;
    __device__ __forceinline__ void operator()(const f32x4 (&acc)[2][2][4][2], const Unit& u, int wr, int wc, int fr, int fq) const {
        const int row0 = u.pm * BM + wr * 64 + fr, col0 = u.pn * BM + wc * 32 + 8 * fq;
        const bool hb = (u.pn * BM >= bias_col0);
        f32x4 bv[2][2];
#pragma unroll
        for (int bj = 0; bj < 2; ++bj)
#pragma unroll
            for (int n = 0; n < 2; ++n) bv[bj][n] = hb ? *(const f32x4*)(bias + (col0 - bias_col0) + bj * HALF + 4 * n) : (f32x4){0.f, 0.f, 0.f, 0.f};
#pragma unroll
        for (int ai = 0; ai < 2; ++ai)
#pragma unroll
            for (int m = 0; m < 4; ++m) { bf16_t* rowp = O + (size_t)(row0 + ai * HALF + m * 16) * ldc + col0;
#pragma unroll
                for (int bj = 0; bj < 2; ++bj) { f32x4 v0 = acc[ai][bj][m][0] + bv[bj][0], v1 = acc[ai][bj][m][1] + bv[bj][1];
                    if (hb) {
#pragma unroll
                        for (int j = 0; j < 4; ++j) { v0[j] = 1.0f + fast_exp2(-fminf(fmaxf(v0[j], -30.f), 30.f) * LOG2E); v1[j] = 1.0f + fast_exp2(-fminf(fmaxf(v1[j], -30.f), 30.f) * LOG2E); } }
                    u32x4 w; w.x = cvt_pk_bf16(v0[0], v0[1]); w.y = cvt_pk_bf16(v0[2], v0[3]); w.z = cvt_pk_bf16(v1[0], v1[1]); w.w = cvt_pk_bf16(v1[2], v1[3]);
                    *(u32x4*)(rowp + bj * HALF) = w; } }
    }
};
struct EpiResid {
    static constexpr bool PERM = true, MIDK = false;
    const float* x_lat; const float* x_ctx; bf16_t* hbuf; float* out; const float* mod; int gate_idx; float gscale; int tile0; int mode;
    template <int MODE> __device__ __forceinline__ void body(const f32x4 (&acc)[2][2][4][2], const Unit& u, int wr, int wc, int fr, int fq) const {
        const int urow0 = (tile0 + u.pm) * BM;
        const RowMap rm = map_row(urow0);
        const float* gp = mod + (size_t)rm.modrow * (NMOD * D) + gate_idx * D;
        const int rloc = wr * 64 + fr, col0 = u.pn * BM + wc * 32 + 8 * fq;
        const float* xs = (rm.is_ctx ? x_ctx : x_lat) + rm.row0 * D + col0;
        bf16_t* hb = hbuf + (size_t)urow0 * D + col0;
        float* ob = out + rm.row0 * D + col0;
        const bool st_ok = (MODE != 2) || !rm.is_ctx;
        constexpr int MG = (MODE == 0) ? 2 : 4;
#pragma unroll
        for (int bj = 0; bj < 2; ++bj) {
            const f32x4 g0 = *(const f32x4*)(gp + col0 + bj * HALF) * gscale, g1 = *(const f32x4*)(gp + col0 + bj * HALF + 4) * gscale;
#pragma unroll
            for (int ai = 0; ai < 2; ++ai)
#pragma unroll
                for (int mg = 0; mg < 4; mg += MG) {
                    f32x4 xf[MODE == 0 ? MG : 1][2]; u32x4 xw[MODE == 0 ? 1 : MG];
#pragma unroll
                    for (int mm = 0; mm < MG; ++mm) { const size_t ro = (size_t)(rloc + ai * HALF + (mg + mm) * 16) * D + bj * HALF;
                        if constexpr (MODE == 0) { xf[mm][0] = *(const f32x4*)(xs + ro); xf[mm][1] = *(const f32x4*)(xs + ro + 4); }
                        else xw[mm] = *(const u32x4*)(hb + ro); }
                    __builtin_amdgcn_sched_barrier(0);
#pragma unroll
                    for (int mm = 0; mm < MG; ++mm) { const int m = mg + mm; const size_t ro = (size_t)(rloc + ai * HALF + m * 16) * D + bj * HALF;
                        f32x4 x0, x1;
                        if constexpr (MODE == 0) { x0 = xf[mm][0]; x1 = xf[mm][1]; }
                        else { const u32x4 w = xw[mm]; x0 = (f32x4){bf_lo(w.x), bf_hi(w.x), bf_lo(w.y), bf_hi(w.y)}; x1 = (f32x4){bf_lo(w.z), bf_hi(w.z), bf_lo(w.w), bf_hi(w.w)}; }
                        const f32x4 y0 = x0 + g0 * acc[ai][bj][m][0], y1 = x1 + g1 * acc[ai][bj][m][1];
                        if constexpr (MODE == 2) { if (st_ok) { *(f32x4*)(ob + ro) = y0; *(f32x4*)(ob + ro + 4) = y1; } }
                        else { u32x4 w; w.x = cvt_pk_bf16(y0[0], y0[1]); w.y = cvt_pk_bf16(y0[2], y0[3]); w.z = cvt_pk_bf16(y1[0], y1[1]); w.w = cvt_pk_bf16(y1[2], y1[3]); *(u32x4*)(hb + ro) = w; }
                    }
                    __builtin_amdgcn_sched_barrier(0);
                }
        }
    }
    __device__ __forceinline__ void operator()(const f32x4 (&acc)[2][2][4][2], const Unit& u, int wr, int wc, int fr, int fq) const {
        if (mode == 1) body<1>(acc, u, wr, wc, fr, fq);
        else if (mode == 0) body<0>(acc, u, wr, wc, fr, fq);
        else body<2>(acc, u, wr, wc, fr, fq);
    }
};
struct EpiBranch {
    static constexpr bool PERM = true, MIDK = true;
    bf16_t* P;
    __device__ __forceinline__ u32x4 ld_raw(unsigned off) const { return *(const u32x4*)((const char*)P + (size_t)off * 2u); }
    __device__ __forceinline__ void to_e(const u32x4 w, float (&e)[8]) const { unpack8(w, e); }
    template <int WHICH> __device__ __forceinline__ void mid(f32x4 (&acc)[2][2][4][2], const Unit& u, int wr, int wc, int fr, int fq) const {
        unsigned base = (unsigned)(u.pm * BM + wr * 64 + fr) * PROJ + (unsigned)(u.pn * BM + wc * 32 + 8 * fq) + OFF_GATE + WHICH * D;
        asm volatile("" : "+v"(base));
#pragma unroll
        for (int ai = 0; ai < 2; ++ai)
#pragma unroll
            for (int mp = 0; mp < 2; ++mp) {
                u32x4 wa[2][2], wb[2][2];
#pragma unroll
                for (int mm = 0; mm < 2; ++mm)
#pragma unroll
                    for (int bj = 0; bj < 2; ++bj) { const unsigned o = base + (unsigned)(ai * HALF + (mp * 2 + mm) * 16) * PROJ + bj * HALF; wa[mm][bj] = ld_raw(o); wb[mm][bj] = ld_raw(o + D); }
                __builtin_amdgcn_sched_barrier(0);
#pragma unroll
                for (int mm = 0; mm < 2; ++mm)
#pragma unroll
                    for (int bj = 0; bj < 2; ++bj) { float ea[8], eb[8]; to_e(wa[mm][bj], ea); to_e(wb[mm][bj], eb);
#pragma unroll
                        for (int n = 0; n < 2; ++n)
#pragma unroll
                            for (int j = 0; j < 4; ++j) acc[ai][bj][mp * 2 + mm][n][j] *= eb[n * 4 + j] * fast_rcp(ea[n * 4 + j]); }
                __builtin_amdgcn_sched_barrier(0);
            }
    }
    __device__ __forceinline__ void operator()(const f32x4 (&acc)[2][2][4][2], const Unit& u, int wr, int wc, int fr, int fq) const {
        unsigned base = (unsigned)(u.pm * BM + wr * 64 + fr) * PROJ + (unsigned)(u.pn * BM + wc * 32 + 8 * fq);
        asm volatile("" : "+v"(base));
#pragma unroll
        for (int ai = 0; ai < 2; ++ai) {
            u32x4 w2[4][2];
#pragma unroll
            for (int m = 0; m < 4; ++m)
#pragma unroll
                for (int bj = 0; bj < 2; ++bj) w2[m][bj] = ld_raw(base + (unsigned)(ai * HALF + m * 16) * PROJ + bj * HALF + OFF_GATE + 2 * D);
            __builtin_amdgcn_sched_barrier(0);
#pragma unroll
            for (int m = 0; m < 4; ++m)
#pragma unroll
                for (int bj = 0; bj < 2; ++bj) { const unsigned o = base + (unsigned)(ai * HALF + m * 16) * PROJ + bj * HALF;
                    float e2[8], ov[8]; to_e(w2[m][bj], e2);
#pragma unroll
                    for (int n = 0; n < 2; ++n)
#pragma unroll
                        for (int j = 0; j < 4; ++j) ov[n * 4 + j] = acc[ai][bj][m][n][j] * fast_rcp(e2[n * 4 + j]);
                    *(u32x4*)((char*)P + (size_t)o * 2u) = pack8(ov); }
            __builtin_amdgcn_sched_barrier(0);
        }
    }
};
}

__device__ __forceinline__ void tr_job(LAS float* tl, const float* src, int ld_src, int K, int Nout, bf16_t* dst, int ld_dst, int dkofs, int mode) {
    const int tid = tid_opaque();
    const int nkt = K / 64, ntl = nkt * (Nout / 64), G = gridDim.x;
    const int ln = tid & 63, lk = tid >> 6, sk2 = (tid & 31) * 2, sn = tid >> 5;
    float r[8];
    int t = bid_opaque();
    auto src_ptr = [&](int tt) -> const float* {
        const int kt = tt % nkt, n0 = (tt / nkt) * 64; int c0 = n0;
        if (mode == 1) { const int pn = n0 >> 8, rr = n0 & 255; c0 = (rr < 128) ? pn * 128 + rr : DFF + pn * 128 + (rr - 128); }
        return src + (size_t)(kt * 64 + lk) * ld_src + c0 + ln; };
    if (t < ntl) { const float* sp = src_ptr(t);
#pragma unroll
        for (int i = 0; i < 8; ++i) r[i] = sp[(size_t)(8 * i) * ld_src]; }
    for (; t < ntl; t += G) {
#pragma unroll
        for (int i = 0; i < 8; ++i) tl[(lk + 8 * i) * 65 + ln] = r[i];
        __syncthreads();
        if (t + G < ntl) { const float* sp = src_ptr(t + G);
#pragma unroll
            for (int i = 0; i < 8; ++i) r[i] = sp[(size_t)(8 * i) * ld_src]; }
        { const int kt = t % nkt, n0 = (t / nkt) * 64;
#pragma unroll
          for (int i = 0; i < 4; ++i) { const int n = sn + 16 * i; *(unsigned*)(dst + (size_t)(n0 + n) * ld_dst + dkofs + kt * 64 + sk2) = cvt_pk_bf16(tl[sk2 * 65 + n], tl[(sk2 + 1) * 65 + n]); } }
        __syncthreads();
    }
}

__device__ void phase_setup(const Params& p, LAS unsigned char* lds) {
    const int tid = tid_opaque(), wid = tid >> 6, lane = tid & 63;
    bf16_t* WT = (bf16_t*)(p.ws + WS_WT);
    LAS float* tl = (LAS float*)lds;
    for (int l = 0; l < NL; ++l) {
        bf16_t* W = WT + (size_t)l * W_LAYER;
        for (int j = 0; j < 2; ++j) {
            tr_job(tl, p.in[I_FFNIN] + ((size_t)l * 2 + j) * D * (2 * DFF), 2 * DFF, D, 2 * DFF, W + (j ? W_FIN1 : W_FIN0), D, 0, 1);
            tr_job(tl, p.in[I_FFNOUT] + ((size_t)l * 2 + j) * DFF * D, D, DFF, D, W + (j ? W_FOUT1 : W_FOUT0), DFF, 0, 0);
        }
        tr_job(tl, p.in[I_WIN] + (size_t)l * D * PROJ, PROJ, D, PROJ, W + W_WIN, D, 0, 0);
        tr_job(tl, p.in[I_WBC] + (size_t)l * 256 * D, D, 256, D, W + W_WB, D, 0, 0);
        tr_job(tl, p.in[I_WBG] + (size_t)l * 256 * D, D, 256, D, W + W_WB, D, 256, 0);
        tr_job(tl, p.in[I_WBA] + (size_t)l * 512 * D, D, 512, D, W + W_WB, D, 512, 0);
        tr_job(tl, p.in[I_WOUT] + (size_t)l * D * D, D, D, D, W + W_WO, D, 0, 0);
        for (int i = bid_opaque() * 512 + tid; i < 65536 / 2; i += gridDim.x * 512) {
            const float2 v = *(const float2*)(p.in[I_GWS] + (size_t)l * 65536 + 2 * i);
            *(unsigned*)(W + W_GWS + 2 * i) = cvt_pk_bf16(v.x, v.y);
        }
    }
    { const int gi = bid_opaque() * 512 + tid;
      if (gi < 1024) { const int pos = gi >> 4, i = gi & 15;
        const int i4 = i & 3, i16 = i >> 2;
        float inv = (i4 == 0) ? 1.0f : (i4 == 1) ? 0.5623413251903491f : (i4 == 2) ? 0.31622776601683794f : 0.1778279410038923f;
        inv *= (i16 == 0) ? 1.0f : (i16 == 1) ? 0.1f : (i16 == 2) ? 0.01f : 0.001f;
        const float a = (float)pos * inv;
        const float kq = __builtin_rintf(a * 0.6366197723675814f);
        float r = __builtin_fmaf(-kq, 1.5707963705062866f, a); r = __builtin_fmaf(kq, 4.371139000186241e-8f, r);
        const float r2 = r * r;
        const float sn = r * (1.0f + r2 * (-1.0f / 6 + r2 * (1.0f / 120 + r2 * (-1.0f / 5040 + r2 * (1.0f / 362880)))));
        const float cs = 1.0f + r2 * (-0.5f + r2 * (1.0f / 24 + r2 * (-1.0f / 720 + r2 * (1.0f / 40320 + r2 * (-1.0f / 3628800)))));
        const int q = ((int)kq) & 3;
        const float c = (q == 0) ? cs : (q == 1) ? -sn : (q == 2) ? -cs : sn;
        const float s = (q == 0) ? sn : (q == 1) ? cs : (q == 2) ? -sn : -cs;
        float2* rt = (float2*)(p.ws + WS_ROPE); rt[gi] = make_float2(c, s); } }
    if (bid_opaque() < NL * 36) {
        LAS float* sc = (LAS float*)lds;
        __syncthreads();
        for (int i = tid; i < 33 * D; i += 512) { const int r = i >> 10, k = i & 1023; const float v = (r < 32) ? p.in[I_C][r * D + k] : p.in[I_CCTX][k]; sc[i] = siluf_(v); }
        __syncthreads();
        float* MOD = (float*)(p.ws + WS_MOD);
        for (int it = bid_opaque(); it < NL * 36; it += gridDim.x) {
            const int l = it / 36, cgp = it % 36, n0 = cgp * 256 + lane * 4;
            const float* wp = p.in[I_WMOD] + (size_t)l * D * (NMOD * D) + n0;
            f32x4 a[5];
#pragma unroll
            for (int i = 0; i < 5; ++i) a[i] = (f32x4){0.f, 0.f, 0.f, 0.f};
            for (int k = 0; k < D; k += 16) {
                f32x4 w[16];
#pragma unroll
                for (int kk = 0; kk < 16; ++kk) w[kk] = *(const f32x4*)(wp + (size_t)(k + kk) * (NMOD * D));
#pragma unroll
                for (int i = 0; i < 5; ++i) { const int r = (i < 4) ? wid + 8 * i : 32;
#pragma unroll
                    for (int k4 = 0; k4 < 4; ++k4) { const f32x4 s4 = *(const LAS f32x4*)(sc + r * D + k + 4 * k4);
                        a[i] += s4[0] * w[4 * k4] + s4[1] * w[4 * k4 + 1] + s4[2] * w[4 * k4 + 2] + s4[3] * w[4 * k4 + 3]; } }
            }
            const f32x4 bv = *(const f32x4*)(p.in[I_BMOD] + (size_t)l * (NMOD * D) + n0);
#pragma unroll
            for (int i = 0; i < 5; ++i) { const int r = (i < 4) ? wid + 8 * i : 32; if (i < 4 || wid == 0) *(f32x4*)(MOD + ((size_t)l * 33 + r) * (NMOD * D) + n0) = a[i] + bv; }
        }
        __syncthreads();
    }
}

__device__ void phase_norm(const Params& p, int l, int j, bool from_inputs, bool skip_ctx) {
    const int tid = tid_opaque(), wid = tid >> 6, lane = tid & 63;
    bf16_t* A = (bf16_t*)(p.ws + WS_A);
    const bf16_t* hbuf = (const bf16_t*)(p.ws + WS_H);
    const float* MOD = (const float*)(p.ws + WS_MOD) + (size_t)l * 33 * (NMOD * D);
    const float* ng = p.in[I_NORMG] + ((size_t)l * 3 + j) * D;
    for (int u = bid_opaque() * 8 + wid; u < T_ALL; u += gridDim.x * 8) {
        const RowMap rm = map_row(u);
        if (skip_ctx && rm.is_ctx) continue;
        const float* sh = MOD + (size_t)rm.modrow * (NMOD * D) + (3 * j) * D; const float* sc = sh + D;
        f32x4 v[4]; float ss = 0.f;
        if (from_inputs) { const float* x = (rm.is_ctx ? p.in[I_CTX] : p.in[I_X]) + rm.row0 * D;
#pragma unroll
            for (int i = 0; i < 4; ++i) v[i] = *(const f32x4*)(x + i * 256 + lane * 4);
        } else { const bf16_t* x = hbuf + (size_t)u * D;
#pragma unroll
            for (int i = 0; i < 4; ++i) { const u32x2 w = *(const u32x2*)(x + i * 256 + lane * 4); v[i] = (f32x4){bf_lo(w.x), bf_hi(w.x), bf_lo(w.y), bf_hi(w.y)}; }
        }
#pragma unroll
        for (int i = 0; i < 4; ++i) ss += v[i][0] * v[i][0] + v[i][1] * v[i][1] + v[i][2] * v[i][2] + v[i][3] * v[i][3];
        ss = wave_sum(ss, lane);
        const float rstd = rsqrtf(ss * (1.0f / D) + EPS);
#pragma unroll
        for (int i = 0; i < 4; ++i) { const int k = i * 256 + lane * 4;
            const f32x4 g = *(const f32x4*)(ng + k), s1 = *(const f32x4*)(sc + k), s0 = *(const f32x4*)(sh + k);
            const f32x4 y = v[i] * rstd * g * (s1 + 1.0f) + s0;
            u32x2 w; w.x = cvt_pk_bf16(y[0], y[1]); w.y = cvt_pk_bf16(y[2], y[3]);
            *(u32x2*)(A + (size_t)u * D + k) = w; }
    }
}

__device__ void phase_prep(const Params& p, int l, LAS unsigned char* lds) {
    const int tid = tid_opaque(), wid = tid >> 6, lane = tid & 63;
    bf16_t* P = (bf16_t*)(p.ws + WS_R1);
    bf16_t* VTL = (bf16_t*)(p.ws + WS_VTL); bf16_t* VTC = (bf16_t*)(p.ws + WS_VTC);
    const float* qg = p.in[I_QG] + l * 64; const float* kg = p.in[I_KG] + l * 64;
    LAS bf16_t* Vs = (LAS bf16_t*)lds;
    const LAS f32x2* rts = (const LAS f32x2*)(lds + 20480);
    __syncthreads();
    *(LAS u32x4*)(lds + 20480 + tid * 16) = *(const u32x4*)(p.ws + WS_ROPE + tid * 16);
    __syncthreads();
    const int c = lane & 7, seg = c >> 2, hf = (c >> 1) & 1, i0 = (c & 1) * 8;
    float gq[8], gk[8];
#pragma unroll
    for (int e = 0; e < 8; ++e) { gq[e] = qg[8 * c + e]; gk[e] = kg[8 * c + e]; }
    for (int it = bid_opaque(); it < TH / 64; it += gridDim.x) {
        const int v0 = it * 64; const bool lat = v0 < H_LAT;
        const int prow = (v0 & (SEQ - 1)) >> 6;
        bf16_t* rowb = P + (size_t)(v0 + wid * 8) * PROJ;
        const int qoff = OFF_Q + (lane >> 3) * 64 + 8 * c, koff = OFF_K + ((lane >> 3) & 1) * 64 + 8 * c;
        u32x4 qr[8], kr[8]; unsigned vr[8];
#pragma unroll
        for (int i = 0; i < 8; ++i) { const bf16_t* rp = rowb + (size_t)i * PROJ; qr[i] = *(const u32x4*)(rp + qoff); kr[i] = *(const u32x4*)(rp + koff); vr[i] = *(const unsigned*)(rp + OFF_V + 2 * lane); }
#pragma unroll
        for (int i = 0; i < 8; ++i) {
            const int rl = wid * 8 + i;
            bf16_t* rowp = rowb + (size_t)i * PROJ;
            const int pp = seg ? rl : prow;
            float cs[8], sn[8];
#pragma unroll
            for (int e = 0; e < 8; ++e) { const f32x2 t2 = rts[pp * 16 + i0 + e]; cs[e] = lat ? t2[0] : 1.0f; sn[e] = lat ? t2[1] : 0.0f; }
            { float x[8]; unpack8(qr[i], x);
              float ss = 0.f;
#pragma unroll
              for (int e = 0; e < 8; ++e) ss += x[e] * x[e];
              ss += shx(ss, 1, lane); ss += shx(ss, 2, lane); ss += shx(ss, 4, lane);
              const float rstd = rsqrtf(ss * (1.0f / 64) + EPS); float o[8];
#pragma unroll
              for (int e = 0; e < 8; ++e) { const float y = x[e] * rstd * gq[e]; const float yp = shx(y, 2, lane);
                  o[e] = (hf ? (y * cs[e] + yp * sn[e]) : (y * cs[e] - yp * sn[e])) * (0.125f * LOG2E); }
              *(u32x4*)(rowp + qoff) = pack8(o); }
            { float x[8]; unpack8(kr[i], x);
              float ss = 0.f;
#pragma unroll
              for (int e = 0; e < 8; ++e) ss += x[e] * x[e];
              ss += shx(ss, 1, lane); ss += shx(ss, 2, lane); ss += shx(ss, 4, lane);
              const float rstd = rsqrtf(ss * (1.0f / 64) + EPS); float o[8];
#pragma unroll
              for (int e = 0; e < 8; ++e) { const float y = x[e] * rstd * gk[e]; const float yp = shx(y, 2, lane);
                  o[e] = hf ? (y * cs[e] + yp * sn[e]) : (y * cs[e] - yp * sn[e]); }
              if (lane < 16) *(u32x4*)(rowp + koff) = pack8(o); }
            { const unsigned w = vr[i];
              Vs[(2 * lane) * 72 + rl] = (bf16_t)(w & 0xffffu); Vs[(2 * lane + 1) * 72 + rl] = (bf16_t)(w >> 16); }
        }
        __syncthreads();
        { const int hd = tid >> 2, ch = tid & 3;
          bf16_t* dst;
          if (lat) { const int bl = v0 >> 11, pos0 = v0 & (SEQ - 1); dst = VTL + ((size_t)bl * 128 + hd) * SEQ + pos0 + ch * 16; }
          else { const int cv = v0 - H_LAT, bl = cv >> 8, pos0 = cv & 255; dst = VTC + ((size_t)bl * 128 + hd) * CTXL + pos0 + ch * 16; }
          const u32x4 a = *(const LAS u32x4*)(Vs + hd * 72 + ch * 16), b = *(const LAS u32x4*)(Vs + hd * 72 + ch * 16 + 8);
          *(u32x4*)dst = a; *(u32x4*)(dst + 8) = b; }
        __syncthreads();
    }
}

struct KeySeg { const bf16_t* K; const bf16_t* Vt; int vstride; int ntiles; int mask; };

__device__ __forceinline__ void attn_item(const Params& p, int l, int hs, int idx) {
    const int tid = tid_opaque(), wid = tid >> 6, lane = tid & 63, fr = lane & 15, fq = lane >> 4;
    const bf16_t* P = (const bf16_t*)(p.ws + WS_R1);
    const bf16_t* VTL = (const bf16_t*)(p.ws + WS_VTL); const bf16_t* VTC = (const bf16_t*)(p.ws + WS_VTC);
    bf16_t* Y = (bf16_t*)(p.ws + WS_A) + (size_t)hs * TH * D;
    int bl, qb, hk; bool lat;
    if (idx < 512) { lat = true; bl = idx >> 5; qb = (idx >> 1) & 15; hk = idx & 1; }
    else { const int j = idx - 512; lat = false; bl = j >> 2; qb = (j >> 1) & 1; hk = j & 1; }
    const int g = wid >> 1, r0 = (wid & 1) * 64, head = hk * 4 + g;
    const int qrow0 = lat ? bl * SEQ + qb * 128 : H_LAT + bl * CTXL + qb * 128;
    const int crow0 = H_LAT + bl * CTXL;
    const bf16_t* vtc = VTC + ((size_t)bl * 2 + hk) * 64 * CTXL;
    const bf16_t* vtl = VTL + ((size_t)bl * 2 + hk) * 64 * SEQ;
    bf16x8 qf[4][2];
    { const bf16_t* qp = P + (size_t)(qrow0 + r0 + fr) * PROJ + OFF_Q + head * 64 + fq * 8;
#pragma unroll
      for (int nq = 0; nq < 4; ++nq)
#pragma unroll
          for (int ks = 0; ks < 2; ++ks) qf[nq][ks] = *(const bf16x8*)(qp + (size_t)nq * 16 * PROJ + ks * 32); }
    f32x4 o[4][4];
#pragma unroll
    for (int a = 0; a < 4; ++a)
#pragma unroll
        for (int b = 0; b < 4; ++b) o[a][b] = (f32x4){0.f, 0.f, 0.f, 0.f};
    const float snk = p.in[I_SINK][l * 8 + head] * LOG2E;
    float mrun[4], lrun[4];
#pragma unroll
    for (int nq = 0; nq < 4; ++nq) { mrun[nq] = snk; lrun[nq] = (fq == 0) ? 1.0f : 0.0f; }

    int lo = 0, nb = 0;
    if (lat) { lo = (qb == 0) ? 4 : (r0 >> 5); const int hi = (qb == 15) ? 8 : (r0 == 0 ? 10 : 12); nb = hi - lo; }
    const int ntot = nb + 8;
    const bf16_t* kband = P + (ptrdiff_t)(bl * SEQ + (qb - 1) * 128) * PROJ + OFF_K + hk * 64 + (size_t)fr * PROJ + fq * 8;
    const bf16_t* kctx = P + (size_t)crow0 * PROJ + OFF_K + hk * 64 + (size_t)fr * PROJ + fq * 8;
    const bf16_t* vband = vtl + (ptrdiff_t)((qb - 1) * 128) + (size_t)fr * SEQ + fq * 4;
    const bf16_t* vctx = vtc + (size_t)fr * CTXL + fq * 4;
    bf16x8 kf[2][2]; bf16x4 vlo[4], vhi[4];
#define ATT_LOAD(i_, KF, VLO, VHI) do { const int _i = (i_); const bool _b = _i < nb; \
        const bf16_t* _kp = _b ? kband + (size_t)(lo + _i) * 32 * PROJ : kctx + (size_t)(_i - nb) * 32 * PROJ; \
        const bf16_t* _vp = _b ? vband + (lo + _i) * 32 : vctx + (_i - nb) * 32; const int _vs = _b ? SEQ : CTXL; \
        _Pragma("unroll") for (int kb = 0; kb < 2; ++kb) _Pragma("unroll") for (int ks = 0; ks < 2; ++ks) KF[kb][ks] = *(const bf16x8*)(_kp + (size_t)kb * 16 * PROJ + ks * 32); \
        _Pragma("unroll") for (int db = 0; db < 4; ++db) { VLO[db] = *(const bf16x4*)(_vp + (size_t)db * 16 * _vs); VHI[db] = *(const bf16x4*)(_vp + (size_t)db * 16 * _vs + 16); } } while (0)
    ATT_LOAD(0, kf, vlo, vhi);
    for (int i = 0; i < ntot; ++i) {
        bf16x8 kfn[2][2]; bf16x4 vlon[4], vhin[4];
        const int inx = (i + 1 < ntot) ? i + 1 : i;
        ATT_LOAD(inx, kfn, vlon, vhin);
        {
            const int bt = lo + i;
            const bool mask = (i < nb) && (bt < 4 || bt >= 8);
            f32x4 s[2][4];
#pragma unroll
            for (int kb = 0; kb < 2; ++kb)
#pragma unroll
                for (int nq = 0; nq < 4; ++nq) {
                    s[kb][nq] = __builtin_amdgcn_mfma_f32_16x16x32_bf16(kf[kb][0], qf[nq][0], (f32x4){0.f, 0.f, 0.f, 0.f}, 0, 0, 0);
                    s[kb][nq] = __builtin_amdgcn_mfma_f32_16x16x32_bf16(kf[kb][1], qf[nq][1], s[kb][nq], 0, 0, 0);
                }
            if (mask) {
#pragma unroll
                for (int kb = 0; kb < 2; ++kb)
#pragma unroll
                    for (int nq = 0; nq < 4; ++nq)
#pragma unroll
                        for (int j = 0; j < 4; ++j) { const int dlt = (bt * 32 - 128 + kb * 16 + fq * 4 + j) - (r0 + nq * 16 + fr);
                            if (dlt > 128 || dlt < -128) s[kb][nq][j] = -1e30f; }
            }
            bf16x8 pf[4];
#pragma unroll
            for (int nq = 0; nq < 4; ++nq) {
                float mx = fmaxf(fmaxf(fmaxf(s[0][nq][0], s[0][nq][1]), fmaxf(s[0][nq][2], s[0][nq][3])), fmaxf(fmaxf(s[1][nq][0], s[1][nq][1]), fmaxf(s[1][nq][2], s[1][nq][3])));
                mx = fmaxf(mx, shx(mx, 16, lane)); mx = fmaxf(mx, shx(mx, 32, lane));
                const float mn = fmaxf(mrun[nq], mx), alpha = fast_exp2(mrun[nq] - mn); mrun[nq] = mn;
                float pv[8], ps = 0.f;
#pragma unroll
                for (int j = 0; j < 4; ++j) { pv[j] = fast_exp2(s[0][nq][j] - mn); pv[4 + j] = fast_exp2(s[1][nq][j] - mn); ps += pv[j] + pv[4 + j]; }
                lrun[nq] = lrun[nq] * alpha + ps;
                const u32x4 w = pack8(pv); pf[nq] = *(const bf16x8*)&w;
#pragma unroll
                for (int db = 0; db < 4; ++db) o[db][nq] *= alpha;
            }
#pragma unroll
            for (int db = 0; db < 4; ++db) { const bf16x8 vf = (bf16x8){vlo[db][0], vlo[db][1], vlo[db][2], vlo[db][3], vhi[db][0], vhi[db][1], vhi[db][2], vhi[db][3]};
#pragma unroll
                for (int nq = 0; nq < 4; ++nq) o[db][nq] = __builtin_amdgcn_mfma_f32_16x16x32_bf16(vf, pf[nq], o[db][nq], 0, 0, 0); }
        }
#pragma unroll
        for (int kb = 0; kb < 2; ++kb)
#pragma unroll
            for (int ks = 0; ks < 2; ++ks) kf[kb][ks] = kfn[kb][ks];
#pragma unroll
        for (int db = 0; db < 4; ++db) { vlo[db] = vlon[db]; vhi[db] = vhin[db]; }
    }
#undef ATT_LOAD
#pragma unroll
    for (int nq = 0; nq < 4; ++nq) {
        float lt = lrun[nq]; lt += shx(lt, 16, lane); lt += shx(lt, 32, lane);
        const float inv = 1.0f / lt;
        bf16_t* yp = Y + (size_t)(qrow0 + r0 + nq * 16 + fr) * D + 512 + head * 64 + fq * 4;
#pragma unroll
        for (int db = 0; db < 4; ++db) { u32x2 w; w.x = cvt_pk_bf16(o[db][nq][0] * inv, o[db][nq][1] * inv); w.y = cvt_pk_bf16(o[db][nq][2] * inv, o[db][nq][3] * inv);
            *(u32x2*)(yp + db * 16) = w; }
    }
}

__device__ __forceinline__ void gmlp_conv_item(const Params& p, int l, int hs, int chunk, LAS unsigned char* lds) {
    const int tid = tid_opaque(), wid = tid >> 6, lane = tid & 63, fr = lane & 15, fq = lane >> 4;
    const bf16_t* P = (const bf16_t*)(p.ws + WS_R1);
    bf16_t* Y = (bf16_t*)(p.ws + WS_A) + (size_t)hs * TH * D;
    const int v0 = chunk * 128;
    LAS bf16_t* vT = (LAS bf16_t*)lds;
    { const float* cw = p.in[I_CONVW] + (size_t)l * 3 * 256;
      const bool lat = v0 < H_LAT;
#pragma unroll 2
      for (int i = 0; i < 8; ++i) {
          const int id = i * 512 + tid, pt = id >> 5, cc = (id & 31) * 8, v = v0 + pt;
          const int pos = lat ? (v & (SEQ - 1)) : ((v - H_LAT) & (CTXL - 1)), n = lat ? SEQ : CTXL;
          const bf16_t* rp = P + (size_t)v * PROJ + cc;
          float bv[8], c1[8], h1[8], acc[8];
          unpack8(*(const u32x4*)(rp + OFF_CB), bv); unpack8(*(const u32x4*)(rp + OFF_CC), c1); unpack8(*(const u32x4*)(rp + OFF_CH), h1);
          { const f32x4 wa = *(const f32x4*)(cw + 256 + cc), wb = *(const f32x4*)(cw + 256 + cc + 4);
#pragma unroll
            for (int e = 0; e < 8; ++e) acc[e] = c1[e] * h1[e] * (e < 4 ? wa[e & 3] : wb[e & 3]); }
          if (pos > 0) { float c0[8], h0[8]; unpack8(*(const u32x4*)(rp - PROJ + OFF_CC), c0); unpack8(*(const u32x4*)(rp - PROJ + OFF_CH), h0);
              const f32x4 wa = *(const f32x4*)(cw + cc), wb = *(const f32x4*)(cw + cc + 4);
#pragma unroll
              for (int e = 0; e < 8; ++e) acc[e] += c0[e] * h0[e] * (e < 4 ? wa[e & 3] : wb[e & 3]); }
          if (pos < n - 1) { float c2[8], h2[8]; unpack8(*(const u32x4*)(rp + PROJ + OFF_CC), c2); unpack8(*(const u32x4*)(rp + PROJ + OFF_CH), h2);
              const f32x4 wa = *(const f32x4*)(cw + 512 + cc), wb = *(const f32x4*)(cw + 512 + cc + 4);
#pragma unroll
              for (int e = 0; e < 8; ++e) acc[e] += c2[e] * h2[e] * (e < 4 ? wa[e & 3] : wb[e & 3]); }
#pragma unroll
          for (int e = 0; e < 8; ++e) acc[e] *= bv[e];
          *(u32x4*)(Y + (size_t)v * D + cc) = pack8(acc);
      } }
    { const float* lg = p.in[I_LNG] + l * 256 + 4 * lane; const float* lb = p.in[I_LNB] + l * 256 + 4 * lane;
      const f32x4 g4 = *(const f32x4*)lg, b4 = *(const f32x4*)lb;
#pragma unroll
      for (int hb = 0; hb < 2; ++hb) {
          u32x2 w[8]; float x[8][4], sm[8], qv[8];
#pragma unroll
          for (int i = 0; i < 8; ++i) w[i] = *(const u32x2*)(P + (size_t)(v0 + wid * 16 + hb * 8 + i) * PROJ + OFF_GV + 4 * lane);
#pragma unroll
          for (int i = 0; i < 8; ++i) { x[i][0] = gelu_tanh(bf_lo(w[i].x)); x[i][1] = gelu_tanh(bf_hi(w[i].x)); x[i][2] = gelu_tanh(bf_lo(w[i].y)); x[i][3] = gelu_tanh(bf_hi(w[i].y));
              sm[i] = (x[i][0] + x[i][1]) + (x[i][2] + x[i][3]); }
#pragma unroll
          for (int st = 1; st < 64; st <<= 1)
#pragma unroll
              for (int i = 0; i < 8; ++i) sm[i] += shx(sm[i], st, lane);
#pragma unroll
          for (int i = 0; i < 8; ++i) { const float mu = sm[i] * (1.0f / 256); float q = 0.f;
#pragma unroll
              for (int e = 0; e < 4; ++e) { x[i][e] -= mu; q += x[i][e] * x[i][e]; }
              qv[i] = q; }
#pragma unroll
          for (int st = 1; st < 64; st <<= 1)
#pragma unroll
              for (int i = 0; i < 8; ++i) qv[i] += shx(qv[i], st, lane);
#pragma unroll
          for (int i = 0; i < 8; ++i) { const float rstd = rsqrtf(qv[i] * (1.0f / 256) + EPS); const int pt = wid * 16 + hb * 8 + i;
#pragma unroll
              for (int e = 0; e < 4; ++e) { const float y = x[i][e] * rstd * g4[e] + b4[e]; vT[(4 * lane + e) * 136 + pt] = (bf16_t)(cvt_pk_bf16(y, 0.f) & 0xffffu); } }
      } }
    __syncthreads();
    { const int g = wid >> 1, ph = wid & 1;
      const bf16_t* wsb = (const bf16_t*)(p.ws + WS_WT) + (size_t)l * W_LAYER + W_GWS + (size_t)g * 128 * 128;
      f32x4 acc[4][4];
#pragma unroll
      for (int a = 0; a < 4; ++a)
#pragma unroll
          for (int b = 0; b < 4; ++b) acc[a][b] = (f32x4){0.f, 0.f, 0.f, 0.f};
#pragma unroll
      for (int kk = 0; kk < 4; ++kk) {
          bf16x8 af[4], bfr[4];
#pragma unroll
          for (int db = 0; db < 4; ++db) af[db] = *(const LAS bf16x8*)(vT + (g * 64 + db * 16 + fr) * 136 + kk * 32 + fq * 8);
#pragma unroll
          for (int pb = 0; pb < 4; ++pb) bfr[pb] = *(const bf16x8*)(wsb + (size_t)((ph * 4 + pb) * 16 + fr) * 128 + kk * 32 + fq * 8);
#pragma unroll
          for (int db = 0; db < 4; ++db)
#pragma unroll
              for (int pb = 0; pb < 4; ++pb) acc[db][pb] = __builtin_amdgcn_mfma_f32_16x16x32_bf16(af[db], bfr[pb], acc[db][pb], 0, 0, 0);
      }
      const float* bs = p.in[I_GBS] + (size_t)l * 512 + g * 128;
      u32x2 uw[4][4]; float bias[4];
#pragma unroll
      for (int pb = 0; pb < 4; ++pb) { const int pt = (ph * 4 + pb) * 16 + fr; bias[pb] = bs[pt];
          const bf16_t* up = P + (size_t)(v0 + pt) * PROJ + OFF_GU + g * 64 + fq * 4;
#pragma unroll
          for (int db = 0; db < 4; ++db) uw[pb][db] = *(const u32x2*)(up + db * 16); }
#pragma unroll
      for (int pb = 0; pb < 4; ++pb) { const int pt = (ph * 4 + pb) * 16 + fr;
          bf16_t* yp = Y + (size_t)(v0 + pt) * D + 256 + g * 64 + fq * 4;
#pragma unroll
          for (int db = 0; db < 4; ++db) { const u32x2 w = uw[pb][db];
              const float y0 = gelu_tanh(bf_lo(w.x)) * (acc[db][pb][0] + bias[pb]), y1 = gelu_tanh(bf_hi(w.x)) * (acc[db][pb][1] + bias[pb]);
              const float y2 = gelu_tanh(bf_lo(w.y)) * (acc[db][pb][2] + bias[pb]), y3 = gelu_tanh(bf_hi(w.y)) * (acc[db][pb][3] + bias[pb]);
              u32x2 ov; ov.x = cvt_pk_bf16(y0, y1); ov.y = cvt_pk_bf16(y2, y3); *(u32x2*)(yp + db * 16) = ov; } } }
    __syncthreads();
}

__device__ void phase_mixers(const Params& p, int l, int hs, LAS unsigned char* lds, bool skip_ctx) {
    const int n_attn = skip_ctx ? 512 : 576, n_gmlp = skip_ctx ? 256 : 288;
#ifndef SKIP_ATTN
    for (int it = bid_opaque(); it < n_attn; it += gridDim.x) attn_item(p, l, hs, it);
#endif
    __builtin_amdgcn_sched_barrier(0);
#ifndef SKIP_GMLP
    { const int G = (int)gridDim.x; int n3 = n_attn - 2 * G; n3 = n3 < 0 ? 0 : (n3 > G / 2 ? G / 2 : n3);
      const int b = bid_opaque();
      if (b >= n3) for (int it = b - n3; it < n_gmlp; it += G - n3) gmlp_conv_item(p, l, hs, it, lds); }
#endif
}

#define XB_TMO      128
#define XB_XCNT(j)  (256  + 64 * (j))
#define XB_XSUB(j)  (1280 + 64 * (j))
#define XB_XGEN(j)  (2304 + 64 * (j))
#define XB_TOP      3328
#define XB_TOPGEN   3392
#define XCD_BAR_WORDS 3456
#define XB_SPIN_CAP (1u << 22)
__device__ __forceinline__ unsigned xb_ld(unsigned* p)              { return __hip_atomic_load(p, __ATOMIC_RELAXED, __HIP_MEMORY_SCOPE_AGENT); }
__device__ __forceinline__ unsigned xb_add(unsigned* p, unsigned v) { return __hip_atomic_fetch_add(p, v, __ATOMIC_RELAXED, __HIP_MEMORY_SCOPE_AGENT); }
__device__ __forceinline__ unsigned xb_xcc_id() { return (unsigned)__builtin_amdgcn_s_getreg((3 << 11) | 20) & 0xFu; }
#define XB_SPIN(cond, bar) do { unsigned _sp = 0; while (cond) { __builtin_amdgcn_s_sleep(1); \
    if ((++_sp & 255u) == 0u) { if (xb_ld(&(bar)[XB_TMO])) break; if (_sp > XB_SPIN_CAP) { atomicAdd(&(bar)[XB_TMO], 1u); break; } } } } while (0)
__device__ __forceinline__ void xcd_barrier_post(unsigned* bar) { if (threadIdx.x == 0) (void)xb_add(&bar[XB_XCNT(xb_xcc_id())], 1u); }
__device__ __forceinline__ void xcd_barrier_complete(unsigned* bar, unsigned x, unsigned& nloc, unsigned& nx) {
    const unsigned G = gridDim.x * gridDim.y * gridDim.z;
    unsigned sum, cnt, mine, sp = 0u;
    for (;;) {
        sum = 0u; cnt = 0u; mine = 0u;
#pragma unroll
        for (unsigned j = 0; j < 16; ++j) { const unsigned c = xb_ld(&bar[XB_XCNT(j)]); sum += c; cnt += (c > 0u) ? 1u : 0u; mine = (j == x) ? c : mine; }
        if (sum == G) break;
        __builtin_amdgcn_s_sleep(1);
        if ((++sp & 255u) == 0u) { if (xb_ld(&bar[XB_TMO])) break; if (sp > XB_SPIN_CAP) { atomicAdd(&bar[XB_TMO], 1u); break; } }
    }
    nloc = mine > 0u ? mine : 1u; nx = cnt > 0u ? cnt : 1u;
}
__device__ __forceinline__ void xcd_barrier(unsigned* bar, volatile LAS unsigned* st) {
    asm volatile("s_waitcnt vmcnt(0)" ::: "memory");
    __syncthreads();
    if (threadIdx.x == 0) {
        const unsigned x = xb_xcc_id();
        __builtin_amdgcn_s_waitcnt(0);
        unsigned nloc = st[0], nx = st[1];
        if (nloc == 0u) { xcd_barrier_complete(bar, x, nloc, nx); st[0] = nloc; st[1] = nx; }
        const unsigned old = xb_add(&bar[XB_XSUB(x)], 1u);
        const unsigned gen = old / nloc;
        if (old + 1u == (gen + 1u) * nloc) {
            __builtin_amdgcn_fence(__ATOMIC_RELEASE, "agent");
            asm volatile("s_waitcnt vmcnt(0)" ::: "memory");
            const unsigned og = xb_add(&bar[XB_TOP], 1u);
            const unsigned tg = og / nx;
            if (og + 1u == (tg + 1u) * nx) xb_add(&bar[XB_TOPGEN], 1u);
            else XB_SPIN(xb_ld(&bar[XB_TOPGEN]) == tg, bar);
            __builtin_amdgcn_fence(__ATOMIC_ACQUIRE, "agent");
            xb_add(&bar[XB_XGEN(x)], 1u);
            asm volatile("s_waitcnt vmcnt(0)" ::: "memory");
        } else {
            XB_SPIN(xb_ld(&bar[XB_XGEN(x)]) == gen, bar);
            __builtin_amdgcn_fence(__ATOMIC_ACQUIRE, "agent");
            asm volatile("s_waitcnt vmcnt(0)" ::: "memory");
        }
    }
    __syncthreads();
}

__device__ void run_phase(const Params& p, int ph, LAS unsigned char* lds) {
    if (ph == 0) {
#ifndef SKIP_SETUP
 phase_setup(p, lds);
#endif
 return; }
    const int q = ph - 1, l = q / 17, r = q % 17;
    const bf16_t* W = (const bf16_t*)(p.ws + WS_WT) + (size_t)l * W_LAYER;
    const float* MOD = (const float*)(p.ws + WS_MOD) + (size_t)l * 33 * (NMOD * D);
    bf16_t* HB = (bf16_t*)(p.ws + WS_H);
    const bool first = (l == 0 && r <= 2);
    const bool lastl = (l == NL - 1);
    bf16_t* A = (bf16_t*)(p.ws + WS_A); bf16_t* R1 = (bf16_t*)(p.ws + WS_R1);
    if (r == 0 || r == 3 || r == 14) {
#ifndef SKIP_NORM
 phase_norm(p, l, r == 0 ? 0 : (r == 3 ? 1 : 2), first, lastl && r == 14);
#endif
 return; }
    if (r == 1 || r == 15) {
        const int j = (r == 1) ? 0 : 1;
        const int sk = (lastl && j == 1) ? 1 : 0;
        pg8::Gemm g{A, D, W + (j ? W_FIN1 : W_FIN0), D, sk ? T_LAT : T_ALL, 2 * DFF, D, sk};
        pg8::EpiSwiglu E{R1};
#ifndef SKIP_UP
        pg8::gemm_phase(lds, g, E);
#endif
        return;
    }
    if (r == 2 || r == 16) {
        const int j = (r == 2) ? 0 : 1;
        const int sk = (lastl && j == 1) ? 1 : 0;
        pg8::Gemm g{R1, DFF, W + (j ? W_FOUT1 : W_FOUT0), DFF, sk ? T_LAT : T_ALL, D, DFF, sk};
        pg8::EpiResid E{p.in[I_X], p.in[I_CTX], HB, p.out, MOD, j ? 8 : 2, 0.5f, 0, first ? 0 : ((l == NL - 1 && r == 16) ? 2 : 1)};
#ifndef SKIP_DOWN
        pg8::gemm_phase(lds, g, E);
#endif
        return;
    }
    const int hs = (r - 4) / 5, rr = (r - 4) % 5;
    if (rr == 0) { pg8::Gemm g{A + (size_t)hs * TH * D, D, W + W_WIN, D, TH, PROJ, D, 0}; pg8::EpiBf16 E{R1, PROJ, p.in[I_BGATE] + (size_t)l * 3 * D, OFF_GATE};
#ifndef SKIP_PROJ
 pg8::gemm_phase(lds, g, E);
#endif
 return; }
    if (rr == 1) {
#ifndef SKIP_PREP
 phase_prep(p, l, lds);
#endif
 return; }
    if (rr == 2) {
#ifndef SKIP_MIX
 phase_mixers(p, l, hs, lds, lastl);
#endif
 return; }
    if (rr == 3) { pg8::Gemm g{A + (size_t)hs * TH * D, D, W + W_WB, D, lastl ? H_LAT : TH, D, D, 0}; pg8::EpiBranch E{R1};
#ifndef SKIP_BRANCH
 pg8::gemm_phase(lds, g, E);
#endif
 return; }
    { pg8::Gemm g{R1, PROJ, W + W_WO, D, lastl ? H_LAT : TH, D, D, 0}; pg8::EpiResid E{p.in[I_X], p.in[I_CTX], HB, p.out, MOD, 5, 1.0f, hs * TILES_H, 1};
#ifndef SKIP_OUT
 pg8::gemm_phase(lds, g, E);
#endif
 }
}

__global__ __launch_bounds__(512, 2) void fwd_megakernel(Params p) {
    extern __shared__ __attribute__((aligned(16))) unsigned char shm[];
    LAS unsigned char* lds = (LAS unsigned char*)shm;
#if MK_SINGLE
    volatile LAS unsigned* bst = (volatile LAS unsigned*)(lds + LDS_BYTES - 16);
    if (threadIdx.x == 0) { bst[0] = 0u; bst[1] = 0u; }
    __syncthreads();
    xcd_barrier_post((unsigned*)(p.ws + WS_BAR));
#endif
    for (int ph = p.ph_lo; ph < p.ph_hi; ++ph) {
#if defined(__HIP_DEVICE_COMPILE__)
        const __attribute__((address_space(4))) char* kp = (const __attribute__((address_space(4))) char*)__builtin_amdgcn_kernarg_segment_ptr();
        asm volatile("" : "+s"(kp));
        const Params lp = *(const Params*)(const char*)kp;
#else
        const Params lp = p;
#endif
        run_phase(lp, ph, lds);
#if MK_SINGLE
        if (ph + 1 < lp.ph_hi) {
            if (ph == 0) cg::this_grid().sync();
            else xcd_barrier((unsigned*)(lp.ws + WS_BAR), (volatile LAS unsigned*)(lds + LDS_BYTES - 16));
        }
#endif
    }
}

extern "C" void kernel_launch(void* const* d_in, const int* in_sizes, int n_in, void* d_out, int out_size, void* d_ws, size_t ws_size, hipStream_t stream) {
    static int grid = 0;
    if (grid == 0) {
        if (n_in != N_IN || out_size != T_LAT * D || ws_size < WS_END) { fprintf(stderr, "kernel_launch: unexpected shapes (n_in %d out %d ws %zu need %zu)\n", n_in, out_size, ws_size, (size_t)WS_END); grid = -1; return; }
        int dev = 0, cus = 0, per_cu = 0;
        (void)hipGetDevice(&dev); (void)hipDeviceGetAttribute(&cus, hipDeviceAttributeMultiprocessorCount, dev);
        if (hipFuncSetAttribute((const void*)fwd_megakernel, hipFuncAttributeMaxDynamicSharedMemorySize, LDS_BYTES) != hipSuccess) { fprintf(stderr, "kernel_launch: hipFuncSetAttribute failed\n"); grid = -1; return; }
        if (hipOccupancyMaxActiveBlocksPerMultiprocessor(&per_cu, (const void*)fwd_megakernel, 512, LDS_BYTES) != hipSuccess || per_cu < 1) { fprintf(stderr, "kernel_launch: occupancy query gave %d\n", per_cu); per_cu = 1; }
        (void)hipGetLastError();
        grid = cus * per_cu;
    }
    if (grid < 0) return;
    Params p{};
    for (int i = 0; i < N_IN; ++i) p.in[i] = (const float*)d_in[i];
    p.out = (float*)d_out; p.ws = (unsigned char*)d_ws;
#if MK_SINGLE
    p.ph_lo = 0; p.ph_hi = N_PHASES;
    if (hipMemsetAsync((char*)d_ws + WS_BAR, 0, 16384, stream) != hipSuccess) { fprintf(stderr, "kernel_launch: memset of the barrier words failed\n"); return; }
    void* args[] = {&p};
    hipError_t e = hipLaunchCooperativeKernel((const void*)fwd_megakernel, dim3(grid), dim3(512), args, LDS_BYTES, stream);
    if (e != hipSuccess) fprintf(stderr, "cooperative launch failed: %s (grid %d)\n", hipGetErrorString(e), grid);
#else
    for (int ph = 0; ph < N_PHASES; ++ph) {
        p.ph_lo = ph; p.ph_hi = ph + 1;
        hipLaunchKernelGGL(fwd_megakernel, dim3(grid), dim3(512), LDS_BYTES, stream, p);
    }
#endif
}
```

```cpp
#include <hip/hip_runtime.h>
#include <hip/hip_cooperative_groups.h>
#include <cstdio>
namespace cg = cooperative_groups;

#ifndef MK_SINGLE
#define MK_SINGLE 1
#endif

#define LAS __attribute__((address_space(3)))
typedef unsigned short bf16_t;
typedef short bf16x8 __attribute__((ext_vector_type(8)));
typedef short bf16x4 __attribute__((ext_vector_type(4)));
typedef float f32x4 __attribute__((ext_vector_type(4)));
typedef unsigned u32x4 __attribute__((ext_vector_type(4)));
typedef unsigned u32x2 __attribute__((ext_vector_type(2)));
typedef float f32x2 __attribute__((ext_vector_type(2)));

constexpr int D = 1024, NB = 32, SEQ = 2048, NL = 4, CTXL = 256, DFF = 2816, PROJ = 5120, NMOD = 9;
constexpr int T_LAT = NB * SEQ, T_CTX = NB * CTXL, T_ALL = T_LAT + T_CTX;
constexpr int H_LAT = T_LAT / 2, H_CTX = T_CTX / 2, TH = H_LAT + H_CTX;
constexpr int TILES_H = TH / 256, TILES_HL = H_LAT / 256;
constexpr int OFF_CB = 0, OFF_CC = 256, OFF_CH = 512, OFF_GU = 768, OFF_GV = 1024, OFF_Q = 1280, OFF_K = 1792, OFF_V = 1920, OFF_GATE = 2048;
constexpr float EPS = 1e-6f;
constexpr float LOG2E = 1.4426950408889634f;

enum { I_X = 0, I_C, I_CTX, I_CCTX, I_WMOD, I_BMOD, I_NORMG, I_FFNIN, I_FFNOUT, I_WIN, I_BGATE, I_CONVW, I_LNG, I_LNB, I_GWS, I_GBS, I_QG, I_KG, I_SINK, I_WBC, I_WBG, I_WBA, I_WOUT, N_IN };

constexpr size_t W_FIN0 = 0, W_FIN1 = 5767168, W_FOUT0 = 11534336, W_FOUT1 = 14417920, W_WIN = 17301504, W_WB = 22544384, W_WO = 23592960, W_GWS = 24641536, W_LAYER = 24707072;
constexpr size_t WS_WT = 0;
constexpr size_t WS_MOD = WS_WT + NL * W_LAYER * 2;
constexpr size_t WS_ROPE = WS_MOD + (size_t)NL * 33 * 9216 * 4;
constexpr size_t WS_HC = WS_ROPE + 8192;
constexpr size_t WS_A = WS_HC + (size_t)T_CTX * D * 4;
constexpr size_t WS_R1 = WS_A + (size_t)T_ALL * D * 2;
constexpr size_t WS_VTL = WS_R1 + (size_t)T_ALL * DFF * 2;
constexpr size_t WS_VTC = WS_VTL + (size_t)16 * 2 * 64 * 2048 * 2;
constexpr size_t WS_BAR = WS_VTC + (size_t)16 * 2 * 64 * 256 * 2;
constexpr size_t WS_H = WS_BAR + 16384;
constexpr size_t WS_END = WS_H + (size_t)T_ALL * D * 2;

constexpr int LDS_BYTES = 143360;
constexpr int N_PHASES = 1 + 17 * NL;

struct Params {
    const float* in[N_IN];
    float* out;
    unsigned char* ws;
    int ph_lo, ph_hi;
};

__device__ __forceinline__ unsigned cvt_pk_bf16(float lo, float hi) { unsigned r; asm volatile("v_cvt_pk_bf16_f32 %0, %1, %2" : "=v"(r) : "v"(lo), "v"(hi)); return r; }
__device__ __forceinline__ int tid_opaque() { int t = threadIdx.x; asm volatile("" : "+v"(t)); return t; }
__device__ __forceinline__ int bid_opaque() { int b = blockIdx.x; asm volatile("" : "+s"(b)); return b; }
__device__ __forceinline__ float bf_lo(unsigned w) { return __uint_as_float(w << 16); }
__device__ __forceinline__ float bf_hi(unsigned w) { return __uint_as_float(w & 0xffff0000u); }
__device__ __forceinline__ float fast_rcp(float x) { return __builtin_amdgcn_rcpf(x); }
__device__ __forceinline__ float fast_exp2(float x) { return __builtin_amdgcn_exp2f(x); }
__device__ __forceinline__ float sigmoidf_(float x) { return fast_rcp(1.0f + fast_exp2(-x * LOG2E)); }
__device__ __forceinline__ float siluf_(float x) { return x * sigmoidf_(x); }
__device__ __forceinline__ float gelu_tanh(float x) { const float z = 0.7978845608028654f * (x + 0.044715f * x * x * x); return x * sigmoidf_(2.0f * z); }
__device__ __forceinline__ float shx(float v, int m, int lane) { return __int_as_float(__builtin_amdgcn_ds_bpermute((lane ^ m) << 2, __float_as_int(v))); }
__device__ __forceinline__ float wave_sum(float v, int lane) {
    v += shx(v, 1, lane); v += shx(v, 2, lane); v += shx(v, 4, lane); v += shx(v, 8, lane); v += shx(v, 16, lane); v += shx(v, 32, lane); return v;
}
__device__ __forceinline__ void unpack8(const u32x4 w, float (&f)[8]) {
    f[0] = bf_lo(w.x); f[1] = bf_hi(w.x); f[2] = bf_lo(w.y); f[3] = bf_hi(w.y); f[4] = bf_lo(w.z); f[5] = bf_hi(w.z); f[6] = bf_lo(w.w); f[7] = bf_hi(w.w);
}
__device__ __forceinline__ u32x4 pack8(const float (&f)[8]) {
    u32x4 w; w.x = cvt_pk_bf16(f[0], f[1]); w.y = cvt_pk_bf16(f[2], f[3]); w.z = cvt_pk_bf16(f[4], f[5]); w.w = cvt_pk_bf16(f[6], f[7]); return w;
}

struct RowMap { size_t row0; int is_ctx; int modrow; };
__device__ __forceinline__ RowMap map_row(int u) {
    const int s = u / TH, v = u - s * TH; RowMap r;
    if (v < H_LAT) { r.row0 = (size_t)s * H_LAT + v; r.is_ctx = 0; r.modrow = (int)(r.row0 >> 11); }
    else { r.row0 = (size_t)s * H_CTX + (v - H_LAT); r.is_ctx = 1; r.modrow = 32; }
    return r;
}

namespace pg8 {
constexpr int BM = 256, BK = 64, HALF = 128, HTB = HALF * BK * 2, STAGE_BYTES = 8 * HTB, NXCD = 8, WGM = 8;
__device__ __forceinline__ int lds_byte(int r, int c) { const int st = (r >> 4) * 2 + (c >> 5), rr = r & 15, cc = c & 31, ob = rr * 64 + cc * 2; return st * 1024 + (ob ^ (((ob >> 9) & 1) << 5)); }
__device__ __forceinline__ void stage_rc(int b, int& R, int& C) { const int st = b / 1024, sb = b % 1024, swz = sb ^ (((sb >> 9) & 1) << 5); R = (st >> 1) * 16 + swz / 64; C = (st & 1) * 32 + (swz % 64) / 2; }
__device__ __forceinline__ int perm32(int rho) { const int n = rho >> 4, i = rho & 15; return 8 * (i >> 2) + 4 * n + (i & 3); }

struct Unit { int pm, pn; };
struct Gemm { const bf16_t* A; int lda; const bf16_t* Bt; int ldb; int M, N, K; int skip_ctx; };

struct StaticOrder {
    int nM, nN, nwg, G, c, skip;
    __device__ void init(int M, int N, int G_, int c_, int skip_) { nM = M / BM; nN = N / BM; nwg = nM * nN; G = G_; c = c_; skip = skip_; }
    __device__ bool next(int i, Unit& u) const {
        const long L = (long)i * G + c; if (L >= nwg) return false;
        int wgid = (int)L; { const int q = nwg / NXCD, r = nwg % NXCD, xcd = wgid % NXCD, off = wgid / NXCD; wgid = (xcd < r ? xcd * (q + 1) : r * (q + 1) + (xcd - r) * q) + off; }
        const int nig = WGM * nN, gid = wgid / nig, fm = gid * WGM, gsz = (nM - fm) < WGM ? (nM - fm) : WGM;
        u.pm = fm + ((wgid % nig) % gsz); u.pn = (wgid % nig) / gsz; if (skip && u.pm >= TILES_HL) u.pm += TILES_H - TILES_HL; return true;
    }
};

template <class Epi>
__device__ __forceinline__ void gemm_phase(LAS unsigned char* lds, const Gemm g, const Epi& E) {
    const int tid = tid_opaque(), wid = __builtin_amdgcn_readfirstlane(tid >> 6), lane = tid & 63, wr = wid >> 2, wc = wid & 3, fr = lane & 15, fq = lane >> 4;
    const int K = g.K, nt = K / BK;
    StaticOrder S; S.init(g.M, g.N, (int)gridDim.x, bid_opaque(), g.skip_ctx);
    unsigned voffA[2], voffB[2];
#pragma unroll
    for (int i = 0; i < 2; ++i) { int R, C; stage_rc(tid * 16 + i * 8192, R, C); const int Rb = Epi::PERM ? ((R & ~31) + perm32(R & 31)) : R;
        voffA[i] = (unsigned)(R * g.lda + C) * 2u; voffB[i] = (unsigned)(Rb * g.ldb + C) * 2u; }
    const size_t kstep = (size_t)(BK * 2);
    const size_t hstepA = (size_t)HALF * g.lda * 2, hstepB = (size_t)HALF * g.ldb * 2;
    const size_t tstepA = 2 * hstepA, tstepB = 2 * hstepB;
    const unsigned ldsw = (unsigned)wid * 1024u;
    const int aoff = lds_byte(wr * 64 + fr, fq * 8), boff = lds_byte(wc * 32 + fr, fq * 8);
#define PG8_SA(b, h) (((b) * 2 + (h)) * HTB)
#define PG8_SB(b, h) ((4 + (b) * 2 + (h)) * HTB)
#define PG8_STAGE(bufoff, gbase, voff) do { _Pragma("unroll") for (int _i = 0; _i < 2; ++_i) \
        __builtin_amdgcn_global_load_lds((const unsigned*)((const char*)(gbase) + (voff)[_i]), (LAS unsigned*)(lds + (bufoff) + ldsw + _i * 8192), 16, 0, 0); } while (0)
#define PG8_LDA(dst, b, h) do { _Pragma("unroll") for (int m = 0; m < 4; ++m) _Pragma("unroll") for (int k = 0; k < 2; ++k) dst[m][k] = *(const LAS bf16x8*)(lds + PG8_SA(b, h) + aoff + m * 2048 + k * 1024); } while (0)
#define PG8_LDB(dst, b, h) do { _Pragma("unroll") for (int n = 0; n < 2; ++n) _Pragma("unroll") for (int k = 0; k < 2; ++k) dst[n][k] = *(const LAS bf16x8*)(lds + PG8_SB(b, h) + boff + n * 2048 + k * 1024); } while (0)
#define PG8_MMA(ai, bj, At, Bt) do { __builtin_amdgcn_s_setprio(1); _Pragma("unroll") for (int m = 0; m < 4; ++m) _Pragma("unroll") for (int n = 0; n < 2; ++n) _Pragma("unroll") for (int k = 0; k < 2; ++k) \
        acc[ai][bj][m][n] = __builtin_amdgcn_mfma_f32_16x16x32_bf16(Bt[n][k], At[m][k], acc[ai][bj][m][n], 0, 0, 0); __builtin_amdgcn_s_setprio(0); } while (0)
#define PG8_WAIT_V(n) asm volatile("s_waitcnt vmcnt(" #n ")" ::: "memory")
#define PG8_WAIT_L(n) asm volatile("s_waitcnt lgkmcnt(" #n ")" ::: "memory")
#define PG8_BAR __builtin_amdgcn_s_barrier()
#define PG8_SCHED __builtin_amdgcn_sched_barrier(0)
#define PG8_KLOOP(TB, TE) for (int t = (TB); t < (TE); t += 2) { \
            const bool last = (t == nt - 2); \
            const char* a1 = cA + (size_t)(t + 1) * kstep; \
            const char* a2 = last ? nA : cA + (size_t)(t + 2) * kstep; const char* b2 = last ? nB : cB + (size_t)(t + 2) * kstep; \
            const char* a3 = a2 + kstep; const char* b3 = b2 + kstep; \
            PG8_LDB(B0, 0, 0); PG8_SCHED; PG8_LDA(At, 0, 0); PG8_STAGE(PG8_SA(1, 1), a1 + hstepA, voffA); \
            PG8_WAIT_L(8); PG8_BAR; PG8_WAIT_L(0); PG8_MMA(0, 0, At, B0); PG8_BAR; PG8_SCHED; \
            PG8_LDB(B1, 0, 1); PG8_STAGE(PG8_SB(0, 0), b2, voffB); \
            PG8_BAR; PG8_WAIT_L(0); PG8_MMA(0, 1, At, B1); PG8_BAR; \
            PG8_LDA(At, 0, 1); PG8_STAGE(PG8_SA(0, 0), a2, voffA); \
            PG8_BAR; PG8_WAIT_L(0); PG8_MMA(1, 0, At, B0); PG8_BAR; PG8_SCHED; \
            PG8_STAGE(PG8_SB(0, 1), b2 + hstepB, voffB); \
            PG8_WAIT_V(6); PG8_BAR; PG8_MMA(1, 1, At, B1); PG8_BAR; \
            PG8_LDB(B0, 1, 0); PG8_SCHED; PG8_LDA(At, 1, 0); PG8_STAGE(PG8_SA(0, 1), a2 + hstepA, voffA); \
            PG8_WAIT_L(8); PG8_BAR; PG8_WAIT_L(0); PG8_MMA(0, 0, At, B0); PG8_BAR; PG8_SCHED; \
            PG8_LDB(B1, 1, 1); PG8_STAGE(PG8_SB(1, 0), b3, voffB); \
            PG8_BAR; PG8_WAIT_L(0); PG8_MMA(0, 1, At, B1); PG8_BAR; \
            PG8_LDA(At, 1, 1); PG8_STAGE(PG8_SA(1, 0), a3, voffA); \
            PG8_BAR; PG8_WAIT_L(0); PG8_MMA(1, 0, At, B0); PG8_BAR; PG8_SCHED; \
            PG8_STAGE(PG8_SB(1, 1), b3 + hstepB, voffB); \
            PG8_WAIT_V(6); PG8_BAR; PG8_MMA(1, 1, At, B1); PG8_BAR; \
        }
    Unit cur, nxt; int ui = 0;
    if (!S.next(0, cur)) return;
    f32x4 acc[2][2][4][2];
#pragma unroll
    for (int a = 0; a < 2; ++a)
#pragma unroll
        for (int b = 0; b < 2; ++b)
#pragma unroll
            for (int m = 0; m < 4; ++m)
#pragma unroll
                for (int n = 0; n < 2; ++n) acc[a][b][m][n] = (f32x4){0.f, 0.f, 0.f, 0.f};
    bf16x8 At[4][2], B0[2][2], B1[2][2];
    const char* cA = (const char*)g.A + (size_t)cur.pm * tstepA; const char* cB = (const char*)g.Bt + (size_t)cur.pn * tstepB;
    PG8_STAGE(PG8_SB(0, 0), cB, voffB); PG8_STAGE(PG8_SA(0, 0), cA, voffA); PG8_STAGE(PG8_SB(0, 1), cB + hstepB, voffB); PG8_STAGE(PG8_SA(0, 1), cA + hstepA, voffA);
    if (wr == 1) PG8_BAR;
    PG8_WAIT_V(4); PG8_BAR;
    PG8_STAGE(PG8_SB(1, 0), cB + kstep, voffB); PG8_STAGE(PG8_SA(1, 0), cA + kstep, voffA); PG8_STAGE(PG8_SB(1, 1), cB + hstepB + kstep, voffB);
    PG8_WAIT_V(6); PG8_BAR;
    for (;;) {
        const bool has_next = S.next(ui + 1, nxt);
        const char* nA = has_next ? (const char*)g.A + (size_t)nxt.pm * tstepA : cA; const char* nB = has_next ? (const char*)g.Bt + (size_t)nxt.pn * tstepB : cB;
        if constexpr (Epi::MIDK) {
            PG8_KLOOP(0, 4)
            E.template mid<0>(acc, cur, wr, wc, fr, fq);
            PG8_KLOOP(4, 8)
            E.template mid<1>(acc, cur, wr, wc, fr, fq);
            PG8_KLOOP(8, nt)
        } else {
            PG8_KLOOP(0, nt)
        }
        E(acc, cur, wr, wc, fr, fq);
        if (!has_next) break;
#pragma unroll
        for (int a = 0; a < 2; ++a)
#pragma unroll
            for (int b = 0; b < 2; ++b)
#pragma unroll
                for (int m = 0; m < 4; ++m)
#pragma unroll
                    for (int n = 0; n < 2; ++n) acc[a][b][m][n] = (f32x4){0.f, 0.f, 0.f, 0.f};
        cur = nxt; cA = nA; cB = nB; ++ui;
    }
    PG8_WAIT_V(0);
    if (wr == 0) PG8_BAR;
    PG8_BAR;
#undef PG8_KLOOP
#undef PG8_SA
#undef PG8_SB
#undef PG8_STAGE
#undef PG8_LDA
#undef PG8_LDB
#undef PG8_MMA
#undef PG8_WAIT_V
#undef PG8_WAIT_L
#undef PG8_BAR
#undef PG8_SCHED
}

struct EpiSwiglu {
    static constexpr bool PERM = true, MIDK = false;
    bf16_t* O;
    __device__ __forceinline__ void operator()(const f32x4 (&acc)[2][2][4][2], const Unit& u, int wr, int wc, int fr, int fq) const {
        const int row0 = u.pm * BM + wr * 64 + fr, col0 = u.pn * 128 + wc * 32 + 8 * fq;
#pragma unroll
        for (int ai = 0; ai < 2; ++ai)
#pragma unroll
            for (int m = 0; m < 4; ++m) {
                float h[8];
#pragma unroll
                for (int n = 0; n < 2; ++n)
#pragma unroll
                    for (int j = 0; j < 4; ++j) h[n * 4 + j] = siluf_(acc[ai][0][m][n][j]) * acc[ai][1][m][n][j];
                *(u32x4*)(O + (size_t)(row0 + ai * HALF + m * 16) * DFF + col0) = pack8(h);
            }
    }
};
struct EpiBf16 {
    static constexpr bool PERM = true, MIDK = false;
    bf16_t* O; int ldc; const float* bias; int bias_col0;
    __device__ __forceinline__ void operator()(const f32x4 (&acc)[2][2][4][2], const Unit& u, int wr, int wc, int fr, int fq) const {
        const int row0 = u.pm * BM + wr * 64 + fr, col0 = u.pn * BM + wc * 32 + 8 * fq;
        const bool hb = (u.pn * BM >= bias_col0);
        f32x4 bv[2][2];
#pragma unroll
        for (int bj = 0; bj < 2; ++bj)
#pragma unroll
            for (int n = 0; n < 2; ++n) bv[bj][n] = hb ? *(const f32x4*)(bias + (col0 - bias_col0) + bj * HALF + 4 * n) : (f32x4){0.f, 0.f, 0.f, 0.f};
#pragma unroll
        for (int ai = 0; ai < 2; ++ai)
#pragma unroll
            for (int m = 0; m < 4; ++m) { bf16_t* rowp = O + (size_t)(row0 + ai * HALF + m * 16) * ldc + col0;
#pragma unroll
                for (int bj = 0; bj < 2; ++bj) { f32x4 v0 = acc[ai][bj][m][0] + bv[bj][0], v1 = acc[ai][bj][m][1] + bv[bj][1];
                    if (hb) {
#pragma unroll
                        for (int j = 0; j < 4; ++j) { v0[j] = 1.0f + fast_exp2(-fminf(fmaxf(v0[j], -30.f), 30.f) * LOG2E); v1[j] = 1.0f + fast_exp2(-fminf(fmaxf(v1[j], -30.f), 30.f) * LOG2E); } }
                    u32x4 w; w.x = cvt_pk_bf16(v0[0], v0[1]); w.y = cvt_pk_bf16(v0[2], v0[3]); w.z = cvt_pk_bf16(v1[0], v1[1]); w.w = cvt_pk_bf16(v1[2], v1[3]);
                    *(u32x4*)(rowp + bj * HALF) = w; } }
    }
};
struct EpiResid {
    static constexpr bool PERM = true, MIDK = false;
    const float* x_lat; const float* x_ctx; bf16_t* hbuf; float* out; const float* mod; int gate_idx; float gscale; int tile0; int mode;
    template <int MODE> __device__ __forceinline__ void body(const f32x4 (&acc)[2][2][4][2], const Unit& u, int wr, int wc, int fr, int fq) const {
        const int urow0 = (tile0 + u.pm) * BM;
        const RowMap rm = map_row(urow0);
        const float* gp = mod + (size_t)rm.modrow * (NMOD * D) + gate_idx * D;
        const int rloc = wr * 64 + fr, col0 = u.pn * BM + wc * 32 + 8 * fq;
        const float* xs = (rm.is_ctx ? x_ctx : x_lat) + rm.row0 * D + col0;
        bf16_t* hb = hbuf + (size_t)urow0 * D + col0;
        float* ob = out + rm.row0 * D + col0;
        const bool st_ok = (MODE != 2) || !rm.is_ctx;
        constexpr int MG = (MODE == 0) ? 2 : 4;
#pragma unroll
        for (int bj = 0; bj < 2; ++bj) {
            const f32x4 g0 = *(const f32x4*)(gp + col0 + bj * HALF) * gscale, g1 = *(const f32x4*)(gp + col0 + bj * HALF + 4) * gscale;
#pragma unroll
            for (int ai = 0; ai < 2; ++ai)
#pragma unroll
                for (int mg = 0; mg < 4; mg += MG) {
                    f32x4 xf[MODE == 0 ? MG : 1][2]; u32x4 xw[MODE == 0 ? 1 : MG];
#pragma unroll
                    for (int mm = 0; mm < MG; ++mm) { const size_t ro = (size_t)(rloc + ai * HALF + (mg + mm) * 16) * D + bj * HALF;
                        if constexpr (MODE == 0) { xf[mm][0] = *(const f32x4*)(xs + ro); xf[mm][1] = *(const f32x4*)(xs + ro + 4); }
                        else xw[mm] = *(const u32x4*)(hb + ro); }
                    __builtin_amdgcn_sched_barrier(0);
#pragma unroll
                    for (int mm = 0; mm < MG; ++mm) { const int m = mg + mm; const size_t ro = (size_t)(rloc + ai * HALF + m * 16) * D + bj * HALF;
                        f32x4 x0, x1;
                        if constexpr (MODE == 0) { x0 = xf[mm][0]; x1 = xf[mm][1]; }
                        else { const u32x4 w = xw[mm]; x0 = (f32x4){bf_lo(w.x), bf_hi(w.x), bf_lo(w.y), bf_hi(w.y)}; x1 = (f32x4){bf_lo(w.z), bf_hi(w.z), bf_lo(w.w), bf_hi(w.w)}; }
                        const f32x4 y0 = x0 + g0 * acc[ai][bj][m][0], y1 = x1 + g1 * acc[ai][bj][m][1];
                        if constexpr (MODE == 2) { if (st_ok) { *(f32x4*)(ob + ro) = y0; *(f32x4*)(ob + ro + 4) = y1; } }
                        else { u32x4 w; w.x = cvt_pk_bf16(y0[0], y0[1]); w.y = cvt_pk_bf16(y0[2], y0[3]); w.z = cvt_pk_bf16(y1[0], y1[1]); w.w = cvt_pk_bf16(y1[2], y1[3]); *(u32x4*)(hb + ro) = w; }
                    }
                    __builtin_amdgcn_sched_barrier(0);
                }
        }
    }
    __device__ __forceinline__ void operator()(const f32x4 (&acc)[2][2][4][2], const Unit& u, int wr, int wc, int fr, int fq) const {
        if (mode == 1) body<1>(acc, u, wr, wc, fr, fq);
        else if (mode == 0) body<0>(acc, u, wr, wc, fr, fq);
        else body<2>(acc, u, wr, wc, fr, fq);
    }
};
struct EpiBranch {
    static constexpr bool PERM = true, MIDK = true;
    bf16_t* P;
    __device__ __forceinline__ u32x4 ld_raw(unsigned off) const { return *(const u32x4*)((const char*)P + (size_t)off * 2u); }
    __device__ __forceinline__ void to_e(const u32x4 w, float (&e)[8]) const { unpack8(w, e); }
    template <int WHICH> __device__ __forceinline__ void mid(f32x4 (&acc)[2][2][4][2], const Unit& u, int wr, int wc, int fr, int fq) const {
        unsigned base = (unsigned)(u.pm * BM + wr * 64 + fr) * PROJ + (unsigned)(u.pn * BM + wc * 32 + 8 * fq) + OFF_GATE + WHICH * D;
        asm volatile("" : "+v"(base));
#pragma unroll
        for (int ai = 0; ai < 2; ++ai)
#pragma unroll
            for (int mp = 0; mp < 2; ++mp) {
                u32x4 wa[2][2], wb[2][2];
#pragma unroll
                for (int mm = 0; mm < 2; ++mm)
#pragma unroll
                    for (int bj = 0; bj < 2; ++bj) { const unsigned o = base + (unsigned)(ai * HALF + (mp * 2 + mm) * 16) * PROJ + bj * HALF; wa[mm][bj] = ld_raw(o); wb[mm][bj] = ld_raw(o + D); }
                __builtin_amdgcn_sched_barrier(0);
#pragma unroll
                for (int mm = 0; mm < 2; ++mm)
#pragma unroll
                    for (int bj = 0; bj < 2; ++bj) { float ea[8], eb[8]; to_e(wa[mm][bj], ea); to_e(wb[mm][bj], eb);
#pragma unroll
                        for (int n = 0; n < 2; ++n)
#pragma unroll
                            for (int j = 0; j < 4; ++j) acc[ai][bj][mp * 2 + mm][n][j] *= eb[n * 4 + j] * fast_rcp(ea[n * 4 + j]); }
                __builtin_amdgcn_sched_barrier(0);
            }
    }
    __device__ __forceinline__ void operator()(const f32x4 (&acc)[2][2][4][2], const Unit& u, int wr, int wc, int fr, int fq) const {
        unsigned base = (unsigned)(u.pm * BM + wr * 64 + fr) * PROJ + (unsigned)(u.pn * BM + wc * 32 + 8 * fq);
        asm volatile("" : "+v"(base));
#pragma unroll
        for (int ai = 0; ai < 2; ++ai) {
            u32x4 w2[4][2];
#pragma unroll
            for (int m = 0; m < 4; ++m)
#pragma unroll
                for (int bj = 0; bj < 2; ++bj) w2[m][bj] = ld_raw(base + (unsigned)(ai * HALF + m * 16) * PROJ + bj * HALF + OFF_GATE + 2 * D);
            __builtin_amdgcn_sched_barrier(0);
#pragma unroll
            for (int m = 0; m < 4; ++m)
#pragma unroll
                for (int bj = 0; bj < 2; ++bj) { const unsigned o = base + (unsigned)(ai * HALF + m * 16) * PROJ + bj * HALF;
                    float e2[8], ov[8]; to_e(w2[m][bj], e2);
#pragma unroll
                    for (int n = 0; n < 2; ++n)
#pragma unroll
                        for (int j = 0; j < 4; ++j) ov[n * 4 + j] = acc[ai][bj][m][n][j] * fast_rcp(e2[n * 4 + j]);
                    *(u32x4*)((char*)P + (size_t)o * 2u) = pack8(ov); }
            __builtin_amdgcn_sched_barrier(0);
        }
    }
};
}

__device__ __forceinline__ void tr_job(LAS float* tl, const float* src, int ld_src, int K, int Nout, bf16_t* dst, int ld_dst, int dkofs, int mode) {
    const int tid = tid_opaque();
    const int nkt = K / 64, ntl = nkt * (Nout / 64), G = gridDim.x;
    const int ln = tid & 63, lk = tid >> 6, sk2 = (tid & 31) * 2, sn = tid >> 5;
    float r[8];
    int t = bid_opaque();
    auto src_ptr = [&](int tt) -> const float* {
        const int kt = tt % nkt, n0 = (tt / nkt) * 64; int c0 = n0;
        if (mode == 1) { const int pn = n0 >> 8, rr = n0 & 255; c0 = (rr < 128) ? pn * 128 + rr : DFF + pn * 128 + (rr - 128); }
        return src + (size_t)(kt * 64 + lk) * ld_src + c0 + ln; };
    if (t < ntl) { const float* sp = src_ptr(t);
#pragma unroll
        for (int i = 0; i < 8; ++i) r[i] = sp[(size_t)(8 * i) * ld_src]; }
    for (; t < ntl; t += G) {
#pragma unroll
        for (int i = 0; i < 8; ++i) tl[(lk + 8 * i) * 65 + ln] = r[i];
        __syncthreads();
        if (t + G < ntl) { const float* sp = src_ptr(t + G);
#pragma unroll
            for (int i = 0; i < 8; ++i) r[i] = sp[(size_t)(8 * i) * ld_src]; }
        { const int kt = t % nkt, n0 = (t / nkt) * 64;
#pragma unroll
          for (int i = 0; i < 4; ++i) { const int n = sn + 16 * i; *(unsigned*)(dst + (size_t)(n0 + n) * ld_dst + dkofs + kt * 64 + sk2) = cvt_pk_bf16(tl[sk2 * 65 + n], tl[(sk2 + 1) * 65 + n]); } }
        __syncthreads();
    }
}

__device__ void phase_setup(const Params& p, LAS unsigned char* lds) {
    const int tid = tid_opaque(), wid = tid >> 6, lane = tid & 63;
    bf16_t* WT = (bf16_t*)(p.ws + WS_WT);
    LAS float* tl = (LAS float*)lds;
    for (int l = 0; l < NL; ++l) {
        bf16_t* W = WT + (size_t)l * W_LAYER;
        for (int j = 0; j < 2; ++j) {
            tr_job(tl, p.in[I_FFNIN] + ((size_t)l * 2 + j) * D * (2 * DFF), 2 * DFF, D, 2 * DFF, W + (j ? W_FIN1 : W_FIN0), D, 0, 1);
            tr_job(tl, p.in[I_FFNOUT] + ((size_t)l * 2 + j) * DFF * D, D, DFF, D, W + (j ? W_FOUT1 : W_FOUT0), DFF, 0, 0);
        }
        tr_job(tl, p.in[I_WIN] + (size_t)l * D * PROJ, PROJ, D, PROJ, W + W_WIN, D, 0, 0);
        tr_job(tl, p.in[I_WBC] + (size_t)l * 256 * D, D, 256, D, W + W_WB, D, 0, 0);
        tr_job(tl, p.in[I_WBG] + (size_t)l * 256 * D, D, 256, D, W + W_WB, D, 256, 0);
        tr_job(tl, p.in[I_WBA] + (size_t)l * 512 * D, D, 512, D, W + W_WB, D, 512, 0);
        tr_job(tl, p.in[I_WOUT] + (size_t)l * D * D, D, D, D, W + W_WO, D, 0, 0);
        for (int i = bid_opaque() * 512 + tid; i < 65536 / 2; i += gridDim.x * 512) {
            const float2 v = *(const float2*)(p.in[I_GWS] + (size_t)l * 65536 + 2 * i);
            *(unsigned*)(W + W_GWS + 2 * i) = cvt_pk_bf16(v.x, v.y);
        }
    }
    { const int gi = bid_opaque() * 512 + tid;
      if (gi < 1024) { const int pos = gi >> 4, i = gi & 15;
        const int i4 = i & 3, i16 = i >> 2;
        float inv = (i4 == 0) ? 1.0f : (i4 == 1) ? 0.5623413251903491f : (i4 == 2) ? 0.31622776601683794f : 0.1778279410038923f;
        inv *= (i16 == 0) ? 1.0f : (i16 == 1) ? 0.1f : (i16 == 2) ? 0.01f : 0.001f;
        const float a = (float)pos * inv;
        const float kq = __builtin_rintf(a * 0.6366197723675814f);
        float r = __builtin_fmaf(-kq, 1.5707963705062866f, a); r = __builtin_fmaf(kq, 4.371139000186241e-8f, r);
        const float r2 = r * r;
        const float sn = r * (1.0f + r2 * (-1.0f / 6 + r2 * (1.0f / 120 + r2 * (-1.0f / 5040 + r2 * (1.0f / 362880)))));
        const float cs = 1.0f + r2 * (-0.5f + r2 * (1.0f / 24 + r2 * (-1.0f / 720 + r2 * (1.0f / 40320 + r2 * (-1.0f / 3628800)))));
        const int q = ((int)kq) & 3;
        const float c = (q == 0) ? cs : (q == 1) ? -sn : (q == 2) ? -cs : sn;
        const float s = (q == 0) ? sn : (q == 1) ? cs : (q == 2) ? -sn : -cs;
        float2* rt = (float2*)(p.ws + WS_ROPE); rt[gi] = make_float2(c, s); } }
    if (bid_opaque() < NL * 36) {
        LAS float* sc = (LAS float*)lds;
        __syncthreads();
        for (int i = tid; i < 33 * D; i += 512) { const int r = i >> 10, k = i & 1023; const float v = (r < 32) ? p.in[I_C][r * D + k] : p.in[I_CCTX][k]; sc[i] = siluf_(v); }
        __syncthreads();
        float* MOD = (float*)(p.ws + WS_MOD);
        for (int it = bid_opaque(); it < NL * 36; it += gridDim.x) {
            const int l = it / 36, cgp = it % 36, n0 = cgp * 256 + lane * 4;
            const float* wp = p.in[I_WMOD] + (size_t)l * D * (NMOD * D) + n0;
            f32x4 a[5];
#pragma unroll
            for (int i = 0; i < 5; ++i) a[i] = (f32x4){0.f, 0.f, 0.f, 0.f};
            for (int k = 0; k < D; k += 16) {
                f32x4 w[16];
#pragma unroll
                for (int kk = 0; kk < 16; ++kk) w[kk] = *(const f32x4*)(wp + (size_t)(k + kk) * (NMOD * D));
#pragma unroll
                for (int i = 0; i < 5; ++i) { const int r = (i < 4) ? wid + 8 * i : 32;
#pragma unroll
                    for (int k4 = 0; k4 < 4; ++k4) { const f32x4 s4 = *(const LAS f32x4*)(sc + r * D + k + 4 * k4);
                        a[i] += s4[0] * w[4 * k4] + s4[1] * w[4 * k4 + 1] + s4[2] * w[4 * k4 + 2] + s4[3] * w[4 * k4 + 3]; } }
            }
            const f32x4 bv = *(const f32x4*)(p.in[I_BMOD] + (size_t)l * (NMOD * D) + n0);
#pragma unroll
            for (int i = 0; i < 5; ++i) { const int r = (i < 4) ? wid + 8 * i : 32; if (i < 4 || wid == 0) *(f32x4*)(MOD + ((size_t)l * 33 + r) * (NMOD * D) + n0) = a[i] + bv; }
        }
        __syncthreads();
    }
}

__device__ void phase_norm(const Params& p, int l, int j, bool from_inputs, bool skip_ctx) {
    const int tid = tid_opaque(), wid = tid >> 6, lane = tid & 63;
    bf16_t* A = (bf16_t*)(p.ws + WS_A);
    const bf16_t* hbuf = (const bf16_t*)(p.ws + WS_H);
    const float* MOD = (const float*)(p.ws + WS_MOD) + (size_t)l * 33 * (NMOD * D);
    const float* ng = p.in[I_NORMG] + ((size_t)l * 3 + j) * D;
    constexpr int NR = 4;
    for (int u = (bid_opaque() * 8 + wid) * NR; u < T_ALL; u += gridDim.x * 8 * NR) {
        const RowMap rm = map_row(u);
        if (skip_ctx && rm.is_ctx) continue;
        const float* sh = MOD + (size_t)rm.modrow * (NMOD * D) + (3 * j) * D; const float* sc = sh + D;
        f32x4 v[NR][4]; float ss[NR];
        if (from_inputs) { const float* x = (rm.is_ctx ? p.in[I_CTX] : p.in[I_X]) + rm.row0 * D;
#pragma unroll
            for (int rr = 0; rr < NR; ++rr)
#pragma unroll
                for (int i = 0; i < 4; ++i) v[rr][i] = *(const f32x4*)(x + rr * D + i * 256 + lane * 4);
        } else { const bf16_t* x = hbuf + (size_t)u * D;
#pragma unroll
            for (int rr = 0; rr < NR; ++rr)
#pragma unroll
                for (int i = 0; i < 4; ++i) { const u32x2 w = *(const u32x2*)(x + rr * D + i * 256 + lane * 4); v[rr][i] = (f32x4){bf_lo(w.x), bf_hi(w.x), bf_lo(w.y), bf_hi(w.y)}; }
        }
        f32x4 gm[4], s0[4];
#pragma unroll
        for (int i = 0; i < 4; ++i) { const int k = i * 256 + lane * 4; gm[i] = *(const f32x4*)(ng + k) * (*(const f32x4*)(sc + k) + 1.0f); s0[i] = *(const f32x4*)(sh + k); }
#pragma unroll
        for (int rr = 0; rr < NR; ++rr) { ss[rr] = 0.f;
#pragma unroll
            for (int i = 0; i < 4; ++i) ss[rr] += v[rr][i][0] * v[rr][i][0] + v[rr][i][1] * v[rr][i][1] + v[rr][i][2] * v[rr][i][2] + v[rr][i][3] * v[rr][i][3]; }
#pragma unroll
        for (int st = 1; st < 64; st <<= 1)
#pragma unroll
            for (int rr = 0; rr < NR; ++rr) ss[rr] += shx(ss[rr], st, lane);
#pragma unroll
        for (int rr = 0; rr < NR; ++rr) { const float rstd = rsqrtf(ss[rr] * (1.0f / D) + EPS);
#pragma unroll
            for (int i = 0; i < 4; ++i) { const int k = i * 256 + lane * 4;
                const f32x4 y = v[rr][i] * rstd * gm[i] + s0[i];
                u32x2 w; w.x = cvt_pk_bf16(y[0], y[1]); w.y = cvt_pk_bf16(y[2], y[3]);
                *(u32x2*)(A + (size_t)(u + rr) * D + k) = w; } }
    }
}

__device__ void phase_prep(const Params& p, int l, LAS unsigned char* lds) {
    const int tid = tid_opaque(), wid = tid >> 6, lane = tid & 63;
    bf16_t* P = (bf16_t*)(p.ws + WS_R1);
    bf16_t* VTL = (bf16_t*)(p.ws + WS_VTL); bf16_t* VTC = (bf16_t*)(p.ws + WS_VTC);
    const float* qg = p.in[I_QG] + l * 64; const float* kg = p.in[I_KG] + l * 64;
    LAS bf16_t* Vs = (LAS bf16_t*)lds;
    const LAS f32x2* rts = (const LAS f32x2*)(lds + 20480);
    __syncthreads();
    *(LAS u32x4*)(lds + 20480 + tid * 16) = *(const u32x4*)(p.ws + WS_ROPE + tid * 16);
    __syncthreads();
    const int c = lane & 7, seg = c >> 2, hf = (c >> 1) & 1, i0 = (c & 1) * 8;
    float gq[8], gk[8];
#pragma unroll
    for (int e = 0; e < 8; ++e) { gq[e] = qg[8 * c + e]; gk[e] = kg[8 * c + e]; }
    for (int it = bid_opaque(); it < TH / 64; it += gridDim.x) {
        const int v0 = it * 64; const bool lat = v0 < H_LAT;
        const int prow = (v0 & (SEQ - 1)) >> 6;
        bf16_t* rowb = P + (size_t)(v0 + wid * 8) * PROJ;
        const int qoff = OFF_Q + (lane >> 3) * 64 + 8 * c, koff = OFF_K + ((lane >> 3) & 1) * 64 + 8 * c;
        u32x4 qr[8], kr[8]; unsigned vr[8];
#pragma unroll
        for (int i = 0; i < 8; ++i) { const bf16_t* rp = rowb + (size_t)i * PROJ; qr[i] = *(const u32x4*)(rp + qoff); kr[i] = *(const u32x4*)(rp + koff); vr[i] = *(const unsigned*)(rp + OFF_V + 2 * lane); }
#pragma unroll
        for (int i = 0; i < 8; ++i) {
            const int rl = wid * 8 + i;
            bf16_t* rowp = rowb + (size_t)i * PROJ;
            const int pp = seg ? rl : prow;
            float cs[8], sn[8];
#pragma unroll
            for (int e = 0; e < 8; ++e) { const f32x2 t2 = rts[pp * 16 + i0 + e]; cs[e] = lat ? t2[0] : 1.0f; sn[e] = lat ? t2[1] : 0.0f; }
            { float x[8]; unpack8(qr[i], x);
              float ss = 0.f;
#pragma unroll
              for (int e = 0; e < 8; ++e) ss += x[e] * x[e];
              ss += shx(ss, 1, lane); ss += shx(ss, 2, lane); ss += shx(ss, 4, lane);
              const float rstd = rsqrtf(ss * (1.0f / 64) + EPS); float o[8];
#pragma unroll
              for (int e = 0; e < 8; ++e) { const float y = x[e] * rstd * gq[e]; const float yp = shx(y, 2, lane);
                  o[e] = (hf ? (y * cs[e] + yp * sn[e]) : (y * cs[e] - yp * sn[e])) * (0.125f * LOG2E); }
              *(u32x4*)(rowp + qoff) = pack8(o); }
            { float x[8]; unpack8(kr[i], x);
              float ss = 0.f;
#pragma unroll
              for (int e = 0; e < 8; ++e) ss += x[e] * x[e];
              ss += shx(ss, 1, lane); ss += shx(ss, 2, lane); ss += shx(ss, 4, lane);
              const float rstd = rsqrtf(ss * (1.0f / 64) + EPS); float o[8];
#pragma unroll
              for (int e = 0; e < 8; ++e) { const float y = x[e] * rstd * gk[e]; const float yp = shx(y, 2, lane);
                  o[e] = hf ? (y * cs[e] + yp * sn[e]) : (y * cs[e] - yp * sn[e]); }
              if (lane < 16) *(u32x4*)(rowp + koff) = pack8(o); }
            { const unsigned w = vr[i];
              Vs[(2 * lane) * 72 + rl] = (bf16_t)(w & 0xffffu); Vs[(2 * lane + 1) * 72 + rl] = (bf16_t)(w >> 16); }
        }
        __syncthreads();
        { const int hd = tid >> 2, ch = tid & 3;
          bf16_t* dst;
          if (lat) { const int bl = v0 >> 11, pos0 = v0 & (SEQ - 1); dst = VTL + ((size_t)bl * 128 + hd) * SEQ + pos0 + ch * 16; }
          else { const int cv = v0 - H_LAT, bl = cv >> 8, pos0 = cv & 255; dst = VTC + ((size_t)bl * 128 + hd) * CTXL + pos0 + ch * 16; }
          const u32x4 a = *(const LAS u32x4*)(Vs + hd * 72 + ch * 16), b = *(const LAS u32x4*)(Vs + hd * 72 + ch * 16 + 8);
          *(u32x4*)dst = a; *(u32x4*)(dst + 8) = b; }
        __syncthreads();
    }
}

struct KeySeg { const bf16_t* K; const bf16_t* Vt; int vstride; int ntiles; int mask; };

__device__ __forceinline__ void attn_item(const Params& p, int l, int hs, int idx) {
    const int tid = tid_opaque(), wid = tid >> 6, lane = tid & 63, fr = lane & 15, fq = lane >> 4;
    const bf16_t* P = (const bf16_t*)(p.ws + WS_R1);
    const bf16_t* VTL = (const bf16_t*)(p.ws + WS_VTL); const bf16_t* VTC = (const bf16_t*)(p.ws + WS_VTC);
    bf16_t* Y = (bf16_t*)(p.ws + WS_A) + (size_t)hs * TH * D;
    int bl, qb, hk; bool lat;
    if (idx < 512) { lat = true; bl = idx >> 5; qb = (idx >> 1) & 15; hk = idx & 1; }
    else { const int j = idx - 512; lat = false; bl = j >> 2; qb = (j >> 1) & 1; hk = j & 1; }
    const int g = wid >> 1, r0 = (wid & 1) * 64, head = hk * 4 + g;
    const int qrow0 = lat ? bl * SEQ + qb * 128 : H_LAT + bl * CTXL + qb * 128;
    const int crow0 = H_LAT + bl * CTXL;
    const bf16_t* vtc = VTC + ((size_t)bl * 2 + hk) * 64 * CTXL;
    const bf16_t* vtl = VTL + ((size_t)bl * 2 + hk) * 64 * SEQ;
    bf16x8 qf[4][2];
    { const bf16_t* qp = P + (size_t)(qrow0 + r0 + fr) * PROJ + OFF_Q + head * 64 + fq * 8;
#pragma unroll
      for (int nq = 0; nq < 4; ++nq)
#pragma unroll
          for (int ks = 0; ks < 2; ++ks) qf[nq][ks] = *(const bf16x8*)(qp + (size_t)nq * 16 * PROJ + ks * 32); }
    f32x4 o[4][4];
#pragma unroll
    for (int a = 0; a < 4; ++a)
#pragma unroll
        for (int b = 0; b < 4; ++b) o[a][b] = (f32x4){0.f, 0.f, 0.f, 0.f};
    const float snk = p.in[I_SINK][l * 8 + head] * LOG2E;
    float mrun[4], lrun[4];
#pragma unroll
    for (int nq = 0; nq < 4; ++nq) { mrun[nq] = snk; lrun[nq] = (fq == 0) ? 1.0f : 0.0f; }

    int lo = 0, nb = 0;
    if (lat) { lo = (qb == 0) ? 4 : (r0 >> 5); const int hi = (qb == 15) ? 8 : (r0 == 0 ? 10 : 12); nb = hi - lo; }
    const int ntot = nb + 8;
    const bf16_t* kband = P + (ptrdiff_t)(bl * SEQ + (qb - 1) * 128) * PROJ + OFF_K + hk * 64 + (size_t)fr * PROJ + fq * 8;
    const bf16_t* kctx = P + (size_t)crow0 * PROJ + OFF_K + hk * 64 + (size_t)fr * PROJ + fq * 8;
    const bf16_t* vband = vtl + (ptrdiff_t)((qb - 1) * 128) + (size_t)fr * SEQ + fq * 4;
    const bf16_t* vctx = vtc + (size_t)fr * CTXL + fq * 4;
    bf16x8 kf[2][2]; bf16x4 vlo[4], vhi[4];
#define ATT_LOAD(i_, KF, VLO, VHI) do { const int _i = (i_); const bool _b = _i < nb; \
        const bf16_t* _kp = _b ? kband + (size_t)(lo + _i) * 32 * PROJ : kctx + (size_t)(_i - nb) * 32 * PROJ; \
        const bf16_t* _vp = _b ? vband + (lo + _i) * 32 : vctx + (_i - nb) * 32; const int _vs = _b ? SEQ : CTXL; \
        _Pragma("unroll") for (int kb = 0; kb < 2; ++kb) _Pragma("unroll") for (int ks = 0; ks < 2; ++ks) KF[kb][ks] = *(const bf16x8*)(_kp + (size_t)kb * 16 * PROJ + ks * 32); \
        _Pragma("unroll") for (int db = 0; db < 4; ++db) { VLO[db] = *(const bf16x4*)(_vp + (size_t)db * 16 * _vs); VHI[db] = *(const bf16x4*)(_vp + (size_t)db * 16 * _vs + 16); } } while (0)
    ATT_LOAD(0, kf, vlo, vhi);
    for (int i = 0; i < ntot; ++i) {
        bf16x8 kfn[2][2]; bf16x4 vlon[4], vhin[4];
        const int inx = (i + 1 < ntot) ? i + 1 : i;
        ATT_LOAD(inx, kfn, vlon, vhin);
        {
            const int bt = lo + i;
            const bool mask = (i < nb) && (bt < 4 || bt >= 8);
            f32x4 s[2][4];
#pragma unroll
            for (int kb = 0; kb < 2; ++kb)
#pragma unroll
                for (int nq = 0; nq < 4; ++nq) {
                    s[kb][nq] = __builtin_amdgcn_mfma_f32_16x16x32_bf16(kf[kb][0], qf[nq][0], (f32x4){0.f, 0.f, 0.f, 0.f}, 0, 0, 0);
                    s[kb][nq] = __builtin_amdgcn_mfma_f32_16x16x32_bf16(kf[kb][1], qf[nq][1], s[kb][nq], 0, 0, 0);
                }
            if (mask) {
#pragma unroll
                for (int kb = 0; kb < 2; ++kb)
#pragma unroll
                    for (int nq = 0; nq < 4; ++nq)
#pragma unroll
                        for (int j = 0; j < 4; ++j) { const int dlt = (bt * 32 - 128 + kb * 16 + fq * 4 + j) - (r0 + nq * 16 + fr);
                            if (dlt > 128 || dlt < -128) s[kb][nq][j] = -1e30f; }
            }
            bf16x8 pf[4];
#pragma unroll
            for (int nq = 0; nq < 4; ++nq) {
                float mx = fmaxf(fmaxf(fmaxf(s[0][nq][0], s[0][nq][1]), fmaxf(s[0][nq][2], s[0][nq][3])), fmaxf(fmaxf(s[1][nq][0], s[1][nq][1]), fmaxf(s[1][nq][2], s[1][nq][3])));
                mx = fmaxf(mx, shx(mx, 16, lane)); mx = fmaxf(mx, shx(mx, 32, lane));
                const float mn = fmaxf(mrun[nq], mx), alpha = fast_exp2(mrun[nq] - mn); mrun[nq] = mn;
                float pv[8], ps = 0.f;
#pragma unroll
                for (int j = 0; j < 4; ++j) { pv[j] = fast_exp2(s[0][nq][j] - mn); pv[4 + j] = fast_exp2(s[1][nq][j] - mn); ps += pv[j] + pv[4 + j]; }
                lrun[nq] = lrun[nq] * alpha + ps;
                const u32x4 w = pack8(pv); pf[nq] = *(const bf16x8*)&w;
#pragma unroll
                for (int db = 0; db < 4; ++db) o[db][nq] *= alpha;
            }
#pragma unroll
            for (int db = 0; db < 4; ++db) { const bf16x8 vf = (bf16x8){vlo[db][0], vlo[db][1], vlo[db][2], vlo[db][3], vhi[db][0], vhi[db][1], vhi[db][2], vhi[db][3]};
#pragma unroll
                for (int nq = 0; nq < 4; ++nq) o[db][nq] = __builtin_amdgcn_mfma_f32_16x16x32_bf16(vf, pf[nq], o[db][nq], 0, 0, 0); }
        }
#pragma unroll
        for (int kb = 0; kb < 2; ++kb)
#pragma unroll
            for (int ks = 0; ks < 2; ++ks) kf[kb][ks] = kfn[kb][ks];
#pragma unroll
        for (int db = 0; db < 4; ++db) { vlo[db] = vlon[db]; vhi[db] = vhin[db]; }
    }
#undef ATT_LOAD
#pragma unroll
    for (int nq = 0; nq < 4; ++nq) {
        float lt = lrun[nq]; lt += shx(lt, 16, lane); lt += shx(lt, 32, lane);
        const float inv = 1.0f / lt;
        bf16_t* yp = Y + (size_t)(qrow0 + r0 + nq * 16 + fr) * D + 512 + head * 64 + fq * 4;
#pragma unroll
        for (int db = 0; db < 4; ++db) { u32x2 w; w.x = cvt_pk_bf16(o[db][nq][0] * inv, o[db][nq][1] * inv); w.y = cvt_pk_bf16(o[db][nq][2] * inv, o[db][nq][3] * inv);
            *(u32x2*)(yp + db * 16) = w; }
    }
}

__device__ __forceinline__ void gmlp_conv_item(const Params& p, int l, int hs, int chunk, LAS unsigned char* lds) {
    const int tid = tid_opaque(), wid = tid >> 6, lane = tid & 63, fr = lane & 15, fq = lane >> 4;
    const bf16_t* P = (const bf16_t*)(p.ws + WS_R1);
    bf16_t* Y = (bf16_t*)(p.ws + WS_A) + (size_t)hs * TH * D;
    const int v0 = chunk * 128;
    LAS bf16_t* vT = (LAS bf16_t*)lds;
    { const float* cw = p.in[I_CONVW] + (size_t)l * 3 * 256;
      const bool lat = v0 < H_LAT;
#pragma unroll 2
      for (int i = 0; i < 8; ++i) {
          const int id = i * 512 + tid, pt = id >> 5, cc = (id & 31) * 8, v = v0 + pt;
          const int pos = lat ? (v & (SEQ - 1)) : ((v - H_LAT) & (CTXL - 1)), n = lat ? SEQ : CTXL;
          const bf16_t* rp = P + (size_t)v * PROJ + cc;
          float bv[8], c1[8], h1[8], acc[8];
          unpack8(*(const u32x4*)(rp + OFF_CB), bv); unpack8(*(const u32x4*)(rp + OFF_CC), c1); unpack8(*(const u32x4*)(rp + OFF_CH), h1);
          { const f32x4 wa = *(const f32x4*)(cw + 256 + cc), wb = *(const f32x4*)(cw + 256 + cc + 4);
#pragma unroll
            for (int e = 0; e < 8; ++e) acc[e] = c1[e] * h1[e] * (e < 4 ? wa[e & 3] : wb[e & 3]); }
          if (pos > 0) { float c0[8], h0[8]; unpack8(*(const u32x4*)(rp - PROJ + OFF_CC), c0); unpack8(*(const u32x4*)(rp - PROJ + OFF_CH), h0);
              const f32x4 wa = *(const f32x4*)(cw + cc), wb = *(const f32x4*)(cw + cc + 4);
#pragma unroll
              for (int e = 0; e < 8; ++e) acc[e] += c0[e] * h0[e] * (e < 4 ? wa[e & 3] : wb[e & 3]); }
          if (pos < n - 1) { float c2[8], h2[8]; unpack8(*(const u32x4*)(rp + PROJ + OFF_CC), c2); unpack8(*(const u32x4*)(rp + PROJ + OFF_CH), h2);
              const f32x4 wa = *(const f32x4*)(cw + 512 + cc), wb = *(const f32x4*)(cw + 512 + cc + 4);
#pragma unroll
              for (int e = 0; e < 8; ++e) acc[e] += c2[e] * h2[e] * (e < 4 ? wa[e & 3] : wb[e & 3]); }
#pragma unroll
          for (int e = 0; e < 8; ++e) acc[e] *= bv[e];
          *(u32x4*)(Y + (size_t)v * D + cc) = pack8(acc);
      } }
    { const float* lg = p.in[I_LNG] + l * 256 + 4 * lane; const float* lb = p.in[I_LNB] + l * 256 + 4 * lane;
      const f32x4 g4 = *(const f32x4*)lg, b4 = *(const f32x4*)lb;
#pragma unroll
      for (int hb = 0; hb < 2; ++hb) {
          u32x2 w[8]; float x[8][4], sm[8], qv[8];
#pragma unroll
          for (int i = 0; i < 8; ++i) w[i] = *(const u32x2*)(P + (size_t)(v0 + wid * 16 + hb * 8 + i) * PROJ + OFF_GV + 4 * lane);
#pragma unroll
          for (int i = 0; i < 8; ++i) { x[i][0] = gelu_tanh(bf_lo(w[i].x)); x[i][1] = gelu_tanh(bf_hi(w[i].x)); x[i][2] = gelu_tanh(bf_lo(w[i].y)); x[i][3] = gelu_tanh(bf_hi(w[i].y));
              sm[i] = (x[i][0] + x[i][1]) + (x[i][2] + x[i][3]); }
#pragma unroll
          for (int st = 1; st < 64; st <<= 1)
#pragma unroll
              for (int i = 0; i < 8; ++i) sm[i] += shx(sm[i], st, lane);
#pragma unroll
          for (int i = 0; i < 8; ++i) { const float mu = sm[i] * (1.0f / 256); float q = 0.f;
#pragma unroll
              for (int e = 0; e < 4; ++e) { x[i][e] -= mu; q += x[i][e] * x[i][e]; }
              qv[i] = q; }
#pragma unroll
          for (int st = 1; st < 64; st <<= 1)
#pragma unroll
              for (int i = 0; i < 8; ++i) qv[i] += shx(qv[i], st, lane);
#pragma unroll
          for (int i = 0; i < 8; ++i) { const float rstd = rsqrtf(qv[i] * (1.0f / 256) + EPS); const int pt = wid * 16 + hb * 8 + i;
#pragma unroll
              for (int e = 0; e < 4; ++e) { const float y = x[i][e] * rstd * g4[e] + b4[e]; vT[(4 * lane + e) * 136 + pt] = (bf16_t)(cvt_pk_bf16(y, 0.f) & 0xffffu); } }
      } }
    __syncthreads();
    { const int g = wid >> 1, ph = wid & 1;
      const bf16_t* wsb = (const bf16_t*)(p.ws + WS_WT) + (size_t)l * W_LAYER + W_GWS + (size_t)g * 128 * 128;
      f32x4 acc[4][4];
#pragma unroll
      for (int a = 0; a < 4; ++a)
#pragma unroll
          for (int b = 0; b < 4; ++b) acc[a][b] = (f32x4){0.f, 0.f, 0.f, 0.f};
#pragma unroll
      for (int kk = 0; kk < 4; ++kk) {
          bf16x8 af[4], bfr[4];
#pragma unroll
          for (int db = 0; db < 4; ++db) af[db] = *(const LAS bf16x8*)(vT + (g * 64 + db * 16 + fr) * 136 + kk * 32 + fq * 8);
#pragma unroll
          for (int pb = 0; pb < 4; ++pb) bfr[pb] = *(const bf16x8*)(wsb + (size_t)((ph * 4 + pb) * 16 + fr) * 128 + kk * 32 + fq * 8);
#pragma unroll
          for (int db = 0; db < 4; ++db)
#pragma unroll
              for (int pb = 0; pb < 4; ++pb) acc[db][pb] = __builtin_amdgcn_mfma_f32_16x16x32_bf16(af[db], bfr[pb], acc[db][pb], 0, 0, 0);
      }
      const float* bs = p.in[I_GBS] + (size_t)l * 512 + g * 128;
      u32x2 uw[4][4]; float bias[4];
#pragma unroll
      for (int pb = 0; pb < 4; ++pb) { const int pt = (ph * 4 + pb) * 16 + fr; bias[pb] = bs[pt];
          const bf16_t* up = P + (size_t)(v0 + pt) * PROJ + OFF_GU + g * 64 + fq * 4;
#pragma unroll
          for (int db = 0; db < 4; ++db) uw[pb][db] = *(const u32x2*)(up + db * 16); }
#pragma unroll
      for (int pb = 0; pb < 4; ++pb) { const int pt = (ph * 4 + pb) * 16 + fr;
          bf16_t* yp = Y + (size_t)(v0 + pt) * D + 256 + g * 64 + fq * 4;
#pragma unroll
          for (int db = 0; db < 4; ++db) { const u32x2 w = uw[pb][db];
              const float y0 = gelu_tanh(bf_lo(w.x)) * (acc[db][pb][0] + bias[pb]), y1 = gelu_tanh(bf_hi(w.x)) * (acc[db][pb][1] + bias[pb]);
              const float y2 = gelu_tanh(bf_lo(w.y)) * (acc[db][pb][2] + bias[pb]), y3 = gelu_tanh(bf_hi(w.y)) * (acc[db][pb][3] + bias[pb]);
              u32x2 ov; ov.x = cvt_pk_bf16(y0, y1); ov.y = cvt_pk_bf16(y2, y3); *(u32x2*)(yp + db * 16) = ov; } } }
    __syncthreads();
}

__device__ void phase_mixers(const Params& p, int l, int hs, LAS unsigned char* lds, bool skip_ctx) {
    const int n_attn = skip_ctx ? 512 : 576, n_gmlp = skip_ctx ? 256 : 288;
#ifndef SKIP_ATTN
    for (int it = bid_opaque(); it < n_attn; it += gridDim.x) attn_item(p, l, hs, it);
#endif
    __builtin_amdgcn_sched_barrier(0);
#ifndef SKIP_GMLP
    { const int G = (int)gridDim.x; int n3 = n_attn - 2 * G; n3 = n3 < 0 ? 0 : (n3 > G / 2 ? G / 2 : n3);
      const int b = bid_opaque();
      if (b >= n3) for (int it = b - n3; it < n_gmlp; it += G - n3) gmlp_conv_item(p, l, hs, it, lds); }
#endif
}

#define XB_TMO      128
#define XB_XCNT(j)  (256  + 64 * (j))
#define XB_XSUB(j)  (1280 + 64 * (j))
#define XB_XGEN(j)  (2304 + 64 * (j))
#define XB_TOP      3328
#define XB_TOPGEN   3392
#define XCD_BAR_WORDS 3456
#define XB_SPIN_CAP (1u << 22)
__device__ __forceinline__ unsigned xb_ld(unsigned* p)              { return __hip_atomic_load(p, __ATOMIC_RELAXED, __HIP_MEMORY_SCOPE_AGENT); }
__device__ __forceinline__ unsigned xb_add(unsigned* p, unsigned v) { return __hip_atomic_fetch_add(p, v, __ATOMIC_RELAXED, __HIP_MEMORY_SCOPE_AGENT); }
__device__ __forceinline__ unsigned xb_xcc_id() { return (unsigned)__builtin_amdgcn_s_getreg((3 << 11) | 20) & 0xFu; }
#define XB_SPIN(cond, bar) do { unsigned _sp = 0; while (cond) { __builtin_amdgcn_s_sleep(1); \
    if ((++_sp & 255u) == 0u) { if (xb_ld(&(bar)[XB_TMO])) break; if (_sp > XB_SPIN_CAP) { atomicAdd(&(bar)[XB_TMO], 1u); break; } } } } while (0)
__device__ __forceinline__ void xcd_barrier_post(unsigned* bar) { if (threadIdx.x == 0) (void)xb_add(&bar[XB_XCNT(xb_xcc_id())], 1u); }
__device__ __forceinline__ void xcd_barrier_complete(unsigned* bar, unsigned x, unsigned& nloc, unsigned& nx) {
    const unsigned G = gridDim.x * gridDim.y * gridDim.z;
    unsigned sum, cnt, mine, sp = 0u;
    for (;;) {
        sum = 0u; cnt = 0u; mine = 0u;
#pragma unroll
        for (unsigned j = 0; j < 16; ++j) { const unsigned c = xb_ld(&bar[XB_XCNT(j)]); sum += c; cnt += (c > 0u) ? 1u : 0u; mine = (j == x) ? c : mine; }
        if (sum == G) break;
        __builtin_amdgcn_s_sleep(1);
        if ((++sp & 255u) == 0u) { if (xb_ld(&bar[XB_TMO])) break; if (sp > XB_SPIN_CAP) { atomicAdd(&bar[XB_TMO], 1u); break; } }
    }
    nloc = mine > 0u ? mine : 1u; nx = cnt > 0u ? cnt : 1u;
}
__device__ __forceinline__ void xcd_barrier(unsigned* bar, volatile LAS unsigned* st) {
    asm volatile("s_waitcnt vmcnt(0)" ::: "memory");
    __syncthreads();
    if (threadIdx.x == 0) {
        const unsigned x = xb_xcc_id();
        __builtin_amdgcn_s_waitcnt(0);
        unsigned nloc = st[0], nx = st[1];
        if (nloc == 0u) { xcd_barrier_complete(bar, x, nloc, nx); st[0] = nloc; st[1] = nx; }
        const unsigned old = xb_add(&bar[XB_XSUB(x)], 1u);
        const unsigned gen = old / nloc;
        if (old + 1u == (gen + 1u) * nloc) {
            __builtin_amdgcn_fence(__ATOMIC_RELEASE, "agent");
            asm volatile("s_waitcnt vmcnt(0)" ::: "memory");
            const unsigned og = xb_add(&bar[XB_TOP], 1u);
            const unsigned tg = og / nx;
            if (og + 1u == (tg + 1u) * nx) xb_add(&bar[XB_TOPGEN], 1u);
            else XB_SPIN(xb_ld(&bar[XB_TOPGEN]) == tg, bar);
            __builtin_amdgcn_fence(__ATOMIC_ACQUIRE, "agent");
            xb_add(&bar[XB_XGEN(x)], 1u);
            asm volatile("s_waitcnt vmcnt(0)" ::: "memory");
        } else {
            XB_SPIN(xb_ld(&bar[XB_XGEN(x)]) == gen, bar);
            __builtin_amdgcn_fence(__ATOMIC_ACQUIRE, "agent");
            asm volatile("s_waitcnt vmcnt(0)" ::: "memory");
        }
    }
    __syncthreads();
}

__device__ void run_phase(const Params& p, int ph, LAS unsigned char* lds) {
    if (ph == 0) {
#ifndef SKIP_SETUP
 phase_setup(p, lds);
#endif
 return; }
    const int q = ph - 1, l = q / 17, r = q % 17;
    const bf16_t* W = (const bf16_t*)(p.ws + WS_WT) + (size_t)l * W_LAYER;
    const float* MOD = (const float*)(p.ws + WS_MOD) + (size_t)l * 33 * (NMOD * D);
    bf16_t* HB = (bf16_t*)(p.ws + WS_H);
    const bool first = (l == 0 && r <= 2);
    const bool lastl = (l == NL - 1);
    bf16_t* A = (bf16_t*)(p.ws + WS_A); bf16_t* R1 = (bf16_t*)(p.ws + WS_R1);
    if (r == 0 || r == 3 || r == 14) {
#ifndef SKIP_NORM
 phase_norm(p, l, r == 0 ? 0 : (r == 3 ? 1 : 2), first, lastl && r == 14);
#endif
 return; }
    if (r == 1 || r == 15) {
        const int j = (r == 1) ? 0 : 1;
        const int sk = (lastl && j == 1) ? 1 : 0;
        pg8::Gemm g{A, D, W + (j ? W_FIN1 : W_FIN0), D, sk ? T_LAT : T_ALL, 2 * DFF, D, sk};
        pg8::EpiSwiglu E{R1};
#ifndef SKIP_UP
        pg8::gemm_phase(lds, g, E);
#endif
        return;
    }
    if (r == 2 || r == 16) {
        const int j = (r == 2) ? 0 : 1;
        const int sk = (lastl && j == 1) ? 1 : 0;
        pg8::Gemm g{R1, DFF, W + (j ? W_FOUT1 : W_FOUT0), DFF, sk ? T_LAT : T_ALL, D, DFF, sk};
        pg8::EpiResid E{p.in[I_X], p.in[I_CTX], HB, p.out, MOD, j ? 8 : 2, 0.5f, 0, first ? 0 : ((l == NL - 1 && r == 16) ? 2 : 1)};
#ifndef SKIP_DOWN
        pg8::gemm_phase(lds, g, E);
#endif
        return;
    }
    const int hs = (r - 4) / 5, rr = (r - 4) % 5;
    if (rr == 0) { pg8::Gemm g{A + (size_t)hs * TH * D, D, W + W_WIN, D, TH, PROJ, D, 0}; pg8::EpiBf16 E{R1, PROJ, p.in[I_BGATE] + (size_t)l * 3 * D, OFF_GATE};
#ifndef SKIP_PROJ
 pg8::gemm_phase(lds, g, E);
#endif
 return; }
    if (rr == 1) {
#ifndef SKIP_PREP
 phase_prep(p, l, lds);
#endif
 return; }
    if (rr == 2) {
#ifndef SKIP_MIX
 phase_mixers(p, l, hs, lds, lastl);
#endif
 return; }
    if (rr == 3) { pg8::Gemm g{A + (size_t)hs * TH * D, D, W + W_WB, D, lastl ? H_LAT : TH, D, D, 0}; pg8::EpiBranch E{R1};
#ifndef SKIP_BRANCH
 pg8::gemm_phase(lds, g, E);
#endif
 return; }
    { pg8::Gemm g{R1, PROJ, W + W_WO, D, lastl ? H_LAT : TH, D, D, 0}; pg8::EpiResid E{p.in[I_X], p.in[I_CTX], HB, p.out, MOD, 5, 1.0f, hs * TILES_H, 1};
#ifndef SKIP_OUT
 pg8::gemm_phase(lds, g, E);
#endif
 }
}

__global__ __launch_bounds__(512, 2) void fwd_megakernel(Params p) {
    extern __shared__ __attribute__((aligned(16))) unsigned char shm[];
    LAS unsigned char* lds = (LAS unsigned char*)shm;
#if MK_SINGLE
    volatile LAS unsigned* bst = (volatile LAS unsigned*)(lds + LDS_BYTES - 16);
    if (threadIdx.x == 0) { bst[0] = 0u; bst[1] = 0u; }
    __syncthreads();
    xcd_barrier_post((unsigned*)(p.ws + WS_BAR));
#endif
    for (int ph = p.ph_lo; ph < p.ph_hi; ++ph) {
#if defined(__HIP_DEVICE_COMPILE__)
        const __attribute__((address_space(4))) char* kp = (const __attribute__((address_space(4))) char*)__builtin_amdgcn_kernarg_segment_ptr();
        asm volatile("" : "+s"(kp));
        const Params lp = *(const Params*)(const char*)kp;
#else
        const Params lp = p;
#endif
        run_phase(lp, ph, lds);
#if MK_SINGLE
        if (ph + 1 < lp.ph_hi) {
            if (ph == 0) cg::this_grid().sync();
            else xcd_barrier((unsigned*)(lp.ws + WS_BAR), (volatile LAS unsigned*)(lds + LDS_BYTES - 16));
        }
#endif
    }
}

extern "C" void kernel_launch(void* const* d_in, const int* in_sizes, int n_in, void* d_out, int out_size, void* d_ws, size_t ws_size, hipStream_t stream) {
    static int grid = 0;
    if (grid == 0) {
        if (n_in != N_IN || out_size != T_LAT * D || ws_size < WS_END) { fprintf(stderr, "kernel_launch: unexpected shapes (n_in %d out %d ws %zu need %zu)\n", n_in, out_size, ws_size, (size_t)WS_END); grid = -1; return; }
        int dev = 0, cus = 0, per_cu = 0;
        (void)hipGetDevice(&dev); (void)hipDeviceGetAttribute(&cus, hipDeviceAttributeMultiprocessorCount, dev);
        if (hipFuncSetAttribute((const void*)fwd_megakernel, hipFuncAttributeMaxDynamicSharedMemorySize, LDS_BYTES) != hipSuccess) { fprintf(stderr, "kernel_launch: hipFuncSetAttribute failed\n"); grid = -1; return; }
        if (hipOccupancyMaxActiveBlocksPerMultiprocessor(&per_cu, (const void*)fwd_megakernel, 512, LDS_BYTES) != hipSuccess || per_cu < 1) { fprintf(stderr, "kernel_launch: occupancy query gave %d\n", per_cu); per_cu = 1; }
        (void)hipGetLastError();
        grid = cus * per_cu;
    }
    if (grid < 0) return;
    Params p{};
    for (int i = 0; i < N_IN; ++i) p.in[i] = (const float*)d_in[i];
    p.out = (float*)d_out; p.ws = (unsigned char*)d_ws;
#if MK_SINGLE
    p.ph_lo = 0; p.ph_hi = N_PHASES;
    if (hipMemsetAsync((char*)d_ws + WS_BAR, 0, 16384, stream) != hipSuccess) { fprintf(stderr, "kernel_launch: memset of the barrier words failed\n"); return; }
    void* args[] = {&p};
    hipError_t e = hipLaunchCooperativeKernel((const void*)fwd_megakernel, dim3(grid), dim3(512), args, LDS_BYTES, stream);
    if (e != hipSuccess) fprintf(stderr, "cooperative launch failed: %s (grid %d)\n", hipGetErrorString(e), grid);
#else
    for (int ph = 0; ph < N_PHASES; ++ph) {
        p.ph_lo = ph; p.ph_hi = ph + 1;
        hipLaunchKernelGGL(fwd_megakernel, dim3(grid), dim3(512), LDS_BYTES, stream, p);
    }
#endif
}
```

```cpp
#include <hip/hip_runtime.h>
#include <hip/hip_cooperative_groups.h>
#include <cstdio>
namespace cg = cooperative_groups;

#ifndef MK_SINGLE
#define MK_SINGLE 1
#endif

#define LAS __attribute__((address_space(3)))
typedef unsigned short bf16_t;
typedef short bf16x8 __attribute__((ext_vector_type(8)));
typedef short bf16x4 __attribute__((ext_vector_type(4)));
typedef float f32x4 __attribute__((ext_vector_type(4)));
typedef unsigned u32x4 __attribute__((ext_vector_type(4)));
typedef unsigned u32x2 __attribute__((ext_vector_type(2)));
typedef float f32x2 __attribute__((ext_vector_type(2)));

constexpr int D = 1024, NB = 32, SEQ = 2048, NL = 4, CTXL = 256, DFF = 2816, PROJ = 5120, NMOD = 9;
constexpr int T_LAT = NB * SEQ, T_CTX = NB * CTXL, T_ALL = T_LAT + T_CTX;
constexpr int NB0 = 14, NB1 = NB - NB0;
constexpr int U1 = NB0 * (SEQ + CTXL);
constexpr int TH_MAX = NB1 * (SEQ + CTXL);
__host__ __device__ __forceinline__ constexpr int part_nb(int s) { return s ? NB1 : NB0; }
__host__ __device__ __forceinline__ constexpr int part_lat(int s) { return part_nb(s) * SEQ; }
__host__ __device__ __forceinline__ constexpr int part_rows(int s) { return part_nb(s) * (SEQ + CTXL); }
__host__ __device__ __forceinline__ constexpr int part_u0(int s) { return s ? U1 : 0; }
constexpr int OFF_CB = 0, OFF_CC = 256, OFF_CH = 512, OFF_GU = 768, OFF_GV = 1024, OFF_Q = 1280, OFF_K = 1792, OFF_V = 1920, OFF_GATE = 2048;
constexpr float EPS = 1e-6f;
constexpr float LOG2E = 1.4426950408889634f;

enum { I_X = 0, I_C, I_CTX, I_CCTX, I_WMOD, I_BMOD, I_NORMG, I_FFNIN, I_FFNOUT, I_WIN, I_BGATE, I_CONVW, I_LNG, I_LNB, I_GWS, I_GBS, I_QG, I_KG, I_SINK, I_WBC, I_WBG, I_WBA, I_WOUT, N_IN };

constexpr size_t W_FIN0 = 0, W_FIN1 = 5767168, W_FOUT0 = 11534336, W_FOUT1 = 14417920, W_WIN = 17301504, W_WB = 22544384, W_WO = 23592960, W_GWS = 24641536, W_LAYER = 24707072;
constexpr size_t WS_WT = 0;
constexpr size_t WS_MOD = WS_WT + NL * W_LAYER * 2;
constexpr size_t WS_ROPE = WS_MOD + (size_t)NL * 33 * 9216 * 4;
constexpr size_t WS_HC = WS_ROPE + 8192;
constexpr size_t WS_A = WS_HC + (size_t)T_CTX * D * 4;
constexpr size_t WS_R1 = WS_A + (size_t)T_ALL * D * 2;
constexpr size_t WS_VTL = WS_R1 + (size_t)TH_MAX * PROJ * 2;
constexpr size_t WS_VTC = WS_VTL + (size_t)NB1 * 2 * 64 * 2048 * 2;
constexpr size_t WS_BAR = WS_VTC + (size_t)NB1 * 2 * 64 * 256 * 2;
constexpr size_t WS_H = WS_BAR + 16384;
constexpr size_t WS_END = WS_H + (size_t)T_ALL * D * 2;

constexpr int LDS_BYTES = 143360;
constexpr int N_PHASES = 1 + 17 * NL;

struct Params {
    const float* in[N_IN];
    float* out;
    unsigned char* ws;
    int ph_lo, ph_hi;
};

__device__ __forceinline__ unsigned cvt_pk_bf16(float lo, float hi) { unsigned r; asm volatile("v_cvt_pk_bf16_f32 %0, %1, %2" : "=v"(r) : "v"(lo), "v"(hi)); return r; }
__device__ __forceinline__ int tid_opaque() { int t = threadIdx.x; asm volatile("" : "+v"(t)); return t; }
__device__ __forceinline__ int bid_opaque() { int b = blockIdx.x; asm volatile("" : "+s"(b)); return b; }
__device__ __forceinline__ float bf_lo(unsigned w) { return __uint_as_float(w << 16); }
__device__ __forceinline__ float bf_hi(unsigned w) { return __uint_as_float(w & 0xffff0000u); }
__device__ __forceinline__ float fast_rcp(float x) { return __builtin_amdgcn_rcpf(x); }
__device__ __forceinline__ float fast_exp2(float x) { return __builtin_amdgcn_exp2f(x); }
__device__ __forceinline__ float sigmoidf_(float x) { return fast_rcp(1.0f + fast_exp2(-x * LOG2E)); }
__device__ __forceinline__ float siluf_(float x) { return x * sigmoidf_(x); }
__device__ __forceinline__ float gelu_tanh(float x) { const float z = 0.7978845608028654f * (x + 0.044715f * x * x * x); return x * sigmoidf_(2.0f * z); }
__device__ __forceinline__ float shx(float v, int m, int lane) { return __int_as_float(__builtin_amdgcn_ds_bpermute((lane ^ m) << 2, __float_as_int(v))); }
__device__ __forceinline__ float wave_sum(float v, int lane) {
    v += shx(v, 1, lane); v += shx(v, 2, lane); v += shx(v, 4, lane); v += shx(v, 8, lane); v += shx(v, 16, lane); v += shx(v, 32, lane); return v;
}
__device__ __forceinline__ void unpack8(const u32x4 w, float (&f)[8]) {
    f[0] = bf_lo(w.x); f[1] = bf_hi(w.x); f[2] = bf_lo(w.y); f[3] = bf_hi(w.y); f[4] = bf_lo(w.z); f[5] = bf_hi(w.z); f[6] = bf_lo(w.w); f[7] = bf_hi(w.w);
}
__device__ __forceinline__ u32x4 pack8(const float (&f)[8]) {
    u32x4 w; w.x = cvt_pk_bf16(f[0], f[1]); w.y = cvt_pk_bf16(f[2], f[3]); w.z = cvt_pk_bf16(f[4], f[5]); w.w = cvt_pk_bf16(f[6], f[7]); return w;
}

struct RowMap { size_t row0; int is_ctx; int modrow; };
__device__ __forceinline__ RowMap map_row(int u) {
    const int s = (u >= U1) ? 1 : 0, v = u - s * U1, latN = part_lat(s); RowMap r;
    if (v < latN) { r.row0 = (size_t)(s ? NB0 * SEQ : 0) + v; r.is_ctx = 0; r.modrow = (int)(r.row0 >> 11); }
    else { r.row0 = (size_t)(s ? NB0 * CTXL : 0) + (v - latN); r.is_ctx = 1; r.modrow = 32; }
    return r;
}

namespace pg8 {
constexpr int BM = 256, BK = 64, HALF = 128, HTB = HALF * BK * 2, STAGE_BYTES = 8 * HTB, NXCD = 8, WGM = 8;
__device__ __forceinline__ int lds_byte(int r, int c) { const int st = (r >> 4) * 2 + (c >> 5), rr = r & 15, cc = c & 31, ob = rr * 64 + cc * 2; return st * 1024 + (ob ^ (((ob >> 9) & 1) << 5)); }
__device__ __forceinline__ void stage_rc(int b, int& R, int& C) { const int st = b / 1024, sb = b % 1024, swz = sb ^ (((sb >> 9) & 1) << 5); R = (st >> 1) * 16 + swz / 64; C = (st & 1) * 32 + (swz % 64) / 2; }
__device__ __forceinline__ int perm32(int rho) { const int n = rho >> 4, i = rho & 15; return 8 * (i >> 2) + 4 * n + (i & 3); }

struct Unit { int pm, pn; };
struct Gemm { const bf16_t* A; int lda; const bf16_t* Bt; int ldb; int M, N, K; int skip_ctx; };

struct StaticOrder {
    int nM, nN, nwg, G, c, skip;
    __device__ void init(int M, int N, int G_, int c_, int skip_) { nM = M / BM; nN = N / BM; nwg = nM * nN; G = G_; c = c_; skip = skip_; }
    __device__ bool next(int i, Unit& u) const {
        const long L = (long)i * G + c; if (L >= nwg) return false;
        int wgid = (int)L; { const int q = nwg / NXCD, r = nwg % NXCD, xcd = wgid % NXCD, off = wgid / NXCD; wgid = (xcd < r ? xcd * (q + 1) : r * (q + 1) + (xcd - r) * q) + off; }
        const int nig = WGM * nN, gid = wgid / nig, fm = gid * WGM, gsz = (nM - fm) < WGM ? (nM - fm) : WGM;
        u.pm = fm + ((wgid % nig) % gsz); u.pn = (wgid % nig) / gsz; if (skip && u.pm >= NB0 * 8) u.pm += NB0; return true;
    }
};

template <class Epi>
__device__ __forceinline__ void gemm_phase(LAS unsigned char* lds, const Gemm g, const Epi& E) {
    const int tid = tid_opaque(), wid = __builtin_amdgcn_readfirstlane(tid >> 6), lane = tid & 63, wr = wid >> 2, wc = wid & 3, fr = lane & 15, fq = lane >> 4;
    const int K = g.K, nt = K / BK;
    StaticOrder S; S.init(g.M, g.N, (int)gridDim.x, bid_opaque(), g.skip_ctx);
    unsigned voffA[2], voffB[2];
#pragma unroll
    for (int i = 0; i < 2; ++i) { int R, C; stage_rc(tid * 16 + i * 8192, R, C); const int Rb = Epi::PERM ? ((R & ~31) + perm32(R & 31)) : R;
        voffA[i] = (unsigned)(R * g.lda + C) * 2u; voffB[i] = (unsigned)(Rb * g.ldb + C) * 2u; }
    const size_t kstep = (size_t)(BK * 2);
    const size_t hstepA = (size_t)HALF * g.lda * 2, hstepB = (size_t)HALF * g.ldb * 2;
    const size_t tstepA = 2 * hstepA, tstepB = 2 * hstepB;
    const unsigned ldsw = (unsigned)wid * 1024u;
    const int aoff = lds_byte(wr * 64 + fr, fq * 8), boff = lds_byte(wc * 32 + fr, fq * 8);
#define PG8_SA(b, h) (((b) * 2 + (h)) * HTB)
#define PG8_SB(b, h) ((4 + (b) * 2 + (h)) * HTB)
#define PG8_STAGE(bufoff, gbase, voff) do { _Pragma("unroll") for (int _i = 0; _i < 2; ++_i) \
        __builtin_amdgcn_global_load_lds((const unsigned*)((const char*)(gbase) + (voff)[_i]), (LAS unsigned*)(lds + (bufoff) + ldsw + _i * 8192), 16, 0, 0); } while (0)
#define PG8_LDA(dst, b, h) do { _Pragma("unroll") for (int m = 0; m < 4; ++m) _Pragma("unroll") for (int k = 0; k < 2; ++k) dst[m][k] = *(const LAS bf16x8*)(lds + PG8_SA(b, h) + aoff + m * 2048 + k * 1024); } while (0)
#define PG8_LDB(dst, b, h) do { _Pragma("unroll") for (int n = 0; n < 2; ++n) _Pragma("unroll") for (int k = 0; k < 2; ++k) dst[n][k] = *(const LAS bf16x8*)(lds + PG8_SB(b, h) + boff + n * 2048 + k * 1024); } while (0)
#define PG8_MMA(ai, bj, At, Bt) do { __builtin_amdgcn_s_setprio(1); _Pragma("unroll") for (int m = 0; m < 4; ++m) _Pragma("unroll") for (int n = 0; n < 2; ++n) _Pragma("unroll") for (int k = 0; k < 2; ++k) \
        acc[ai][bj][m][n] = __builtin_amdgcn_mfma_f32_16x16x32_bf16(Bt[n][k], At[m][k], acc[ai][bj][m][n], 0, 0, 0); __builtin_amdgcn_s_setprio(0); } while (0)
#define PG8_WAIT_V(n) asm volatile("s_waitcnt vmcnt(" #n ")" ::: "memory")
#define PG8_WAIT_L(n) asm volatile("s_waitcnt lgkmcnt(" #n ")" ::: "memory")
#define PG8_BAR __builtin_amdgcn_s_barrier()
#define PG8_SCHED __builtin_amdgcn_sched_barrier(0)
#define PG8_KLOOP(TB, TE) for (int t = (TB); t < (TE); t += 2) { \
            const bool last = (t == nt - 2); \
            const char* a1 = cA + (size_t)(t + 1) * kstep; \
            const char* a2 = last ? nA : cA + (size_t)(t + 2) * kstep; const char* b2 = last ? nB : cB + (size_t)(t + 2) * kstep; \
            const char* a3 = a2 + kstep; const char* b3 = b2 + kstep; \
            PG8_LDB(B0, 0, 0); PG8_SCHED; PG8_LDA(At, 0, 0); PG8_STAGE(PG8_SA(1, 1), a1 + hstepA, voffA); \
            PG8_WAIT_L(8); PG8_BAR; PG8_WAIT_L(0); PG8_MMA(0, 0, At, B0); PG8_BAR; PG8_SCHED; \
            PG8_LDB(B1, 0, 1); PG8_STAGE(PG8_SB(0, 0), b2, voffB); \
            PG8_BAR; PG8_WAIT_L(0); PG8_MMA(0, 1, At, B1); PG8_BAR; \
            PG8_LDA(At, 0, 1); PG8_STAGE(PG8_SA(0, 0), a2, voffA); \
            PG8_BAR; PG8_WAIT_L(0); PG8_MMA(1, 0, At, B0); PG8_BAR; PG8_SCHED; \
            PG8_STAGE(PG8_SB(0, 1), b2 + hstepB, voffB); \
            PG8_WAIT_V(6); PG8_BAR; PG8_MMA(1, 1, At, B1); PG8_BAR; \
            PG8_LDB(B0, 1, 0); PG8_SCHED; PG8_LDA(At, 1, 0); PG8_STAGE(PG8_SA(0, 1), a2 + hstepA, voffA); \
            PG8_WAIT_L(8); PG8_BAR; PG8_WAIT_L(0); PG8_MMA(0, 0, At, B0); PG8_BAR; PG8_SCHED; \
            PG8_LDB(B1, 1, 1); PG8_STAGE(PG8_SB(1, 0), b3, voffB); \
            PG8_BAR; PG8_WAIT_L(0); PG8_MMA(0, 1, At, B1); PG8_BAR; \
            PG8_LDA(At, 1, 1); PG8_STAGE(PG8_SA(1, 0), a3, voffA); \
            PG8_BAR; PG8_WAIT_L(0); PG8_MMA(1, 0, At, B0); PG8_BAR; PG8_SCHED; \
            PG8_STAGE(PG8_SB(1, 1), b3 + hstepB, voffB); \
            PG8_WAIT_V(6); PG8_BAR; PG8_MMA(1, 1, At, B1); PG8_BAR; \
        }
    Unit cur, nxt; int ui = 0;
    if (!S.next(0, cur)) return;
    f32x4 acc[2][2][4][2];
#pragma unroll
    for (int a = 0; a < 2; ++a)
#pragma unroll
        for (int b = 0; b < 2; ++b)
#pragma unroll
            for (int m = 0; m < 4; ++m)
#pragma unroll
                for (int n = 0; n < 2; ++n) acc[a][b][m][n] = (f32x4){0.f, 0.f, 0.f, 0.f};
    bf16x8 At[4][2], B0[2][2], B1[2][2];
    const char* cA = (const char*)g.A + (size_t)cur.pm * tstepA; const char* cB = (const char*)g.Bt + (size_t)cur.pn * tstepB;
    PG8_STAGE(PG8_SB(0, 0), cB, voffB); PG8_STAGE(PG8_SA(0, 0), cA, voffA); PG8_STAGE(PG8_SB(0, 1), cB + hstepB, voffB); PG8_STAGE(PG8_SA(0, 1), cA + hstepA, voffA);
    if (wr == 1) PG8_BAR;
    PG8_WAIT_V(4); PG8_BAR;
    PG8_STAGE(PG8_SB(1, 0), cB + kstep, voffB); PG8_STAGE(PG8_SA(1, 0), cA + kstep, voffA); PG8_STAGE(PG8_SB(1, 1), cB + hstepB + kstep, voffB);
    PG8_WAIT_V(6); PG8_BAR;
    for (;;) {
        const bool has_next = S.next(ui + 1, nxt);
        const char* nA = has_next ? (const char*)g.A + (size_t)nxt.pm * tstepA : cA; const char* nB = has_next ? (const char*)g.Bt + (size_t)nxt.pn * tstepB : cB;
        if constexpr (Epi::MIDK) {
            PG8_KLOOP(0, 4)
            E.template mid<0>(acc, cur, wr, wc, fr, fq);
            PG8_KLOOP(4, 8)
            E.template mid<1>(acc, cur, wr, wc, fr, fq);
            PG8_KLOOP(8, nt)
        } else {
            PG8_KLOOP(0, nt)
        }
        E(acc, cur, wr, wc, fr, fq);
        if (!has_next) break;
#pragma unroll
        for (int a = 0; a < 2; ++a)
#pragma unroll
            for (int b = 0; b < 2; ++b)
#pragma unroll
                for (int m = 0; m < 4; ++m)
#pragma unroll
                    for (int n = 0; n < 2; ++n) acc[a][b][m][n] = (f32x4){0.f, 0.f, 0.f, 0.f};
        cur = nxt; cA = nA; cB = nB; ++ui;
    }
    PG8_WAIT_V(0);
    if (wr == 0) PG8_BAR;
    PG8_BAR;
#undef PG8_KLOOP
#undef PG8_SA
#undef PG8_SB
#undef PG8_STAGE
#undef PG8_LDA
#undef PG8_LDB
#undef PG8_MMA
#undef PG8_WAIT_V
#undef PG8_WAIT_L
#undef PG8_BAR
#undef PG8_SCHED
}

struct EpiSwiglu {
    static constexpr bool PERM = true, MIDK = false;
    bf16_t* O;
    __device__ __forceinline__ void operator()(const f32x4 (&acc)[2][2][4][2], const Unit& u, int wr, int wc, int fr, int fq) const {
        const int row0 = u.pm * BM + wr * 64 + fr, col0 = u.pn * 128 + wc * 32 + 8 * fq;
#pragma unroll
        for (int ai = 0; ai < 2; ++ai)
#pragma unroll
            for (int m = 0; m < 4; ++m) {
                float h[8];
#pragma unroll
                for (int n = 0; n < 2; ++n)
#pragma unroll
                    for (int j = 0; j < 4; ++j) h[n * 4 + j] = siluf_(acc[ai][0][m][n][j]) * acc[ai][1][m][n][j];
                *(u32x4*)(O + (size_t)(row0 + ai * HALF + m * 16) * DFF + col0) = pack8(h);
            }
    }
};
struct EpiBf16 {
    static constexpr bool PERM = true, MIDK = false;
    bf16_t* O; int ldc; const float* bias; int bias_col0;
    __device__ __forceinline__ void operator()(const f32x4 (&acc)[2][2][4][2], const Unit& u, int wr, int wc, int fr, int fq) const {
        const int row0 = u.pm * BM + wr * 64 + fr, col0 = u.pn * BM + wc * 32 + 8 * fq;
        const bool hb = (u.pn * BM >= bias_col0);
        f32x4 bv[2][2];
#pragma unroll
        for (int bj = 0; bj < 2; ++bj)
#pragma unroll
            for (int n = 0; n < 2; ++n) bv[bj][n] = hb ? *(const f32x4*)(bias + (col0 - bias_col0) + bj * HALF + 4 * n) : (f32x4){0.f, 0.f, 0.f, 0.f};
#pragma unroll
        for (int ai = 0; ai < 2; ++ai)
#pragma unroll
            for (int m = 0; m < 4; ++m) { bf16_t* rowp = O + (size_t)(row0 + ai * HALF + m * 16) * ldc + col0;
#pragma unroll
                for (int bj = 0; bj < 2; ++bj) { f32x4 v0 = acc[ai][bj][m][0] + bv[bj][0], v1 = acc[ai][bj][m][1] + bv[bj][1];
                    if (hb) {
#pragma unroll
                        for (int j = 0; j < 4; ++j) { v0[j] = 1.0f + fast_exp2(-fminf(fmaxf(v0[j], -30.f), 30.f) * LOG2E); v1[j] = 1.0f + fast_exp2(-fminf(fmaxf(v1[j], -30.f), 30.f) * LOG2E); } }
                    u32x4 w; w.x = cvt_pk_bf16(v0[0], v0[1]); w.y = cvt_pk_bf16(v0[2], v0[3]); w.z = cvt_pk_bf16(v1[0], v1[1]); w.w = cvt_pk_bf16(v1[2], v1[3]);
                    *(u32x4*)(rowp + bj * HALF) = w; } }
    }
};
struct EpiResid {
    static constexpr bool PERM = true, MIDK = false;
    const float* x_lat; const float* x_ctx; bf16_t* hbuf; float* out; const float* mod; int gate_idx; float gscale; int tile0; int mode;
    template <int MODE> __device__ __forceinline__ void body(const f32x4 (&acc)[2][2][4][2], const Unit& u, int wr, int wc, int fr, int fq) const {
        const int urow0 = (tile0 + u.pm) * BM;
        const RowMap rm = map_row(urow0);
        const float* gp = mod + (size_t)rm.modrow * (NMOD * D) + gate_idx * D;
        const int rloc = wr * 64 + fr, col0 = u.pn * BM + wc * 32 + 8 * fq;
        const float* xs = (rm.is_ctx ? x_ctx : x_lat) + rm.row0 * D + col0;
        bf16_t* hb = hbuf + (size_t)urow0 * D + col0;
        float* ob = out + rm.row0 * D + col0;
        const bool st_ok = (MODE != 2) || !rm.is_ctx;
        constexpr int MG = (MODE == 0) ? 2 : 4;
#pragma unroll
        for (int bj = 0; bj < 2; ++bj) {
            const f32x4 g0 = *(const f32x4*)(gp + col0 + bj * HALF) * gscale, g1 = *(const f32x4*)(gp + col0 + bj * HALF + 4) * gscale;
#pragma unroll
            for (int ai = 0; ai < 2; ++ai)
#pragma unroll
                for (int mg = 0; mg < 4; mg += MG) {
                    f32x4 xf[MODE == 0 ? MG : 1][2]; u32x4 xw[MODE == 0 ? 1 : MG];
#pragma unroll
                    for (int mm = 0; mm < MG; ++mm) { const size_t ro = (size_t)(rloc + ai * HALF + (mg + mm) * 16) * D + bj * HALF;
                        if constexpr (MODE == 0) { xf[mm][0] = *(const f32x4*)(xs + ro); xf[mm][1] = *(const f32x4*)(xs + ro + 4); }
                        else xw[mm] = *(const u32x4*)(hb + ro); }
                    __builtin_amdgcn_sched_barrier(0);
#pragma unroll
                    for (int mm = 0; mm < MG; ++mm) { const int m = mg + mm; const size_t ro = (size_t)(rloc + ai * HALF + m * 16) * D + bj * HALF;
                        f32x4 x0, x1;
                        if constexpr (MODE == 0) { x0 = xf[mm][0]; x1 = xf[mm][1]; }
                        else { const u32x4 w = xw[mm]; x0 = (f32x4){bf_lo(w.x), bf_hi(w.x), bf_lo(w.y), bf_hi(w.y)}; x1 = (f32x4){bf_lo(w.z), bf_hi(w.z), bf_lo(w.w), bf_hi(w.w)}; }
                        const f32x4 y0 = x0 + g0 * acc[ai][bj][m][0], y1 = x1 + g1 * acc[ai][bj][m][1];
                        if constexpr (MODE == 2) { if (st_ok) { *(f32x4*)(ob + ro) = y0; *(f32x4*)(ob + ro + 4) = y1; } }
                        else { u32x4 w; w.x = cvt_pk_bf16(y0[0], y0[1]); w.y = cvt_pk_bf16(y0[2], y0[3]); w.z = cvt_pk_bf16(y1[0], y1[1]); w.w = cvt_pk_bf16(y1[2], y1[3]); *(u32x4*)(hb + ro) = w; }
                    }
                    __builtin_amdgcn_sched_barrier(0);
                }
        }
    }
    __device__ __forceinline__ void operator()(const f32x4 (&acc)[2][2][4][2], const Unit& u, int wr, int wc, int fr, int fq) const {
        if (mode == 1) body<1>(acc, u, wr, wc, fr, fq);
        else if (mode == 0) body<0>(acc, u, wr, wc, fr, fq);
        else body<2>(acc, u, wr, wc, fr, fq);
    }
};
struct EpiBranch {
    static constexpr bool PERM = true, MIDK = true;
    bf16_t* P;
    __device__ __forceinline__ u32x4 ld_raw(unsigned off) const { return *(const u32x4*)((const char*)P + (size_t)off * 2u); }
    __device__ __forceinline__ void to_e(const u32x4 w, float (&e)[8]) const { unpack8(w, e); }
    template <int WHICH> __device__ __forceinline__ void mid(f32x4 (&acc)[2][2][4][2], const Unit& u, int wr, int wc, int fr, int fq) const {
        unsigned base = (unsigned)(u.pm * BM + wr * 64 + fr) * PROJ + (unsigned)(u.pn * BM + wc * 32 + 8 * fq) + OFF_GATE + WHICH * D;
        asm volatile("" : "+v"(base));
#pragma unroll
        for (int ai = 0; ai < 2; ++ai)
#pragma unroll
            for (int mp = 0; mp < 2; ++mp) {
                u32x4 wa[2][2], wb[2][2];
#pragma unroll
                for (int mm = 0; mm < 2; ++mm)
#pragma unroll
                    for (int bj = 0; bj < 2; ++bj) { const unsigned o = base + (unsigned)(ai * HALF + (mp * 2 + mm) * 16) * PROJ + bj * HALF; wa[mm][bj] = ld_raw(o); wb[mm][bj] = ld_raw(o + D); }
                __builtin_amdgcn_sched_barrier(0);
#pragma unroll
                for (int mm = 0; mm < 2; ++mm)
#pragma unroll
                    for (int bj = 0; bj < 2; ++bj) { float ea[8], eb[8]; to_e(wa[mm][bj], ea); to_e(wb[mm][bj], eb);
#pragma unroll
                        for (int n = 0; n < 2; ++n)
#pragma unroll
                            for (int j = 0; j < 4; ++j) acc[ai][bj][mp * 2 + mm][n][j] *= eb[n * 4 + j] * fast_rcp(ea[n * 4 + j]); }
                __builtin_amdgcn_sched_barrier(0);
            }
    }
    __device__ __forceinline__ void operator()(const f32x4 (&acc)[2][2][4][2], const Unit& u, int wr, int wc, int fr, int fq) const {
        unsigned base = (unsigned)(u.pm * BM + wr * 64 + fr) * PROJ + (unsigned)(u.pn * BM + wc * 32 + 8 * fq);
        asm volatile("" : "+v"(base));
#pragma unroll
        for (int ai = 0; ai < 2; ++ai) {
            u32x4 w2[4][2];
#pragma unroll
            for (int m = 0; m < 4; ++m)
#pragma unroll
                for (int bj = 0; bj < 2; ++bj) w2[m][bj] = ld_raw(base + (unsigned)(ai * HALF + m * 16) * PROJ + bj * HALF + OFF_GATE + 2 * D);
            __builtin_amdgcn_sched_barrier(0);
#pragma unroll
            for (int m = 0; m < 4; ++m)
#pragma unroll
                for (int bj = 0; bj < 2; ++bj) { const unsigned o = base + (unsigned)(ai * HALF + m * 16) * PROJ + bj * HALF;
                    float e2[8], ov[8]; to_e(w2[m][bj], e2);
#pragma unroll
                    for (int n = 0; n < 2; ++n)
#pragma unroll
                        for (int j = 0; j < 4; ++j) ov[n * 4 + j] = acc[ai][bj][m][n][j] * fast_rcp(e2[n * 4 + j]);
                    *(u32x4*)((char*)P + (size_t)o * 2u) = pack8(ov); }
            __builtin_amdgcn_sched_barrier(0);
        }
    }
};
}

__device__ __forceinline__ void tr_job(LAS float* tl, const float* src, int ld_src, int K, int Nout, bf16_t* dst, int ld_dst, int dkofs, int mode) {
    const int tid = tid_opaque();
    const int nkt = K / 64, ntl = nkt * (Nout / 64), G = gridDim.x;
    const int ln = tid & 63, lk = tid >> 6, sk2 = (tid & 31) * 2, sn = tid >> 5;
    float r[8];
    int t = bid_opaque();
    auto src_ptr = [&](int tt) -> const float* {
        const int kt = tt % nkt, n0 = (tt / nkt) * 64; int c0 = n0;
        if (mode == 1) { const int pn = n0 >> 8, rr = n0 & 255; c0 = (rr < 128) ? pn * 128 + rr : DFF + pn * 128 + (rr - 128); }
        return src + (size_t)(kt * 64 + lk) * ld_src + c0 + ln; };
    if (t < ntl) { const float* sp = src_ptr(t);
#pragma unroll
        for (int i = 0; i < 8; ++i) r[i] = sp[(size_t)(8 * i) * ld_src]; }
    for (; t < ntl; t += G) {
#pragma unroll
        for (int i = 0; i < 8; ++i) tl[(lk + 8 * i) * 65 + ln] = r[i];
        __syncthreads();
        if (t + G < ntl) { const float* sp = src_ptr(t + G);
#pragma unroll
            for (int i = 0; i < 8; ++i) r[i] = sp[(size_t)(8 * i) * ld_src]; }
        { const int kt = t % nkt, n0 = (t / nkt) * 64;
#pragma unroll
          for (int i = 0; i < 4; ++i) { const int n = sn + 16 * i; *(unsigned*)(dst + (size_t)(n0 + n) * ld_dst + dkofs + kt * 64 + sk2) = cvt_pk_bf16(tl[sk2 * 65 + n], tl[(sk2 + 1) * 65 + n]); } }
        __syncthreads();
    }
}

__device__ void phase_setup(const Params& p, LAS unsigned char* lds) {
    const int tid = tid_opaque(), wid = tid >> 6, lane = tid & 63;
    bf16_t* WT = (bf16_t*)(p.ws + WS_WT);
    LAS float* tl = (LAS float*)lds;
    for (int l = 0; l < NL; ++l) {
        bf16_t* W = WT + (size_t)l * W_LAYER;
        for (int j = 0; j < 2; ++j) {
            tr_job(tl, p.in[I_FFNIN] + ((size_t)l * 2 + j) * D * (2 * DFF), 2 * DFF, D, 2 * DFF, W + (j ? W_FIN1 : W_FIN0), D, 0, 1);
            tr_job(tl, p.in[I_FFNOUT] + ((size_t)l * 2 + j) * DFF * D, D, DFF, D, W + (j ? W_FOUT1 : W_FOUT0), DFF, 0, 0);
        }
        tr_job(tl, p.in[I_WIN] + (size_t)l * D * PROJ, PROJ, D, PROJ, W + W_WIN, D, 0, 0);
        tr_job(tl, p.in[I_WBC] + (size_t)l * 256 * D, D, 256, D, W + W_WB, D, 0, 0);
        tr_job(tl, p.in[I_WBG] + (size_t)l * 256 * D, D, 256, D, W + W_WB, D, 256, 0);
        tr_job(tl, p.in[I_WBA] + (size_t)l * 512 * D, D, 512, D, W + W_WB, D, 512, 0);
        tr_job(tl, p.in[I_WOUT] + (size_t)l * D * D, D, D, D, W + W_WO, D, 0, 0);
        for (int i = bid_opaque() * 512 + tid; i < 65536 / 2; i += gridDim.x * 512) {
            const float2 v = *(const float2*)(p.in[I_GWS] + (size_t)l * 65536 + 2 * i);
            *(unsigned*)(W + W_GWS + 2 * i) = cvt_pk_bf16(v.x, v.y);
        }
    }
    { const int gi = bid_opaque() * 512 + tid;
      if (gi < 1024) { const int pos = gi >> 4, i = gi & 15;
        const int i4 = i & 3, i16 = i >> 2;
        float inv = (i4 == 0) ? 1.0f : (i4 == 1) ? 0.5623413251903491f : (i4 == 2) ? 0.31622776601683794f : 0.1778279410038923f;
        inv *= (i16 == 0) ? 1.0f : (i16 == 1) ? 0.1f : (i16 == 2) ? 0.01f : 0.001f;
        const float a = (float)pos * inv;
        const float kq = __builtin_rintf(a * 0.6366197723675814f);
        float r = __builtin_fmaf(-kq, 1.5707963705062866f, a); r = __builtin_fmaf(kq, 4.371139000186241e-8f, r);
        const float r2 = r * r;
        const float sn = r * (1.0f + r2 * (-1.0f / 6 + r2 * (1.0f / 120 + r2 * (-1.0f / 5040 + r2 * (1.0f / 362880)))));
        const float cs = 1.0f + r2 * (-0.5f + r2 * (1.0f / 24 + r2 * (-1.0f / 720 + r2 * (1.0f / 40320 + r2 * (-1.0f / 3628800)))));
        const int q = ((int)kq) & 3;
        const float c = (q == 0) ? cs : (q == 1) ? -sn : (q == 2) ? -cs : sn;
        const float s = (q == 0) ? sn : (q == 1) ? cs : (q == 2) ? -sn : -cs;
        float2* rt = (float2*)(p.ws + WS_ROPE); rt[gi] = make_float2(c, s); } }
    if (bid_opaque() < NL * 36) {
        LAS float* sc = (LAS float*)lds;
        __syncthreads();
        for (int i = tid; i < 33 * D; i += 512) { const int r = i >> 10, k = i & 1023; const float v = (r < 32) ? p.in[I_C][r * D + k] : p.in[I_CCTX][k]; sc[i] = siluf_(v); }
        __syncthreads();
        float* MOD = (float*)(p.ws + WS_MOD);
        for (int it = bid_opaque(); it < NL * 36; it += gridDim.x) {
            const int l = it / 36, cgp = it % 36, n0 = cgp * 256 + lane * 4;
            const float* wp = p.in[I_WMOD] + (size_t)l * D * (NMOD * D) + n0;
            f32x4 a[5];
#pragma unroll
            for (int i = 0; i < 5; ++i) a[i] = (f32x4){0.f, 0.f, 0.f, 0.f};
            for (int k = 0; k < D; k += 16) {
                f32x4 w[16];
#pragma unroll
                for (int kk = 0; kk < 16; ++kk) w[kk] = *(const f32x4*)(wp + (size_t)(k + kk) * (NMOD * D));
#pragma unroll
                for (int i = 0; i < 5; ++i) { const int r = (i < 4) ? wid + 8 * i : 32;
#pragma unroll
                    for (int k4 = 0; k4 < 4; ++k4) { const f32x4 s4 = *(const LAS f32x4*)(sc + r * D + k + 4 * k4);
                        a[i] += s4[0] * w[4 * k4] + s4[1] * w[4 * k4 + 1] + s4[2] * w[4 * k4 + 2] + s4[3] * w[4 * k4 + 3]; } }
            }
            const f32x4 bv = *(const f32x4*)(p.in[I_BMOD] + (size_t)l * (NMOD * D) + n0);
#pragma unroll
            for (int i = 0; i < 5; ++i) { const int r = (i < 4) ? wid + 8 * i : 32; if (i < 4 || wid == 0) *(f32x4*)(MOD + ((size_t)l * 33 + r) * (NMOD * D) + n0) = a[i] + bv; }
        }
        __syncthreads();
    }
}

__device__ void phase_norm(const Params& p, int l, int j, bool from_inputs, bool skip_ctx) {
    const int tid = tid_opaque(), wid = tid >> 6, lane = tid & 63;
    bf16_t* A = (bf16_t*)(p.ws + WS_A);
    const bf16_t* hbuf = (const bf16_t*)(p.ws + WS_H);
    const float* MOD = (const float*)(p.ws + WS_MOD) + (size_t)l * 33 * (NMOD * D);
    const float* ng = p.in[I_NORMG] + ((size_t)l * 3 + j) * D;
    constexpr int NR = 4;
    for (int u = (bid_opaque() * 8 + wid) * NR; u < T_ALL; u += gridDim.x * 8 * NR) {
        const RowMap rm = map_row(u);
        if (skip_ctx && rm.is_ctx) continue;
        const float* sh = MOD + (size_t)rm.modrow * (NMOD * D) + (3 * j) * D; const float* sc = sh + D;
        f32x4 v[NR][4]; float ss[NR];
        if (from_inputs) { const float* x = (rm.is_ctx ? p.in[I_CTX] : p.in[I_X]) + rm.row0 * D;
#pragma unroll
            for (int rr = 0; rr < NR; ++rr)
#pragma unroll
                for (int i = 0; i < 4; ++i) v[rr][i] = *(const f32x4*)(x + rr * D + i * 256 + lane * 4);
        } else { const bf16_t* x = hbuf + (size_t)u * D;
#pragma unroll
            for (int rr = 0; rr < NR; ++rr)
#pragma unroll
                for (int i = 0; i < 4; ++i) { const u32x2 w = *(const u32x2*)(x + rr * D + i * 256 + lane * 4); v[rr][i] = (f32x4){bf_lo(w.x), bf_hi(w.x), bf_lo(w.y), bf_hi(w.y)}; }
        }
        f32x4 gm[4], s0[4];
#pragma unroll
        for (int i = 0; i < 4; ++i) { const int k = i * 256 + lane * 4; gm[i] = *(const f32x4*)(ng + k) * (*(const f32x4*)(sc + k) + 1.0f); s0[i] = *(const f32x4*)(sh + k); }
#pragma unroll
        for (int rr = 0; rr < NR; ++rr) { ss[rr] = 0.f;
#pragma unroll
            for (int i = 0; i < 4; ++i) ss[rr] += v[rr][i][0] * v[rr][i][0] + v[rr][i][1] * v[rr][i][1] + v[rr][i][2] * v[rr][i][2] + v[rr][i][3] * v[rr][i][3]; }
#pragma unroll
        for (int st = 1; st < 64; st <<= 1)
#pragma unroll
            for (int rr = 0; rr < NR; ++rr) ss[rr] += shx(ss[rr], st, lane);
#pragma unroll
        for (int rr = 0; rr < NR; ++rr) { const float rstd = rsqrtf(ss[rr] * (1.0f / D) + EPS);
#pragma unroll
            for (int i = 0; i < 4; ++i) { const int k = i * 256 + lane * 4;
                const f32x4 y = v[rr][i] * rstd * gm[i] + s0[i];
                u32x2 w; w.x = cvt_pk_bf16(y[0], y[1]); w.y = cvt_pk_bf16(y[2], y[3]);
                *(u32x2*)(A + (size_t)(u + rr) * D + k) = w; } }
    }
}

__device__ void phase_prep(const Params& p, int l, int hs, LAS unsigned char* lds) {
    const int THp = part_rows(hs), latN = part_lat(hs);
    const int tid = tid_opaque(), wid = tid >> 6, lane = tid & 63;
    bf16_t* P = (bf16_t*)(p.ws + WS_R1);
    bf16_t* VTL = (bf16_t*)(p.ws + WS_VTL); bf16_t* VTC = (bf16_t*)(p.ws + WS_VTC);
    const float* qg = p.in[I_QG] + l * 64; const float* kg = p.in[I_KG] + l * 64;
    LAS bf16_t* Vs = (LAS bf16_t*)lds;
    const LAS f32x2* rts = (const LAS f32x2*)(lds + 20480);
    __syncthreads();
    *(LAS u32x4*)(lds + 20480 + tid * 16) = *(const u32x4*)(p.ws + WS_ROPE + tid * 16);
    __syncthreads();
    const int c = lane & 7, seg = c >> 2, hf = (c >> 1) & 1, i0 = (c & 1) * 8;
    float gq[8], gk[8];
#pragma unroll
    for (int e = 0; e < 8; ++e) { gq[e] = qg[8 * c + e]; gk[e] = kg[8 * c + e]; }
    for (int it = bid_opaque(); it < THp / 64; it += gridDim.x) {
        const int v0 = it * 64; const bool lat = v0 < latN;
        const int prow = (v0 & (SEQ - 1)) >> 6;
        bf16_t* rowb = P + (size_t)(v0 + wid * 8) * PROJ;
        const int qoff = OFF_Q + (lane >> 3) * 64 + 8 * c, koff = OFF_K + ((lane >> 3) & 1) * 64 + 8 * c;
        u32x4 qr[8], kr[8]; unsigned vr[8];
#pragma unroll
        for (int i = 0; i < 8; ++i) { const bf16_t* rp = rowb + (size_t)i * PROJ; qr[i] = *(const u32x4*)(rp + qoff); kr[i] = *(const u32x4*)(rp + koff); vr[i] = *(const unsigned*)(rp + OFF_V + 2 * lane); }
#pragma unroll
        for (int i = 0; i < 8; ++i) {
            const int rl = wid * 8 + i;
            bf16_t* rowp = rowb + (size_t)i * PROJ;
            const int pp = seg ? rl : prow;
            float cs[8], sn[8];
#pragma unroll
            for (int e = 0; e < 8; ++e) { const f32x2 t2 = rts[pp * 16 + i0 + e]; cs[e] = lat ? t2[0] : 1.0f; sn[e] = lat ? t2[1] : 0.0f; }
            { float x[8]; unpack8(qr[i], x);
              float ss = 0.f;
#pragma unroll
              for (int e = 0; e < 8; ++e) ss += x[e] * x[e];
              ss += shx(ss, 1, lane); ss += shx(ss, 2, lane); ss += shx(ss, 4, lane);
              const float rstd = rsqrtf(ss * (1.0f / 64) + EPS); float o[8];
#pragma unroll
              for (int e = 0; e < 8; ++e) { const float y = x[e] * rstd * gq[e]; const float yp = shx(y, 2, lane);
                  o[e] = (hf ? (y * cs[e] + yp * sn[e]) : (y * cs[e] - yp * sn[e])) * (0.125f * LOG2E); }
              *(u32x4*)(rowp + qoff) = pack8(o); }
            { float x[8]; unpack8(kr[i], x);
              float ss = 0.f;
#pragma unroll
              for (int e = 0; e < 8; ++e) ss += x[e] * x[e];
              ss += shx(ss, 1, lane); ss += shx(ss, 2, lane); ss += shx(ss, 4, lane);
              const float rstd = rsqrtf(ss * (1.0f / 64) + EPS); float o[8];
#pragma unroll
              for (int e = 0; e < 8; ++e) { const float y = x[e] * rstd * gk[e]; const float yp = shx(y, 2, lane);
                  o[e] = hf ? (y * cs[e] + yp * sn[e]) : (y * cs[e] - yp * sn[e]); }
              if (lane < 16) *(u32x4*)(rowp + koff) = pack8(o); }
            { const unsigned w = vr[i];
              Vs[(2 * lane) * 72 + rl] = (bf16_t)(w & 0xffffu); Vs[(2 * lane + 1) * 72 + rl] = (bf16_t)(w >> 16); }
        }
        __syncthreads();
        { const int hd = tid >> 2, ch = tid & 3;
          bf16_t* dst;
          if (lat) { const int bl = v0 >> 11, pos0 = v0 & (SEQ - 1); dst = VTL + ((size_t)bl * 128 + hd) * SEQ + pos0 + ch * 16; }
          else { const int cv = v0 - latN, bl = cv >> 8, pos0 = cv & 255; dst = VTC + ((size_t)bl * 128 + hd) * CTXL + pos0 + ch * 16; }
          const u32x4 a = *(const LAS u32x4*)(Vs + hd * 72 + ch * 16), b = *(const LAS u32x4*)(Vs + hd * 72 + ch * 16 + 8);
          *(u32x4*)dst = a; *(u32x4*)(dst + 8) = b; }
        __syncthreads();
    }
}

struct KeySeg { const bf16_t* K; const bf16_t* Vt; int vstride; int ntiles; int mask; };

__device__ __forceinline__ void attn_item(const Params& p, int l, int hs, int idx) {
    const int tid = tid_opaque(), wid = tid >> 6, lane = tid & 63, fr = lane & 15, fq = lane >> 4;
    const bf16_t* P = (const bf16_t*)(p.ws + WS_R1);
    const bf16_t* VTL = (const bf16_t*)(p.ws + WS_VTL); const bf16_t* VTC = (const bf16_t*)(p.ws + WS_VTC);
    bf16_t* Y = (bf16_t*)(p.ws + WS_A) + (size_t)part_u0(hs) * D;
    const int latN = part_lat(hs), nli = part_nb(hs) * 32;
    int bl, qb, hk; bool lat;
    if (idx < nli) { lat = true; bl = idx >> 5; qb = (idx >> 1) & 15; hk = idx & 1; }
    else { const int j = idx - nli; lat = false; bl = j >> 2; qb = (j >> 1) & 1; hk = j & 1; }
    const int g = wid >> 1, r0 = (wid & 1) * 64, head = hk * 4 + g;
    const int qrow0 = lat ? bl * SEQ + qb * 128 : latN + bl * CTXL + qb * 128;
    const int crow0 = latN + bl * CTXL;
    const bf16_t* vtc = VTC + ((size_t)bl * 2 + hk) * 64 * CTXL;
    const bf16_t* vtl = VTL + ((size_t)bl * 2 + hk) * 64 * SEQ;
    bf16x8 qf[4][2];
    { const bf16_t* qp = P + (size_t)(qrow0 + r0 + fr) * PROJ + OFF_Q + head * 64 + fq * 8;
#pragma unroll
      for (int nq = 0; nq < 4; ++nq)
#pragma unroll
          for (int ks = 0; ks < 2; ++ks) qf[nq][ks] = *(const bf16x8*)(qp + (size_t)nq * 16 * PROJ + ks * 32); }
    f32x4 o[4][4];
#pragma unroll
    for (int a = 0; a < 4; ++a)
#pragma unroll
        for (int b = 0; b < 4; ++b) o[a][b] = (f32x4){0.f, 0.f, 0.f, 0.f};
    const float snk = p.in[I_SINK][l * 8 + head] * LOG2E;
    float mrun[4], lrun[4];
#pragma unroll
    for (int nq = 0; nq < 4; ++nq) { mrun[nq] = snk; lrun[nq] = (fq == 0) ? 1.0f : 0.0f; }

    int lo = 0, nb = 0;
    if (lat) { lo = (qb == 0) ? 4 : (r0 >> 5); const int hi = (qb == 15) ? 8 : (r0 == 0 ? 10 : 12); nb = hi - lo; }
    const int ntot = nb + 8;
    const bf16_t* kband = P + (ptrdiff_t)(bl * SEQ + (qb - 1) * 128) * PROJ + OFF_K + hk * 64 + (size_t)fr * PROJ + fq * 8;
    const bf16_t* kctx = P + (size_t)crow0 * PROJ + OFF_K + hk * 64 + (size_t)fr * PROJ + fq * 8;
    const bf16_t* vband = vtl + (ptrdiff_t)((qb - 1) * 128) + (size_t)fr * SEQ + fq * 4;
    const bf16_t* vctx = vtc + (size_t)fr * CTXL + fq * 4;
    bf16x8 kf[2][2]; bf16x4 vlo[4], vhi[4];
#define ATT_LOAD(i_, KF, VLO, VHI) do { const int _i = (i_); const bool _b = _i < nb; \
        const bf16_t* _kp = _b ? kband + (size_t)(lo + _i) * 32 * PROJ : kctx + (size_t)(_i - nb) * 32 * PROJ; \
        const bf16_t* _vp = _b ? vband + (lo + _i) * 32 : vctx + (_i - nb) * 32; const int _vs = _b ? SEQ : CTXL; \
        _Pragma("unroll") for (int kb = 0; kb < 2; ++kb) _Pragma("unroll") for (int ks = 0; ks < 2; ++ks) KF[kb][ks] = *(const bf16x8*)(_kp + (size_t)kb * 16 * PROJ + ks * 32); \
        _Pragma("unroll") for (int db = 0; db < 4; ++db) { VLO[db] = *(const bf16x4*)(_vp + (size_t)db * 16 * _vs); VHI[db] = *(const bf16x4*)(_vp + (size_t)db * 16 * _vs + 16); } } while (0)
    ATT_LOAD(0, kf, vlo, vhi);
    for (int i = 0; i < ntot; ++i) {
        bf16x8 kfn[2][2]; bf16x4 vlon[4], vhin[4];
        const int inx = (i + 1 < ntot) ? i + 1 : i;
        ATT_LOAD(inx, kfn, vlon, vhin);
        {
            const int bt = lo + i;
            const bool mask = (i < nb) && (bt < 4 || bt >= 8);
            f32x4 s[2][4];
#pragma unroll
            for (int kb = 0; kb < 2; ++kb)
#pragma unroll
                for (int nq = 0; nq < 4; ++nq) {
                    s[kb][nq] = __builtin_amdgcn_mfma_f32_16x16x32_bf16(kf[kb][0], qf[nq][0], (f32x4){0.f, 0.f, 0.f, 0.f}, 0, 0, 0);
                    s[kb][nq] = __builtin_amdgcn_mfma_f32_16x16x32_bf16(kf[kb][1], qf[nq][1], s[kb][nq], 0, 0, 0);
                }
            if (mask) {
#pragma unroll
                for (int kb = 0; kb < 2; ++kb)
#pragma unroll
                    for (int nq = 0; nq < 4; ++nq)
#pragma unroll
                        for (int j = 0; j < 4; ++j) { const int dlt = (bt * 32 - 128 + kb * 16 + fq * 4 + j) - (r0 + nq * 16 + fr);
                            if (dlt > 128 || dlt < -128) s[kb][nq][j] = -1e30f; }
            }
            bf16x8 pf[4];
#pragma unroll
            for (int nq = 0; nq < 4; ++nq) {
                float mx = fmaxf(fmaxf(fmaxf(s[0][nq][0], s[0][nq][1]), fmaxf(s[0][nq][2], s[0][nq][3])), fmaxf(fmaxf(s[1][nq][0], s[1][nq][1]), fmaxf(s[1][nq][2], s[1][nq][3])));
                mx = fmaxf(mx, shx(mx, 16, lane)); mx = fmaxf(mx, shx(mx, 32, lane));
                const float mn = fmaxf(mrun[nq], mx), alpha = fast_exp2(mrun[nq] - mn); mrun[nq] = mn;
                float pv[8], ps = 0.f;
#pragma unroll
                for (int j = 0; j < 4; ++j) { pv[j] = fast_exp2(s[0][nq][j] - mn); pv[4 + j] = fast_exp2(s[1][nq][j] - mn); ps += pv[j] + pv[4 + j]; }
                lrun[nq] = lrun[nq] * alpha + ps;
                const u32x4 w = pack8(pv); pf[nq] = *(const bf16x8*)&w;
#pragma unroll
                for (int db = 0; db < 4; ++db) o[db][nq] *= alpha;
            }
#pragma unroll
            for (int db = 0; db < 4; ++db) { const bf16x8 vf = (bf16x8){vlo[db][0], vlo[db][1], vlo[db][2], vlo[db][3], vhi[db][0], vhi[db][1], vhi[db][2], vhi[db][3]};
#pragma unroll
                for (int nq = 0; nq < 4; ++nq) o[db][nq] = __builtin_amdgcn_mfma_f32_16x16x32_bf16(vf, pf[nq], o[db][nq], 0, 0, 0); }
        }
#pragma unroll
        for (int kb = 0; kb < 2; ++kb)
#pragma unroll
            for (int ks = 0; ks < 2; ++ks) kf[kb][ks] = kfn[kb][ks];
#pragma unroll
        for (int db = 0; db < 4; ++db) { vlo[db] = vlon[db]; vhi[db] = vhin[db]; }
    }
#undef ATT_LOAD
#pragma unroll
    for (int nq = 0; nq < 4; ++nq) {
        float lt = lrun[nq]; lt += shx(lt, 16, lane); lt += shx(lt, 32, lane);
        const float inv = 1.0f / lt;
        bf16_t* yp = Y + (size_t)(qrow0 + r0 + nq * 16 + fr) * D + 512 + head * 64 + fq * 4;
#pragma unroll
        for (int db = 0; db < 4; ++db) { u32x2 w; w.x = cvt_pk_bf16(o[db][nq][0] * inv, o[db][nq][1] * inv); w.y = cvt_pk_bf16(o[db][nq][2] * inv, o[db][nq][3] * inv);
            *(u32x2*)(yp + db * 16) = w; }
    }
}

__device__ __forceinline__ void gmlp_conv_item(const Params& p, int l, int hs, int chunk, LAS unsigned char* lds) {
    const int tid = tid_opaque(), wid = tid >> 6, lane = tid & 63, fr = lane & 15, fq = lane >> 4;
    const bf16_t* P = (const bf16_t*)(p.ws + WS_R1);
    bf16_t* Y = (bf16_t*)(p.ws + WS_A) + (size_t)part_u0(hs) * D;
    const int v0 = chunk * 128, latN = part_lat(hs);
    LAS bf16_t* vT = (LAS bf16_t*)lds;
    { const float* cw = p.in[I_CONVW] + (size_t)l * 3 * 256;
      const bool lat = v0 < latN;
#pragma unroll 2
      for (int i = 0; i < 8; ++i) {
          const int id = i * 512 + tid, pt = id >> 5, cc = (id & 31) * 8, v = v0 + pt;
          const int pos = lat ? (v & (SEQ - 1)) : ((v - latN) & (CTXL - 1)), n = lat ? SEQ : CTXL;
          const bf16_t* rp = P + (size_t)v * PROJ + cc;
          float bv[8], c1[8], h1[8], acc[8];
          unpack8(*(const u32x4*)(rp + OFF_CB), bv); unpack8(*(const u32x4*)(rp + OFF_CC), c1); unpack8(*(const u32x4*)(rp + OFF_CH), h1);
          { const f32x4 wa = *(const f32x4*)(cw + 256 + cc), wb = *(const f32x4*)(cw + 256 + cc + 4);
#pragma unroll
            for (int e = 0; e < 8; ++e) acc[e] = c1[e] * h1[e] * (e < 4 ? wa[e & 3] : wb[e & 3]); }
          if (pos > 0) { float c0[8], h0[8]; unpack8(*(const u32x4*)(rp - PROJ + OFF_CC), c0); unpack8(*(const u32x4*)(rp - PROJ + OFF_CH), h0);
              const f32x4 wa = *(const f32x4*)(cw + cc), wb = *(const f32x4*)(cw + cc + 4);
#pragma unroll
              for (int e = 0; e < 8; ++e) acc[e] += c0[e] * h0[e] * (e < 4 ? wa[e & 3] : wb[e & 3]); }
          if (pos < n - 1) { float c2[8], h2[8]; unpack8(*(const u32x4*)(rp + PROJ + OFF_CC), c2); unpack8(*(const u32x4*)(rp + PROJ + OFF_CH), h2);
              const f32x4 wa = *(const f32x4*)(cw + 512 + cc), wb = *(const f32x4*)(cw + 512 + cc + 4);
#pragma unroll
              for (int e = 0; e < 8; ++e) acc[e] += c2[e] * h2[e] * (e < 4 ? wa[e & 3] : wb[e & 3]); }
#pragma unroll
          for (int e = 0; e < 8; ++e) acc[e] *= bv[e];
          *(u32x4*)(Y + (size_t)v * D + cc) = pack8(acc);
      } }
    { const float* lg = p.in[I_LNG] + l * 256 + 4 * lane; const float* lb = p.in[I_LNB] + l * 256 + 4 * lane;
      const f32x4 g4 = *(const f32x4*)lg, b4 = *(const f32x4*)lb;
#pragma unroll
      for (int hb = 0; hb < 2; ++hb) {
          u32x2 w[8]; float x[8][4], sm[8], qv[8];
#pragma unroll
          for (int i = 0; i < 8; ++i) w[i] = *(const u32x2*)(P + (size_t)(v0 + wid * 16 + hb * 8 + i) * PROJ + OFF_GV + 4 * lane);
#pragma unroll
          for (int i = 0; i < 8; ++i) { x[i][0] = gelu_tanh(bf_lo(w[i].x)); x[i][1] = gelu_tanh(bf_hi(w[i].x)); x[i][2] = gelu_tanh(bf_lo(w[i].y)); x[i][3] = gelu_tanh(bf_hi(w[i].y));
              sm[i] = (x[i][0] + x[i][1]) + (x[i][2] + x[i][3]); }
#pragma unroll
          for (int st = 1; st < 64; st <<= 1)
#pragma unroll
              for (int i = 0; i < 8; ++i) sm[i] += shx(sm[i], st, lane);
#pragma unroll
          for (int i = 0; i < 8; ++i) { const float mu = sm[i] * (1.0f / 256); float q = 0.f;
#pragma unroll
              for (int e = 0; e < 4; ++e) { x[i][e] -= mu; q += x[i][e] * x[i][e]; }
              qv[i] = q; }
#pragma unroll
          for (int st = 1; st < 64; st <<= 1)
#pragma unroll
              for (int i = 0; i < 8; ++i) qv[i] += shx(qv[i], st, lane);
#pragma unroll
          for (int i = 0; i < 8; ++i) { const float rstd = rsqrtf(qv[i] * (1.0f / 256) + EPS); const int pt = wid * 16 + hb * 8 + i;
#pragma unroll
              for (int e = 0; e < 4; ++e) { const float y = x[i][e] * rstd * g4[e] + b4[e]; vT[(4 * lane + e) * 136 + pt] = (bf16_t)(cvt_pk_bf16(y, 0.f) & 0xffffu); } }
      } }
    __syncthreads();
    { const int g = wid >> 1, ph = wid & 1;
      const bf16_t* wsb = (const bf16_t*)(p.ws + WS_WT) + (size_t)l * W_LAYER + W_GWS + (size_t)g * 128 * 128;
      f32x4 acc[4][4];
#pragma unroll
      for (int a = 0; a < 4; ++a)
#pragma unroll
          for (int b = 0; b < 4; ++b) acc[a][b] = (f32x4){0.f, 0.f, 0.f, 0.f};
#pragma unroll
      for (int kk = 0; kk < 4; ++kk) {
          bf16x8 af[4], bfr[4];
#pragma unroll
          for (int db = 0; db < 4; ++db) af[db] = *(const LAS bf16x8*)(vT + (g * 64 + db * 16 + fr) * 136 + kk * 32 + fq * 8);
#pragma unroll
          for (int pb = 0; pb < 4; ++pb) bfr[pb] = *(const bf16x8*)(wsb + (size_t)((ph * 4 + pb) * 16 + fr) * 128 + kk * 32 + fq * 8);
#pragma unroll
          for (int db = 0; db < 4; ++db)
#pragma unroll
              for (int pb = 0; pb < 4; ++pb) acc[db][pb] = __builtin_amdgcn_mfma_f32_16x16x32_bf16(af[db], bfr[pb], acc[db][pb], 0, 0, 0);
      }
      const float* bs = p.in[I_GBS] + (size_t)l * 512 + g * 128;
      u32x2 uw[4][4]; float bias[4];
#pragma unroll
      for (int pb = 0; pb < 4; ++pb) { const int pt = (ph * 4 + pb) * 16 + fr; bias[pb] = bs[pt];
          const bf16_t* up = P + (size_t)(v0 + pt) * PROJ + OFF_GU + g * 64 + fq * 4;
#pragma unroll
          for (int db = 0; db < 4; ++db) uw[pb][db] = *(const u32x2*)(up + db * 16); }
#pragma unroll
      for (int pb = 0; pb < 4; ++pb) { const int pt = (ph * 4 + pb) * 16 + fr;
          bf16_t* yp = Y + (size_t)(v0 + pt) * D + 256 + g * 64 + fq * 4;
#pragma unroll
          for (int db = 0; db < 4; ++db) { const u32x2 w = uw[pb][db];
              const float y0 = gelu_tanh(bf_lo(w.x)) * (acc[db][pb][0] + bias[pb]), y1 = gelu_tanh(bf_hi(w.x)) * (acc[db][pb][1] + bias[pb]);
              const float y2 = gelu_tanh(bf_lo(w.y)) * (acc[db][pb][2] + bias[pb]), y3 = gelu_tanh(bf_hi(w.y)) * (acc[db][pb][3] + bias[pb]);
              u32x2 ov; ov.x = cvt_pk_bf16(y0, y1); ov.y = cvt_pk_bf16(y2, y3); *(u32x2*)(yp + db * 16) = ov; } } }
    __syncthreads();
}

__device__ void phase_mixers(const Params& p, int l, int hs, LAS unsigned char* lds, bool skip_ctx) {
    const int n_attn = part_nb(hs) * (skip_ctx ? 32 : 36), n_gmlp = (skip_ctx ? part_lat(hs) : part_rows(hs)) / 128;
#ifndef SKIP_ATTN
    for (int it = bid_opaque(); it < n_attn; it += gridDim.x) attn_item(p, l, hs, it);
#endif
    __builtin_amdgcn_sched_barrier(0);
#ifndef SKIP_GMLP
    { const int G = (int)gridDim.x; int n3 = n_attn - 2 * G; n3 = n3 < 0 ? 0 : n3 % G;
      for (int it = (bid_opaque() - n3 + G) % G; it < n_gmlp; it += G) gmlp_conv_item(p, l, hs, it, lds); }
#endif
}

#define XB_TMO      128
#define XB_XCNT(j)  (256  + 64 * (j))
#define XB_XSUB(j)  (1280 + 64 * (j))
#define XB_XGEN(j)  (2304 + 64 * (j))
#define XB_TOP      3328
#define XB_TOPGEN   3392
#define XCD_BAR_WORDS 3456
#define XB_SPIN_CAP (1u << 22)
__device__ __forceinline__ unsigned xb_ld(unsigned* p)              { return __hip_atomic_load(p, __ATOMIC_RELAXED, __HIP_MEMORY_SCOPE_AGENT); }
__device__ __forceinline__ unsigned xb_add(unsigned* p, unsigned v) { return __hip_atomic_fetch_add(p, v, __ATOMIC_RELAXED, __HIP_MEMORY_SCOPE_AGENT); }
__device__ __forceinline__ unsigned xb_xcc_id() { return (unsigned)__builtin_amdgcn_s_getreg((3 << 11) | 20) & 0xFu; }
#define XB_SPIN(cond, bar) do { unsigned _sp = 0; while (cond) { __builtin_amdgcn_s_sleep(1); \
    if ((++_sp & 255u) == 0u) { if (xb_ld(&(bar)[XB_TMO])) break; if (_sp > XB_SPIN_CAP) { atomicAdd(&(bar)[XB_TMO], 1u); break; } } } } while (0)
__device__ __forceinline__ void xcd_barrier_post(unsigned* bar) { if (threadIdx.x == 0) (void)xb_add(&bar[XB_XCNT(xb_xcc_id())], 1u); }
__device__ __forceinline__ void xcd_barrier_complete(unsigned* bar, unsigned x, unsigned& nloc, unsigned& nx) {
    const unsigned G = gridDim.x * gridDim.y * gridDim.z;
    unsigned sum, cnt, mine, sp = 0u;
    for (;;) {
        sum = 0u; cnt = 0u; mine = 0u;
#pragma unroll
        for (unsigned j = 0; j < 16; ++j) { const unsigned c = xb_ld(&bar[XB_XCNT(j)]); sum += c; cnt += (c > 0u) ? 1u : 0u; mine = (j == x) ? c : mine; }
        if (sum == G) break;
        __builtin_amdgcn_s_sleep(1);
        if ((++sp & 255u) == 0u) { if (xb_ld(&bar[XB_TMO])) break; if (sp > XB_SPIN_CAP) { atomicAdd(&bar[XB_TMO], 1u); break; } }
    }
    nloc = mine > 0u ? mine : 1u; nx = cnt > 0u ? cnt : 1u;
}
__device__ __forceinline__ void xcd_barrier(unsigned* bar, volatile LAS unsigned* st) {
    asm volatile("s_waitcnt vmcnt(0)" ::: "memory");
    __syncthreads();
    if (threadIdx.x == 0) {
        const unsigned x = xb_xcc_id();
        __builtin_amdgcn_s_waitcnt(0);
        unsigned nloc = st[0], nx = st[1];
        if (nloc == 0u) { xcd_barrier_complete(bar, x, nloc, nx); st[0] = nloc; st[1] = nx; }
        const unsigned old = xb_add(&bar[XB_XSUB(x)], 1u);
        const unsigned gen = old / nloc;
        if (old + 1u == (gen + 1u) * nloc) {
            __builtin_amdgcn_fence(__ATOMIC_RELEASE, "agent");
            asm volatile("s_waitcnt vmcnt(0)" ::: "memory");
            const unsigned og = xb_add(&bar[XB_TOP], 1u);
            const unsigned tg = og / nx;
            if (og + 1u == (tg + 1u) * nx) xb_add(&bar[XB_TOPGEN], 1u);
            else XB_SPIN(xb_ld(&bar[XB_TOPGEN]) == tg, bar);
            __builtin_amdgcn_fence(__ATOMIC_ACQUIRE, "agent");
            xb_add(&bar[XB_XGEN(x)], 1u);
            asm volatile("s_waitcnt vmcnt(0)" ::: "memory");
        } else {
            XB_SPIN(xb_ld(&bar[XB_XGEN(x)]) == gen, bar);
            __builtin_amdgcn_fence(__ATOMIC_ACQUIRE, "agent");
            asm volatile("s_waitcnt vmcnt(0)" ::: "memory");
        }
    }
    __syncthreads();
}

__device__ void run_phase(const Params& p, int ph, LAS unsigned char* lds) {
    if (ph == 0) {
#ifndef SKIP_SETUP
 phase_setup(p, lds);
#endif
 return; }
    const int q = ph - 1, l = q / 17, r = q % 17;
    const bf16_t* W = (const bf16_t*)(p.ws + WS_WT) + (size_t)l * W_LAYER;
    const float* MOD = (const float*)(p.ws + WS_MOD) + (size_t)l * 33 * (NMOD * D);
    bf16_t* HB = (bf16_t*)(p.ws + WS_H);
    const bool first = (l == 0 && r <= 2);
    const bool lastl = (l == NL - 1);
    bf16_t* A = (bf16_t*)(p.ws + WS_A); bf16_t* R1 = (bf16_t*)(p.ws + WS_R1);
    if (r == 0 || r == 3 || r == 14) {
#ifndef SKIP_NORM
 phase_norm(p, l, r == 0 ? 0 : (r == 3 ? 1 : 2), first, lastl && r == 14);
#endif
 return; }
    if (r == 1 || r == 15) {
        const int j = (r == 1) ? 0 : 1;
        const int sk = (lastl && j == 1) ? 1 : 0;
        pg8::Gemm g{A, D, W + (j ? W_FIN1 : W_FIN0), D, sk ? T_LAT : T_ALL, 2 * DFF, D, sk};
        pg8::EpiSwiglu E{R1};
#ifndef SKIP_UP
        pg8::gemm_phase(lds, g, E);
#endif
        return;
    }
    if (r == 2 || r == 16) {
        const int j = (r == 2) ? 0 : 1;
        const int sk = (lastl && j == 1) ? 1 : 0;
        pg8::Gemm g{R1, DFF, W + (j ? W_FOUT1 : W_FOUT0), DFF, sk ? T_LAT : T_ALL, D, DFF, sk};
        pg8::EpiResid E{p.in[I_X], p.in[I_CTX], HB, p.out, MOD, j ? 8 : 2, 0.5f, 0, first ? 0 : ((l == NL - 1 && r == 16) ? 2 : 1)};
#ifndef SKIP_DOWN
        pg8::gemm_phase(lds, g, E);
#endif
        return;
    }
    const int hs = (r - 4) / 5, rr = (r - 4) % 5;
    if (rr == 0) { pg8::Gemm g{A + (size_t)part_u0(hs) * D, D, W + W_WIN, D, part_rows(hs), PROJ, D, 0}; pg8::EpiBf16 E{R1, PROJ, p.in[I_BGATE] + (size_t)l * 3 * D, OFF_GATE};
#ifndef SKIP_PROJ
 pg8::gemm_phase(lds, g, E);
#endif
 return; }
    if (rr == 1) {
#ifndef SKIP_PREP
 phase_prep(p, l, hs, lds);
#endif
 return; }
    if (rr == 2) {
#ifndef SKIP_MIX
 phase_mixers(p, l, hs, lds, lastl);
#endif
 return; }
    if (rr == 3) { pg8::Gemm g{A + (size_t)part_u0(hs) * D, D, W + W_WB, D, lastl ? part_lat(hs) : part_rows(hs), D, D, 0}; pg8::EpiBranch E{R1};
#ifndef SKIP_BRANCH
 pg8::gemm_phase(lds, g, E);
#endif
 return; }
    { pg8::Gemm g{R1, PROJ, W + W_WO, D, lastl ? part_lat(hs) : part_rows(hs), D, D, 0}; pg8::EpiResid E{p.in[I_X], p.in[I_CTX], HB, p.out, MOD, 5, 1.0f, part_u0(hs) / 256, 1};
#ifndef SKIP_OUT
 pg8::gemm_phase(lds, g, E);
#endif
 }
}

__global__ __launch_bounds__(512, 2) void fwd_megakernel(Params p) {
    extern __shared__ __attribute__((aligned(16))) unsigned char shm[];
    LAS unsigned char* lds = (LAS unsigned char*)shm;
#if MK_SINGLE
    volatile LAS unsigned* bst = (volatile LAS unsigned*)(lds + LDS_BYTES - 16);
    if (threadIdx.x == 0) { bst[0] = 0u; bst[1] = 0u; }
    __syncthreads();
    xcd_barrier_post((unsigned*)(p.ws + WS_BAR));
#endif
    for (int ph = p.ph_lo; ph < p.ph_hi; ++ph) {
#if defined(__HIP_DEVICE_COMPILE__)
        const __attribute__((address_space(4))) char* kp = (const __attribute__((address_space(4))) char*)__builtin_amdgcn_kernarg_segment_ptr();
        asm volatile("" : "+s"(kp));
        const Params lp = *(const Params*)(const char*)kp;
#else
        const Params lp = p;
#endif
        run_phase(lp, ph, lds);
#if MK_SINGLE
        if (ph + 1 < lp.ph_hi) {
            if (ph == 0) cg::this_grid().sync();
            else xcd_barrier((unsigned*)(lp.ws + WS_BAR), (volatile LAS unsigned*)(lds + LDS_BYTES - 16));
        }
#endif
    }
}

extern "C" void kernel_launch(void* const* d_in, const int* in_sizes, int n_in, void* d_out, int out_size, void* d_ws, size_t ws_size, hipStream_t stream) {
    static int grid = 0;
    if (grid == 0) {
        if (n_in != N_IN || out_size != T_LAT * D || ws_size < WS_END) { fprintf(stderr, "kernel_launch: unexpected shapes (n_in %d out %d ws %zu need %zu)\n", n_in, out_size, ws_size, (size_t)WS_END); grid = -1; return; }
        int dev = 0, cus = 0, per_cu = 0;
        (void)hipGetDevice(&dev); (void)hipDeviceGetAttribute(&cus, hipDeviceAttributeMultiprocessorCount, dev);
        if (hipFuncSetAttribute((const void*)fwd_megakernel, hipFuncAttributeMaxDynamicSharedMemorySize, LDS_BYTES) != hipSuccess) { fprintf(stderr, "kernel_launch: hipFuncSetAttribute failed\n"); grid = -1; return; }
        if (hipOccupancyMaxActiveBlocksPerMultiprocessor(&per_cu, (const void*)fwd_megakernel, 512, LDS_BYTES) != hipSuccess || per_cu < 1) { fprintf(stderr, "kernel_launch: occupancy query gave %d\n", per_cu); per_cu = 1; }
        (void)hipGetLastError();
        grid = cus * per_cu;
    }
    if (grid < 0) return;
    Params p{};
    for (int i = 0; i < N_IN; ++i) p.in[i] = (const float*)d_in[i];
    p.out = (float*)d_out; p.ws = (unsigned char*)d_ws;
#if MK_SINGLE
    p.ph_lo = 0; p.ph_hi = N_PHASES;
    if (hipMemsetAsync((char*)d_ws + WS_BAR, 0, 16384, stream) != hipSuccess) { fprintf(stderr, "kernel_launch: memset of the barrier words failed\n"); return; }
    void* args[] = {&p};
    hipError_t e = hipLaunchCooperativeKernel((const void*)fwd_megakernel, dim3(grid), dim3(512), args, LDS_BYTES, stream);
    if (e != hipSuccess) fprintf(stderr, "cooperative launch failed: %s (grid %d)\n", hipGetErrorString(e), grid);
#else
    for (int ph = 0; ph < N_PHASES; ++ph) {
        p.ph_lo = ph; p.ph_hi = ph + 1;
        hipLaunchKernelGGL(fwd_megakernel, dim3(grid), dim3(512), LDS_BYTES, stream, p);
    }
#endif
}
```

```cpp
#include <hip/hip_runtime.h>
#include <hip/hip_cooperative_groups.h>
#include <cstdio>
namespace cg = cooperative_groups;

#ifndef MK_SINGLE
#define MK_SINGLE 1
#endif

#define LAS __attribute__((address_space(3)))
typedef unsigned short bf16_t;
typedef short bf16x8 __attribute__((ext_vector_type(8)));
typedef short bf16x4 __attribute__((ext_vector_type(4)));
typedef float f32x4 __attribute__((ext_vector_type(4)));
typedef unsigned u32x4 __attribute__((ext_vector_type(4)));
typedef unsigned u32x2 __attribute__((ext_vector_type(2)));
typedef float f32x2 __attribute__((ext_vector_type(2)));

constexpr int D = 1024, NB = 32, SEQ = 2048, NL = 4, CTXL = 256, DFF = 2816, PROJ = 5120, NMOD = 9;
constexpr int T_LAT = NB * SEQ, T_CTX = NB * CTXL, T_ALL = T_LAT + T_CTX;
constexpr int NB0 = 14, NB1 = NB - NB0;
constexpr int U1 = NB0 * (SEQ + CTXL);
constexpr int TH_MAX = NB1 * (SEQ + CTXL);
__host__ __device__ __forceinline__ constexpr int part_nb(int s) { return s ? NB1 : NB0; }
__host__ __device__ __forceinline__ constexpr int part_lat(int s) { return part_nb(s) * SEQ; }
__host__ __device__ __forceinline__ constexpr int part_rows(int s) { return part_nb(s) * (SEQ + CTXL); }
__host__ __device__ __forceinline__ constexpr int part_u0(int s) { return s ? U1 : 0; }
constexpr int OFF_CB = 0, OFF_CC = 256, OFF_CH = 512, OFF_GU = 768, OFF_GV = 1024, OFF_Q = 1280, OFF_K = 1792, OFF_V = 1920, OFF_GATE = 2048;
constexpr float EPS = 1e-6f;
constexpr float LOG2E = 1.4426950408889634f;

enum { I_X = 0, I_C, I_CTX, I_CCTX, I_WMOD, I_BMOD, I_NORMG, I_FFNIN, I_FFNOUT, I_WIN, I_BGATE, I_CONVW, I_LNG, I_LNB, I_GWS, I_GBS, I_QG, I_KG, I_SINK, I_WBC, I_WBG, I_WBA, I_WOUT, N_IN };

constexpr size_t W_FIN0 = 0, W_FIN1 = 5767168, W_FOUT0 = 11534336, W_FOUT1 = 14417920, W_WIN = 17301504, W_WB = 22544384, W_WO = 23592960, W_GWS = 24641536, W_LAYER = 24707072;
constexpr size_t WS_WT = 0;
constexpr size_t WS_MOD = WS_WT + NL * W_LAYER * 2;
constexpr size_t WS_ROPE = WS_MOD + (size_t)NL * 33 * 9216 * 4;
constexpr size_t WS_HC = WS_ROPE + 8192;
constexpr size_t WS_A = WS_HC + (size_t)T_CTX * D * 4;
constexpr size_t WS_R1 = WS_A + (size_t)T_ALL * D * 2;
constexpr size_t WS_VTL = WS_R1 + (size_t)TH_MAX * PROJ * 2;
constexpr size_t WS_VTC = WS_VTL + (size_t)NB1 * 2 * 64 * 2048 * 2;
constexpr size_t WS_BAR = WS_VTC + (size_t)NB1 * 2 * 64 * 256 * 2;
constexpr size_t WS_H = WS_BAR + 16384;
constexpr size_t WS_END = WS_H + (size_t)T_ALL * D * 2;

constexpr int LDS_BYTES = 143360;
constexpr int N_PHASES = 1 + 17 * NL;

struct Params {
    const float* in[N_IN];
    float* out;
    unsigned char* ws;
    int ph_lo, ph_hi;
};

__device__ __forceinline__ unsigned cvt_pk_bf16(float lo, float hi) { unsigned r; asm volatile("v_cvt_pk_bf16_f32 %0, %1, %2" : "=v"(r) : "v"(lo), "v"(hi)); return r; }
__device__ __forceinline__ int tid_opaque() { int t = threadIdx.x; asm volatile("" : "+v"(t)); return t; }
__device__ __forceinline__ int bid_opaque() { int b = blockIdx.x; asm volatile("" : "+s"(b)); return b; }
__device__ __forceinline__ float bf_lo(unsigned w) { return __uint_as_float(w << 16); }
__device__ __forceinline__ float bf_hi(unsigned w) { return __uint_as_float(w & 0xffff0000u); }
__device__ __forceinline__ float fast_rcp(float x) { return __builtin_amdgcn_rcpf(x); }
__device__ __forceinline__ float fast_exp2(float x) { return __builtin_amdgcn_exp2f(x); }
__device__ __forceinline__ float sigmoidf_(float x) { return fast_rcp(1.0f + fast_exp2(-x * LOG2E)); }
__device__ __forceinline__ float siluf_(float x) { return x * sigmoidf_(x); }
__device__ __forceinline__ float gelu_tanh(float x) { const float z = 0.7978845608028654f * (x + 0.044715f * x * x * x); return x * sigmoidf_(2.0f * z); }
__device__ __forceinline__ float shx(float v, int m, int lane) { return __int_as_float(__builtin_amdgcn_ds_bpermute((lane ^ m) << 2, __float_as_int(v))); }
__device__ __forceinline__ float wave_sum(float v, int lane) {
    v += shx(v, 1, lane); v += shx(v, 2, lane); v += shx(v, 4, lane); v += shx(v, 8, lane); v += shx(v, 16, lane); v += shx(v, 32, lane); return v;
}
__device__ __forceinline__ void unpack8(const u32x4 w, float (&f)[8]) {
    f[0] = bf_lo(w.x); f[1] = bf_hi(w.x); f[2] = bf_lo(w.y); f[3] = bf_hi(w.y); f[4] = bf_lo(w.z); f[5] = bf_hi(w.z); f[6] = bf_lo(w.w); f[7] = bf_hi(w.w);
}
__device__ __forceinline__ u32x4 pack8(const float (&f)[8]) {
    u32x4 w; w.x = cvt_pk_bf16(f[0], f[1]); w.y = cvt_pk_bf16(f[2], f[3]); w.z = cvt_pk_bf16(f[4], f[5]); w.w = cvt_pk_bf16(f[6], f[7]); return w;
}

struct RowMap { size_t row0; int is_ctx; int modrow; };
__device__ __forceinline__ RowMap map_row(int u) {
    const int s = (u >= U1) ? 1 : 0, v = u - s * U1, latN = part_lat(s); RowMap r;
    if (v < latN) { r.row0 = (size_t)(s ? NB0 * SEQ : 0) + v; r.is_ctx = 0; r.modrow = (int)(r.row0 >> 11); }
    else { r.row0 = (size_t)(s ? NB0 * CTXL : 0) + (v - latN); r.is_ctx = 1; r.modrow = 32; }
    return r;
}

namespace pg8 {
constexpr int BM = 256, BK = 64, HALF = 128, HTB = HALF * BK * 2, STAGE_BYTES = 8 * HTB, NXCD = 8, WGM = 8;
__device__ __forceinline__ int lds_byte(int r, int c) { const int st = (r >> 4) * 2 + (c >> 5), rr = r & 15, cc = c & 31, ob = rr * 64 + cc * 2; return st * 1024 + (ob ^ (((ob >> 9) & 1) << 5)); }
__device__ __forceinline__ void stage_rc(int b, int& R, int& C) { const int st = b / 1024, sb = b % 1024, swz = sb ^ (((sb >> 9) & 1) << 5); R = (st >> 1) * 16 + swz / 64; C = (st & 1) * 32 + (swz % 64) / 2; }
__device__ __forceinline__ int perm32(int rho) { const int n = rho >> 4, i = rho & 15; return 8 * (i >> 2) + 4 * n + (i & 3); }

struct Unit { int pm, pn; };
struct Gemm { const bf16_t* A; int lda; const bf16_t* Bt; int ldb; int M, N, K; int skip_ctx; };

struct StaticOrder {
    int nM, nN, nwg, G, c, skip;
    __device__ void init(int M, int N, int G_, int c_, int skip_) { nM = M / BM; nN = N / BM; nwg = nM * nN; G = G_; c = c_; skip = skip_; }
    __device__ bool next(int i, Unit& u) const {
        const long L = (long)i * G + c; if (L >= nwg) return false;
        int wgid = (int)L; { const int q = nwg / NXCD, r = nwg % NXCD, xcd = wgid % NXCD, off = wgid / NXCD; wgid = (xcd < r ? xcd * (q + 1) : r * (q + 1) + (xcd - r) * q) + off; }
        const int nig = WGM * nN, gid = wgid / nig, fm = gid * WGM, gsz = (nM - fm) < WGM ? (nM - fm) : WGM;
        u.pm = fm + ((wgid % nig) % gsz); u.pn = (wgid % nig) / gsz; if (skip && u.pm >= NB0 * 8) u.pm += NB0; return true;
    }
};

template <class Epi>
__device__ __forceinline__ void gemm_phase(LAS unsigned char* lds, const Gemm g, const Epi& E) {
    const int tid = tid_opaque(), wid = __builtin_amdgcn_readfirstlane(tid >> 6), lane = tid & 63, wr = wid >> 2, wc = wid & 3, fr = lane & 15, fq = lane >> 4;
    const int K = g.K, nt = K / BK;
    StaticOrder S; S.init(g.M, g.N, (int)gridDim.x, bid_opaque(), g.skip_ctx);
    unsigned voffA[2], voffB[2];
#pragma unroll
    for (int i = 0; i < 2; ++i) { int R, C; stage_rc(tid * 16 + i * 8192, R, C); const int Rb = Epi::PERM ? ((R & ~31) + perm32(R & 31)) : R;
        voffA[i] = (unsigned)(R * g.lda + C) * 2u; voffB[i] = (unsigned)(Rb * g.ldb + C) * 2u; }
    const size_t kstep = (size_t)(BK * 2);
    const size_t hstepA = (size_t)HALF * g.lda * 2, hstepB = (size_t)HALF * g.ldb * 2;
    const size_t tstepA = 2 * hstepA, tstepB = 2 * hstepB;
    const unsigned ldsw = (unsigned)wid * 1024u;
    const int aoff = lds_byte(wr * 64 + fr, fq * 8), boff = lds_byte(wc * 32 + fr, fq * 8);
#define PG8_SA(b, h) (((b) * 2 + (h)) * HTB)
#define PG8_SB(b, h) ((4 + (b) * 2 + (h)) * HTB)
#define PG8_STAGE(bufoff, gbase, voff) do { _Pragma("unroll") for (int _i = 0; _i < 2; ++_i) \
        __builtin_amdgcn_global_load_lds((const unsigned*)((const char*)(gbase) + (voff)[_i]), (LAS unsigned*)(lds + (bufoff) + ldsw + _i * 8192), 16, 0, 0); } while (0)
#define PG8_LDA(dst, b, h) do { _Pragma("unroll") for (int m = 0; m < 4; ++m) _Pragma("unroll") for (int k = 0; k < 2; ++k) dst[m][k] = *(const LAS bf16x8*)(lds + PG8_SA(b, h) + aoff + m * 2048 + k * 1024); } while (0)
#define PG8_LDB(dst, b, h) do { _Pragma("unroll") for (int n = 0; n < 2; ++n) _Pragma("unroll") for (int k = 0; k < 2; ++k) dst[n][k] = *(const LAS bf16x8*)(lds + PG8_SB(b, h) + boff + n * 2048 + k * 1024); } while (0)
#define PG8_MMA(ai, bj, At, Bt) do { __builtin_amdgcn_s_setprio(1); _Pragma("unroll") for (int m = 0; m < 4; ++m) _Pragma("unroll") for (int n = 0; n < 2; ++n) _Pragma("unroll") for (int k = 0; k < 2; ++k) \
        acc[ai][bj][m][n] = __builtin_amdgcn_mfma_f32_16x16x32_bf16(Bt[n][k], At[m][k], acc[ai][bj][m][n], 0, 0, 0); __builtin_amdgcn_s_setprio(0); } while (0)
#define PG8_WAIT_V(n) asm volatile("s_waitcnt vmcnt(" #n ")" ::: "memory")
#define PG8_WAIT_L(n) asm volatile("s_waitcnt lgkmcnt(" #n ")" ::: "memory")
#define PG8_BAR __builtin_amdgcn_s_barrier()
#define PG8_SCHED __builtin_amdgcn_sched_barrier(0)
#define PG8_KLOOP(TB, TE) for (int t = (TB); t < (TE); t += 2) { \
            const bool last = (t == nt - 2); \
            const char* a1 = cA + (size_t)(t + 1) * kstep; \
            const char* a2 = last ? nA : cA + (size_t)(t + 2) * kstep; const char* b2 = last ? nB : cB + (size_t)(t + 2) * kstep; \
            const char* a3 = a2 + kstep; const char* b3 = b2 + kstep; \
            PG8_LDB(B0, 0, 0); PG8_SCHED; PG8_LDA(At, 0, 0); PG8_STAGE(PG8_SA(1, 1), a1 + hstepA, voffA); \
            PG8_WAIT_L(8); PG8_BAR; PG8_WAIT_L(0); PG8_MMA(0, 0, At, B0); PG8_BAR; PG8_SCHED; \
            PG8_LDB(B1, 0, 1); PG8_STAGE(PG8_SB(0, 0), b2, voffB); \
            PG8_BAR; PG8_WAIT_L(0); PG8_MMA(0, 1, At, B1); PG8_BAR; \
            PG8_LDA(At, 0, 1); PG8_STAGE(PG8_SA(0, 0), a2, voffA); \
            PG8_BAR; PG8_WAIT_L(0); PG8_MMA(1, 0, At, B0); PG8_BAR; PG8_SCHED; \
            PG8_STAGE(PG8_SB(0, 1), b2 + hstepB, voffB); \
            PG8_WAIT_V(6); PG8_BAR; PG8_MMA(1, 1, At, B1); PG8_BAR; \
            PG8_LDB(B0, 1, 0); PG8_SCHED; PG8_LDA(At, 1, 0); PG8_STAGE(PG8_SA(0, 1), a2 + hstepA, voffA); \
            PG8_WAIT_L(8); PG8_BAR; PG8_WAIT_L(0); PG8_MMA(0, 0, At, B0); PG8_BAR; PG8_SCHED; \
            PG8_LDB(B1, 1, 1); PG8_STAGE(PG8_SB(1, 0), b3, voffB); \
            PG8_BAR; PG8_WAIT_L(0); PG8_MMA(0, 1, At, B1); PG8_BAR; \
            PG8_LDA(At, 1, 1); PG8_STAGE(PG8_SA(1, 0), a3, voffA); \
            PG8_BAR; PG8_WAIT_L(0); PG8_MMA(1, 0, At, B0); PG8_BAR; PG8_SCHED; \
            PG8_STAGE(PG8_SB(1, 1), b3 + hstepB, voffB); \
            PG8_WAIT_V(6); PG8_BAR; PG8_MMA(1, 1, At, B1); PG8_BAR; \
        }
    Unit cur, nxt; int ui = 0;
    if (!S.next(0, cur)) return;
    f32x4 acc[2][2][4][2];
#pragma unroll
    for (int a = 0; a < 2; ++a)
#pragma unroll
        for (int b = 0; b < 2; ++b)
#pragma unroll
            for (int m = 0; m < 4; ++m)
#pragma unroll
                for (int n = 0; n < 2; ++n) acc[a][b][m][n] = (f32x4){0.f, 0.f, 0.f, 0.f};
    bf16x8 At[4][2], B0[2][2], B1[2][2];
    const char* cA = (const char*)g.A + (size_t)cur.pm * tstepA; const char* cB = (const char*)g.Bt + (size_t)cur.pn * tstepB;
    PG8_STAGE(PG8_SB(0, 0), cB, voffB); PG8_STAGE(PG8_SA(0, 0), cA, voffA); PG8_STAGE(PG8_SB(0, 1), cB + hstepB, voffB); PG8_STAGE(PG8_SA(0, 1), cA + hstepA, voffA);
    if (wr == 1) PG8_BAR;
    PG8_WAIT_V(4); PG8_BAR;
    PG8_STAGE(PG8_SB(1, 0), cB + kstep, voffB); PG8_STAGE(PG8_SA(1, 0), cA + kstep, voffA); PG8_STAGE(PG8_SB(1, 1), cB + hstepB + kstep, voffB);
    PG8_WAIT_V(6); PG8_BAR;
    for (;;) {
        const bool has_next = S.next(ui + 1, nxt);
        const char* nA = has_next ? (const char*)g.A + (size_t)nxt.pm * tstepA : cA; const char* nB = has_next ? (const char*)g.Bt + (size_t)nxt.pn * tstepB : cB;
        if constexpr (Epi::MIDK) {
            PG8_KLOOP(0, 4)
            E.template mid<0>(acc, cur, wr, wc, fr, fq);
            PG8_KLOOP(4, 8)
            E.template mid<1>(acc, cur, wr, wc, fr, fq);
            PG8_KLOOP(8, nt)
        } else {
            PG8_KLOOP(0, nt)
        }
        E(acc, cur, wr, wc, fr, fq);
        if (!has_next) break;
#pragma unroll
        for (int a = 0; a < 2; ++a)
#pragma unroll
            for (int b = 0; b < 2; ++b)
#pragma unroll
                for (int m = 0; m < 4; ++m)
#pragma unroll
                    for (int n = 0; n < 2; ++n) acc[a][b][m][n] = (f32x4){0.f, 0.f, 0.f, 0.f};
        cur = nxt; cA = nA; cB = nB; ++ui;
    }
    PG8_WAIT_V(0);
    if (wr == 0) PG8_BAR;
    PG8_BAR;
#undef PG8_KLOOP
#undef PG8_SA
#undef PG8_SB
#undef PG8_STAGE
#undef PG8_LDA
#undef PG8_LDB
#undef PG8_MMA
#undef PG8_WAIT_V
#undef PG8_WAIT_L
#undef PG8_BAR
#undef PG8_SCHED
}

struct EpiSwiglu {
    static constexpr bool PERM = true, MIDK = false;
    bf16_t* O;
    __device__ __forceinline__ void operator()(const f32x4 (&acc)[2][2][4][2], const Unit& u, int wr, int wc, int fr, int fq) const {
        const int row0 = u.pm * BM + wr * 64 + fr, col0 = u.pn * 128 + wc * 32 + 8 * fq;
#pragma unroll
        for (int ai = 0; ai < 2; ++ai)
#pragma unroll
            for (int m = 0; m < 4; ++m) {
                float h[8];
#pragma unroll
                for (int n = 0; n < 2; ++n)
#pragma unroll
                    for (int j = 0; j < 4; ++j) h[n * 4 + j] = siluf_(acc[ai][0][m][n][j]) * acc[ai][1][m][n][j];
                *(u32x4*)(O + (size_t)(row0 + ai * HALF + m * 16) * DFF + col0) = pack8(h);
            }
    }
};
struct EpiBf16 {
    static constexpr bool PERM = true, MIDK = false;
    bf16_t* O; int ldc; const float* bias; int bias_col0;
    __device__ __forceinline__ void operator()(const f32x4 (&acc)[2][2][4][2], const Unit& u, int wr, int wc, int fr, int fq) const {
        const int row0 = u.pm * BM + wr * 64 + fr, col0 = u.pn * BM + wc * 32 + 8 * fq;
        const bool hb = (u.pn * BM >= bias_col0);
        f32x4 bv[2][2];
#pragma unroll
        for (int bj = 0; bj < 2; ++bj)
#pragma unroll
            for (int n = 0; n < 2; ++n) bv[bj][n] = hb ? *(const f32x4*)(bias + (col0 - bias_col0) + bj * HALF + 4 * n) : (f32x4){0.f, 0.f, 0.f, 0.f};
#pragma unroll
        for (int ai = 0; ai < 2; ++ai)
#pragma unroll
            for (int m = 0; m < 4; ++m) { bf16_t* rowp = O + (size_t)(row0 + ai * HALF + m * 16) * ldc + col0;
#pragma unroll
                for (int bj = 0; bj < 2; ++bj) { f32x4 v0 = acc[ai][bj][m][0] + bv[bj][0], v1 = acc[ai][bj][m][1] + bv[bj][1];
                    if (hb) {
#pragma unroll
                        for (int j = 0; j < 4; ++j) { v0[j] = 1.0f + fast_exp2(-fminf(fmaxf(v0[j], -30.f), 30.f) * LOG2E); v1[j] = 1.0f + fast_exp2(-fminf(fmaxf(v1[j], -30.f), 30.f) * LOG2E); } }
                    u32x4 w; w.x = cvt_pk_bf16(v0[0], v0[1]); w.y = cvt_pk_bf16(v0[2], v0[3]); w.z = cvt_pk_bf16(v1[0], v1[1]); w.w = cvt_pk_bf16(v1[2], v1[3]);
                    *(u32x4*)(rowp + bj * HALF) = w; } }
    }
};
struct EpiResid {
    static constexpr bool PERM = true, MIDK = false;
    const float* x_lat; const float* x_ctx; bf16_t* hbuf; float* out; const float* mod; int gate_idx; float gscale; int tile0; int mode;
    template <int MODE> __device__ __forceinline__ void body(const f32x4 (&acc)[2][2][4][2], const Unit& u, int wr, int wc, int fr, int fq) const {
        const int urow0 = (tile0 + u.pm) * BM;
        const RowMap rm = map_row(urow0);
        const float* gp = mod + (size_t)rm.modrow * (NMOD * D) + gate_idx * D;
        const int rloc = wr * 64 + fr, col0 = u.pn * BM + wc * 32 + 8 * fq;
        const float* xs = (rm.is_ctx ? x_ctx : x_lat) + rm.row0 * D + col0;
        bf16_t* hb = hbuf + (size_t)urow0 * D + col0;
        float* ob = out + rm.row0 * D + col0;
        const bool st_ok = (MODE != 2) || !rm.is_ctx;
        constexpr int MG = (MODE == 0) ? 2 : 4;
#pragma unroll
        for (int bj = 0; bj < 2; ++bj) {
            const f32x4 g0 = *(const f32x4*)(gp + col0 + bj * HALF) * gscale, g1 = *(const f32x4*)(gp + col0 + bj * HALF + 4) * gscale;
#pragma unroll
            for (int ai = 0; ai < 2; ++ai)
#pragma unroll
                for (int mg = 0; mg < 4; mg += MG) {
                    f32x4 xf[MODE == 0 ? MG : 1][2]; u32x4 xw[MODE == 0 ? 1 : MG];
#pragma unroll
                    for (int mm = 0; mm < MG; ++mm) { const size_t ro = (size_t)(rloc + ai * HALF + (mg + mm) * 16) * D + bj * HALF;
                        if constexpr (MODE == 0) { xf[mm][0] = *(const f32x4*)(xs + ro); xf[mm][1] = *(const f32x4*)(xs + ro + 4); }
                        else xw[mm] = *(const u32x4*)(hb + ro); }
                    __builtin_amdgcn_sched_barrier(0);
#pragma unroll
                    for (int mm = 0; mm < MG; ++mm) { const int m = mg + mm; const size_t ro = (size_t)(rloc + ai * HALF + m * 16) * D + bj * HALF;
                        f32x4 x0, x1;
                        if constexpr (MODE == 0) { x0 = xf[mm][0]; x1 = xf[mm][1]; }
                        else { const u32x4 w = xw[mm]; x0 = (f32x4){bf_lo(w.x), bf_hi(w.x), bf_lo(w.y), bf_hi(w.y)}; x1 = (f32x4){bf_lo(w.z), bf_hi(w.z), bf_lo(w.w), bf_hi(w.w)}; }
                        const f32x4 y0 = x0 + g0 * acc[ai][bj][m][0], y1 = x1 + g1 * acc[ai][bj][m][1];
                        if constexpr (MODE == 2) { if (st_ok) { *(f32x4*)(ob + ro) = y0; *(f32x4*)(ob + ro + 4) = y1; } }
                        else { u32x4 w; w.x = cvt_pk_bf16(y0[0], y0[1]); w.y = cvt_pk_bf16(y0[2], y0[3]); w.z = cvt_pk_bf16(y1[0], y1[1]); w.w = cvt_pk_bf16(y1[2], y1[3]); *(u32x4*)(hb + ro) = w; }
                    }
                    __builtin_amdgcn_sched_barrier(0);
                }
        }
    }
    __device__ __forceinline__ void operator()(const f32x4 (&acc)[2][2][4][2], const Unit& u, int wr, int wc, int fr, int fq) const {
        if (mode == 1) body<1>(acc, u, wr, wc, fr, fq);
        else if (mode == 0) body<0>(acc, u, wr, wc, fr, fq);
        else body<2>(acc, u, wr, wc, fr, fq);
    }
};
struct EpiBranch {
    static constexpr bool PERM = true, MIDK = true;
    bf16_t* P;
    __device__ __forceinline__ u32x4 ld_raw(unsigned off) const { return *(const u32x4*)((const char*)P + (size_t)off * 2u); }
    __device__ __forceinline__ void to_e(const u32x4 w, float (&e)[8]) const { unpack8(w, e); }
    template <int WHICH> __device__ __forceinline__ void mid(f32x4 (&acc)[2][2][4][2], const Unit& u, int wr, int wc, int fr, int fq) const {
        unsigned base = (unsigned)(u.pm * BM + wr * 64 + fr) * PROJ + (unsigned)(u.pn * BM + wc * 32 + 8 * fq) + OFF_GATE + WHICH * D;
        asm volatile("" : "+v"(base));
#pragma unroll
        for (int ai = 0; ai < 2; ++ai)
#pragma unroll
            for (int mp = 0; mp < 2; ++mp) {
                u32x4 wa[2][2], wb[2][2];
#pragma unroll
                for (int mm = 0; mm < 2; ++mm)
#pragma unroll
                    for (int bj = 0; bj < 2; ++bj) { const unsigned o = base + (unsigned)(ai * HALF + (mp * 2 + mm) * 16) * PROJ + bj * HALF; wa[mm][bj] = ld_raw(o); wb[mm][bj] = ld_raw(o + D); }
                __builtin_amdgcn_sched_barrier(0);
#pragma unroll
                for (int mm = 0; mm < 2; ++mm)
#pragma unroll
                    for (int bj = 0; bj < 2; ++bj) { float ea[8], eb[8]; to_e(wa[mm][bj], ea); to_e(wb[mm][bj], eb);
#pragma unroll
                        for (int n = 0; n < 2; ++n)
#pragma unroll
                            for (int j = 0; j < 4; ++j) acc[ai][bj][mp * 2 + mm][n][j] *= eb[n * 4 + j] * fast_rcp(ea[n * 4 + j]); }
                __builtin_amdgcn_sched_barrier(0);
            }
    }
    __device__ __forceinline__ void operator()(const f32x4 (&acc)[2][2][4][2], const Unit& u, int wr, int wc, int fr, int fq) const {
        unsigned base = (unsigned)(u.pm * BM + wr * 64 + fr) * PROJ + (unsigned)(u.pn * BM + wc * 32 + 8 * fq);
        asm volatile("" : "+v"(base));
#pragma unroll
        for (int ai = 0; ai < 2; ++ai) {
            u32x4 w2[4][2];
#pragma unroll
            for (int m = 0; m < 4; ++m)
#pragma unroll
                for (int bj = 0; bj < 2; ++bj) w2[m][bj] = ld_raw(base + (unsigned)(ai * HALF + m * 16) * PROJ + bj * HALF + OFF_GATE + 2 * D);
            __builtin_amdgcn_sched_barrier(0);
#pragma unroll
            for (int m = 0; m < 4; ++m)
#pragma unroll
                for (int bj = 0; bj < 2; ++bj) { const unsigned o = base + (unsigned)(ai * HALF + m * 16) * PROJ + bj * HALF;
                    float e2[8], ov[8]; to_e(w2[m][bj], e2);
#pragma unroll
                    for (int n = 0; n < 2; ++n)
#pragma unroll
                        for (int j = 0; j < 4; ++j) ov[n * 4 + j] = acc[ai][bj][m][n][j] * fast_rcp(e2[n * 4 + j]);
                    *(u32x4*)((char*)P + (size_t)o * 2u) = pack8(ov); }
            __builtin_amdgcn_sched_barrier(0);
        }
    }
};
}

__device__ __forceinline__ void tr_job(LAS float* tl, const float* src, int ld_src, int K, int Nout, bf16_t* dst, int ld_dst, int dkofs, int mode) {
    const int tid = tid_opaque();
    const int nkt = K / 64, ntl = nkt * (Nout / 64), G = gridDim.x;
    const int ln = tid & 63, lk = tid >> 6, sk2 = (tid & 31) * 2, sn = tid >> 5;
    float r[8];
    int t = bid_opaque();
    auto src_ptr = [&](int tt) -> const float* {
        const int kt = tt % nkt, n0 = (tt / nkt) * 64; int c0 = n0;
        if (mode == 1) { const int pn = n0 >> 8, rr = n0 & 255; c0 = (rr < 128) ? pn * 128 + rr : DFF + pn * 128 + (rr - 128); }
        return src + (size_t)(kt * 64 + lk) * ld_src + c0 + ln; };
    if (t < ntl) { const float* sp = src_ptr(t);
#pragma unroll
        for (int i = 0; i < 8; ++i) r[i] = sp[(size_t)(8 * i) * ld_src]; }
    for (; t < ntl; t += G) {
#pragma unroll
        for (int i = 0; i < 8; ++i) tl[(lk + 8 * i) * 65 + ln] = r[i];
        __syncthreads();
        if (t + G < ntl) { const float* sp = src_ptr(t + G);
#pragma unroll
            for (int i = 0; i < 8; ++i) r[i] = sp[(size_t)(8 * i) * ld_src]; }
        { const int kt = t % nkt, n0 = (t / nkt) * 64;
#pragma unroll
          for (int i = 0; i < 4; ++i) { const int n = sn + 16 * i; *(unsigned*)(dst + (size_t)(n0 + n) * ld_dst + dkofs + kt * 64 + sk2) = cvt_pk_bf16(tl[sk2 * 65 + n], tl[(sk2 + 1) * 65 + n]); } }
        __syncthreads();
    }
}

__device__ void phase_setup(const Params& p, LAS unsigned char* lds) {
    const int tid = tid_opaque(), wid = tid >> 6, lane = tid & 63;
    bf16_t* WT = (bf16_t*)(p.ws + WS_WT);
    LAS float* tl = (LAS float*)lds;
    for (int l = 0; l < NL; ++l) {
        bf16_t* W = WT + (size_t)l * W_LAYER;
        for (int j = 0; j < 2; ++j) {
            tr_job(tl, p.in[I_FFNIN] + ((size_t)l * 2 + j) * D * (2 * DFF), 2 * DFF, D, 2 * DFF, W + (j ? W_FIN1 : W_FIN0), D, 0, 1);
            tr_job(tl, p.in[I_FFNOUT] + ((size_t)l * 2 + j) * DFF * D, D, DFF, D, W + (j ? W_FOUT1 : W_FOUT0), DFF, 0, 0);
        }
        tr_job(tl, p.in[I_WIN] + (size_t)l * D * PROJ, PROJ, D, PROJ, W + W_WIN, D, 0, 0);
        tr_job(tl, p.in[I_WBC] + (size_t)l * 256 * D, D, 256, D, W + W_WB, D, 0, 0);
        tr_job(tl, p.in[I_WBG] + (size_t)l * 256 * D, D, 256, D, W + W_WB, D, 256, 0);
        tr_job(tl, p.in[I_WBA] + (size_t)l * 512 * D, D, 512, D, W + W_WB, D, 512, 0);
        tr_job(tl, p.in[I_WOUT] + (size_t)l * D * D, D, D, D, W + W_WO, D, 0, 0);
        for (int i = bid_opaque() * 512 + tid; i < 65536 / 2; i += gridDim.x * 512) {
            const float2 v = *(const float2*)(p.in[I_GWS] + (size_t)l * 65536 + 2 * i);
            *(unsigned*)(W + W_GWS + 2 * i) = cvt_pk_bf16(v.x, v.y);
        }
    }
    { const int gi = bid_opaque() * 512 + tid;
      if (gi < 1024) { const int pos = gi >> 4, i = gi & 15;
        const int i4 = i & 3, i16 = i >> 2;
        float inv = (i4 == 0) ? 1.0f : (i4 == 1) ? 0.5623413251903491f : (i4 == 2) ? 0.31622776601683794f : 0.1778279410038923f;
        inv *= (i16 == 0) ? 1.0f : (i16 == 1) ? 0.1f : (i16 == 2) ? 0.01f : 0.001f;
        const float a = (float)pos * inv;
        const float kq = __builtin_rintf(a * 0.6366197723675814f);
        float r = __builtin_fmaf(-kq, 1.5707963705062866f, a); r = __builtin_fmaf(kq, 4.371139000186241e-8f, r);
        const float r2 = r * r;
        const float sn = r * (1.0f + r2 * (-1.0f / 6 + r2 * (1.0f / 120 + r2 * (-1.0f / 5040 + r2 * (1.0f / 362880)))));
        const float cs = 1.0f + r2 * (-0.5f + r2 * (1.0f / 24 + r2 * (-1.0f / 720 + r2 * (1.0f / 40320 + r2 * (-1.0f / 3628800)))));
        const int q = ((int)kq) & 3;
        const float c = (q == 0) ? cs : (q == 1) ? -sn : (q == 2) ? -cs : sn;
        const float s = (q == 0) ? sn : (q == 1) ? cs : (q == 2) ? -sn : -cs;
        float2* rt = (float2*)(p.ws + WS_ROPE); rt[gi] = make_float2(c, s); } }
    if (bid_opaque() < NL * 36) {
        LAS float* sc = (LAS float*)lds;
        __syncthreads();
        for (int i = tid; i < 33 * D; i += 512) { const int r = i >> 10, k = i & 1023; const float v = (r < 32) ? p.in[I_C][r * D + k] : p.in[I_CCTX][k]; sc[i] = siluf_(v); }
        __syncthreads();
        float* MOD = (float*)(p.ws + WS_MOD);
        for (int it = bid_opaque(); it < NL * 36; it += gridDim.x) {
            const int l = it / 36, cgp = it % 36, n0 = cgp * 256 + lane * 4;
            const float* wp = p.in[I_WMOD] + (size_t)l * D * (NMOD * D) + n0;
            f32x4 a[5];
#pragma unroll
            for (int i = 0; i < 5; ++i) a[i] = (f32x4){0.f, 0.f, 0.f, 0.f};
            for (int k = 0; k < D; k += 16) {
                f32x4 w[16];
#pragma unroll
                for (int kk = 0; kk < 16; ++kk) w[kk] = *(const f32x4*)(wp + (size_t)(k + kk) * (NMOD * D));
#pragma unroll
                for (int i = 0; i < 5; ++i) { const int r = (i < 4) ? wid + 8 * i : 32;
#pragma unroll
                    for (int k4 = 0; k4 < 4; ++k4) { const f32x4 s4 = *(const LAS f32x4*)(sc + r * D + k + 4 * k4);
                        a[i] += s4[0] * w[4 * k4] + s4[1] * w[4 * k4 + 1] + s4[2] * w[4 * k4 + 2] + s4[3] * w[4 * k4 + 3]; } }
            }
            const f32x4 bv = *(const f32x4*)(p.in[I_BMOD] + (size_t)l * (NMOD * D) + n0);
#pragma unroll
            for (int i = 0; i < 5; ++i) { const int r = (i < 4) ? wid + 8 * i : 32; if (i < 4 || wid == 0) *(f32x4*)(MOD + ((size_t)l * 33 + r) * (NMOD * D) + n0) = a[i] + bv; }
        }
        __syncthreads();
    }
}

__device__ void phase_norm(const Params& p, int l, int j, bool from_inputs, bool skip_ctx) {
    const int tid = tid_opaque(), wid = tid >> 6, lane = tid & 63;
    bf16_t* A = (bf16_t*)(p.ws + WS_A);
    const bf16_t* hbuf = (const bf16_t*)(p.ws + WS_H);
    const float* MOD = (const float*)(p.ws + WS_MOD) + (size_t)l * 33 * (NMOD * D);
    const float* ng = p.in[I_NORMG] + ((size_t)l * 3 + j) * D;
    constexpr int NR = 4;
    for (int u = (bid_opaque() * 8 + wid) * NR; u < T_ALL; u += gridDim.x * 8 * NR) {
        const RowMap rm = map_row(u);
        if (skip_ctx && rm.is_ctx) continue;
        const float* sh = MOD + (size_t)rm.modrow * (NMOD * D) + (3 * j) * D; const float* sc = sh + D;
        f32x4 v[NR][4]; float ss[NR];
        if (from_inputs) { const float* x = (rm.is_ctx ? p.in[I_CTX] : p.in[I_X]) + rm.row0 * D;
#pragma unroll
            for (int rr = 0; rr < NR; ++rr)
#pragma unroll
                for (int i = 0; i < 4; ++i) v[rr][i] = *(const f32x4*)(x + rr * D + i * 256 + lane * 4);
        } else { const bf16_t* x = hbuf + (size_t)u * D;
#pragma unroll
            for (int rr = 0; rr < NR; ++rr)
#pragma unroll
                for (int i = 0; i < 4; ++i) { const u32x2 w = *(const u32x2*)(x + rr * D + i * 256 + lane * 4); v[rr][i] = (f32x4){bf_lo(w.x), bf_hi(w.x), bf_lo(w.y), bf_hi(w.y)}; }
        }
        f32x4 gm[4], s0[4];
#pragma unroll
        for (int i = 0; i < 4; ++i) { const int k = i * 256 + lane * 4; gm[i] = *(const f32x4*)(ng + k) * (*(const f32x4*)(sc + k) + 1.0f); s0[i] = *(const f32x4*)(sh + k); }
#pragma unroll
        for (int rr = 0; rr < NR; ++rr) { ss[rr] = 0.f;
#pragma unroll
            for (int i = 0; i < 4; ++i) ss[rr] += v[rr][i][0] * v[rr][i][0] + v[rr][i][1] * v[rr][i][1] + v[rr][i][2] * v[rr][i][2] + v[rr][i][3] * v[rr][i][3]; }
#pragma unroll
        for (int st = 1; st < 64; st <<= 1)
#pragma unroll
            for (int rr = 0; rr < NR; ++rr) ss[rr] += shx(ss[rr], st, lane);
#pragma unroll
        for (int rr = 0; rr < NR; ++rr) { const float rstd = rsqrtf(ss[rr] * (1.0f / D) + EPS);
#pragma unroll
            for (int i = 0; i < 4; ++i) { const int k = i * 256 + lane * 4;
                const f32x4 y = v[rr][i] * rstd * gm[i] + s0[i];
                u32x2 w; w.x = cvt_pk_bf16(y[0], y[1]); w.y = cvt_pk_bf16(y[2], y[3]);
                *(u32x2*)(A + (size_t)(u + rr) * D + k) = w; } }
    }
}

__device__ void phase_prep(const Params& p, int l, int hs, LAS unsigned char* lds) {
    const int THp = part_rows(hs), latN = part_lat(hs);
    const int tid = tid_opaque(), wid = tid >> 6, lane = tid & 63;
    bf16_t* P = (bf16_t*)(p.ws + WS_R1);
    bf16_t* VTL = (bf16_t*)(p.ws + WS_VTL); bf16_t* VTC = (bf16_t*)(p.ws + WS_VTC);
    const float* qg = p.in[I_QG] + l * 64; const float* kg = p.in[I_KG] + l * 64;
    LAS bf16_t* Vs = (LAS bf16_t*)lds;
    const LAS f32x2* rts = (const LAS f32x2*)(lds + 20480);
    __syncthreads();
    *(LAS u32x4*)(lds + 20480 + tid * 16) = *(const u32x4*)(p.ws + WS_ROPE + tid * 16);
    __syncthreads();
    const int c = lane & 7, seg = c >> 2, hf = (c >> 1) & 1, i0 = (c & 1) * 8;
    float gq[8], gk[8];
#pragma unroll
    for (int e = 0; e < 8; ++e) { gq[e] = qg[8 * c + e]; gk[e] = kg[8 * c + e]; }
    for (int it = bid_opaque(); it < THp / 64; it += gridDim.x) {
        const int v0 = it * 64; const bool lat = v0 < latN;
        const int prow = (v0 & (SEQ - 1)) >> 6;
        bf16_t* rowb = P + (size_t)(v0 + wid * 8) * PROJ;
        const int qoff = OFF_Q + (lane >> 3) * 64 + 8 * c, koff = OFF_K + ((lane >> 3) & 1) * 64 + 8 * c;
        u32x4 qr[8], kr[8]; unsigned vr[8];
#pragma unroll
        for (int i = 0; i < 8; ++i) { const bf16_t* rp = rowb + (size_t)i * PROJ; qr[i] = *(const u32x4*)(rp + qoff); kr[i] = *(const u32x4*)(rp + koff); vr[i] = *(const unsigned*)(rp + OFF_V + 2 * lane); }
#pragma unroll
        for (int i = 0; i < 8; ++i) {
            const int rl = wid * 8 + i;
            bf16_t* rowp = rowb + (size_t)i * PROJ;
            const int pp = seg ? rl : prow;
            float cs[8], sn[8];
#pragma unroll
            for (int e = 0; e < 8; ++e) { const f32x2 t2 = rts[pp * 16 + i0 + e]; cs[e] = lat ? t2[0] : 1.0f; sn[e] = lat ? t2[1] : 0.0f; }
            { float x[8]; unpack8(qr[i], x);
              float ss = 0.f;
#pragma unroll
              for (int e = 0; e < 8; ++e) ss += x[e] * x[e];
              ss += shx(ss, 1, lane); ss += shx(ss, 2, lane); ss += shx(ss, 4, lane);
              const float rstd = rsqrtf(ss * (1.0f / 64) + EPS); float o[8];
#pragma unroll
              for (int e = 0; e < 8; ++e) { const float y = x[e] * rstd * gq[e]; const float yp = shx(y, 2, lane);
                  o[e] = (hf ? (y * cs[e] + yp * sn[e]) : (y * cs[e] - yp * sn[e])) * (0.125f * LOG2E); }
              *(u32x4*)(rowp + qoff) = pack8(o); }
            { float x[8]; unpack8(kr[i], x);
              float ss = 0.f;
#pragma unroll
              for (int e = 0; e < 8; ++e) ss += x[e] * x[e];
              ss += shx(ss, 1, lane); ss += shx(ss, 2, lane); ss += shx(ss, 4, lane);
              const float rstd = rsqrtf(ss * (1.0f / 64) + EPS); float o[8];
#pragma unroll
              for (int e = 0; e < 8; ++e) { const float y = x[e] * rstd * gk[e]; const float yp = shx(y, 2, lane);
                  o[e] = hf ? (y * cs[e] + yp * sn[e]) : (y * cs[e] - yp * sn[e]); }
              if (lane < 16) *(u32x4*)(rowp + koff) = pack8(o); }
            { const unsigned w = vr[i];
              Vs[(2 * lane) * 72 + rl] = (bf16_t)(w & 0xffffu); Vs[(2 * lane + 1) * 72 + rl] = (bf16_t)(w >> 16); }
        }
        __syncthreads();
        { const int hd = tid >> 2, ch = tid & 3;
          bf16_t* dst;
          if (lat) { const int bl = v0 >> 11, pos0 = v0 & (SEQ - 1); dst = VTL + ((size_t)bl * 128 + hd) * SEQ + pos0 + ch * 16; }
          else { const int cv = v0 - latN, bl = cv >> 8, pos0 = cv & 255; dst = VTC + ((size_t)bl * 128 + hd) * CTXL + pos0 + ch * 16; }
          const u32x4 a = *(const LAS u32x4*)(Vs + hd * 72 + ch * 16), b = *(const LAS u32x4*)(Vs + hd * 72 + ch * 16 + 8);
          *(u32x4*)dst = a; *(u32x4*)(dst + 8) = b; }
        __syncthreads();
    }
}

struct KeySeg { const bf16_t* K; const bf16_t* Vt; int vstride; int ntiles; int mask; };

__device__ __forceinline__ void attn_item(const Params& p, int l, int hs, int idx) {
    const int tid = tid_opaque(), wid = __builtin_amdgcn_readfirstlane(tid >> 6), lane = tid & 63, fr = lane & 15, fq = lane >> 4;
    const bf16_t* P = (const bf16_t*)(p.ws + WS_R1);
    const bf16_t* VTL = (const bf16_t*)(p.ws + WS_VTL); const bf16_t* VTC = (const bf16_t*)(p.ws + WS_VTC);
    bf16_t* Y = (bf16_t*)(p.ws + WS_A) + (size_t)part_u0(hs) * D;
    const int latN = part_lat(hs), nli = part_nb(hs) * 32;
    int bl, qb, hk; bool lat;
    if (idx < nli) { lat = true; bl = idx >> 5; qb = (idx >> 1) & 15; hk = idx & 1; }
    else { const int j = idx - nli; lat = false; bl = j >> 2; qb = (j >> 1) & 1; hk = j & 1; }
    const int g = wid >> 1, r0 = (wid & 1) * 64, head = hk * 4 + g;
    const int qrow0 = lat ? bl * SEQ + qb * 128 : latN + bl * CTXL + qb * 128;
    const int crow0 = latN + bl * CTXL;
    bf16x8 qf[4][2];
    { const bf16_t* qp = P + (size_t)(qrow0 + r0 + fr) * PROJ + OFF_Q + head * 64 + fq * 8;
#pragma unroll
      for (int nq = 0; nq < 4; ++nq)
#pragma unroll
          for (int ks = 0; ks < 2; ++ks) qf[nq][ks] = *(const bf16x8*)(qp + (size_t)nq * 16 * PROJ + ks * 32); }
    f32x4 o[4][4];
#pragma unroll
    for (int a = 0; a < 4; ++a)
#pragma unroll
        for (int b = 0; b < 4; ++b) o[a][b] = (f32x4){0.f, 0.f, 0.f, 0.f};
    const float snk = p.in[I_SINK][l * 8 + head] * LOG2E;
    float mrun[4], lrun[4];
#pragma unroll
    for (int nq = 0; nq < 4; ++nq) { mrun[nq] = snk; lrun[nq] = (fq == 0) ? 1.0f : 0.0f; }

    int lo = 0, nb = 0;
    if (lat) { lo = (qb == 0) ? 4 : (r0 >> 5); const int hi = (qb == 15) ? 8 : (r0 == 0 ? 10 : 12); nb = hi - lo; }
    const int ntot = nb + 8;
    const char* kband = (const char*)(P + (ptrdiff_t)(bl * SEQ + (qb - 1) * 128 + lo * 32) * PROJ + OFF_K + hk * 64);
    const char* kctx = (const char*)(P + (size_t)crow0 * PROJ + OFF_K + hk * 64);
    const char* vband = (const char*)(VTL + ((size_t)bl * 2 + hk) * 64 * SEQ + (ptrdiff_t)((qb - 1) * 128 + lo * 32));
    const char* vctx = (const char*)(VTC + ((size_t)bl * 2 + hk) * 64 * CTXL);
    const unsigned klane = (unsigned)(fr * PROJ + fq * 8) * 2u, vlane_b = (unsigned)(fr * SEQ + fq * 4) * 2u, vlane_c = (unsigned)(fr * CTXL + fq * 4) * 2u;
#define ATT_LOAD(i_, KF, VLO, VHI) do { const int _i = (i_); \
        if (_i < nb) { const char* _kp = kband + (size_t)_i * (32 * PROJ * 2); const char* _vp = vband + _i * 64; \
            _Pragma("unroll") for (int kb = 0; kb < 2; ++kb) _Pragma("unroll") for (int ks = 0; ks < 2; ++ks) KF[kb][ks] = *(const bf16x8*)(_kp + kb * (16 * PROJ * 2) + ks * 64 + klane); \
            _Pragma("unroll") for (int db = 0; db < 4; ++db) { VLO[db] = *(const bf16x4*)(_vp + db * (16 * SEQ * 2) + vlane_b); VHI[db] = *(const bf16x4*)(_vp + db * (16 * SEQ * 2) + 32 + vlane_b); } \
        } else { const char* _kp = kctx + (size_t)(_i - nb) * (32 * PROJ * 2); const char* _vp = vctx + (_i - nb) * 64; \
            _Pragma("unroll") for (int kb = 0; kb < 2; ++kb) _Pragma("unroll") for (int ks = 0; ks < 2; ++ks) KF[kb][ks] = *(const bf16x8*)(_kp + kb * (16 * PROJ * 2) + ks * 64 + klane); \
            _Pragma("unroll") for (int db = 0; db < 4; ++db) { VLO[db] = *(const bf16x4*)(_vp + db * (16 * CTXL * 2) + vlane_c); VHI[db] = *(const bf16x4*)(_vp + db * (16 * CTXL * 2) + 32 + vlane_c); } } } while (0)
#define ATT_COMPUTE(i_, KF, VLO, VHI) do { const int _ci = (i_); const int bt = lo + _ci; const bool mask = (_ci < nb) && (bt < 4 || bt >= 8); \
        f32x4 s[2][4]; \
        _Pragma("unroll") for (int kb = 0; kb < 2; ++kb) _Pragma("unroll") for (int nq = 0; nq < 4; ++nq) { \
            s[kb][nq] = __builtin_amdgcn_mfma_f32_16x16x32_bf16(KF[kb][0], qf[nq][0], (f32x4){0.f, 0.f, 0.f, 0.f}, 0, 0, 0); \
            s[kb][nq] = __builtin_amdgcn_mfma_f32_16x16x32_bf16(KF[kb][1], qf[nq][1], s[kb][nq], 0, 0, 0); } \
        if (mask) { \
            _Pragma("unroll") for (int kb = 0; kb < 2; ++kb) _Pragma("unroll") for (int nq = 0; nq < 4; ++nq) _Pragma("unroll") for (int j = 0; j < 4; ++j) { \
                const int dlt = (bt * 32 - 128 + kb * 16 + fq * 4 + j) - (r0 + nq * 16 + fr); if (dlt > 128 || dlt < -128) s[kb][nq][j] = -1e30f; } } \
        bf16x8 pf[4]; \
        _Pragma("unroll") for (int nq = 0; nq < 4; ++nq) { \
            float mx = fmaxf(fmaxf(fmaxf(s[0][nq][0], s[0][nq][1]), fmaxf(s[0][nq][2], s[0][nq][3])), fmaxf(fmaxf(s[1][nq][0], s[1][nq][1]), fmaxf(s[1][nq][2], s[1][nq][3]))); \
            mx = fmaxf(mx, shx(mx, 16, lane)); mx = fmaxf(mx, shx(mx, 32, lane)); \
            const float mn = fmaxf(mrun[nq], mx), alpha = fast_exp2(mrun[nq] - mn); mrun[nq] = mn; \
            float pv[8], ps = 0.f; \
            _Pragma("unroll") for (int j = 0; j < 4; ++j) { pv[j] = fast_exp2(s[0][nq][j] - mn); pv[4 + j] = fast_exp2(s[1][nq][j] - mn); ps += pv[j] + pv[4 + j]; } \
            lrun[nq] = lrun[nq] * alpha + ps; \
            const u32x4 w = pack8(pv); pf[nq] = *(const bf16x8*)&w; \
            _Pragma("unroll") for (int db = 0; db < 4; ++db) o[db][nq] *= alpha; } \
        _Pragma("unroll") for (int db = 0; db < 4; ++db) { const bf16x8 vf = (bf16x8){VLO[db][0], VLO[db][1], VLO[db][2], VLO[db][3], VHI[db][0], VHI[db][1], VHI[db][2], VHI[db][3]}; \
            _Pragma("unroll") for (int nq = 0; nq < 4; ++nq) o[db][nq] = __builtin_amdgcn_mfma_f32_16x16x32_bf16(vf, pf[nq], o[db][nq], 0, 0, 0); } } while (0)
    bf16x8 kfa[2][2], kfb[2][2]; bf16x4 vla[4], vha[4], vlb[4], vhb[4];
    ATT_LOAD(0, kfa, vla, vha);
    for (int i = 0; i < ntot; i += 2) {
        const int i1 = (i + 1 < ntot) ? i + 1 : i;
        ATT_LOAD(i1, kfb, vlb, vhb);
        ATT_COMPUTE(i, kfa, vla, vha);
        const int i2 = (i + 2 < ntot) ? i + 2 : i;
        ATT_LOAD(i2, kfa, vla, vha);
        if (i + 1 < ntot) ATT_COMPUTE(i + 1, kfb, vlb, vhb);
    }
#undef ATT_LOAD
#undef ATT_COMPUTE
#pragma unroll
    for (int nq = 0; nq < 4; ++nq) {
        float lt = lrun[nq]; lt += shx(lt, 16, lane); lt += shx(lt, 32, lane);
        const float inv = 1.0f / lt;
        bf16_t* yp = Y + (size_t)(qrow0 + r0 + nq * 16 + fr) * D + 512 + head * 64 + fq * 4;
#pragma unroll
        for (int db = 0; db < 4; ++db) { u32x2 w; w.x = cvt_pk_bf16(o[db][nq][0] * inv, o[db][nq][1] * inv); w.y = cvt_pk_bf16(o[db][nq][2] * inv, o[db][nq][3] * inv);
            *(u32x2*)(yp + db * 16) = w; }
    }
}

__device__ __forceinline__ void gmlp_conv_item(const Params& p, int l, int hs, int chunk, LAS unsigned char* lds) {
    const int tid = tid_opaque(), wid = tid >> 6, lane = tid & 63, fr = lane & 15, fq = lane >> 4;
    const bf16_t* P = (const bf16_t*)(p.ws + WS_R1);
    bf16_t* Y = (bf16_t*)(p.ws + WS_A) + (size_t)part_u0(hs) * D;
    const int v0 = chunk * 128, latN = part_lat(hs);
    LAS bf16_t* vT = (LAS bf16_t*)lds;
    { const float* cw = p.in[I_CONVW] + (size_t)l * 3 * 256;
      const bool lat = v0 < latN;
#pragma unroll 2
      for (int i = 0; i < 8; ++i) {
          const int id = i * 512 + tid, pt = id >> 5, cc = (id & 31) * 8, v = v0 + pt;
          const int pos = lat ? (v & (SEQ - 1)) : ((v - latN) & (CTXL - 1)), n = lat ? SEQ : CTXL;
          const bf16_t* rp = P + (size_t)v * PROJ + cc;
          float bv[8], c1[8], h1[8], acc[8];
          unpack8(*(const u32x4*)(rp + OFF_CB), bv); unpack8(*(const u32x4*)(rp + OFF_CC), c1); unpack8(*(const u32x4*)(rp + OFF_CH), h1);
          { const f32x4 wa = *(const f32x4*)(cw + 256 + cc), wb = *(const f32x4*)(cw + 256 + cc + 4);
#pragma unroll
            for (int e = 0; e < 8; ++e) acc[e] = c1[e] * h1[e] * (e < 4 ? wa[e & 3] : wb[e & 3]); }
          if (pos > 0) { float c0[8], h0[8]; unpack8(*(const u32x4*)(rp - PROJ + OFF_CC), c0); unpack8(*(const u32x4*)(rp - PROJ + OFF_CH), h0);
              const f32x4 wa = *(const f32x4*)(cw + cc), wb = *(const f32x4*)(cw + cc + 4);
#pragma unroll
              for (int e = 0; e < 8; ++e) acc[e] += c0[e] * h0[e] * (e < 4 ? wa[e & 3] : wb[e & 3]); }
          if (pos < n - 1) { float c2[8], h2[8]; unpack8(*(const u32x4*)(rp + PROJ + OFF_CC), c2); unpack8(*(const u32x4*)(rp + PROJ + OFF_CH), h2);
              const f32x4 wa = *(const f32x4*)(cw + 512 + cc), wb = *(const f32x4*)(cw + 512 + cc + 4);
#pragma unroll
              for (int e = 0; e < 8; ++e) acc[e] += c2[e] * h2[e] * (e < 4 ? wa[e & 3] : wb[e & 3]); }
#pragma unroll
          for (int e = 0; e < 8; ++e) acc[e] *= bv[e];
          *(u32x4*)(Y + (size_t)v * D + cc) = pack8(acc);
      } }
    { const float* lg = p.in[I_LNG] + l * 256 + 4 * lane; const float* lb = p.in[I_LNB] + l * 256 + 4 * lane;
      const f32x4 g4 = *(const f32x4*)lg, b4 = *(const f32x4*)lb;
#pragma unroll
      for (int hb = 0; hb < 2; ++hb) {
          u32x2 w[8]; float x[8][4], sm[8], qv[8];
#pragma unroll
          for (int i = 0; i < 8; ++i) w[i] = *(const u32x2*)(P + (size_t)(v0 + wid * 16 + hb * 8 + i) * PROJ + OFF_GV + 4 * lane);
#pragma unroll
          for (int i = 0; i < 8; ++i) { x[i][0] = gelu_tanh(bf_lo(w[i].x)); x[i][1] = gelu_tanh(bf_hi(w[i].x)); x[i][2] = gelu_tanh(bf_lo(w[i].y)); x[i][3] = gelu_tanh(bf_hi(w[i].y));
              sm[i] = (x[i][0] + x[i][1]) + (x[i][2] + x[i][3]); }
#pragma unroll
          for (int st = 1; st < 64; st <<= 1)
#pragma unroll
              for (int i = 0; i < 8; ++i) sm[i] += shx(sm[i], st, lane);
#pragma unroll
          for (int i = 0; i < 8; ++i) { const float mu = sm[i] * (1.0f / 256); float q = 0.f;
#pragma unroll
              for (int e = 0; e < 4; ++e) { x[i][e] -= mu; q += x[i][e] * x[i][e]; }
              qv[i] = q; }
#pragma unroll
          for (int st = 1; st < 64; st <<= 1)
#pragma unroll
              for (int i = 0; i < 8; ++i) qv[i] += shx(qv[i], st, lane);
#pragma unroll
          for (int i = 0; i < 8; ++i) { const float rstd = rsqrtf(qv[i] * (1.0f / 256) + EPS); const int pt = wid * 16 + hb * 8 + i;
#pragma unroll
              for (int e = 0; e < 4; ++e) { const float y = x[i][e] * rstd * g4[e] + b4[e]; vT[(4 * lane + e) * 136 + pt] = (bf16_t)(cvt_pk_bf16(y, 0.f) & 0xffffu); } }
      } }
    __syncthreads();
    { const int g = wid >> 1, ph = wid & 1;
      const bf16_t* wsb = (const bf16_t*)(p.ws + WS_WT) + (size_t)l * W_LAYER + W_GWS + (size_t)g * 128 * 128;
      f32x4 acc[4][4];
#pragma unroll
      for (int a = 0; a < 4; ++a)
#pragma unroll
          for (int b = 0; b < 4; ++b) acc[a][b] = (f32x4){0.f, 0.f, 0.f, 0.f};
#pragma unroll
      for (int kk = 0; kk < 4; ++kk) {
          bf16x8 af[4], bfr[4];
#pragma unroll
          for (int db = 0; db < 4; ++db) af[db] = *(const LAS bf16x8*)(vT + (g * 64 + db * 16 + fr) * 136 + kk * 32 + fq * 8);
#pragma unroll
          for (int pb = 0; pb < 4; ++pb) bfr[pb] = *(const bf16x8*)(wsb + (size_t)((ph * 4 + pb) * 16 + fr) * 128 + kk * 32 + fq * 8);
#pragma unroll
          for (int db = 0; db < 4; ++db)
#pragma unroll
              for (int pb = 0; pb < 4; ++pb) acc[db][pb] = __builtin_amdgcn_mfma_f32_16x16x32_bf16(af[db], bfr[pb], acc[db][pb], 0, 0, 0);
      }
      const float* bs = p.in[I_GBS] + (size_t)l * 512 + g * 128;
      u32x2 uw[4][4]; float bias[4];
#pragma unroll
      for (int pb = 0; pb < 4; ++pb) { const int pt = (ph * 4 + pb) * 16 + fr; bias[pb] = bs[pt];
          const bf16_t* up = P + (size_t)(v0 + pt) * PROJ + OFF_GU + g * 64 + fq * 4;
#pragma unroll
          for (int db = 0; db < 4; ++db) uw[pb][db] = *(const u32x2*)(up + db * 16); }
#pragma unroll
      for (int pb = 0; pb < 4; ++pb) { const int pt = (ph * 4 + pb) * 16 + fr;
          bf16_t* yp = Y + (size_t)(v0 + pt) * D + 256 + g * 64 + fq * 4;
#pragma unroll
          for (int db = 0; db < 4; ++db) { const u32x2 w = uw[pb][db];
              const float y0 = gelu_tanh(bf_lo(w.x)) * (acc[db][pb][0] + bias[pb]), y1 = gelu_tanh(bf_hi(w.x)) * (acc[db][pb][1] + bias[pb]);
              const float y2 = gelu_tanh(bf_lo(w.y)) * (acc[db][pb][2] + bias[pb]), y3 = gelu_tanh(bf_hi(w.y)) * (acc[db][pb][3] + bias[pb]);
              u32x2 ov; ov.x = cvt_pk_bf16(y0, y1); ov.y = cvt_pk_bf16(y2, y3); *(u32x2*)(yp + db * 16) = ov; } } }
    __syncthreads();
}

__device__ void phase_mixers(const Params& p, int l, int hs, LAS unsigned char* lds, bool skip_ctx) {
    const int n_attn = part_nb(hs) * (skip_ctx ? 32 : 36), n_gmlp = (skip_ctx ? part_lat(hs) : part_rows(hs)) / 128;
#ifndef SKIP_ATTN
    for (int it = bid_opaque(); it < n_attn; it += gridDim.x) attn_item(p, l, hs, it);
#endif
    __builtin_amdgcn_sched_barrier(0);
#ifndef SKIP_GMLP
    { const int G = (int)gridDim.x; int n3 = n_attn - 2 * G; n3 = n3 < 0 ? 0 : n3 % G;
      for (int it = (bid_opaque() - n3 + G) % G; it < n_gmlp; it += G) gmlp_conv_item(p, l, hs, it, lds); }
#endif
}

#define XB_TMO      128
#define XB_XCNT(j)  (256  + 64 * (j))
#define XB_XSUB(j)  (1280 + 64 * (j))
#define XB_XGEN(j)  (2304 + 64 * (j))
#define XB_TOP      3328
#define XB_TOPGEN   3392
#define XCD_BAR_WORDS 3456
#define XB_SPIN_CAP (1u << 22)
__device__ __forceinline__ unsigned xb_ld(unsigned* p)              { return __hip_atomic_load(p, __ATOMIC_RELAXED, __HIP_MEMORY_SCOPE_AGENT); }
__device__ __forceinline__ unsigned xb_add(unsigned* p, unsigned v) { return __hip_atomic_fetch_add(p, v, __ATOMIC_RELAXED, __HIP_MEMORY_SCOPE_AGENT); }
__device__ __forceinline__ unsigned xb_xcc_id() { return (unsigned)__builtin_amdgcn_s_getreg((3 << 11) | 20) & 0xFu; }
#define XB_SPIN(cond, bar) do { unsigned _sp = 0; while (cond) { __builtin_amdgcn_s_sleep(1); \
    if ((++_sp & 255u) == 0u) { if (xb_ld(&(bar)[XB_TMO])) break; if (_sp > XB_SPIN_CAP) { atomicAdd(&(bar)[XB_TMO], 1u); break; } } } } while (0)
__device__ __forceinline__ void xcd_barrier_post(unsigned* bar) { if (threadIdx.x == 0) (void)xb_add(&bar[XB_XCNT(xb_xcc_id())], 1u); }
__device__ __forceinline__ void xcd_barrier_complete(unsigned* bar, unsigned x, unsigned& nloc, unsigned& nx) {
    const unsigned G = gridDim.x * gridDim.y * gridDim.z;
    unsigned sum, cnt, mine, sp = 0u;
    for (;;) {
        sum = 0u; cnt = 0u; mine = 0u;
#pragma unroll
        for (unsigned j = 0; j < 16; ++j) { const unsigned c = xb_ld(&bar[XB_XCNT(j)]); sum += c; cnt += (c > 0u) ? 1u : 0u; mine = (j == x) ? c : mine; }
        if (sum == G) break;
        __builtin_amdgcn_s_sleep(1);
        if ((++sp & 255u) == 0u) { if (xb_ld(&bar[XB_TMO])) break; if (sp > XB_SPIN_CAP) { atomicAdd(&bar[XB_TMO], 1u); break; } }
    }
    nloc = mine > 0u ? mine : 1u; nx = cnt > 0u ? cnt : 1u;
}
__device__ __forceinline__ void xcd_barrier(unsigned* bar, volatile LAS unsigned* st) {
    asm volatile("s_waitcnt vmcnt(0)" ::: "memory");
    __syncthreads();
    if (threadIdx.x == 0) {
        const unsigned x = xb_xcc_id();
        __builtin_amdgcn_s_waitcnt(0);
        unsigned nloc = st[0], nx = st[1];
        if (nloc == 0u) { xcd_barrier_complete(bar, x, nloc, nx); st[0] = nloc; st[1] = nx; }
        const unsigned old = xb_add(&bar[XB_XSUB(x)], 1u);
        const unsigned gen = old / nloc;
        if (old + 1u == (gen + 1u) * nloc) {
            __builtin_amdgcn_fence(__ATOMIC_RELEASE, "agent");
            asm volatile("s_waitcnt vmcnt(0)" ::: "memory");
            const unsigned og = xb_add(&bar[XB_TOP], 1u);
            const unsigned tg = og / nx;
            if (og + 1u == (tg + 1u) * nx) xb_add(&bar[XB_TOPGEN], 1u);
            else XB_SPIN(xb_ld(&bar[XB_TOPGEN]) == tg, bar);
            __builtin_amdgcn_fence(__ATOMIC_ACQUIRE, "agent");
            xb_add(&bar[XB_XGEN(x)], 1u);
            asm volatile("s_waitcnt vmcnt(0)" ::: "memory");
        } else {
            XB_SPIN(xb_ld(&bar[XB_XGEN(x)]) == gen, bar);
            __builtin_amdgcn_fence(__ATOMIC_ACQUIRE, "agent");
            asm volatile("s_waitcnt vmcnt(0)" ::: "memory");
        }
    }
    __syncthreads();
}

__device__ void run_phase(const Params& p, int ph, LAS unsigned char* lds) {
    if (ph == 0) {
#ifndef SKIP_SETUP
 phase_setup(p, lds);
#endif
 return; }
    const int q = ph - 1, l = q / 17, r = q % 17;
    const bf16_t* W = (const bf16_t*)(p.ws + WS_WT) + (size_t)l * W_LAYER;
    const float* MOD = (const float*)(p.ws + WS_MOD) + (size_t)l * 33 * (NMOD * D);
    bf16_t* HB = (bf16_t*)(p.ws + WS_H);
    const bool first = (l == 0 && r <= 2);
    const bool lastl = (l == NL - 1);
    bf16_t* A = (bf16_t*)(p.ws + WS_A); bf16_t* R1 = (bf16_t*)(p.ws + WS_R1);
    if (r == 0 || r == 3 || r == 14) {
#ifndef SKIP_NORM
 phase_norm(p, l, r == 0 ? 0 : (r == 3 ? 1 : 2), first, lastl && r == 14);
#endif
 return; }
    if (r == 1 || r == 15) {
        const int j = (r == 1) ? 0 : 1;
        const int sk = (lastl && j == 1) ? 1 : 0;
        pg8::Gemm g{A, D, W + (j ? W_FIN1 : W_FIN0), D, sk ? T_LAT : T_ALL, 2 * DFF, D, sk};
        pg8::EpiSwiglu E{R1};
#ifndef SKIP_UP
        pg8::gemm_phase(lds, g, E);
#endif
        return;
    }
    if (r == 2 || r == 16) {
        const int j = (r == 2) ? 0 : 1;
        const int sk = (lastl && j == 1) ? 1 : 0;
        pg8::Gemm g{R1, DFF, W + (j ? W_FOUT1 : W_FOUT0), DFF, sk ? T_LAT : T_ALL, D, DFF, sk};
        pg8::EpiResid E{p.in[I_X], p.in[I_CTX], HB, p.out, MOD, j ? 8 : 2, 0.5f, 0, first ? 0 : ((l == NL - 1 && r == 16) ? 2 : 1)};
#ifndef SKIP_DOWN
        pg8::gemm_phase(lds, g, E);
#endif
        return;
    }
    const int hs = (r - 4) / 5, rr = (r - 4) % 5;
    if (rr == 0) { pg8::Gemm g{A + (size_t)part_u0(hs) * D, D, W + W_WIN, D, part_rows(hs), PROJ, D, 0}; pg8::EpiBf16 E{R1, PROJ, p.in[I_BGATE] + (size_t)l * 3 * D, OFF_GATE};
#ifndef SKIP_PROJ
 pg8::gemm_phase(lds, g, E);
#endif
 return; }
    if (rr == 1) {
#ifndef SKIP_PREP
 phase_prep(p, l, hs, lds);
#endif
 return; }
    if (rr == 2) {
#ifndef SKIP_MIX
 phase_mixers(p, l, hs, lds, lastl);
#endif
 return; }
    if (rr == 3) { pg8::Gemm g{A + (size_t)part_u0(hs) * D, D, W + W_WB, D, lastl ? part_lat(hs) : part_rows(hs), D, D, 0}; pg8::EpiBranch E{R1};
#ifndef SKIP_BRANCH
 pg8::gemm_phase(lds, g, E);
#endif
 return; }
    { pg8::Gemm g{R1, PROJ, W + W_WO, D, lastl ? part_lat(hs) : part_rows(hs), D, D, 0}; pg8::EpiResid E{p.in[I_X], p.in[I_CTX], HB, p.out, MOD, 5, 1.0f, part_u0(hs) / 256, 1};
#ifndef SKIP_OUT
 pg8::gemm_phase(lds, g, E);
#endif
 }
}

__global__ __launch_bounds__(512, 2) void fwd_megakernel(Params p) {
    extern __shared__ __attribute__((aligned(16))) unsigned char shm[];
    LAS unsigned char* lds = (LAS unsigned char*)shm;
#if MK_SINGLE
    volatile LAS unsigned* bst = (volatile LAS unsigned*)(lds + LDS_BYTES - 16);
    if (threadIdx.x == 0) { bst[0] = 0u; bst[1] = 0u; }
    __syncthreads();
    xcd_barrier_post((unsigned*)(p.ws + WS_BAR));
#endif
    for (int ph = p.ph_lo; ph < p.ph_hi; ++ph) {
#if defined(__HIP_DEVICE_COMPILE__)
        const __attribute__((address_space(4))) char* kp = (const __attribute__((address_space(4))) char*)__builtin_amdgcn_kernarg_segment_ptr();
        asm volatile("" : "+s"(kp));
        const Params lp = *(const Params*)(const char*)kp;
#else
        const Params lp = p;
#endif
        run_phase(lp, ph, lds);
#if MK_SINGLE
        if (ph + 1 < lp.ph_hi) {
            if (ph == 0) cg::this_grid().sync();
            else xcd_barrier((unsigned*)(lp.ws + WS_BAR), (volatile LAS unsigned*)(lds + LDS_BYTES - 16));
        }
#endif
    }
}

extern "C" void kernel_launch(void* const* d_in, const int* in_sizes, int n_in, void* d_out, int out_size, void* d_ws, size_t ws_size, hipStream_t stream) {
    static int grid = 0;
    if (grid == 0) {
        if (n_in != N_IN || out_size != T_LAT * D || ws_size < WS_END) { fprintf(stderr, "kernel_launch: unexpected shapes (n_in %d out %d ws %zu need %zu)\n", n_in, out_size, ws_size, (size_t)WS_END); grid = -1; return; }
        int dev = 0, cus = 0, per_cu = 0;
        (void)hipGetDevice(&dev); (void)hipDeviceGetAttribute(&cus, hipDeviceAttributeMultiprocessorCount, dev);
        if (hipFuncSetAttribute((const void*)fwd_megakernel, hipFuncAttributeMaxDynamicSharedMemorySize, LDS_BYTES) != hipSuccess) { fprintf(stderr, "kernel_launch: hipFuncSetAttribute failed\n"); grid = -1; return; }
        if (hipOccupancyMaxActiveBlocksPerMultiprocessor(&per_cu, (const void*)fwd_megakernel, 512, LDS_BYTES) != hipSuccess || per_cu < 1) { fprintf(stderr, "kernel_launch: occupancy query gave %d\n", per_cu); per_cu = 1; }
        (void)hipGetLastError();
        grid = cus * per_cu;
    }
    if (grid < 0) return;
    Params p{};
    for (int i = 0; i < N_IN; ++i) p.in[i] = (const float*)d_in[i];
    p.out = (float*)d_out; p.ws = (unsigned char*)d_ws;
#if MK_SINGLE
    p.ph_lo = 0; p.ph_hi = N_PHASES;
    if (hipMemsetAsync((char*)d_ws + WS_BAR, 0, 16384, stream) != hipSuccess) { fprintf(stderr, "kernel_launch: memset of the barrier words failed\n"); return; }
    void* args[] = {&p};
    hipError_t e = hipLaunchCooperativeKernel((const void*)fwd_megakernel, dim3(grid), dim3(512), args, LDS_BYTES, stream);
    if (e != hipSuccess) fprintf(stderr, "cooperative launch failed: %s (grid %d)\n", hipGetErrorString(e), grid);
#else
    for (int ph = 0; ph < N_PHASES; ++ph) {
        p.ph_lo = ph; p.ph_hi = ph + 1;
        hipLaunchKernelGGL(fwd_megakernel, dim3(grid), dim3(512), LDS_BYTES, stream, p);
    }
#endif
}
```

```cpp
#include <hip/hip_runtime.h>
#include <hip/hip_cooperative_groups.h>
#include <cstdio>
namespace cg = cooperative_groups;

#ifndef MK_SINGLE
#define MK_SINGLE 1
#endif

#define LAS __attribute__((address_space(3)))
typedef unsigned short bf16_t;
typedef short bf16x8 __attribute__((ext_vector_type(8)));
typedef short bf16x4 __attribute__((ext_vector_type(4)));
typedef float f32x4 __attribute__((ext_vector_type(4)));
typedef unsigned u32x4 __attribute__((ext_vector_type(4)));
typedef unsigned u32x2 __attribute__((ext_vector_type(2)));
typedef float f32x2 __attribute__((ext_vector_type(2)));

constexpr int D = 1024, NB = 32, SEQ = 2048, NL = 4, CTXL = 256, DFF = 2816, PROJ = 5120, NMOD = 9;
constexpr int T_LAT = NB * SEQ, T_CTX = NB * CTXL, T_ALL = T_LAT + T_CTX;
constexpr int NB0 = 14, NB1 = NB - NB0;
constexpr int U1 = NB0 * (SEQ + CTXL);
constexpr int TH_MAX = NB1 * (SEQ + CTXL);
__host__ __device__ __forceinline__ constexpr int part_nb(int s) { return s ? NB1 : NB0; }
__host__ __device__ __forceinline__ constexpr int part_lat(int s) { return part_nb(s) * SEQ; }
__host__ __device__ __forceinline__ constexpr int part_rows(int s) { return part_nb(s) * (SEQ + CTXL); }
__host__ __device__ __forceinline__ constexpr int part_u0(int s) { return s ? U1 : 0; }
constexpr int OFF_CB = 0, OFF_CC = 256, OFF_CH = 512, OFF_GU = 768, OFF_GV = 1024, OFF_Q = 1280, OFF_K = 1792, OFF_V = 1920, OFF_GATE = 2048;
constexpr float EPS = 1e-6f;
constexpr float LOG2E = 1.4426950408889634f;

enum { I_X = 0, I_C, I_CTX, I_CCTX, I_WMOD, I_BMOD, I_NORMG, I_FFNIN, I_FFNOUT, I_WIN, I_BGATE, I_CONVW, I_LNG, I_LNB, I_GWS, I_GBS, I_QG, I_KG, I_SINK, I_WBC, I_WBG, I_WBA, I_WOUT, N_IN };

constexpr size_t W_FIN0 = 0, W_FIN1 = 5767168, W_FOUT0 = 11534336, W_FOUT1 = 14417920, W_WIN = 17301504, W_WB = 22544384, W_WO = 23592960, W_GWS = 24641536, W_LAYER = 24707072;
constexpr size_t WS_WT = 0;
constexpr size_t WS_MOD = WS_WT + NL * W_LAYER * 2;
constexpr size_t WS_ROPE = WS_MOD + (size_t)NL * 33 * 9216 * 4;
constexpr size_t WS_HC = WS_ROPE + 8192;
constexpr size_t WS_A = WS_HC + (size_t)T_CTX * D * 4;
constexpr size_t WS_R1 = WS_A + (size_t)T_ALL * D * 2;
constexpr size_t WS_VTL = WS_R1 + (size_t)TH_MAX * PROJ * 2;
constexpr size_t WS_VTC = WS_VTL + (size_t)NB1 * 2 * 64 * 2048 * 2;
constexpr size_t WS_BAR = WS_VTC + (size_t)NB1 * 2 * 64 * 256 * 2;
constexpr size_t WS_H = WS_BAR + 16384;
constexpr size_t WS_END = WS_H + (size_t)T_ALL * D * 2;

constexpr int LDS_BYTES = 143360;
constexpr int N_PHASES = 1 + 17 * NL;

struct Params {
    const float* in[N_IN];
    float* out;
    unsigned char* ws;
    int ph_lo, ph_hi;
};

__device__ __forceinline__ unsigned cvt_pk_bf16(float lo, float hi) { unsigned r; asm volatile("v_cvt_pk_bf16_f32 %0, %1, %2" : "=v"(r) : "v"(lo), "v"(hi)); return r; }
__device__ __forceinline__ int tid_opaque() { int t = threadIdx.x; asm volatile("" : "+v"(t)); return t; }
__device__ __forceinline__ int bid_opaque() { int b = blockIdx.x; asm volatile("" : "+s"(b)); return b; }
__device__ __forceinline__ float bf_lo(unsigned w) { return __uint_as_float(w << 16); }
__device__ __forceinline__ float bf_hi(unsigned w) { return __uint_as_float(w & 0xffff0000u); }
__device__ __forceinline__ float fast_rcp(float x) { return __builtin_amdgcn_rcpf(x); }
__device__ __forceinline__ float fast_exp2(float x) { return __builtin_amdgcn_exp2f(x); }
__device__ __forceinline__ float sigmoidf_(float x) { return fast_rcp(1.0f + fast_exp2(-x * LOG2E)); }
__device__ __forceinline__ float siluf_(float x) { return x * sigmoidf_(x); }
__device__ __forceinline__ float gelu_tanh(float x) { const float z = 0.7978845608028654f * (x + 0.044715f * x * x * x); return x * sigmoidf_(2.0f * z); }
__device__ __forceinline__ float shx(float v, int m, int lane) { return __int_as_float(__builtin_amdgcn_ds_bpermute((lane ^ m) << 2, __float_as_int(v))); }
__device__ __forceinline__ float wave_sum(float v, int lane) {
    v += shx(v, 1, lane); v += shx(v, 2, lane); v += shx(v, 4, lane); v += shx(v, 8, lane); v += shx(v, 16, lane); v += shx(v, 32, lane); return v;
}
__device__ __forceinline__ void unpack8(const u32x4 w, float (&f)[8]) {
    f[0] = bf_lo(w.x); f[1] = bf_hi(w.x); f[2] = bf_lo(w.y); f[3] = bf_hi(w.y); f[4] = bf_lo(w.z); f[5] = bf_hi(w.z); f[6] = bf_lo(w.w); f[7] = bf_hi(w.w);
}
__device__ __forceinline__ u32x4 pack8(const float (&f)[8]) {
    u32x4 w; w.x = cvt_pk_bf16(f[0], f[1]); w.y = cvt_pk_bf16(f[2], f[3]); w.z = cvt_pk_bf16(f[4], f[5]); w.w = cvt_pk_bf16(f[6], f[7]); return w;
}

struct RowMap { size_t row0; int is_ctx; int modrow; };
__device__ __forceinline__ RowMap map_row(int u) {
    const int s = (u >= U1) ? 1 : 0, v = u - s * U1, latN = part_lat(s); RowMap r;
    if (v < latN) { r.row0 = (size_t)(s ? NB0 * SEQ : 0) + v; r.is_ctx = 0; r.modrow = (int)(r.row0 >> 11); }
    else { r.row0 = (size_t)(s ? NB0 * CTXL : 0) + (v - latN); r.is_ctx = 1; r.modrow = 32; }
    return r;
}

namespace pg8 {
constexpr int BM = 256, BK = 64, HALF = 128, HTB = HALF * BK * 2, STAGE_BYTES = 8 * HTB, NXCD = 8, WGM = 4;
__device__ __forceinline__ int lds_byte(int r, int c) { const int st = (r >> 4) * 2 + (c >> 5), rr = r & 15, cc = c & 31, ob = rr * 64 + cc * 2; return st * 1024 + (ob ^ (((ob >> 9) & 1) << 5)); }
__device__ __forceinline__ void stage_rc(int b, int& R, int& C) { const int st = b / 1024, sb = b % 1024, swz = sb ^ (((sb >> 9) & 1) << 5); R = (st >> 1) * 16 + swz / 64; C = (st & 1) * 32 + (swz % 64) / 2; }
__device__ __forceinline__ int perm32(int rho) { const int n = rho >> 4, i = rho & 15; return 8 * (i >> 2) + 4 * n + (i & 3); }

struct Unit { int pm, pn; };
struct Gemm { const bf16_t* A; int lda; const bf16_t* Bt; int ldb; int M, N, K; int skip_ctx; };

struct StaticOrder {
    int nM, nN, nwg, G, c, skip;
    __device__ void init(int M, int N, int G_, int c_, int skip_) { nM = M / BM; nN = N / BM; nwg = nM * nN; G = G_; c = c_; skip = skip_; }
    __device__ bool next(int i, Unit& u) const {
        const long L = (long)i * G + c; if (L >= nwg) return false;
        int wgid = (int)L; { const int q = nwg / NXCD, r = nwg % NXCD, xcd = wgid % NXCD, off = wgid / NXCD; wgid = (xcd < r ? xcd * (q + 1) : r * (q + 1) + (xcd - r) * q) + off; }
        const int nig = WGM * nN, gid = wgid / nig, fm = gid * WGM, gsz = (nM - fm) < WGM ? (nM - fm) : WGM;
        u.pm = fm + ((wgid % nig) % gsz); u.pn = (wgid % nig) / gsz; if (skip && u.pm >= NB0 * 8) u.pm += NB0; return true;
    }
};

template <class Epi>
__device__ __forceinline__ void gemm_phase(LAS unsigned char* lds, const Gemm g, const Epi& E) {
    const int tid = tid_opaque(), wid = __builtin_amdgcn_readfirstlane(tid >> 6), lane = tid & 63, wr = wid >> 2, wc = wid & 3, fr = lane & 15, fq = lane >> 4;
    const int K = g.K, nt = K / BK;
    StaticOrder S; S.init(g.M, g.N, (int)gridDim.x, bid_opaque(), g.skip_ctx);
    unsigned voffA[2], voffB[2];
#pragma unroll
    for (int i = 0; i < 2; ++i) { int R, C; stage_rc(tid * 16 + i * 8192, R, C); const int Rb = Epi::PERM ? ((R & ~31) + perm32(R & 31)) : R;
        voffA[i] = (unsigned)(R * g.lda + C) * 2u; voffB[i] = (unsigned)(Rb * g.ldb + C) * 2u; }
    const size_t kstep = (size_t)(BK * 2);
    const size_t hstepA = (size_t)HALF * g.lda * 2, hstepB = (size_t)HALF * g.ldb * 2;
    const size_t tstepA = 2 * hstepA, tstepB = 2 * hstepB;
    const unsigned ldsw = (unsigned)wid * 1024u;
    const int aoff = lds_byte(wr * 64 + fr, fq * 8), boff = lds_byte(wc * 32 + fr, fq * 8);
#define PG8_SA(b, h) (((b) * 2 + (h)) * HTB)
#define PG8_SB(b, h) ((4 + (b) * 2 + (h)) * HTB)
#define PG8_STAGE(bufoff, gbase, voff) do { _Pragma("unroll") for (int _i = 0; _i < 2; ++_i) \
        __builtin_amdgcn_global_load_lds((const unsigned*)((const char*)(gbase) + (voff)[_i]), (LAS unsigned*)(lds + (bufoff) + ldsw + _i * 8192), 16, 0, 0); } while (0)
#define PG8_LDA(dst, b, h) do { _Pragma("unroll") for (int m = 0; m < 4; ++m) _Pragma("unroll") for (int k = 0; k < 2; ++k) dst[m][k] = *(const LAS bf16x8*)(lds + PG8_SA(b, h) + aoff + m * 2048 + k * 1024); } while (0)
#define PG8_LDB(dst, b, h) do { _Pragma("unroll") for (int n = 0; n < 2; ++n) _Pragma("unroll") for (int k = 0; k < 2; ++k) dst[n][k] = *(const LAS bf16x8*)(lds + PG8_SB(b, h) + boff + n * 2048 + k * 1024); } while (0)
#define PG8_MMA(ai, bj, At, Bt) do { __builtin_amdgcn_s_setprio(1); _Pragma("unroll") for (int m = 0; m < 4; ++m) _Pragma("unroll") for (int n = 0; n < 2; ++n) _Pragma("unroll") for (int k = 0; k < 2; ++k) \
        acc[ai][bj][m][n] = __builtin_amdgcn_mfma_f32_16x16x32_bf16(Bt[n][k], At[m][k], acc[ai][bj][m][n], 0, 0, 0); __builtin_amdgcn_s_setprio(0); } while (0)
#define PG8_WAIT_V(n) asm volatile("s_waitcnt vmcnt(" #n ")" ::: "memory")
#define PG8_WAIT_L(n) asm volatile("s_waitcnt lgkmcnt(" #n ")" ::: "memory")
#define PG8_BAR __builtin_amdgcn_s_barrier()
#define PG8_SCHED __builtin_amdgcn_sched_barrier(0)
#define PG8_KLOOP(TB, TE) for (int t = (TB); t < (TE); t += 2) { \
            const bool last = (t == nt - 2); \
            const char* a1 = cA + (size_t)(t + 1) * kstep; \
            const char* a2 = last ? nA : cA + (size_t)(t + 2) * kstep; const char* b2 = last ? nB : cB + (size_t)(t + 2) * kstep; \
            const char* a3 = a2 + kstep; const char* b3 = b2 + kstep; \
            PG8_LDB(B0, 0, 0); PG8_SCHED; PG8_LDA(At, 0, 0); PG8_STAGE(PG8_SA(1, 1), a1 + hstepA, voffA); \
            PG8_WAIT_L(8); PG8_BAR; PG8_WAIT_L(0); PG8_MMA(0, 0, At, B0); PG8_BAR; PG8_SCHED; \
            PG8_LDB(B1, 0, 1); PG8_STAGE(PG8_SB(0, 0), b2, voffB); \
            PG8_BAR; PG8_WAIT_L(0); PG8_MMA(0, 1, At, B1); PG8_BAR; \
            PG8_LDA(At, 0, 1); PG8_STAGE(PG8_SA(0, 0), a2, voffA); \
            PG8_BAR; PG8_WAIT_L(0); PG8_MMA(1, 0, At, B0); PG8_BAR; PG8_SCHED; \
            PG8_STAGE(PG8_SB(0, 1), b2 + hstepB, voffB); \
            PG8_WAIT_V(6); PG8_BAR; PG8_MMA(1, 1, At, B1); PG8_BAR; \
            PG8_LDB(B0, 1, 0); PG8_SCHED; PG8_LDA(At, 1, 0); PG8_STAGE(PG8_SA(0, 1), a2 + hstepA, voffA); \
            PG8_WAIT_L(8); PG8_BAR; PG8_WAIT_L(0); PG8_MMA(0, 0, At, B0); PG8_BAR; PG8_SCHED; \
            PG8_LDB(B1, 1, 1); PG8_STAGE(PG8_SB(1, 0), b3, voffB); \
            PG8_BAR; PG8_WAIT_L(0); PG8_MMA(0, 1, At, B1); PG8_BAR; \
            PG8_LDA(At, 1, 1); PG8_STAGE(PG8_SA(1, 0), a3, voffA); \
            PG8_BAR; PG8_WAIT_L(0); PG8_MMA(1, 0, At, B0); PG8_BAR; PG8_SCHED; \
            PG8_STAGE(PG8_SB(1, 1), b3 + hstepB, voffB); \
            PG8_WAIT_V(6); PG8_BAR; PG8_MMA(1, 1, At, B1); PG8_BAR; \
        }
    Unit cur, nxt; int ui = 0;
    if (!S.next(0, cur)) return;
    f32x4 acc[2][2][4][2];
#pragma unroll
    for (int a = 0; a < 2; ++a)
#pragma unroll
        for (int b = 0; b < 2; ++b)
#pragma unroll
            for (int m = 0; m < 4; ++m)
#pragma unroll
                for (int n = 0; n < 2; ++n) acc[a][b][m][n] = (f32x4){0.f, 0.f, 0.f, 0.f};
    bf16x8 At[4][2], B0[2][2], B1[2][2];
    const char* cA = (const char*)g.A + (size_t)cur.pm * tstepA; const char* cB = (const char*)g.Bt + (size_t)cur.pn * tstepB;
    PG8_STAGE(PG8_SB(0, 0), cB, voffB); PG8_STAGE(PG8_SA(0, 0), cA, voffA); PG8_STAGE(PG8_SB(0, 1), cB + hstepB, voffB); PG8_STAGE(PG8_SA(0, 1), cA + hstepA, voffA);
    if (wr == 1) PG8_BAR;
    PG8_WAIT_V(4); PG8_BAR;
    PG8_STAGE(PG8_SB(1, 0), cB + kstep, voffB); PG8_STAGE(PG8_SA(1, 0), cA + kstep, voffA); PG8_STAGE(PG8_SB(1, 1), cB + hstepB + kstep, voffB);
    PG8_WAIT_V(6); PG8_BAR;
    for (;;) {
        const bool has_next = S.next(ui + 1, nxt);
        const char* nA = has_next ? (const char*)g.A + (size_t)nxt.pm * tstepA : cA; const char* nB = has_next ? (const char*)g.Bt + (size_t)nxt.pn * tstepB : cB;
        if constexpr (Epi::MIDK) {
            PG8_KLOOP(0, 4)
            E.template mid<0>(acc, cur, wr, wc, fr, fq);
            PG8_KLOOP(4, 8)
            E.template mid<1>(acc, cur, wr, wc, fr, fq);
            PG8_KLOOP(8, nt)
        } else {
            PG8_KLOOP(0, nt)
        }
        E(acc, cur, wr, wc, fr, fq);
        if (!has_next) break;
#pragma unroll
        for (int a = 0; a < 2; ++a)
#pragma unroll
            for (int b = 0; b < 2; ++b)
#pragma unroll
                for (int m = 0; m < 4; ++m)
#pragma unroll
                    for (int n = 0; n < 2; ++n) acc[a][b][m][n] = (f32x4){0.f, 0.f, 0.f, 0.f};
        cur = nxt; cA = nA; cB = nB; ++ui;
    }
    PG8_WAIT_V(0);
    if (wr == 0) PG8_BAR;
    PG8_BAR;
#undef PG8_KLOOP
#undef PG8_SA
#undef PG8_SB
#undef PG8_STAGE
#undef PG8_LDA
#undef PG8_LDB
#undef PG8_MMA
#undef PG8_WAIT_V
#undef PG8_WAIT_L
#undef PG8_BAR
#undef PG8_SCHED
}

struct EpiSwiglu {
    static constexpr bool PERM = true, MIDK = false;
    bf16_t* O;
    __device__ __forceinline__ void operator()(const f32x4 (&acc)[2][2][4][2], const Unit& u, int wr, int wc, int fr, int fq) const {
        const int row0 = u.pm * BM + wr * 64 + fr, col0 = u.pn * 128 + wc * 32 + 8 * fq;
#pragma unroll
        for (int ai = 0; ai < 2; ++ai)
#pragma unroll
            for (int m = 0; m < 4; ++m) {
                float h[8];
#pragma unroll
                for (int n = 0; n < 2; ++n)
#pragma unroll
                    for (int j = 0; j < 4; ++j) h[n * 4 + j] = siluf_(acc[ai][0][m][n][j]) * acc[ai][1][m][n][j];
                *(u32x4*)(O + (size_t)(row0 + ai * HALF + m * 16) * DFF + col0) = pack8(h);
            }
    }
};
struct EpiBf16 {
    static constexpr bool PERM = true, MIDK = false;
    bf16_t* O; int ldc; const float* bias; int bias_col0;
    __device__ __forceinline__ void operator()(const f32x4 (&acc)[2][2][4][2], const Unit& u, int wr, int wc, int fr, int fq) const {
        const int row0 = u.pm * BM + wr * 64 + fr, col0 = u.pn * BM + wc * 32 + 8 * fq;
        const bool hb = (u.pn * BM >= bias_col0);
        f32x4 bv[2][2];
#pragma unroll
        for (int bj = 0; bj < 2; ++bj)
#pragma unroll
            for (int n = 0; n < 2; ++n) bv[bj][n] = hb ? *(const f32x4*)(bias + (col0 - bias_col0) + bj * HALF + 4 * n) : (f32x4){0.f, 0.f, 0.f, 0.f};
#pragma unroll
        for (int ai = 0; ai < 2; ++ai)
#pragma unroll
            for (int m = 0; m < 4; ++m) { bf16_t* rowp = O + (size_t)(row0 + ai * HALF + m * 16) * ldc + col0;
#pragma unroll
                for (int bj = 0; bj < 2; ++bj) { f32x4 v0 = acc[ai][bj][m][0] + bv[bj][0], v1 = acc[ai][bj][m][1] + bv[bj][1];
                    if (hb) {
#pragma unroll
                        for (int j = 0; j < 4; ++j) { v0[j] = 1.0f + fast_exp2(-fminf(fmaxf(v0[j], -30.f), 30.f) * LOG2E); v1[j] = 1.0f + fast_exp2(-fminf(fmaxf(v1[j], -30.f), 30.f) * LOG2E); } }
                    u32x4 w; w.x = cvt_pk_bf16(v0[0], v0[1]); w.y = cvt_pk_bf16(v0[2], v0[3]); w.z = cvt_pk_bf16(v1[0], v1[1]); w.w = cvt_pk_bf16(v1[2], v1[3]);
                    *(u32x4*)(rowp + bj * HALF) = w; } }
    }
};
struct EpiResid {
    static constexpr bool PERM = true, MIDK = false;
    const float* x_lat; const float* x_ctx; bf16_t* hbuf; float* out; const float* mod; int gate_idx; float gscale; int tile0; int mode;
    template <int MODE> __device__ __forceinline__ void body(const f32x4 (&acc)[2][2][4][2], const Unit& u, int wr, int wc, int fr, int fq) const {
        const int urow0 = (tile0 + u.pm) * BM;
        const RowMap rm = map_row(urow0);
        const float* gp = mod + (size_t)rm.modrow * (NMOD * D) + gate_idx * D;
        const int rloc = wr * 64 + fr, col0 = u.pn * BM + wc * 32 + 8 * fq;
        const float* xs = (rm.is_ctx ? x_ctx : x_lat) + rm.row0 * D + col0;
        bf16_t* hb = hbuf + (size_t)urow0 * D + col0;
        float* ob = out + rm.row0 * D + col0;
        const bool st_ok = (MODE != 2) || !rm.is_ctx;
        constexpr int MG = (MODE == 0) ? 2 : 4;
#pragma unroll
        for (int bj = 0; bj < 2; ++bj) {
            const f32x4 g0 = *(const f32x4*)(gp + col0 + bj * HALF) * gscale, g1 = *(const f32x4*)(gp + col0 + bj * HALF + 4) * gscale;
#pragma unroll
            for (int ai = 0; ai < 2; ++ai)
#pragma unroll
                for (int mg = 0; mg < 4; mg += MG) {
                    f32x4 xf[MODE == 0 ? MG : 1][2]; u32x4 xw[MODE == 0 ? 1 : MG];
#pragma unroll
                    for (int mm = 0; mm < MG; ++mm) { const size_t ro = (size_t)(rloc + ai * HALF + (mg + mm) * 16) * D + bj * HALF;
                        if constexpr (MODE == 0) { xf[mm][0] = *(const f32x4*)(xs + ro); xf[mm][1] = *(const f32x4*)(xs + ro + 4); }
                        else xw[mm] = *(const u32x4*)(hb + ro); }
                    __builtin_amdgcn_sched_barrier(0);
#pragma unroll
                    for (int mm = 0; mm < MG; ++mm) { const int m = mg + mm; const size_t ro = (size_t)(rloc + ai * HALF + m * 16) * D + bj * HALF;
                        f32x4 x0, x1;
                        if constexpr (MODE == 0) { x0 = xf[mm][0]; x1 = xf[mm][1]; }
                        else { const u32x4 w = xw[mm]; x0 = (f32x4){bf_lo(w.x), bf_hi(w.x), bf_lo(w.y), bf_hi(w.y)}; x1 = (f32x4){bf_lo(w.z), bf_hi(w.z), bf_lo(w.w), bf_hi(w.w)}; }
                        const f32x4 y0 = x0 + g0 * acc[ai][bj][m][0], y1 = x1 + g1 * acc[ai][bj][m][1];
                        if constexpr (MODE == 2) { if (st_ok) { *(f32x4*)(ob + ro) = y0; *(f32x4*)(ob + ro + 4) = y1; } }
                        else { u32x4 w; w.x = cvt_pk_bf16(y0[0], y0[1]); w.y = cvt_pk_bf16(y0[2], y0[3]); w.z = cvt_pk_bf16(y1[0], y1[1]); w.w = cvt_pk_bf16(y1[2], y1[3]); *(u32x4*)(hb + ro) = w; }
                    }
                    __builtin_amdgcn_sched_barrier(0);
                }
        }
    }
    __device__ __forceinline__ void operator()(const f32x4 (&acc)[2][2][4][2], const Unit& u, int wr, int wc, int fr, int fq) const {
        if (mode == 1) body<1>(acc, u, wr, wc, fr, fq);
        else if (mode == 0) body<0>(acc, u, wr, wc, fr, fq);
        else body<2>(acc, u, wr, wc, fr, fq);
    }
};
struct EpiBranch {
    static constexpr bool PERM = true, MIDK = true;
    bf16_t* P;
    __device__ __forceinline__ u32x4 ld_raw(unsigned off) const { return *(const u32x4*)((const char*)P + (size_t)off * 2u); }
    __device__ __forceinline__ void to_e(const u32x4 w, float (&e)[8]) const { unpack8(w, e); }
    template <int WHICH> __device__ __forceinline__ void mid(f32x4 (&acc)[2][2][4][2], const Unit& u, int wr, int wc, int fr, int fq) const {
        unsigned base = (unsigned)(u.pm * BM + wr * 64 + fr) * PROJ + (unsigned)(u.pn * BM + wc * 32 + 8 * fq) + OFF_GATE + WHICH * D;
        asm volatile("" : "+v"(base));
#pragma unroll
        for (int ai = 0; ai < 2; ++ai)
#pragma unroll
            for (int mp = 0; mp < 2; ++mp) {
                u32x4 wa[2][2], wb[2][2];
#pragma unroll
                for (int mm = 0; mm < 2; ++mm)
#pragma unroll
                    for (int bj = 0; bj < 2; ++bj) { const unsigned o = base + (unsigned)(ai * HALF + (mp * 2 + mm) * 16) * PROJ + bj * HALF; wa[mm][bj] = ld_raw(o); wb[mm][bj] = ld_raw(o + D); }
                __builtin_amdgcn_sched_barrier(0);
#pragma unroll
                for (int mm = 0; mm < 2; ++mm)
#pragma unroll
                    for (int bj = 0; bj < 2; ++bj) { float ea[8], eb[8]; to_e(wa[mm][bj], ea); to_e(wb[mm][bj], eb);
#pragma unroll
                        for (int n = 0; n < 2; ++n)
#pragma unroll
                            for (int j = 0; j < 4; ++j) acc[ai][bj][mp * 2 + mm][n][j] *= eb[n * 4 + j] * fast_rcp(ea[n * 4 + j]); }
                __builtin_amdgcn_sched_barrier(0);
            }
    }
    __device__ __forceinline__ void operator()(const f32x4 (&acc)[2][2][4][2], const Unit& u, int wr, int wc, int fr, int fq) const {
        unsigned base = (unsigned)(u.pm * BM + wr * 64 + fr) * PROJ + (unsigned)(u.pn * BM + wc * 32 + 8 * fq);
        asm volatile("" : "+v"(base));
#pragma unroll
        for (int ai = 0; ai < 2; ++ai) {
            u32x4 w2[4][2];
#pragma unroll
            for (int m = 0; m < 4; ++m)
#pragma unroll
                for (int bj = 0; bj < 2; ++bj) w2[m][bj] = ld_raw(base + (unsigned)(ai * HALF + m * 16) * PROJ + bj * HALF + OFF_GATE + 2 * D);
            __builtin_amdgcn_sched_barrier(0);
#pragma unroll
            for (int m = 0; m < 4; ++m)
#pragma unroll
                for (int bj = 0; bj < 2; ++bj) { const unsigned o = base + (unsigned)(ai * HALF + m * 16) * PROJ + bj * HALF;
                    float e2[8], ov[8]; to_e(w2[m][bj], e2);
#pragma unroll
                    for (int n = 0; n < 2; ++n)
#pragma unroll
                        for (int j = 0; j < 4; ++j) ov[n * 4 + j] = acc[ai][bj][m][n][j] * fast_rcp(e2[n * 4 + j]);
                    *(u32x4*)((char*)P + (size_t)o * 2u) = pack8(ov); }
            __builtin_amdgcn_sched_barrier(0);
        }
    }
};
}

__device__ __forceinline__ void tr_job(LAS float* tl, const float* src, int ld_src, int K, int Nout, bf16_t* dst, int ld_dst, int dkofs, int mode) {
    const int tid = tid_opaque();
    const int nkt = K / 64, ntl = nkt * (Nout / 64), G = gridDim.x;
    const int ln = tid & 63, lk = tid >> 6, sk2 = (tid & 31) * 2, sn = tid >> 5;
    float r[8];
    int t = bid_opaque();
    auto src_ptr = [&](int tt) -> const float* {
        const int kt = tt % nkt, n0 = (tt / nkt) * 64; int c0 = n0;
        if (mode == 1) { const int pn = n0 >> 8, rr = n0 & 255; c0 = (rr < 128) ? pn * 128 + rr : DFF + pn * 128 + (rr - 128); }
        return src + (size_t)(kt * 64 + lk) * ld_src + c0 + ln; };
    if (t < ntl) { const float* sp = src_ptr(t);
#pragma unroll
        for (int i = 0; i < 8; ++i) r[i] = sp[(size_t)(8 * i) * ld_src]; }
    for (; t < ntl; t += G) {
#pragma unroll
        for (int i = 0; i < 8; ++i) tl[(lk + 8 * i) * 65 + ln] = r[i];
        __syncthreads();
        if (t + G < ntl) { const float* sp = src_ptr(t + G);
#pragma unroll
            for (int i = 0; i < 8; ++i) r[i] = sp[(size_t)(8 * i) * ld_src]; }
        { const int kt = t % nkt, n0 = (t / nkt) * 64;
#pragma unroll
          for (int i = 0; i < 4; ++i) { const int n = sn + 16 * i; *(unsigned*)(dst + (size_t)(n0 + n) * ld_dst + dkofs + kt * 64 + sk2) = cvt_pk_bf16(tl[sk2 * 65 + n], tl[(sk2 + 1) * 65 + n]); } }
        __syncthreads();
    }
}

__device__ void phase_setup(const Params& p, LAS unsigned char* lds) {
    const int tid = tid_opaque(), wid = tid >> 6, lane = tid & 63;
    bf16_t* WT = (bf16_t*)(p.ws + WS_WT);
    LAS float* tl = (LAS float*)lds;
    for (int l = 0; l < NL; ++l) {
        bf16_t* W = WT + (size_t)l * W_LAYER;
        for (int j = 0; j < 2; ++j) {
            tr_job(tl, p.in[I_FFNIN] + ((size_t)l * 2 + j) * D * (2 * DFF), 2 * DFF, D, 2 * DFF, W + (j ? W_FIN1 : W_FIN0), D, 0, 1);
            tr_job(tl, p.in[I_FFNOUT] + ((size_t)l * 2 + j) * DFF * D, D, DFF, D, W + (j ? W_FOUT1 : W_FOUT0), DFF, 0, 0);
        }
        tr_job(tl, p.in[I_WIN] + (size_t)l * D * PROJ, PROJ, D, PROJ, W + W_WIN, D, 0, 0);
        tr_job(tl, p.in[I_WBC] + (size_t)l * 256 * D, D, 256, D, W + W_WB, D, 0, 0);
        tr_job(tl, p.in[I_WBG] + (size_t)l * 256 * D, D, 256, D, W + W_WB, D, 256, 0);
        tr_job(tl, p.in[I_WBA] + (size_t)l * 512 * D, D, 512, D, W + W_WB, D, 512, 0);
        tr_job(tl, p.in[I_WOUT] + (size_t)l * D * D, D, D, D, W + W_WO, D, 0, 0);
        for (int i = bid_opaque() * 512 + tid; i < 65536 / 2; i += gridDim.x * 512) {
            const float2 v = *(const float2*)(p.in[I_GWS] + (size_t)l * 65536 + 2 * i);
            *(unsigned*)(W + W_GWS + 2 * i) = cvt_pk_bf16(v.x, v.y);
        }
    }
    { const int gi = bid_opaque() * 512 + tid;
      if (gi < 1024) { const int pos = gi >> 4, i = gi & 15;
        const int i4 = i & 3, i16 = i >> 2;
        float inv = (i4 == 0) ? 1.0f : (i4 == 1) ? 0.5623413251903491f : (i4 == 2) ? 0.31622776601683794f : 0.1778279410038923f;
        inv *= (i16 == 0) ? 1.0f : (i16 == 1) ? 0.1f : (i16 == 2) ? 0.01f : 0.001f;
        const float a = (float)pos * inv;
        const float kq = __builtin_rintf(a * 0.6366197723675814f);
        float r = __builtin_fmaf(-kq, 1.5707963705062866f, a); r = __builtin_fmaf(kq, 4.371139000186241e-8f, r);
        const float r2 = r * r;
        const float sn = r * (1.0f + r2 * (-1.0f / 6 + r2 * (1.0f / 120 + r2 * (-1.0f / 5040 + r2 * (1.0f / 362880)))));
        const float cs = 1.0f + r2 * (-0.5f + r2 * (1.0f / 24 + r2 * (-1.0f / 720 + r2 * (1.0f / 40320 + r2 * (-1.0f / 3628800)))));
        const int q = ((int)kq) & 3;
        const float c = (q == 0) ? cs : (q == 1) ? -sn : (q == 2) ? -cs : sn;
        const float s = (q == 0) ? sn : (q == 1) ? cs : (q == 2) ? -sn : -cs;
        float2* rt = (float2*)(p.ws + WS_ROPE); rt[gi] = make_float2(c, s); } }
    if (bid_opaque() < NL * 36) {
        LAS float* sc = (LAS float*)lds;
        __syncthreads();
        for (int i = tid; i < 33 * D; i += 512) { const int r = i >> 10, k = i & 1023; const float v = (r < 32) ? p.in[I_C][r * D + k] : p.in[I_CCTX][k]; sc[i] = siluf_(v); }
        __syncthreads();
        float* MOD = (float*)(p.ws + WS_MOD);
        for (int it = bid_opaque(); it < NL * 36; it += gridDim.x) {
            const int l = it / 36, cgp = it % 36, n0 = cgp * 256 + lane * 4;
            const float* wp = p.in[I_WMOD] + (size_t)l * D * (NMOD * D) + n0;
            f32x4 a[5];
#pragma unroll
            for (int i = 0; i < 5; ++i) a[i] = (f32x4){0.f, 0.f, 0.f, 0.f};
            for (int k = 0; k < D; k += 16) {
                f32x4 w[16];
#pragma unroll
                for (int kk = 0; kk < 16; ++kk) w[kk] = *(const f32x4*)(wp + (size_t)(k + kk) * (NMOD * D));
#pragma unroll
                for (int i = 0; i < 5; ++i) { const int r = (i < 4) ? wid + 8 * i : 32;
#pragma unroll
                    for (int k4 = 0; k4 < 4; ++k4) { const f32x4 s4 = *(const LAS f32x4*)(sc + r * D + k + 4 * k4);
                        a[i] += s4[0] * w[4 * k4] + s4[1] * w[4 * k4 + 1] + s4[2] * w[4 * k4 + 2] + s4[3] * w[4 * k4 + 3]; } }
            }
            const f32x4 bv = *(const f32x4*)(p.in[I_BMOD] + (size_t)l * (NMOD * D) + n0);
#pragma unroll
            for (int i = 0; i < 5; ++i) { const int r = (i < 4) ? wid + 8 * i : 32; if (i < 4 || wid == 0) *(f32x4*)(MOD + ((size_t)l * 33 + r) * (NMOD * D) + n0) = a[i] + bv; }
        }
        __syncthreads();
    }
}

__device__ void phase_norm(const Params& p, int l, int j, bool from_inputs, bool skip_ctx) {
    const int tid = tid_opaque(), wid = tid >> 6, lane = tid & 63;
    bf16_t* A = (bf16_t*)(p.ws + WS_A);
    const bf16_t* hbuf = (const bf16_t*)(p.ws + WS_H);
    const float* MOD = (const float*)(p.ws + WS_MOD) + (size_t)l * 33 * (NMOD * D);
    const float* ng = p.in[I_NORMG] + ((size_t)l * 3 + j) * D;
    constexpr int NR = 4;
    for (int u = (bid_opaque() * 8 + wid) * NR; u < T_ALL; u += gridDim.x * 8 * NR) {
        const RowMap rm = map_row(u);
        if (skip_ctx && rm.is_ctx) continue;
        const float* sh = MOD + (size_t)rm.modrow * (NMOD * D) + (3 * j) * D; const float* sc = sh + D;
        f32x4 v[NR][4]; float ss[NR];
        if (from_inputs) { const float* x = (rm.is_ctx ? p.in[I_CTX] : p.in[I_X]) + rm.row0 * D;
#pragma unroll
            for (int rr = 0; rr < NR; ++rr)
#pragma unroll
                for (int i = 0; i < 4; ++i) v[rr][i] = *(const f32x4*)(x + rr * D + i * 256 + lane * 4);
        } else { const bf16_t* x = hbuf + (size_t)u * D;
#pragma unroll
            for (int rr = 0; rr < NR; ++rr)
#pragma unroll
                for (int i = 0; i < 4; ++i) { const u32x2 w = *(const u32x2*)(x + rr * D + i * 256 + lane * 4); v[rr][i] = (f32x4){bf_lo(w.x), bf_hi(w.x), bf_lo(w.y), bf_hi(w.y)}; }
        }
        f32x4 gm[4], s0[4];
#pragma unroll
        for (int i = 0; i < 4; ++i) { const int k = i * 256 + lane * 4; gm[i] = *(const f32x4*)(ng + k) * (*(const f32x4*)(sc + k) + 1.0f); s0[i] = *(const f32x4*)(sh + k); }
#pragma unroll
        for (int rr = 0; rr < NR; ++rr) { ss[rr] = 0.f;
#pragma unroll
            for (int i = 0; i < 4; ++i) ss[rr] += v[rr][i][0] * v[rr][i][0] + v[rr][i][1] * v[rr][i][1] + v[rr][i][2] * v[rr][i][2] + v[rr][i][3] * v[rr][i][3]; }
#pragma unroll
        for (int st = 1; st < 64; st <<= 1)
#pragma unroll
            for (int rr = 0; rr < NR; ++rr) ss[rr] += shx(ss[rr], st, lane);
#pragma unroll
        for (int rr = 0; rr < NR; ++rr) { const float rstd = rsqrtf(ss[rr] * (1.0f / D) + EPS);
#pragma unroll
            for (int i = 0; i < 4; ++i) { const int k = i * 256 + lane * 4;
                const f32x4 y = v[rr][i] * rstd * gm[i] + s0[i];
                u32x2 w; w.x = cvt_pk_bf16(y[0], y[1]); w.y = cvt_pk_bf16(y[2], y[3]);
                *(u32x2*)(A + (size_t)(u + rr) * D + k) = w; } }
    }
}

__device__ void phase_prep(const Params& p, int l, int hs, LAS unsigned char* lds) {
    const int THp = part_rows(hs), latN = part_lat(hs);
    const int tid = tid_opaque(), wid = tid >> 6, lane = tid & 63;
    bf16_t* P = (bf16_t*)(p.ws + WS_R1);
    bf16_t* VTL = (bf16_t*)(p.ws + WS_VTL); bf16_t* VTC = (bf16_t*)(p.ws + WS_VTC);
    const float* qg = p.in[I_QG] + l * 64; const float* kg = p.in[I_KG] + l * 64;
    LAS bf16_t* Vs = (LAS bf16_t*)lds;
    const LAS f32x2* rts = (const LAS f32x2*)(lds + 20480);
    __syncthreads();
    *(LAS u32x4*)(lds + 20480 + tid * 16) = *(const u32x4*)(p.ws + WS_ROPE + tid * 16);
    __syncthreads();
    const int c = lane & 7, seg = c >> 2, hf = (c >> 1) & 1, i0 = (c & 1) * 8;
    float gq[8], gk[8];
#pragma unroll
    for (int e = 0; e < 8; ++e) { gq[e] = qg[8 * c + e]; gk[e] = kg[8 * c + e]; }
    for (int it = bid_opaque(); it < THp / 64; it += gridDim.x) {
        const int v0 = it * 64; const bool lat = v0 < latN;
        const int prow = (v0 & (SEQ - 1)) >> 6;
        bf16_t* rowb = P + (size_t)(v0 + wid * 8) * PROJ;
        const int qoff = OFF_Q + (lane >> 3) * 64 + 8 * c, koff = OFF_K + ((lane >> 3) & 1) * 64 + 8 * c;
        u32x4 qr[8], kr[8]; unsigned vr[8];
#pragma unroll
        for (int i = 0; i < 8; ++i) { const bf16_t* rp = rowb + (size_t)i * PROJ; qr[i] = *(const u32x4*)(rp + qoff); kr[i] = *(const u32x4*)(rp + koff); vr[i] = *(const unsigned*)(rp + OFF_V + 2 * lane); }
#pragma unroll
        for (int i = 0; i < 8; ++i) {
            const int rl = wid * 8 + i;
            bf16_t* rowp = rowb + (size_t)i * PROJ;
            const int pp = seg ? rl : prow;
            float cs[8], sn[8];
#pragma unroll
            for (int e = 0; e < 8; ++e) { const f32x2 t2 = rts[pp * 16 + i0 + e]; cs[e] = lat ? t2[0] : 1.0f; sn[e] = lat ? t2[1] : 0.0f; }
            { float x[8]; unpack8(qr[i], x);
              float ss = 0.f;
#pragma unroll
              for (int e = 0; e < 8; ++e) ss += x[e] * x[e];
              ss += shx(ss, 1, lane); ss += shx(ss, 2, lane); ss += shx(ss, 4, lane);
              const float rstd = rsqrtf(ss * (1.0f / 64) + EPS); float o[8];
#pragma unroll
              for (int e = 0; e < 8; ++e) { const float y = x[e] * rstd * gq[e]; const float yp = shx(y, 2, lane);
                  o[e] = (hf ? (y * cs[e] + yp * sn[e]) : (y * cs[e] - yp * sn[e])) * (0.125f * LOG2E); }
              *(u32x4*)(rowp + qoff) = pack8(o); }
            { float x[8]; unpack8(kr[i], x);
              float ss = 0.f;
#pragma unroll
              for (int e = 0; e < 8; ++e) ss += x[e] * x[e];
              ss += shx(ss, 1, lane); ss += shx(ss, 2, lane); ss += shx(ss, 4, lane);
              const float rstd = rsqrtf(ss * (1.0f / 64) + EPS); float o[8];
#pragma unroll
              for (int e = 0; e < 8; ++e) { const float y = x[e] * rstd * gk[e]; const float yp = shx(y, 2, lane);
                  o[e] = hf ? (y * cs[e] + yp * sn[e]) : (y * cs[e] - yp * sn[e]); }
              if (lane < 16) *(u32x4*)(rowp + koff) = pack8(o); }
            { const unsigned w = vr[i];
              Vs[(2 * lane) * 72 + rl] = (bf16_t)(w & 0xffffu); Vs[(2 * lane + 1) * 72 + rl] = (bf16_t)(w >> 16); }
        }
        __syncthreads();
        { const int hd = tid >> 2, ch = tid & 3;
          bf16_t* dst;
          if (lat) { const int bl = v0 >> 11, pos0 = v0 & (SEQ - 1); dst = VTL + ((size_t)bl * 128 + hd) * SEQ + pos0 + ch * 16; }
          else { const int cv = v0 - latN, bl = cv >> 8, pos0 = cv & 255; dst = VTC + ((size_t)bl * 128 + hd) * CTXL + pos0 + ch * 16; }
          const u32x4 a = *(const LAS u32x4*)(Vs + hd * 72 + ch * 16), b = *(const LAS u32x4*)(Vs + hd * 72 + ch * 16 + 8);
          *(u32x4*)dst = a; *(u32x4*)(dst + 8) = b; }
        __syncthreads();
    }
}

struct KeySeg { const bf16_t* K; const bf16_t* Vt; int vstride; int ntiles; int mask; };

__device__ __forceinline__ void attn_item(const Params& p, int l, int hs, int idx) {
    const int tid = tid_opaque(), wid = __builtin_amdgcn_readfirstlane(tid >> 6), lane = tid & 63, fr = lane & 15, fq = lane >> 4;
    const bf16_t* P = (const bf16_t*)(p.ws + WS_R1);
    const bf16_t* VTL = (const bf16_t*)(p.ws + WS_VTL); const bf16_t* VTC = (const bf16_t*)(p.ws + WS_VTC);
    bf16_t* Y = (bf16_t*)(p.ws + WS_A) + (size_t)part_u0(hs) * D;
    const int latN = part_lat(hs), nli = part_nb(hs) * 32;
    int bl, qb, hk; bool lat;
    if (idx < nli) { lat = true; bl = idx >> 5; qb = (idx >> 1) & 15; hk = idx & 1; }
    else { const int j = idx - nli; lat = false; bl = j >> 2; qb = (j >> 1) & 1; hk = j & 1; }
    const int g = wid >> 1, r0 = (wid & 1) * 64, head = hk * 4 + g;
    const int qrow0 = lat ? bl * SEQ + qb * 128 : latN + bl * CTXL + qb * 128;
    const int crow0 = latN + bl * CTXL;
    bf16x8 qf[4][2];
    { const bf16_t* qp = P + (size_t)(qrow0 + r0 + fr) * PROJ + OFF_Q + head * 64 + fq * 8;
#pragma unroll
      for (int nq = 0; nq < 4; ++nq)
#pragma unroll
          for (int ks = 0; ks < 2; ++ks) qf[nq][ks] = *(const bf16x8*)(qp + (size_t)nq * 16 * PROJ + ks * 32); }
    f32x4 o[4][4];
#pragma unroll
    for (int a = 0; a < 4; ++a)
#pragma unroll
        for (int b = 0; b < 4; ++b) o[a][b] = (f32x4){0.f, 0.f, 0.f, 0.f};
    const float snk = p.in[I_SINK][l * 8 + head] * LOG2E;
    float mrun[4], lrun[4];
#pragma unroll
    for (int nq = 0; nq < 4; ++nq) { mrun[nq] = snk; lrun[nq] = (fq == 0) ? 1.0f : 0.0f; }

    int lo = 0, nb = 0;
    if (lat) { lo = (qb == 0) ? 4 : (r0 >> 5); const int hi = (qb == 15) ? 8 : (r0 == 0 ? 10 : 12); nb = hi - lo; }
    const int ntot = nb + 8;
    const char* kband = (const char*)(P + (ptrdiff_t)(bl * SEQ + (qb - 1) * 128 + lo * 32) * PROJ + OFF_K + hk * 64);
    const char* kctx = (const char*)(P + (size_t)crow0 * PROJ + OFF_K + hk * 64);
    const char* vband = (const char*)(VTL + ((size_t)bl * 2 + hk) * 64 * SEQ + (ptrdiff_t)((qb - 1) * 128 + lo * 32));
    const char* vctx = (const char*)(VTC + ((size_t)bl * 2 + hk) * 64 * CTXL);
    const unsigned klane = (unsigned)(fr * PROJ + fq * 8) * 2u, vlane_b = (unsigned)(fr * SEQ + fq * 4) * 2u, vlane_c = (unsigned)(fr * CTXL + fq * 4) * 2u;
#define ATT_LOAD(i_, KF, VLO, VHI) do { const int _i = (i_); \
        if (_i < nb) { const char* _kp = kband + (size_t)_i * (32 * PROJ * 2); const char* _vp = vband + _i * 64; \
            _Pragma("unroll") for (int kb = 0; kb < 2; ++kb) _Pragma("unroll") for (int ks = 0; ks < 2; ++ks) KF[kb][ks] = *(const bf16x8*)(_kp + kb * (16 * PROJ * 2) + ks * 64 + klane); \
            _Pragma("unroll") for (int db = 0; db < 4; ++db) { VLO[db] = *(const bf16x4*)(_vp + db * (16 * SEQ * 2) + vlane_b); VHI[db] = *(const bf16x4*)(_vp + db * (16 * SEQ * 2) + 32 + vlane_b); } \
        } else { const char* _kp = kctx + (size_t)(_i - nb) * (32 * PROJ * 2); const char* _vp = vctx + (_i - nb) * 64; \
            _Pragma("unroll") for (int kb = 0; kb < 2; ++kb) _Pragma("unroll") for (int ks = 0; ks < 2; ++ks) KF[kb][ks] = *(const bf16x8*)(_kp + kb * (16 * PROJ * 2) + ks * 64 + klane); \
            _Pragma("unroll") for (int db = 0; db < 4; ++db) { VLO[db] = *(const bf16x4*)(_vp + db * (16 * CTXL * 2) + vlane_c); VHI[db] = *(const bf16x4*)(_vp + db * (16 * CTXL * 2) + 32 + vlane_c); } } } while (0)
#define ATT_COMPUTE(i_, KF, VLO, VHI) do { const int _ci = (i_); const int bt = lo + _ci; const bool mask = (_ci < nb) && (bt < 4 || bt >= 8); \
        f32x4 s[2][4]; \
        _Pragma("unroll") for (int kb = 0; kb < 2; ++kb) _Pragma("unroll") for (int nq = 0; nq < 4; ++nq) { \
            s[kb][nq] = __builtin_amdgcn_mfma_f32_16x16x32_bf16(KF[kb][0], qf[nq][0], (f32x4){0.f, 0.f, 0.f, 0.f}, 0, 0, 0); \
            s[kb][nq] = __builtin_amdgcn_mfma_f32_16x16x32_bf16(KF[kb][1], qf[nq][1], s[kb][nq], 0, 0, 0); } \
        if (mask) { \
            _Pragma("unroll") for (int kb = 0; kb < 2; ++kb) _Pragma("unroll") for (int nq = 0; nq < 4; ++nq) _Pragma("unroll") for (int j = 0; j < 4; ++j) { \
                const int dlt = (bt * 32 - 128 + kb * 16 + fq * 4 + j) - (r0 + nq * 16 + fr); if (dlt > 128 || dlt < -128) s[kb][nq][j] = -1e30f; } } \
        bf16x8 pf[4]; \
        _Pragma("unroll") for (int nq = 0; nq < 4; ++nq) { \
            float mx = fmaxf(fmaxf(fmaxf(s[0][nq][0], s[0][nq][1]), fmaxf(s[0][nq][2], s[0][nq][3])), fmaxf(fmaxf(s[1][nq][0], s[1][nq][1]), fmaxf(s[1][nq][2], s[1][nq][3]))); \
            mx = fmaxf(mx, shx(mx, 16, lane)); mx = fmaxf(mx, shx(mx, 32, lane)); \
            const float mn = fmaxf(mrun[nq], mx), alpha = fast_exp2(mrun[nq] - mn); mrun[nq] = mn; \
            float pv[8], ps = 0.f; \
            _Pragma("unroll") for (int j = 0; j < 4; ++j) { pv[j] = fast_exp2(s[0][nq][j] - mn); pv[4 + j] = fast_exp2(s[1][nq][j] - mn); ps += pv[j] + pv[4 + j]; } \
            lrun[nq] = lrun[nq] * alpha + ps; \
            const u32x4 w = pack8(pv); pf[nq] = *(const bf16x8*)&w; \
            _Pragma("unroll") for (int db = 0; db < 4; ++db) o[db][nq] *= alpha; } \
        _Pragma("unroll") for (int db = 0; db < 4; ++db) { const bf16x8 vf = (bf16x8){VLO[db][0], VLO[db][1], VLO[db][2], VLO[db][3], VHI[db][0], VHI[db][1], VHI[db][2], VHI[db][3]}; \
            _Pragma("unroll") for (int nq = 0; nq < 4; ++nq) o[db][nq] = __builtin_amdgcn_mfma_f32_16x16x32_bf16(vf, pf[nq], o[db][nq], 0, 0, 0); } } while (0)
    bf16x8 kfa[2][2], kfb[2][2]; bf16x4 vla[4], vha[4], vlb[4], vhb[4];
    ATT_LOAD(0, kfa, vla, vha);
    for (int i = 0; i < ntot; i += 2) {
        const int i1 = (i + 1 < ntot) ? i + 1 : i;
        ATT_LOAD(i1, kfb, vlb, vhb);
        ATT_COMPUTE(i, kfa, vla, vha);
        const int i2 = (i + 2 < ntot) ? i + 2 : i;
        ATT_LOAD(i2, kfa, vla, vha);
        if (i + 1 < ntot) ATT_COMPUTE(i + 1, kfb, vlb, vhb);
    }
#undef ATT_LOAD
#undef ATT_COMPUTE
#pragma unroll
    for (int nq = 0; nq < 4; ++nq) {
        float lt = lrun[nq]; lt += shx(lt, 16, lane); lt += shx(lt, 32, lane);
        const float inv = 1.0f / lt;
        bf16_t* yp = Y + (size_t)(qrow0 + r0 + nq * 16 + fr) * D + 512 + head * 64 + fq * 4;
#pragma unroll
        for (int db = 0; db < 4; ++db) { u32x2 w; w.x = cvt_pk_bf16(o[db][nq][0] * inv, o[db][nq][1] * inv); w.y = cvt_pk_bf16(o[db][nq][2] * inv, o[db][nq][3] * inv);
            *(u32x2*)(yp + db * 16) = w; }
    }
}

__device__ __forceinline__ void gmlp_conv_item(const Params& p, int l, int hs, int chunk, LAS unsigned char* lds) {
    const int tid = tid_opaque(), wid = tid >> 6, lane = tid & 63, fr = lane & 15, fq = lane >> 4;
    const bf16_t* P = (const bf16_t*)(p.ws + WS_R1);
    bf16_t* Y = (bf16_t*)(p.ws + WS_A) + (size_t)part_u0(hs) * D;
    const int v0 = chunk * 128, latN = part_lat(hs);
    LAS bf16_t* vT = (LAS bf16_t*)lds;
    { const float* cw = p.in[I_CONVW] + (size_t)l * 3 * 256;
      const bool lat = v0 < latN;
#pragma unroll 2
      for (int i = 0; i < 8; ++i) {
          const int id = i * 512 + tid, pt = id >> 5, cc = (id & 31) * 8, v = v0 + pt;
          const int pos = lat ? (v & (SEQ - 1)) : ((v - latN) & (CTXL - 1)), n = lat ? SEQ : CTXL;
          const bf16_t* rp = P + (size_t)v * PROJ + cc;
          float bv[8], c1[8], h1[8], acc[8];
          unpack8(*(const u32x4*)(rp + OFF_CB), bv); unpack8(*(const u32x4*)(rp + OFF_CC), c1); unpack8(*(const u32x4*)(rp + OFF_CH), h1);
          { const f32x4 wa = *(const f32x4*)(cw + 256 + cc), wb = *(const f32x4*)(cw + 256 + cc + 4);
#pragma unroll
            for (int e = 0; e < 8; ++e) acc[e] = c1[e] * h1[e] * (e < 4 ? wa[e & 3] : wb[e & 3]); }
          if (pos > 0) { float c0[8], h0[8]; unpack8(*(const u32x4*)(rp - PROJ + OFF_CC), c0); unpack8(*(const u32x4*)(rp - PROJ + OFF_CH), h0);
              const f32x4 wa = *(const f32x4*)(cw + cc), wb = *(const f32x4*)(cw + cc + 4);
#pragma unroll
              for (int e = 0; e < 8; ++e) acc[e] += c0[e] * h0[e] * (e < 4 ? wa[e & 3] : wb[e & 3]); }
          if (pos < n - 1) { float c2[8], h2[8]; unpack8(*(const u32x4*)(rp + PROJ + OFF_CC), c2); unpack8(*(const u32x4*)(rp + PROJ + OFF_CH), h2);
              const f32x4 wa = *(const f32x4*)(cw + 512 + cc), wb = *(const f32x4*)(cw + 512 + cc + 4);
#pragma unroll
              for (int e = 0; e < 8; ++e) acc[e] += c2[e] * h2[e] * (e < 4 ? wa[e & 3] : wb[e & 3]); }
#pragma unroll
          for (int e = 0; e < 8; ++e) acc[e] *= bv[e];
          *(u32x4*)(Y + (size_t)v * D + cc) = pack8(acc);
      } }
    { const float* lg = p.in[I_LNG] + l * 256 + 4 * lane; const float* lb = p.in[I_LNB] + l * 256 + 4 * lane;
      const f32x4 g4 = *(const f32x4*)lg, b4 = *(const f32x4*)lb;
#pragma unroll
      for (int hb = 0; hb < 2; ++hb) {
          u32x2 w[8]; float x[8][4], sm[8], qv[8];
#pragma unroll
          for (int i = 0; i < 8; ++i) w[i] = *(const u32x2*)(P + (size_t)(v0 + wid * 16 + hb * 8 + i) * PROJ + OFF_GV + 4 * lane);
#pragma unroll
          for (int i = 0; i < 8; ++i) { x[i][0] = gelu_tanh(bf_lo(w[i].x)); x[i][1] = gelu_tanh(bf_hi(w[i].x)); x[i][2] = gelu_tanh(bf_lo(w[i].y)); x[i][3] = gelu_tanh(bf_hi(w[i].y));
              sm[i] = (x[i][0] + x[i][1]) + (x[i][2] + x[i][3]); }
#pragma unroll
          for (int st = 1; st < 64; st <<= 1)
#pragma unroll
              for (int i = 0; i < 8; ++i) sm[i] += shx(sm[i], st, lane);
#pragma unroll
          for (int i = 0; i < 8; ++i) { const float mu = sm[i] * (1.0f / 256); float q = 0.f;
#pragma unroll
              for (int e = 0; e < 4; ++e) { x[i][e] -= mu; q += x[i][e] * x[i][e]; }
              qv[i] = q; }
#pragma unroll
          for (int st = 1; st < 64; st <<= 1)
#pragma unroll
              for (int i = 0; i < 8; ++i) qv[i] += shx(qv[i], st, lane);
#pragma unroll
          for (int i = 0; i < 8; ++i) { const float rstd = rsqrtf(qv[i] * (1.0f / 256) + EPS); const int pt = wid * 16 + hb * 8 + i;
#pragma unroll
              for (int e = 0; e < 4; ++e) { const float y = x[i][e] * rstd * g4[e] + b4[e]; vT[(4 * lane + e) * 136 + pt] = (bf16_t)(cvt_pk_bf16(y, 0.f) & 0xffffu); } }
      } }
    __syncthreads();
    { const int g = wid >> 1, ph = wid & 1;
      const bf16_t* wsb = (const bf16_t*)(p.ws + WS_WT) + (size_t)l * W_LAYER + W_GWS + (size_t)g * 128 * 128;
      f32x4 acc[4][4];
#pragma unroll
      for (int a = 0; a < 4; ++a)
#pragma unroll
          for (int b = 0; b < 4; ++b) acc[a][b] = (f32x4){0.f, 0.f, 0.f, 0.f};
#pragma unroll
      for (int kk = 0; kk < 4; ++kk) {
          bf16x8 af[4], bfr[4];
#pragma unroll
          for (int db = 0; db < 4; ++db) af[db] = *(const LAS bf16x8*)(vT + (g * 64 + db * 16 + fr) * 136 + kk * 32 + fq * 8);
#pragma unroll
          for (int pb = 0; pb < 4; ++pb) bfr[pb] = *(const bf16x8*)(wsb + (size_t)((ph * 4 + pb) * 16 + fr) * 128 + kk * 32 + fq * 8);
#pragma unroll
          for (int db = 0; db < 4; ++db)
#pragma unroll
              for (int pb = 0; pb < 4; ++pb) acc[db][pb] = __builtin_amdgcn_mfma_f32_16x16x32_bf16(af[db], bfr[pb], acc[db][pb], 0, 0, 0);
      }
      const float* bs = p.in[I_GBS] + (size_t)l * 512 + g * 128;
      u32x2 uw[4][4]; float bias[4];
#pragma unroll
      for (int pb = 0; pb < 4; ++pb) { const int pt = (ph * 4 + pb) * 16 + fr; bias[pb] = bs[pt];
          const bf16_t* up = P + (size_t)(v0 + pt) * PROJ + OFF_GU + g * 64 + fq * 4;
#pragma unroll
          for (int db = 0; db < 4; ++db) uw[pb][db] = *(const u32x2*)(up + db * 16); }
#pragma unroll
      for (int pb = 0; pb < 4; ++pb) { const int pt = (ph * 4 + pb) * 16 + fr;
          bf16_t* yp = Y + (size_t)(v0 + pt) * D + 256 + g * 64 + fq * 4;
#pragma unroll
          for (int db = 0; db < 4; ++db) { const u32x2 w = uw[pb][db];
              const float y0 = gelu_tanh(bf_lo(w.x)) * (acc[db][pb][0] + bias[pb]), y1 = gelu_tanh(bf_hi(w.x)) * (acc[db][pb][1] + bias[pb]);
              const float y2 = gelu_tanh(bf_lo(w.y)) * (acc[db][pb][2] + bias[pb]), y3 = gelu_tanh(bf_hi(w.y)) * (acc[db][pb][3] + bias[pb]);
              u32x2 ov; ov.x = cvt_pk_bf16(y0, y1); ov.y = cvt_pk_bf16(y2, y3); *(u32x2*)(yp + db * 16) = ov; } } }
    __syncthreads();
}

__device__ void phase_mixers(const Params& p, int l, int hs, LAS unsigned char* lds, bool skip_ctx) {
    const int n_attn = part_nb(hs) * (skip_ctx ? 32 : 36), n_gmlp = (skip_ctx ? part_lat(hs) : part_rows(hs)) / 128;
#ifndef SKIP_ATTN
    for (int it = bid_opaque(); it < n_attn; it += gridDim.x) attn_item(p, l, hs, it);
#endif
    __builtin_amdgcn_sched_barrier(0);
#ifndef SKIP_GMLP
    { const int G = (int)gridDim.x; int n3 = n_attn - 2 * G; n3 = n3 < 0 ? 0 : n3 % G;
      for (int it = (bid_opaque() - n3 + G) % G; it < n_gmlp; it += G) gmlp_conv_item(p, l, hs, it, lds); }
#endif
}

#define XB_TMO      128
#define XB_XCNT(j)  (256  + 64 * (j))
#define XB_XSUB(j)  (1280 + 64 * (j))
#define XB_XGEN(j)  (2304 + 64 * (j))
#define XB_TOP      3328
#define XB_TOPGEN   3392
#define XCD_BAR_WORDS 3456
#define XB_SPIN_CAP (1u << 22)
__device__ __forceinline__ unsigned xb_ld(unsigned* p)              { return __hip_atomic_load(p, __ATOMIC_RELAXED, __HIP_MEMORY_SCOPE_AGENT); }
__device__ __forceinline__ unsigned xb_add(unsigned* p, unsigned v) { return __hip_atomic_fetch_add(p, v, __ATOMIC_RELAXED, __HIP_MEMORY_SCOPE_AGENT); }
__device__ __forceinline__ unsigned xb_xcc_id() { return (unsigned)__builtin_amdgcn_s_getreg((3 << 11) | 20) & 0xFu; }
#define XB_SPIN(cond, bar) do { unsigned _sp = 0; while (cond) { __builtin_amdgcn_s_sleep(1); \
    if ((++_sp & 255u) == 0u) { if (xb_ld(&(bar)[XB_TMO])) break; if (_sp > XB_SPIN_CAP) { atomicAdd(&(bar)[XB_TMO], 1u); break; } } } } while (0)
__device__ __forceinline__ void xcd_barrier_post(unsigned* bar) { if (threadIdx.x == 0) (void)xb_add(&bar[XB_XCNT(xb_xcc_id())], 1u); }
__device__ __forceinline__ void xcd_barrier_complete(unsigned* bar, unsigned x, unsigned& nloc, unsigned& nx) {
    const unsigned G = gridDim.x * gridDim.y * gridDim.z;
    unsigned sum, cnt, mine, sp = 0u;
    for (;;) {
        sum = 0u; cnt = 0u; mine = 0u;
#pragma unroll
        for (unsigned j = 0; j < 16; ++j) { const unsigned c = xb_ld(&bar[XB_XCNT(j)]); sum += c; cnt += (c > 0u) ? 1u : 0u; mine = (j == x) ? c : mine; }
        if (sum == G) break;
        __builtin_amdgcn_s_sleep(1);
        if ((++sp & 255u) == 0u) { if (xb_ld(&bar[XB_TMO])) break; if (sp > XB_SPIN_CAP) { atomicAdd(&bar[XB_TMO], 1u); break; } }
    }
    nloc = mine > 0u ? mine : 1u; nx = cnt > 0u ? cnt : 1u;
}
__device__ __forceinline__ void xcd_barrier(unsigned* bar, volatile LAS unsigned* st) {
    asm volatile("s_waitcnt vmcnt(0)" ::: "memory");
    __syncthreads();
    if (threadIdx.x == 0) {
        const unsigned x = xb_xcc_id();
        __builtin_amdgcn_s_waitcnt(0);
        unsigned nloc = st[0], nx = st[1];
        if (nloc == 0u) { xcd_barrier_complete(bar, x, nloc, nx); st[0] = nloc; st[1] = nx; }
        const unsigned old = xb_add(&bar[XB_XSUB(x)], 1u);
        const unsigned gen = old / nloc;
        if (old + 1u == (gen + 1u) * nloc) {
            __builtin_amdgcn_fence(__ATOMIC_RELEASE, "agent");
            asm volatile("s_waitcnt vmcnt(0)" ::: "memory");
            const unsigned og = xb_add(&bar[XB_TOP], 1u);
            const unsigned tg = og / nx;
            if (og + 1u == (tg + 1u) * nx) xb_add(&bar[XB_TOPGEN], 1u);
            else XB_SPIN(xb_ld(&bar[XB_TOPGEN]) == tg, bar);
            __builtin_amdgcn_fence(__ATOMIC_ACQUIRE, "agent");
            xb_add(&bar[XB_XGEN(x)], 1u);
            asm volatile("s_waitcnt vmcnt(0)" ::: "memory");
        } else {
            XB_SPIN(xb_ld(&bar[XB_XGEN(x)]) == gen, bar);
            __builtin_amdgcn_fence(__ATOMIC_ACQUIRE, "agent");
            asm volatile("s_waitcnt vmcnt(0)" ::: "memory");
        }
    }
    __syncthreads();
}

__device__ void run_phase(const Params& p, int ph, LAS unsigned char* lds) {
    if (ph == 0) {
#ifndef SKIP_SETUP
 phase_setup(p, lds);
#endif
 return; }
    const int q = ph - 1, l = q / 17, r = q % 17;
    const bf16_t* W = (const bf16_t*)(p.ws + WS_WT) + (size_t)l * W_LAYER;
    const float* MOD = (const float*)(p.ws + WS_MOD) + (size_t)l * 33 * (NMOD * D);
    bf16_t* HB = (bf16_t*)(p.ws + WS_H);
    const bool first = (l == 0 && r <= 2);
    const bool lastl = (l == NL - 1);
    bf16_t* A = (bf16_t*)(p.ws + WS_A); bf16_t* R1 = (bf16_t*)(p.ws + WS_R1);
    if (r == 0 || r == 3 || r == 14) {
#ifndef SKIP_NORM
 phase_norm(p, l, r == 0 ? 0 : (r == 3 ? 1 : 2), first, lastl && r == 14);
#endif
 return; }
    if (r == 1 || r == 15) {
        const int j = (r == 1) ? 0 : 1;
        const int sk = (lastl && j == 1) ? 1 : 0;
        pg8::Gemm g{A, D, W + (j ? W_FIN1 : W_FIN0), D, sk ? T_LAT : T_ALL, 2 * DFF, D, sk};
        pg8::EpiSwiglu E{R1};
#ifndef SKIP_UP
        pg8::gemm_phase(lds, g, E);
#endif
        return;
    }
    if (r == 2 || r == 16) {
        const int j = (r == 2) ? 0 : 1;
        const int sk = (lastl && j == 1) ? 1 : 0;
        pg8::Gemm g{R1, DFF, W + (j ? W_FOUT1 : W_FOUT0), DFF, sk ? T_LAT : T_ALL, D, DFF, sk};
        pg8::EpiResid E{p.in[I_X], p.in[I_CTX], HB, p.out, MOD, j ? 8 : 2, 0.5f, 0, first ? 0 : ((l == NL - 1 && r == 16) ? 2 : 1)};
#ifndef SKIP_DOWN
        pg8::gemm_phase(lds, g, E);
#endif
        return;
    }
    const int hs = (r - 4) / 5, rr = (r - 4) % 5;
    if (rr == 0) { pg8::Gemm g{A + (size_t)part_u0(hs) * D, D, W + W_WIN, D, part_rows(hs), PROJ, D, 0}; pg8::EpiBf16 E{R1, PROJ, p.in[I_BGATE] + (size_t)l * 3 * D, OFF_GATE};
#ifndef SKIP_PROJ
 pg8::gemm_phase(lds, g, E);
#endif
 return; }
    if (rr == 1) {
#ifndef SKIP_PREP
 phase_prep(p, l, hs, lds);
#endif
 return; }
    if (rr == 2) {
#ifndef SKIP_MIX
 phase_mixers(p, l, hs, lds, lastl);
#endif
 return; }
    if (rr == 3) { pg8::Gemm g{A + (size_t)part_u0(hs) * D, D, W + W_WB, D, lastl ? part_lat(hs) : part_rows(hs), D, D, 0}; pg8::EpiBranch E{R1};
#ifndef SKIP_BRANCH
 pg8::gemm_phase(lds, g, E);
#endif
 return; }
    { pg8::Gemm g{R1, PROJ, W + W_WO, D, lastl ? part_lat(hs) : part_rows(hs), D, D, 0}; pg8::EpiResid E{p.in[I_X], p.in[I_CTX], HB, p.out, MOD, 5, 1.0f, part_u0(hs) / 256, 1};
#ifndef SKIP_OUT
 pg8::gemm_phase(lds, g, E);
#endif
 }
}

__global__ __launch_bounds__(512, 2) void fwd_megakernel(Params p) {
    extern __shared__ __attribute__((aligned(16))) unsigned char shm[];
    LAS unsigned char* lds = (LAS unsigned char*)shm;
#if MK_SINGLE
    volatile LAS unsigned* bst = (volatile LAS unsigned*)(lds + LDS_BYTES - 16);
    if (threadIdx.x == 0) { bst[0] = 0u; bst[1] = 0u; }
    __syncthreads();
    xcd_barrier_post((unsigned*)(p.ws + WS_BAR));
#endif
    for (int ph = p.ph_lo; ph < p.ph_hi; ++ph) {
#if defined(__HIP_DEVICE_COMPILE__)
        const __attribute__((address_space(4))) char* kp = (const __attribute__((address_space(4))) char*)__builtin_amdgcn_kernarg_segment_ptr();
        asm volatile("" : "+s"(kp));
        const Params lp = *(const Params*)(const char*)kp;
#else
        const Params lp = p;
#endif
        run_phase(lp, ph, lds);
#if MK_SINGLE
        if (ph + 1 < lp.ph_hi) {
            if (ph == 0) cg::this_grid().sync();
            else xcd_barrier((unsigned*)(lp.ws + WS_BAR), (volatile LAS unsigned*)(lds + LDS_BYTES - 16));
        }
#endif
    }
}

extern "C" void kernel_launch(void* const* d_in, const int* in_sizes, int n_in, void* d_out, int out_size, void* d_ws, size_t ws_size, hipStream_t stream) {
    static int grid = 0;
    if (grid == 0) {
        if (n_in != N_IN || out_size != T_LAT * D || ws_size < WS_END) { fprintf(stderr, "kernel_launch: unexpected shapes (n_in %d out %d ws %zu need %zu)\n", n_in, out_size, ws_size, (size_t)WS_END); grid = -1; return; }
        int dev = 0, cus = 0, per_cu = 0;
        (void)hipGetDevice(&dev); (void)hipDeviceGetAttribute(&cus, hipDeviceAttributeMultiprocessorCount, dev);
        if (hipFuncSetAttribute((const void*)fwd_megakernel, hipFuncAttributeMaxDynamicSharedMemorySize, LDS_BYTES) != hipSuccess) { fprintf(stderr, "kernel_launch: hipFuncSetAttribute failed\n"); grid = -1; return; }
        if (hipOccupancyMaxActiveBlocksPerMultiprocessor(&per_cu, (const void*)fwd_megakernel, 512, LDS_BYTES) != hipSuccess || per_cu < 1) { fprintf(stderr, "kernel_launch: occupancy query gave %d\n", per_cu); per_cu = 1; }
        (void)hipGetLastError();
        grid = cus * per_cu;
    }
    if (grid < 0) return;
    Params p{};
    for (int i = 0; i < N_IN; ++i) p.in[i] = (const float*)d_in[i];
    p.out = (float*)d_out; p.ws = (unsigned char*)d_ws;
#if MK_SINGLE
    p.ph_lo = 0; p.ph_hi = N_PHASES;
    if (hipMemsetAsync((char*)d_ws + WS_BAR, 0, 16384, stream) != hipSuccess) { fprintf(stderr, "kernel_launch: memset of the barrier words failed\n"); return; }
    void* args[] = {&p};
    hipError_t e = hipLaunchCooperativeKernel((const void*)fwd_megakernel, dim3(grid), dim3(512), args, LDS_BYTES, stream);
    if (e != hipSuccess) fprintf(stderr, "cooperative launch failed: %s (grid %d)\n", hipGetErrorString(e), grid);
#else
    for (int ph = 0; ph < N_PHASES; ++ph) {
        p.ph_lo = ph; p.ph_hi = ph + 1;
        hipLaunchKernelGGL(fwd_megakernel, dim3(grid), dim3(512), LDS_BYTES, stream, p);
    }
#endif
}
```

```cpp
#include <hip/hip_runtime.h>
#include <hip/hip_cooperative_groups.h>
#include <cstdio>
namespace cg = cooperative_groups;

#ifndef MK_SINGLE
#define MK_SINGLE 1
#endif

#define LAS __attribute__((address_space(3)))
typedef unsigned short bf16_t;
typedef short bf16x8 __attribute__((ext_vector_type(8)));
typedef short bf16x4 __attribute__((ext_vector_type(4)));
typedef float f32x4 __attribute__((ext_vector_type(4)));
typedef unsigned u32x4 __attribute__((ext_vector_type(4)));
typedef unsigned u32x2 __attribute__((ext_vector_type(2)));
typedef float f32x2 __attribute__((ext_vector_type(2)));

constexpr int D = 1024, NB = 32, SEQ = 2048, NL = 4, CTXL = 256, DFF = 2816, PROJ = 5120, NMOD = 9;
constexpr int T_LAT = NB * SEQ, T_CTX = NB * CTXL, T_ALL = T_LAT + T_CTX;
constexpr int NB0 = 14, NB1 = NB - NB0;
constexpr int U1 = NB0 * (SEQ + CTXL);
constexpr int TH_MAX = NB1 * (SEQ + CTXL);
__host__ __device__ __forceinline__ constexpr int part_nb(int s) { return s ? NB1 : NB0; }
__host__ __device__ __forceinline__ constexpr int part_lat(int s) { return part_nb(s) * SEQ; }
__host__ __device__ __forceinline__ constexpr int part_rows(int s) { return part_nb(s) * (SEQ + CTXL); }
__host__ __device__ __forceinline__ constexpr int part_u0(int s) { return s ? U1 : 0; }
constexpr int OFF_CB = 0, OFF_CC = 256, OFF_CH = 512, OFF_GU = 768, OFF_GV = 1024, OFF_Q = 1280, OFF_K = 1792, OFF_V = 1920, OFF_GATE = 2048;
constexpr float EPS = 1e-6f;
constexpr float LOG2E = 1.4426950408889634f;

enum { I_X = 0, I_C, I_CTX, I_CCTX, I_WMOD, I_BMOD, I_NORMG, I_FFNIN, I_FFNOUT, I_WIN, I_BGATE, I_CONVW, I_LNG, I_LNB, I_GWS, I_GBS, I_QG, I_KG, I_SINK, I_WBC, I_WBG, I_WBA, I_WOUT, N_IN };

constexpr size_t W_FIN0 = 0, W_FIN1 = 5767168, W_FOUT0 = 11534336, W_FOUT1 = 14417920, W_WIN = 17301504, W_WB = 22544384, W_WO = 23592960, W_GWS = 24641536, W_LAYER = 24707072;
constexpr size_t WS_WT = 0;
constexpr size_t WS_MOD = WS_WT + NL * W_LAYER * 2;
constexpr size_t WS_ROPE = WS_MOD + (size_t)NL * 33 * 9216 * 4;
constexpr size_t WS_HC = WS_ROPE + 8192;
constexpr size_t WS_A = WS_HC + (size_t)T_CTX * D * 4;
constexpr size_t WS_R1 = WS_A + (size_t)T_ALL * D * 2;
constexpr size_t WS_VTL = WS_R1 + (size_t)TH_MAX * PROJ * 2;
constexpr size_t WS_VTC = WS_VTL + (size_t)NB1 * 2 * 64 * 2048 * 2;
constexpr size_t WS_BAR = WS_VTC + (size_t)NB1 * 2 * 64 * 256 * 2;
constexpr size_t WS_H = WS_BAR + 16384;
constexpr size_t WS_END = WS_H + (size_t)T_ALL * D * 2;

constexpr int LDS_BYTES = 143360;
constexpr int N_PHASES = 1 + 17 * NL;

struct Params {
    const float* in[N_IN];
    float* out;
    unsigned char* ws;
    int ph_lo, ph_hi;
};

__device__ __forceinline__ unsigned cvt_pk_bf16(float lo, float hi) { unsigned r; asm volatile("v_cvt_pk_bf16_f32 %0, %1, %2" : "=v"(r) : "v"(lo), "v"(hi)); return r; }
__device__ __forceinline__ int tid_opaque() { int t = threadIdx.x; asm volatile("" : "+v"(t)); return t; }
__device__ __forceinline__ int bid_opaque() { int b = blockIdx.x; asm volatile("" : "+s"(b)); return b; }
__device__ __forceinline__ float bf_lo(unsigned w) { return __uint_as_float(w << 16); }
__device__ __forceinline__ float bf_hi(unsigned w) { return __uint_as_float(w & 0xffff0000u); }
__device__ __forceinline__ float fast_rcp(float x) { return __builtin_amdgcn_rcpf(x); }
__device__ __forceinline__ float fast_exp2(float x) { return __builtin_amdgcn_exp2f(x); }
__device__ __forceinline__ float sigmoidf_(float x) { return fast_rcp(1.0f + fast_exp2(-x * LOG2E)); }
__device__ __forceinline__ float siluf_(float x) { return x * sigmoidf_(x); }
__device__ __forceinline__ float gelu_tanh(float x) { const float z = 0.7978845608028654f * (x + 0.044715f * x * x * x); return x * sigmoidf_(2.0f * z); }
__device__ __forceinline__ float shx(float v, int m, int lane) { return __int_as_float(__builtin_amdgcn_ds_bpermute((lane ^ m) << 2, __float_as_int(v))); }
__device__ __forceinline__ float wave_sum(float v, int lane) {
    v += shx(v, 1, lane); v += shx(v, 2, lane); v += shx(v, 4, lane); v += shx(v, 8, lane); v += shx(v, 16, lane); v += shx(v, 32, lane); return v;
}
__device__ __forceinline__ void unpack8(const u32x4 w, float (&f)[8]) {
    f[0] = bf_lo(w.x); f[1] = bf_hi(w.x); f[2] = bf_lo(w.y); f[3] = bf_hi(w.y); f[4] = bf_lo(w.z); f[5] = bf_hi(w.z); f[6] = bf_lo(w.w); f[7] = bf_hi(w.w);
}
__device__ __forceinline__ u32x4 pack8(const float (&f)[8]) {
    u32x4 w; w.x = cvt_pk_bf16(f[0], f[1]); w.y = cvt_pk_bf16(f[2], f[3]); w.z = cvt_pk_bf16(f[4], f[5]); w.w = cvt_pk_bf16(f[6], f[7]); return w;
}

struct RowMap { size_t row0; int is_ctx; int modrow; };
__device__ __forceinline__ RowMap map_row(int u) {
    const int s = (u >= U1) ? 1 : 0, v = u - s * U1, latN = part_lat(s); RowMap r;
    if (v < latN) { r.row0 = (size_t)(s ? NB0 * SEQ : 0) + v; r.is_ctx = 0; r.modrow = (int)(r.row0 >> 11); }
    else { r.row0 = (size_t)(s ? NB0 * CTXL : 0) + (v - latN); r.is_ctx = 1; r.modrow = 32; }
    return r;
}

namespace pg8 {
constexpr int BM = 256, BK = 64, HALF = 128, HTB = HALF * BK * 2, STAGE_BYTES = 8 * HTB, NXCD = 8, WGM = 4;
__device__ __forceinline__ int lds_byte(int r, int c) { const int st = (r >> 4) * 2 + (c >> 5), rr = r & 15, cc = c & 31, ob = rr * 64 + cc * 2; return st * 1024 + (ob ^ (((ob >> 9) & 1) << 5)); }
__device__ __forceinline__ void stage_rc(int b, int& R, int& C) { const int st = b / 1024, sb = b % 1024, swz = sb ^ (((sb >> 9) & 1) << 5); R = (st >> 1) * 16 + swz / 64; C = (st & 1) * 32 + (swz % 64) / 2; }
__device__ __forceinline__ int perm32(int rho) { const int n = rho >> 4, i = rho & 15; return 8 * (i >> 2) + 4 * n + (i & 3); }

struct Unit { int pm, pn; };
struct Gemm { const bf16_t* A; int lda; const bf16_t* Bt; int ldb; int M, N, K; int skip_ctx; };

struct StaticOrder {
    int nM, nN, nwg, G, c, skip;
    __device__ void init(int M, int N, int G_, int c_, int skip_) { nM = M / BM; nN = N / BM; nwg = nM * nN; G = G_; c = c_; skip = skip_; }
    __device__ bool next(int i, Unit& u) const {
        const long L = (long)i * G + c; if (L >= nwg) return false;
        int wgid = (int)L; { const int q = nwg / NXCD, r = nwg % NXCD, xcd = wgid % NXCD, off = wgid / NXCD; wgid = (xcd < r ? xcd * (q + 1) : r * (q + 1) + (xcd - r) * q) + off; }
        const int nig = WGM * nN, gid = wgid / nig, fm = gid * WGM, gsz = (nM - fm) < WGM ? (nM - fm) : WGM;
        u.pm = fm + ((wgid % nig) % gsz); u.pn = (wgid % nig) / gsz; if (skip && u.pm >= NB0 * 8) u.pm += NB0; return true;
    }
};

template <class Epi>
__device__ __forceinline__ void gemm_phase(LAS unsigned char* lds, const Gemm g, const Epi& E) {
    const int tid = tid_opaque(), wid = __builtin_amdgcn_readfirstlane(tid >> 6), lane = tid & 63, wr = wid >> 2, wc = wid & 3, fr = lane & 15, fq = lane >> 4;
    const int K = g.K, nt = K / BK;
    StaticOrder S; S.init(g.M, g.N, (int)gridDim.x, bid_opaque(), g.skip_ctx);
    unsigned voffA[2], voffB[2];
#pragma unroll
    for (int i = 0; i < 2; ++i) { int R, C; stage_rc(tid * 16 + i * 8192, R, C); const int Rb = Epi::PERM ? ((R & ~31) + perm32(R & 31)) : R;
        voffA[i] = (unsigned)(R * g.lda + C) * 2u; voffB[i] = (unsigned)(Rb * g.ldb + C) * 2u; }
    const size_t kstep = (size_t)(BK * 2);
    const size_t hstepA = (size_t)HALF * g.lda * 2, hstepB = (size_t)HALF * g.ldb * 2;
    const size_t tstepA = 2 * hstepA, tstepB = 2 * hstepB;
    const unsigned ldsw = (unsigned)wid * 1024u;
    const int aoff = lds_byte(wr * 64 + fr, fq * 8), boff = lds_byte(wc * 32 + fr, fq * 8);
#define PG8_SA(b, h) (((b) * 2 + (h)) * HTB)
#define PG8_SB(b, h) ((4 + (b) * 2 + (h)) * HTB)
#define PG8_STAGE(bufoff, gbase, voff) do { _Pragma("unroll") for (int _i = 0; _i < 2; ++_i) \
        __builtin_amdgcn_global_load_lds((const unsigned*)((const char*)(gbase) + (voff)[_i]), (LAS unsigned*)(lds + (bufoff) + ldsw + _i * 8192), 16, 0, 0); } while (0)
#define PG8_LDA(dst, b, h) do { _Pragma("unroll") for (int m = 0; m < 4; ++m) _Pragma("unroll") for (int k = 0; k < 2; ++k) dst[m][k] = *(const LAS bf16x8*)(lds + PG8_SA(b, h) + aoff + m * 2048 + k * 1024); } while (0)
#define PG8_LDB(dst, b, h) do { _Pragma("unroll") for (int n = 0; n < 2; ++n) _Pragma("unroll") for (int k = 0; k < 2; ++k) dst[n][k] = *(const LAS bf16x8*)(lds + PG8_SB(b, h) + boff + n * 2048 + k * 1024); } while (0)
#define PG8_MMA(ai, bj, At, Bt) do { __builtin_amdgcn_s_setprio(1); _Pragma("unroll") for (int m = 0; m < 4; ++m) _Pragma("unroll") for (int n = 0; n < 2; ++n) _Pragma("unroll") for (int k = 0; k < 2; ++k) \
        acc[ai][bj][m][n] = __builtin_amdgcn_mfma_f32_16x16x32_bf16(Bt[n][k], At[m][k], acc[ai][bj][m][n], 0, 0, 0); __builtin_amdgcn_s_setprio(0); } while (0)
#define PG8_WAIT_V(n) asm volatile("s_waitcnt vmcnt(" #n ")" ::: "memory")
#define PG8_WAIT_L(n) asm volatile("s_waitcnt lgkmcnt(" #n ")" ::: "memory")
#define PG8_BAR __builtin_amdgcn_s_barrier()
#define PG8_SCHED __builtin_amdgcn_sched_barrier(0)
#define PG8_KLOOP(TB, TE) for (int t = (TB); t < (TE); t += 2) { \
            const bool last = (t == nt - 2); \
            const char* a1 = cA + (size_t)(t + 1) * kstep; \
            const char* a2 = last ? nA : cA + (size_t)(t + 2) * kstep; const char* b2 = last ? nB : cB + (size_t)(t + 2) * kstep; \
            const char* a3 = a2 + kstep; const char* b3 = b2 + kstep; \
            PG8_LDB(B0, 0, 0); PG8_SCHED; PG8_LDA(At, 0, 0); PG8_STAGE(PG8_SA(1, 1), a1 + hstepA, voffA); \
            PG8_WAIT_L(8); PG8_BAR; PG8_WAIT_L(0); PG8_MMA(0, 0, At, B0); PG8_BAR; PG8_SCHED; \
            PG8_LDB(B1, 0, 1); PG8_STAGE(PG8_SB(0, 0), b2, voffB); \
            PG8_BAR; PG8_WAIT_L(0); PG8_MMA(0, 1, At, B1); PG8_BAR; \
            PG8_LDA(At, 0, 1); PG8_STAGE(PG8_SA(0, 0), a2, voffA); \
            PG8_BAR; PG8_WAIT_L(0); PG8_MMA(1, 0, At, B0); PG8_BAR; PG8_SCHED; \
            PG8_STAGE(PG8_SB(0, 1), b2 + hstepB, voffB); \
            PG8_WAIT_V(6); PG8_BAR; PG8_MMA(1, 1, At, B1); PG8_BAR; \
            PG8_LDB(B0, 1, 0); PG8_SCHED; PG8_LDA(At, 1, 0); PG8_STAGE(PG8_SA(0, 1), a2 + hstepA, voffA); \
            PG8_WAIT_L(8); PG8_BAR; PG8_WAIT_L(0); PG8_MMA(0, 0, At, B0); PG8_BAR; PG8_SCHED; \
            PG8_LDB(B1, 1, 1); PG8_STAGE(PG8_SB(1, 0), b3, voffB); \
            PG8_BAR; PG8_WAIT_L(0); PG8_MMA(0, 1, At, B1); PG8_BAR; \
            PG8_LDA(At, 1, 1); PG8_STAGE(PG8_SA(1, 0), a3, voffA); \
            PG8_BAR; PG8_WAIT_L(0); PG8_MMA(1, 0, At, B0); PG8_BAR; PG8_SCHED; \
            PG8_STAGE(PG8_SB(1, 1), b3 + hstepB, voffB); \
            PG8_WAIT_V(6); PG8_BAR; PG8_MMA(1, 1, At, B1); PG8_BAR; \
        }
    Unit cur, nxt; int ui = 0;
    if (!S.next(0, cur)) return;
    f32x4 acc[2][2][4][2];
#pragma unroll
    for (int a = 0; a < 2; ++a)
#pragma unroll
        for (int b = 0; b < 2; ++b)
#pragma unroll
            for (int m = 0; m < 4; ++m)
#pragma unroll
                for (int n = 0; n < 2; ++n) acc[a][b][m][n] = (f32x4){0.f, 0.f, 0.f, 0.f};
    bf16x8 At[4][2], B0[2][2], B1[2][2];
    const char* cA = (const char*)g.A + (size_t)cur.pm * tstepA; const char* cB = (const char*)g.Bt + (size_t)cur.pn * tstepB;
    PG8_STAGE(PG8_SB(0, 0), cB, voffB); PG8_STAGE(PG8_SA(0, 0), cA, voffA); PG8_STAGE(PG8_SB(0, 1), cB + hstepB, voffB); PG8_STAGE(PG8_SA(0, 1), cA + hstepA, voffA);
    if (wr == 1) PG8_BAR;
    PG8_WAIT_V(4); PG8_BAR;
    PG8_STAGE(PG8_SB(1, 0), cB + kstep, voffB); PG8_STAGE(PG8_SA(1, 0), cA + kstep, voffA); PG8_STAGE(PG8_SB(1, 1), cB + hstepB + kstep, voffB);
    PG8_WAIT_V(6); PG8_BAR;
    for (;;) {
        const bool has_next = S.next(ui + 1, nxt);
        const char* nA = has_next ? (const char*)g.A + (size_t)nxt.pm * tstepA : cA; const char* nB = has_next ? (const char*)g.Bt + (size_t)nxt.pn * tstepB : cB;
        if constexpr (Epi::MIDK) {
            PG8_KLOOP(0, 4)
            E.template mid<0>(acc, cur, wr, wc, fr, fq);
            PG8_KLOOP(4, 8)
            E.template mid<1>(acc, cur, wr, wc, fr, fq);
            PG8_KLOOP(8, nt)
        } else {
            PG8_KLOOP(0, nt)
        }
        E(acc, cur, wr, wc, fr, fq);
        if (!has_next) break;
#pragma unroll
        for (int a = 0; a < 2; ++a)
#pragma unroll
            for (int b = 0; b < 2; ++b)
#pragma unroll
                for (int m = 0; m < 4; ++m)
#pragma unroll
                    for (int n = 0; n < 2; ++n) acc[a][b][m][n] = (f32x4){0.f, 0.f, 0.f, 0.f};
        cur = nxt; cA = nA; cB = nB; ++ui;
    }
    PG8_WAIT_V(0);
    if (wr == 0) PG8_BAR;
    PG8_BAR;
#undef PG8_KLOOP
#undef PG8_SA
#undef PG8_SB
#undef PG8_STAGE
#undef PG8_LDA
#undef PG8_LDB
#undef PG8_MMA
#undef PG8_WAIT_V
#undef PG8_WAIT_L
#undef PG8_BAR
#undef PG8_SCHED
}

struct EpiSwiglu {
    static constexpr bool PERM = true, MIDK = false;
    bf16_t* O;
    __device__ __forceinline__ void operator()(const f32x4 (&acc)[2][2][4][2], const Unit& u, int wr, int wc, int fr, int fq) const {
        const int row0 = u.pm * BM + wr * 64 + fr, col0 = u.pn * 128 + wc * 32 + 8 * fq;
#pragma unroll
        for (int ai = 0; ai < 2; ++ai)
#pragma unroll
            for (int m = 0; m < 4; ++m) {
                float h[8];
#pragma unroll
                for (int n = 0; n < 2; ++n)
#pragma unroll
                    for (int j = 0; j < 4; j += 2) {
                        const f32x2 a2 = (f32x2){acc[ai][0][m][n][j], acc[ai][0][m][n][j + 1]}, u2 = (f32x2){acc[ai][1][m][n][j], acc[ai][1][m][n][j + 1]};
                        const f32x2 t2 = a2 * (-LOG2E);
                        f32x2 d2 = (f32x2){fast_exp2(t2[0]), fast_exp2(t2[1])}; d2 = d2 + 1.0f;
                        const f32x2 r2 = (f32x2){fast_rcp(d2[0]), fast_rcp(d2[1])};
                        const f32x2 h2 = (a2 * u2) * r2;
                        h[n * 4 + j] = h2[0]; h[n * 4 + j + 1] = h2[1]; }
                *(u32x4*)(O + (size_t)(row0 + ai * HALF + m * 16) * DFF + col0) = pack8(h);
            }
    }
};
struct EpiBf16 {
    static constexpr bool PERM = true, MIDK = false;
    bf16_t* O; int ldc; const float* bias; int bias_col0;
    __device__ __forceinline__ void operator()(const f32x4 (&acc)[2][2][4][2], const Unit& u, int wr, int wc, int fr, int fq) const {
        const int row0 = u.pm * BM + wr * 64 + fr, col0 = u.pn * BM + wc * 32 + 8 * fq;
        const bool hb = (u.pn * BM >= bias_col0);
        f32x4 bv[2][2];
#pragma unroll
        for (int bj = 0; bj < 2; ++bj)
#pragma unroll
            for (int n = 0; n < 2; ++n) bv[bj][n] = hb ? *(const f32x4*)(bias + (col0 - bias_col0) + bj * HALF + 4 * n) : (f32x4){0.f, 0.f, 0.f, 0.f};
#pragma unroll
        for (int ai = 0; ai < 2; ++ai)
#pragma unroll
            for (int m = 0; m < 4; ++m) { bf16_t* rowp = O + (size_t)(row0 + ai * HALF + m * 16) * ldc + col0;
#pragma unroll
                for (int bj = 0; bj < 2; ++bj) { f32x4 v0 = acc[ai][bj][m][0] + bv[bj][0], v1 = acc[ai][bj][m][1] + bv[bj][1];
                    if (hb) {
#pragma unroll
                        for (int j = 0; j < 4; j += 2) {
                            const f32x2 c0 = (f32x2){fminf(fmaxf(v0[j], -30.f), 30.f), fminf(fmaxf(v0[j + 1], -30.f), 30.f)} * (-LOG2E);
                            const f32x2 c1 = (f32x2){fminf(fmaxf(v1[j], -30.f), 30.f), fminf(fmaxf(v1[j + 1], -30.f), 30.f)} * (-LOG2E);
                            const f32x2 e0 = (f32x2){fast_exp2(c0[0]), fast_exp2(c0[1])} + 1.0f, e1 = (f32x2){fast_exp2(c1[0]), fast_exp2(c1[1])} + 1.0f;
                            v0[j] = e0[0]; v0[j + 1] = e0[1]; v1[j] = e1[0]; v1[j + 1] = e1[1]; } }
                    u32x4 w; w.x = cvt_pk_bf16(v0[0], v0[1]); w.y = cvt_pk_bf16(v0[2], v0[3]); w.z = cvt_pk_bf16(v1[0], v1[1]); w.w = cvt_pk_bf16(v1[2], v1[3]);
                    *(u32x4*)(rowp + bj * HALF) = w; } }
    }
};
struct EpiResid {
    static constexpr bool PERM = true, MIDK = false;
    const float* x_lat; const float* x_ctx; bf16_t* hbuf; float* out; const float* mod; int gate_idx; float gscale; int tile0; int mode;
    template <int MODE> __device__ __forceinline__ void body(const f32x4 (&acc)[2][2][4][2], const Unit& u, int wr, int wc, int fr, int fq) const {
        const int urow0 = (tile0 + u.pm) * BM;
        const RowMap rm = map_row(urow0);
        const float* gp = mod + (size_t)rm.modrow * (NMOD * D) + gate_idx * D;
        const int rloc = wr * 64 + fr, col0 = u.pn * BM + wc * 32 + 8 * fq;
        const float* xs = (rm.is_ctx ? x_ctx : x_lat) + rm.row0 * D + col0;
        bf16_t* hb = hbuf + (size_t)urow0 * D + col0;
        float* ob = out + rm.row0 * D + col0;
        const bool st_ok = (MODE != 2) || !rm.is_ctx;
        constexpr int MG = (MODE == 0) ? 2 : 4;
#pragma unroll
        for (int bj = 0; bj < 2; ++bj) {
            const f32x4 g0 = *(const f32x4*)(gp + col0 + bj * HALF) * gscale, g1 = *(const f32x4*)(gp + col0 + bj * HALF + 4) * gscale;
#pragma unroll
            for (int ai = 0; ai < 2; ++ai)
#pragma unroll
                for (int mg = 0; mg < 4; mg += MG) {
                    f32x4 xf[MODE == 0 ? MG : 1][2]; u32x4 xw[MODE == 0 ? 1 : MG];
#pragma unroll
                    for (int mm = 0; mm < MG; ++mm) { const size_t ro = (size_t)(rloc + ai * HALF + (mg + mm) * 16) * D + bj * HALF;
                        if constexpr (MODE == 0) { xf[mm][0] = *(const f32x4*)(xs + ro); xf[mm][1] = *(const f32x4*)(xs + ro + 4); }
                        else xw[mm] = *(const u32x4*)(hb + ro); }
                    __builtin_amdgcn_sched_barrier(0);
#pragma unroll
                    for (int mm = 0; mm < MG; ++mm) { const int m = mg + mm; const size_t ro = (size_t)(rloc + ai * HALF + m * 16) * D + bj * HALF;
                        f32x4 x0, x1;
                        if constexpr (MODE == 0) { x0 = xf[mm][0]; x1 = xf[mm][1]; }
                        else { const u32x4 w = xw[mm]; x0 = (f32x4){bf_lo(w.x), bf_hi(w.x), bf_lo(w.y), bf_hi(w.y)}; x1 = (f32x4){bf_lo(w.z), bf_hi(w.z), bf_lo(w.w), bf_hi(w.w)}; }
                        const f32x4 y0 = x0 + g0 * acc[ai][bj][m][0], y1 = x1 + g1 * acc[ai][bj][m][1];
                        if constexpr (MODE == 2) { if (st_ok) { *(f32x4*)(ob + ro) = y0; *(f32x4*)(ob + ro + 4) = y1; } }
                        else { u32x4 w; w.x = cvt_pk_bf16(y0[0], y0[1]); w.y = cvt_pk_bf16(y0[2], y0[3]); w.z = cvt_pk_bf16(y1[0], y1[1]); w.w = cvt_pk_bf16(y1[2], y1[3]); *(u32x4*)(hb + ro) = w; }
                    }
                    __builtin_amdgcn_sched_barrier(0);
                }
        }
    }
    __device__ __forceinline__ void operator()(const f32x4 (&acc)[2][2][4][2], const Unit& u, int wr, int wc, int fr, int fq) const {
        if (mode == 1) body<1>(acc, u, wr, wc, fr, fq);
        else if (mode == 0) body<0>(acc, u, wr, wc, fr, fq);
        else body<2>(acc, u, wr, wc, fr, fq);
    }
};
struct EpiBranch {
    static constexpr bool PERM = true, MIDK = true;
    bf16_t* P;
    __device__ __forceinline__ u32x4 ld_raw(unsigned off) const { return *(const u32x4*)((const char*)P + (size_t)off * 2u); }
    __device__ __forceinline__ void to_e(const u32x4 w, float (&e)[8]) const { unpack8(w, e); }
    template <int WHICH> __device__ __forceinline__ void mid(f32x4 (&acc)[2][2][4][2], const Unit& u, int wr, int wc, int fr, int fq) const {
        unsigned base = (unsigned)(u.pm * BM + wr * 64 + fr) * PROJ + (unsigned)(u.pn * BM + wc * 32 + 8 * fq) + OFF_GATE + WHICH * D;
        asm volatile("" : "+v"(base));
#pragma unroll
        for (int ai = 0; ai < 2; ++ai)
#pragma unroll
            for (int mp = 0; mp < 2; ++mp) {
                u32x4 wa[2][2], wb[2][2];
#pragma unroll
                for (int mm = 0; mm < 2; ++mm)
#pragma unroll
                    for (int bj = 0; bj < 2; ++bj) { const unsigned o = base + (unsigned)(ai * HALF + (mp * 2 + mm) * 16) * PROJ + bj * HALF; wa[mm][bj] = ld_raw(o); wb[mm][bj] = ld_raw(o + D); }
                __builtin_amdgcn_sched_barrier(0);
#pragma unroll
                for (int mm = 0; mm < 2; ++mm)
#pragma unroll
                    for (int bj = 0; bj < 2; ++bj) { float ea[8], eb[8]; to_e(wa[mm][bj], ea); to_e(wb[mm][bj], eb);
#pragma unroll
                        for (int n = 0; n < 2; ++n)
#pragma unroll
                            for (int j = 0; j < 4; j += 2) { const f32x2 r2 = (f32x2){fast_rcp(ea[n * 4 + j]), fast_rcp(ea[n * 4 + j + 1])}, b2 = (f32x2){eb[n * 4 + j], eb[n * 4 + j + 1]};
                                const f32x2 v2 = (f32x2){acc[ai][bj][mp * 2 + mm][n][j], acc[ai][bj][mp * 2 + mm][n][j + 1]} * (b2 * r2);
                                acc[ai][bj][mp * 2 + mm][n][j] = v2[0]; acc[ai][bj][mp * 2 + mm][n][j + 1] = v2[1]; } }
                __builtin_amdgcn_sched_barrier(0);
            }
    }
    __device__ __forceinline__ void operator()(const f32x4 (&acc)[2][2][4][2], const Unit& u, int wr, int wc, int fr, int fq) const {
        unsigned base = (unsigned)(u.pm * BM + wr * 64 + fr) * PROJ + (unsigned)(u.pn * BM + wc * 32 + 8 * fq);
        asm volatile("" : "+v"(base));
#pragma unroll
        for (int ai = 0; ai < 2; ++ai) {
            u32x4 w2[4][2];
#pragma unroll
            for (int m = 0; m < 4; ++m)
#pragma unroll
                for (int bj = 0; bj < 2; ++bj) w2[m][bj] = ld_raw(base + (unsigned)(ai * HALF + m * 16) * PROJ + bj * HALF + OFF_GATE + 2 * D);
            __builtin_amdgcn_sched_barrier(0);
#pragma unroll
            for (int m = 0; m < 4; ++m)
#pragma unroll
                for (int bj = 0; bj < 2; ++bj) { const unsigned o = base + (unsigned)(ai * HALF + m * 16) * PROJ + bj * HALF;
                    float e2[8], ov[8]; to_e(w2[m][bj], e2);
#pragma unroll
                    for (int n = 0; n < 2; ++n)
#pragma unroll
                        for (int j = 0; j < 4; ++j) ov[n * 4 + j] = acc[ai][bj][m][n][j] * fast_rcp(e2[n * 4 + j]);
                    *(u32x4*)((char*)P + (size_t)o * 2u) = pack8(ov); }
            __builtin_amdgcn_sched_barrier(0);
        }
    }
};
}

__device__ __forceinline__ void tr_job(LAS float* tl, const float* src, int ld_src, int K, int Nout, bf16_t* dst, int ld_dst, int dkofs, int mode) {
    const int tid = tid_opaque();
    const int nkt = K / 64, ntl = nkt * (Nout / 64), G = gridDim.x;
    const int ln = tid & 63, lk = tid >> 6, sk2 = (tid & 31) * 2, sn = tid >> 5;
    float r[8];
    int t = bid_opaque();
    auto src_ptr = [&](int tt) -> const float* {
        const int kt = tt % nkt, n0 = (tt / nkt) * 64; int c0 = n0;
        if (mode == 1) { const int pn = n0 >> 8, rr = n0 & 255; c0 = (rr < 128) ? pn * 128 + rr : DFF + pn * 128 + (rr - 128); }
        return src + (size_t)(kt * 64 + lk) * ld_src + c0 + ln; };
    if (t < ntl) { const float* sp = src_ptr(t);
#pragma unroll
        for (int i = 0; i < 8; ++i) r[i] = sp[(size_t)(8 * i) * ld_src]; }
    for (; t < ntl; t += G) {
#pragma unroll
        for (int i = 0; i < 8; ++i) tl[(lk + 8 * i) * 65 + ln] = r[i];
        __syncthreads();
        if (t + G < ntl) { const float* sp = src_ptr(t + G);
#pragma unroll
            for (int i = 0; i < 8; ++i) r[i] = sp[(size_t)(8 * i) * ld_src]; }
        { const int kt = t % nkt, n0 = (t / nkt) * 64;
#pragma unroll
          for (int i = 0; i < 4; ++i) { const int n = sn + 16 * i; *(unsigned*)(dst + (size_t)(n0 + n) * ld_dst + dkofs + kt * 64 + sk2) = cvt_pk_bf16(tl[sk2 * 65 + n], tl[(sk2 + 1) * 65 + n]); } }
        __syncthreads();
    }
}

__device__ void phase_setup(const Params& p, LAS unsigned char* lds) {
    const int tid = tid_opaque(), wid = tid >> 6, lane = tid & 63;
    bf16_t* WT = (bf16_t*)(p.ws + WS_WT);
    LAS float* tl = (LAS float*)lds;
    for (int l = 0; l < NL; ++l) {
        bf16_t* W = WT + (size_t)l * W_LAYER;
        for (int j = 0; j < 2; ++j) {
            tr_job(tl, p.in[I_FFNIN] + ((size_t)l * 2 + j) * D * (2 * DFF), 2 * DFF, D, 2 * DFF, W + (j ? W_FIN1 : W_FIN0), D, 0, 1);
            tr_job(tl, p.in[I_FFNOUT] + ((size_t)l * 2 + j) * DFF * D, D, DFF, D, W + (j ? W_FOUT1 : W_FOUT0), DFF, 0, 0);
        }
        tr_job(tl, p.in[I_WIN] + (size_t)l * D * PROJ, PROJ, D, PROJ, W + W_WIN, D, 0, 0);
        tr_job(tl, p.in[I_WBC] + (size_t)l * 256 * D, D, 256, D, W + W_WB, D, 0, 0);
        tr_job(tl, p.in[I_WBG] + (size_t)l * 256 * D, D, 256, D, W + W_WB, D, 256, 0);
        tr_job(tl, p.in[I_WBA] + (size_t)l * 512 * D, D, 512, D, W + W_WB, D, 512, 0);
        tr_job(tl, p.in[I_WOUT] + (size_t)l * D * D, D, D, D, W + W_WO, D, 0, 0);
        for (int i = bid_opaque() * 512 + tid; i < 65536 / 2; i += gridDim.x * 512) {
            const float2 v = *(const float2*)(p.in[I_GWS] + (size_t)l * 65536 + 2 * i);
            *(unsigned*)(W + W_GWS + 2 * i) = cvt_pk_bf16(v.x, v.y);
        }
    }
    { const int gi = bid_opaque() * 512 + tid;
      if (gi < 1024) { const int pos = gi >> 4, i = gi & 15;
        const int i4 = i & 3, i16 = i >> 2;
        float inv = (i4 == 0) ? 1.0f : (i4 == 1) ? 0.5623413251903491f : (i4 == 2) ? 0.31622776601683794f : 0.1778279410038923f;
        inv *= (i16 == 0) ? 1.0f : (i16 == 1) ? 0.1f : (i16 == 2) ? 0.01f : 0.001f;
        const float a = (float)pos * inv;
        const float kq = __builtin_rintf(a * 0.6366197723675814f);
        float r = __builtin_fmaf(-kq, 1.5707963705062866f, a); r = __builtin_fmaf(kq, 4.371139000186241e-8f, r);
        const float r2 = r * r;
        const float sn = r * (1.0f + r2 * (-1.0f / 6 + r2 * (1.0f / 120 + r2 * (-1.0f / 5040 + r2 * (1.0f / 362880)))));
        const float cs = 1.0f + r2 * (-0.5f + r2 * (1.0f / 24 + r2 * (-1.0f / 720 + r2 * (1.0f / 40320 + r2 * (-1.0f / 3628800)))));
        const int q = ((int)kq) & 3;
        const float c = (q == 0) ? cs : (q == 1) ? -sn : (q == 2) ? -cs : sn;
        const float s = (q == 0) ? sn : (q == 1) ? cs : (q == 2) ? -sn : -cs;
        float2* rt = (float2*)(p.ws + WS_ROPE); rt[gi] = make_float2(c, s); } }
    if (bid_opaque() < NL * 36) {
        LAS float* sc = (LAS float*)lds;
        __syncthreads();
        for (int i = tid; i < 33 * D; i += 512) { const int r = i >> 10, k = i & 1023; const float v = (r < 32) ? p.in[I_C][r * D + k] : p.in[I_CCTX][k]; sc[i] = siluf_(v); }
        __syncthreads();
        float* MOD = (float*)(p.ws + WS_MOD);
        for (int it = bid_opaque(); it < NL * 36; it += gridDim.x) {
            const int l = it / 36, cgp = it % 36, n0 = cgp * 256 + lane * 4;
            const float* wp = p.in[I_WMOD] + (size_t)l * D * (NMOD * D) + n0;
            f32x4 a[5];
#pragma unroll
            for (int i = 0; i < 5; ++i) a[i] = (f32x4){0.f, 0.f, 0.f, 0.f};
            for (int k = 0; k < D; k += 16) {
                f32x4 w[16];
#pragma unroll
                for (int kk = 0; kk < 16; ++kk) w[kk] = *(const f32x4*)(wp + (size_t)(k + kk) * (NMOD * D));
#pragma unroll
                for (int i = 0; i < 5; ++i) { const int r = (i < 4) ? wid + 8 * i : 32;
#pragma unroll
                    for (int k4 = 0; k4 < 4; ++k4) { const f32x4 s4 = *(const LAS f32x4*)(sc + r * D + k + 4 * k4);
                        a[i] += s4[0] * w[4 * k4] + s4[1] * w[4 * k4 + 1] + s4[2] * w[4 * k4 + 2] + s4[3] * w[4 * k4 + 3]; } }
            }
            const f32x4 bv = *(const f32x4*)(p.in[I_BMOD] + (size_t)l * (NMOD * D) + n0);
#pragma unroll
            for (int i = 0; i < 5; ++i) { const int r = (i < 4) ? wid + 8 * i : 32; if (i < 4 || wid == 0) *(f32x4*)(MOD + ((size_t)l * 33 + r) * (NMOD * D) + n0) = a[i] + bv; }
        }
        __syncthreads();
    }
}

__device__ void phase_norm(const Params& p, int l, int j, bool from_inputs, bool skip_ctx) {
    const int tid = tid_opaque(), wid = tid >> 6, lane = tid & 63;
    bf16_t* A = (bf16_t*)(p.ws + WS_A);
    const bf16_t* hbuf = (const bf16_t*)(p.ws + WS_H);
    const float* MOD = (const float*)(p.ws + WS_MOD) + (size_t)l * 33 * (NMOD * D);
    const float* ng = p.in[I_NORMG] + ((size_t)l * 3 + j) * D;
    constexpr int NR = 4;
    for (int u = (bid_opaque() * 8 + wid) * NR; u < T_ALL; u += gridDim.x * 8 * NR) {
        const RowMap rm = map_row(u);
        if (skip_ctx && rm.is_ctx) continue;
        const float* sh = MOD + (size_t)rm.modrow * (NMOD * D) + (3 * j) * D; const float* sc = sh + D;
        f32x4 v[NR][4]; float ss[NR];
        if (from_inputs) { const float* x = (rm.is_ctx ? p.in[I_CTX] : p.in[I_X]) + rm.row0 * D;
#pragma unroll
            for (int rr = 0; rr < NR; ++rr)
#pragma unroll
                for (int i = 0; i < 4; ++i) v[rr][i] = *(const f32x4*)(x + rr * D + i * 256 + lane * 4);
        } else { const bf16_t* x = hbuf + (size_t)u * D;
#pragma unroll
            for (int rr = 0; rr < NR; ++rr)
#pragma unroll
                for (int i = 0; i < 4; ++i) { const u32x2 w = *(const u32x2*)(x + rr * D + i * 256 + lane * 4); v[rr][i] = (f32x4){bf_lo(w.x), bf_hi(w.x), bf_lo(w.y), bf_hi(w.y)}; }
        }
        f32x4 gm[4], s0[4];
#pragma unroll
        for (int i = 0; i < 4; ++i) { const int k = i * 256 + lane * 4; gm[i] = *(const f32x4*)(ng + k) * (*(const f32x4*)(sc + k) + 1.0f); s0[i] = *(const f32x4*)(sh + k); }
#pragma unroll
        for (int rr = 0; rr < NR; ++rr) { ss[rr] = 0.f;
#pragma unroll
            for (int i = 0; i < 4; ++i) ss[rr] += v[rr][i][0] * v[rr][i][0] + v[rr][i][1] * v[rr][i][1] + v[rr][i][2] * v[rr][i][2] + v[rr][i][3] * v[rr][i][3]; }
#pragma unroll
        for (int st = 1; st < 64; st <<= 1)
#pragma unroll
            for (int rr = 0; rr < NR; ++rr) ss[rr] += shx(ss[rr], st, lane);
#pragma unroll
        for (int rr = 0; rr < NR; ++rr) { const float rstd = rsqrtf(ss[rr] * (1.0f / D) + EPS);
#pragma unroll
            for (int i = 0; i < 4; ++i) { const int k = i * 256 + lane * 4;
                const f32x4 y = v[rr][i] * rstd * gm[i] + s0[i];
                u32x2 w; w.x = cvt_pk_bf16(y[0], y[1]); w.y = cvt_pk_bf16(y[2], y[3]);
                *(u32x2*)(A + (size_t)(u + rr) * D + k) = w; } }
    }
}

__device__ void phase_prep(const Params& p, int l, int hs, LAS unsigned char* lds) {
    const int THp = part_rows(hs), latN = part_lat(hs);
    const int tid = tid_opaque(), wid = tid >> 6, lane = tid & 63;
    bf16_t* P = (bf16_t*)(p.ws + WS_R1);
    bf16_t* VTL = (bf16_t*)(p.ws + WS_VTL); bf16_t* VTC = (bf16_t*)(p.ws + WS_VTC);
    const float* qg = p.in[I_QG] + l * 64; const float* kg = p.in[I_KG] + l * 64;
    LAS bf16_t* Vs = (LAS bf16_t*)lds;
    const LAS f32x2* rts = (const LAS f32x2*)(lds + 20480);
    __syncthreads();
    *(LAS u32x4*)(lds + 20480 + tid * 16) = *(const u32x4*)(p.ws + WS_ROPE + tid * 16);
    __syncthreads();
    const int c = lane & 7, seg = c >> 2, hf = (c >> 1) & 1, i0 = (c & 1) * 8;
    float gq[8], gk[8];
#pragma unroll
    for (int e = 0; e < 8; ++e) { gq[e] = qg[8 * c + e]; gk[e] = kg[8 * c + e]; }
    for (int it = bid_opaque(); it < THp / 64; it += gridDim.x) {
        const int v0 = it * 64; const bool lat = v0 < latN;
        const int prow = (v0 & (SEQ - 1)) >> 6;
        bf16_t* rowb = P + (size_t)(v0 + wid * 8) * PROJ;
        const int qoff = OFF_Q + (lane >> 3) * 64 + 8 * c, koff = OFF_K + ((lane >> 3) & 1) * 64 + 8 * c;
        u32x4 qr[8], kr[8]; unsigned vr[8];
#pragma unroll
        for (int i = 0; i < 8; ++i) { const bf16_t* rp = rowb + (size_t)i * PROJ; qr[i] = *(const u32x4*)(rp + qoff); kr[i] = *(const u32x4*)(rp + koff); vr[i] = *(const unsigned*)(rp + OFF_V + 2 * lane); }
#pragma unroll
        for (int i = 0; i < 8; ++i) {
            const int rl = wid * 8 + i;
            bf16_t* rowp = rowb + (size_t)i * PROJ;
            const int pp = seg ? rl : prow;
            float cs[8], sn[8];
#pragma unroll
            for (int e = 0; e < 8; ++e) { const f32x2 t2 = rts[pp * 16 + i0 + e]; cs[e] = lat ? t2[0] : 1.0f; sn[e] = lat ? t2[1] : 0.0f; }
            { float x[8]; unpack8(qr[i], x);
              float ss = 0.f;
#pragma unroll
              for (int e = 0; e < 8; ++e) ss += x[e] * x[e];
              ss += shx(ss, 1, lane); ss += shx(ss, 2, lane); ss += shx(ss, 4, lane);
              const float rstd = rsqrtf(ss * (1.0f / 64) + EPS); float o[8];
#pragma unroll
              for (int e = 0; e < 8; ++e) { const float y = x[e] * rstd * gq[e]; const float yp = shx(y, 2, lane);
                  o[e] = (hf ? (y * cs[e] + yp * sn[e]) : (y * cs[e] - yp * sn[e])) * (0.125f * LOG2E); }
              *(u32x4*)(rowp + qoff) = pack8(o); }
            { float x[8]; unpack8(kr[i], x);
              float ss = 0.f;
#pragma unroll
              for (int e = 0; e < 8; ++e) ss += x[e] * x[e];
              ss += shx(ss, 1, lane); ss += shx(ss, 2, lane); ss += shx(ss, 4, lane);
              const float rstd = rsqrtf(ss * (1.0f / 64) + EPS); float o[8];
#pragma unroll
              for (int e = 0; e < 8; ++e) { const float y = x[e] * rstd * gk[e]; const float yp = shx(y, 2, lane);
                  o[e] = hf ? (y * cs[e] + yp * sn[e]) : (y * cs[e] - yp * sn[e]); }
              if (lane < 16) *(u32x4*)(rowp + koff) = pack8(o); }
            { const unsigned w = vr[i];
              Vs[(2 * lane) * 72 + rl] = (bf16_t)(w & 0xffffu); Vs[(2 * lane + 1) * 72 + rl] = (bf16_t)(w >> 16); }
        }
        __syncthreads();
        { const int hd = tid >> 2, ch = tid & 3;
          bf16_t* dst;
          if (lat) { const int bl = v0 >> 11, pos0 = v0 & (SEQ - 1); dst = VTL + ((size_t)bl * 128 + hd) * SEQ + pos0 + ch * 16; }
          else { const int cv = v0 - latN, bl = cv >> 8, pos0 = cv & 255; dst = VTC + ((size_t)bl * 128 + hd) * CTXL + pos0 + ch * 16; }
          const u32x4 a = *(const LAS u32x4*)(Vs + hd * 72 + ch * 16), b = *(const LAS u32x4*)(Vs + hd * 72 + ch * 16 + 8);
          *(u32x4*)dst = a; *(u32x4*)(dst + 8) = b; }
        __syncthreads();
    }
}

struct KeySeg { const bf16_t* K; const bf16_t* Vt; int vstride; int ntiles; int mask; };

__device__ __forceinline__ void attn_item(const Params& p, int l, int hs, int idx) {
    const int tid = tid_opaque(), wid = __builtin_amdgcn_readfirstlane(tid >> 6), lane = tid & 63, fr = lane & 15, fq = lane >> 4;
    const bf16_t* P = (const bf16_t*)(p.ws + WS_R1);
    const bf16_t* VTL = (const bf16_t*)(p.ws + WS_VTL); const bf16_t* VTC = (const bf16_t*)(p.ws + WS_VTC);
    bf16_t* Y = (bf16_t*)(p.ws + WS_A) + (size_t)part_u0(hs) * D;
    const int latN = part_lat(hs), nli = part_nb(hs) * 32;
    int bl, qb, hk; bool lat;
    if (idx < nli) { lat = true; bl = idx >> 5; qb = (idx >> 1) & 15; hk = idx & 1; }
    else { const int j = idx - nli; lat = false; bl = j >> 2; qb = (j >> 1) & 1; hk = j & 1; }
    const int g = wid >> 1, r0 = (wid & 1) * 64, head = hk * 4 + g;
    const int qrow0 = lat ? bl * SEQ + qb * 128 : latN + bl * CTXL + qb * 128;
    const int crow0 = latN + bl * CTXL;
    bf16x8 qf[4][2];
    { const bf16_t* qp = P + (size_t)(qrow0 + r0 + fr) * PROJ + OFF_Q + head * 64 + fq * 8;
#pragma unroll
      for (int nq = 0; nq < 4; ++nq)
#pragma unroll
          for (int ks = 0; ks < 2; ++ks) qf[nq][ks] = *(const bf16x8*)(qp + (size_t)nq * 16 * PROJ + ks * 32); }
    f32x4 o[4][4];
#pragma unroll
    for (int a = 0; a < 4; ++a)
#pragma unroll
        for (int b = 0; b < 4; ++b) o[a][b] = (f32x4){0.f, 0.f, 0.f, 0.f};
    const float snk = p.in[I_SINK][l * 8 + head] * LOG2E;
    float mrun[4], lrun[4];
#pragma unroll
    for (int nq = 0; nq < 4; ++nq) { mrun[nq] = snk; lrun[nq] = (fq == 0) ? 1.0f : 0.0f; }

    int lo = 0, nb = 0;
    if (lat) { lo = (qb == 0) ? 4 : (r0 >> 5); const int hi = (qb == 15) ? 8 : (r0 == 0 ? 10 : 12); nb = hi - lo; }
    const int ntot = nb + 8;
    const char* kband = (const char*)(P + (ptrdiff_t)(bl * SEQ + (qb - 1) * 128 + lo * 32) * PROJ + OFF_K + hk * 64);
    const char* kctx = (const char*)(P + (size_t)crow0 * PROJ + OFF_K + hk * 64);
    const char* vband = (const char*)(VTL + ((size_t)bl * 2 + hk) * 64 * SEQ + (ptrdiff_t)((qb - 1) * 128 + lo * 32));
    const char* vctx = (const char*)(VTC + ((size_t)bl * 2 + hk) * 64 * CTXL);
    const unsigned klane = (unsigned)(fr * PROJ + fq * 8) * 2u, vlane_b = (unsigned)(fr * SEQ + fq * 4) * 2u, vlane_c = (unsigned)(fr * CTXL + fq * 4) * 2u;
#define ATT_LOAD(i_, KF, VLO, VHI) do { const int _i = (i_); \
        if (_i < nb) { const char* _kp = kband + (size_t)_i * (32 * PROJ * 2); const char* _vp = vband + _i * 64; \
            _Pragma("unroll") for (int kb = 0; kb < 2; ++kb) _Pragma("unroll") for (int ks = 0; ks < 2; ++ks) KF[kb][ks] = *(const bf16x8*)(_kp + kb * (16 * PROJ * 2) + ks * 64 + klane); \
            _Pragma("unroll") for (int db = 0; db < 4; ++db) { VLO[db] = *(const bf16x4*)(_vp + db * (16 * SEQ * 2) + vlane_b); VHI[db] = *(const bf16x4*)(_vp + db * (16 * SEQ * 2) + 32 + vlane_b); } \
        } else { const char* _kp = kctx + (size_t)(_i - nb) * (32 * PROJ * 2); const char* _vp = vctx + (_i - nb) * 64; \
            _Pragma("unroll") for (int kb = 0; kb < 2; ++kb) _Pragma("unroll") for (int ks = 0; ks < 2; ++ks) KF[kb][ks] = *(const bf16x8*)(_kp + kb * (16 * PROJ * 2) + ks * 64 + klane); \
            _Pragma("unroll") for (int db = 0; db < 4; ++db) { VLO[db] = *(const bf16x4*)(_vp + db * (16 * CTXL * 2) + vlane_c); VHI[db] = *(const bf16x4*)(_vp + db * (16 * CTXL * 2) + 32 + vlane_c); } } } while (0)
#define ATT_COMPUTE(i_, KF, VLO, VHI) do { const int _ci = (i_); const int bt = lo + _ci; const bool mask = (_ci < nb) && (bt < 4 || bt >= 8); \
        f32x4 s[2][4]; \
        _Pragma("unroll") for (int kb = 0; kb < 2; ++kb) _Pragma("unroll") for (int nq = 0; nq < 4; ++nq) { \
            s[kb][nq] = __builtin_amdgcn_mfma_f32_16x16x32_bf16(KF[kb][0], qf[nq][0], (f32x4){0.f, 0.f, 0.f, 0.f}, 0, 0, 0); \
            s[kb][nq] = __builtin_amdgcn_mfma_f32_16x16x32_bf16(KF[kb][1], qf[nq][1], s[kb][nq], 0, 0, 0); } \
        if (mask) { \
            _Pragma("unroll") for (int kb = 0; kb < 2; ++kb) _Pragma("unroll") for (int nq = 0; nq < 4; ++nq) _Pragma("unroll") for (int j = 0; j < 4; ++j) { \
                const int dlt = (bt * 32 - 128 + kb * 16 + fq * 4 + j) - (r0 + nq * 16 + fr); if (dlt > 128 || dlt < -128) s[kb][nq][j] = -1e30f; } } \
        bf16x8 pf[4]; \
        _Pragma("unroll") for (int nq = 0; nq < 4; ++nq) { \
            float mx = fmaxf(fmaxf(fmaxf(s[0][nq][0], s[0][nq][1]), fmaxf(s[0][nq][2], s[0][nq][3])), fmaxf(fmaxf(s[1][nq][0], s[1][nq][1]), fmaxf(s[1][nq][2], s[1][nq][3]))); \
            mx = fmaxf(mx, shx(mx, 16, lane)); mx = fmaxf(mx, shx(mx, 32, lane)); \
            const float mn = fmaxf(mrun[nq], mx), alpha = fast_exp2(mrun[nq] - mn); mrun[nq] = mn; \
            float pv[8]; f32x2 ps2 = (f32x2){0.f, 0.f}; const f32x2 mn2 = (f32x2){mn, mn}; \
            _Pragma("unroll") for (int kb = 0; kb < 2; ++kb) _Pragma("unroll") for (int j = 0; j < 4; j += 2) { \
                const f32x2 d2 = (f32x2){s[kb][nq][j], s[kb][nq][j + 1]} - mn2; const f32x2 e2 = (f32x2){fast_exp2(d2[0]), fast_exp2(d2[1])}; \
                pv[kb * 4 + j] = e2[0]; pv[kb * 4 + j + 1] = e2[1]; ps2 = ps2 + e2; } \
            lrun[nq] = lrun[nq] * alpha + (ps2[0] + ps2[1]); \
            const u32x4 w = pack8(pv); pf[nq] = *(const bf16x8*)&w; \
            _Pragma("unroll") for (int db = 0; db < 4; ++db) o[db][nq] *= alpha; } \
        _Pragma("unroll") for (int db = 0; db < 4; ++db) { const bf16x8 vf = (bf16x8){VLO[db][0], VLO[db][1], VLO[db][2], VLO[db][3], VHI[db][0], VHI[db][1], VHI[db][2], VHI[db][3]}; \
            _Pragma("unroll") for (int nq = 0; nq < 4; ++nq) o[db][nq] = __builtin_amdgcn_mfma_f32_16x16x32_bf16(vf, pf[nq], o[db][nq], 0, 0, 0); } } while (0)
    bf16x8 kfa[2][2], kfb[2][2]; bf16x4 vla[4], vha[4], vlb[4], vhb[4];
    ATT_LOAD(0, kfa, vla, vha);
    for (int i = 0; i < ntot; i += 2) {
        const int i1 = (i + 1 < ntot) ? i + 1 : i;
        ATT_LOAD(i1, kfb, vlb, vhb);
        ATT_COMPUTE(i, kfa, vla, vha);
        const int i2 = (i + 2 < ntot) ? i + 2 : i;
        ATT_LOAD(i2, kfa, vla, vha);
        if (i + 1 < ntot) ATT_COMPUTE(i + 1, kfb, vlb, vhb);
    }
#undef ATT_LOAD
#undef ATT_COMPUTE
#pragma unroll
    for (int nq = 0; nq < 4; ++nq) {
        float lt = lrun[nq]; lt += shx(lt, 16, lane); lt += shx(lt, 32, lane);
        const float inv = 1.0f / lt;
        bf16_t* yp = Y + (size_t)(qrow0 + r0 + nq * 16 + fr) * D + 512 + head * 64 + fq * 4;
#pragma unroll
        for (int db = 0; db < 4; ++db) { u32x2 w; w.x = cvt_pk_bf16(o[db][nq][0] * inv, o[db][nq][1] * inv); w.y = cvt_pk_bf16(o[db][nq][2] * inv, o[db][nq][3] * inv);
            *(u32x2*)(yp + db * 16) = w; }
    }
}

__device__ __forceinline__ void gmlp_conv_item(const Params& p, int l, int hs, int chunk, LAS unsigned char* lds) {
    const int tid = tid_opaque(), wid = tid >> 6, lane = tid & 63, fr = lane & 15, fq = lane >> 4;
    const bf16_t* P = (const bf16_t*)(p.ws + WS_R1);
    bf16_t* Y = (bf16_t*)(p.ws + WS_A) + (size_t)part_u0(hs) * D;
    const int v0 = chunk * 128, latN = part_lat(hs);
    LAS bf16_t* vT = (LAS bf16_t*)lds;
    { const float* cw = p.in[I_CONVW] + (size_t)l * 3 * 256;
      const bool lat = v0 < latN;
#pragma unroll 2
      for (int i = 0; i < 8; ++i) {
          const int id = i * 512 + tid, pt = id >> 5, cc = (id & 31) * 8, v = v0 + pt;
          const int pos = lat ? (v & (SEQ - 1)) : ((v - latN) & (CTXL - 1)), n = lat ? SEQ : CTXL;
          const bf16_t* rp = P + (size_t)v * PROJ + cc;
          float bv[8], c1[8], h1[8], acc[8];
          unpack8(*(const u32x4*)(rp + OFF_CB), bv); unpack8(*(const u32x4*)(rp + OFF_CC), c1); unpack8(*(const u32x4*)(rp + OFF_CH), h1);
          { const f32x4 wa = *(const f32x4*)(cw + 256 + cc), wb = *(const f32x4*)(cw + 256 + cc + 4);
#pragma unroll
            for (int e = 0; e < 8; ++e) acc[e] = c1[e] * h1[e] * (e < 4 ? wa[e & 3] : wb[e & 3]); }
          if (pos > 0) { float c0[8], h0[8]; unpack8(*(const u32x4*)(rp - PROJ + OFF_CC), c0); unpack8(*(const u32x4*)(rp - PROJ + OFF_CH), h0);
              const f32x4 wa = *(const f32x4*)(cw + cc), wb = *(const f32x4*)(cw + cc + 4);
#pragma unroll
              for (int e = 0; e < 8; ++e) acc[e] += c0[e] * h0[e] * (e < 4 ? wa[e & 3] : wb[e & 3]); }
          if (pos < n - 1) { float c2[8], h2[8]; unpack8(*(const u32x4*)(rp + PROJ + OFF_CC), c2); unpack8(*(const u32x4*)(rp + PROJ + OFF_CH), h2);
              const f32x4 wa = *(const f32x4*)(cw + 512 + cc), wb = *(const f32x4*)(cw + 512 + cc + 4);
#pragma unroll
              for (int e = 0; e < 8; ++e) acc[e] += c2[e] * h2[e] * (e < 4 ? wa[e & 3] : wb[e & 3]); }
#pragma unroll
          for (int e = 0; e < 8; ++e) acc[e] *= bv[e];
          *(u32x4*)(Y + (size_t)v * D + cc) = pack8(acc);
      } }
    { const float* lg = p.in[I_LNG] + l * 256 + 4 * lane; const float* lb = p.in[I_LNB] + l * 256 + 4 * lane;
      const f32x4 g4 = *(const f32x4*)lg, b4 = *(const f32x4*)lb;
#pragma unroll
      for (int hb = 0; hb < 2; ++hb) {
          u32x2 w[8]; float x[8][4], sm[8], qv[8];
#pragma unroll
          for (int i = 0; i < 8; ++i) w[i] = *(const u32x2*)(P + (size_t)(v0 + wid * 16 + hb * 8 + i) * PROJ + OFF_GV + 4 * lane);
#pragma unroll
          for (int i = 0; i < 8; ++i) { x[i][0] = gelu_tanh(bf_lo(w[i].x)); x[i][1] = gelu_tanh(bf_hi(w[i].x)); x[i][2] = gelu_tanh(bf_lo(w[i].y)); x[i][3] = gelu_tanh(bf_hi(w[i].y));
              sm[i] = (x[i][0] + x[i][1]) + (x[i][2] + x[i][3]); }
#pragma unroll
          for (int st = 1; st < 64; st <<= 1)
#pragma unroll
              for (int i = 0; i < 8; ++i) sm[i] += shx(sm[i], st, lane);
#pragma unroll
          for (int i = 0; i < 8; ++i) { const float mu = sm[i] * (1.0f / 256); float q = 0.f;
#pragma unroll
              for (int e = 0; e < 4; ++e) { x[i][e] -= mu; q += x[i][e] * x[i][e]; }
              qv[i] = q; }
#pragma unroll
          for (int st = 1; st < 64; st <<= 1)
#pragma unroll
              for (int i = 0; i < 8; ++i) qv[i] += shx(qv[i], st, lane);
#pragma unroll
          for (int i = 0; i < 8; ++i) { const float rstd = rsqrtf(qv[i] * (1.0f / 256) + EPS); const int pt = wid * 16 + hb * 8 + i;
#pragma unroll
              for (int e = 0; e < 4; ++e) { const float y = x[i][e] * rstd * g4[e] + b4[e]; vT[(4 * lane + e) * 136 + pt] = (bf16_t)(cvt_pk_bf16(y, 0.f) & 0xffffu); } }
      } }
    __syncthreads();
    { const int g = wid >> 1, ph = wid & 1;
      const bf16_t* wsb = (const bf16_t*)(p.ws + WS_WT) + (size_t)l * W_LAYER + W_GWS + (size_t)g * 128 * 128;
      f32x4 acc[4][4];
#pragma unroll
      for (int a = 0; a < 4; ++a)
#pragma unroll
          for (int b = 0; b < 4; ++b) acc[a][b] = (f32x4){0.f, 0.f, 0.f, 0.f};
#pragma unroll
      for (int kk = 0; kk < 4; ++kk) {
          bf16x8 af[4], bfr[4];
#pragma unroll
          for (int db = 0; db < 4; ++db) af[db] = *(const LAS bf16x8*)(vT + (g * 64 + db * 16 + fr) * 136 + kk * 32 + fq * 8);
#pragma unroll
          for (int pb = 0; pb < 4; ++pb) bfr[pb] = *(const bf16x8*)(wsb + (size_t)((ph * 4 + pb) * 16 + fr) * 128 + kk * 32 + fq * 8);
#pragma unroll
          for (int db = 0; db < 4; ++db)
#pragma unroll
              for (int pb = 0; pb < 4; ++pb) acc[db][pb] = __builtin_amdgcn_mfma_f32_16x16x32_bf16(af[db], bfr[pb], acc[db][pb], 0, 0, 0);
      }
      const float* bs = p.in[I_GBS] + (size_t)l * 512 + g * 128;
      u32x2 uw[4][4]; float bias[4];
#pragma unroll
      for (int pb = 0; pb < 4; ++pb) { const int pt = (ph * 4 + pb) * 16 + fr; bias[pb] = bs[pt];
          const bf16_t* up = P + (size_t)(v0 + pt) * PROJ + OFF_GU + g * 64 + fq * 4;
#pragma unroll
          for (int db = 0; db < 4; ++db) uw[pb][db] = *(const u32x2*)(up + db * 16); }
#pragma unroll
      for (int pb = 0; pb < 4; ++pb) { const int pt = (ph * 4 + pb) * 16 + fr;
          bf16_t* yp = Y + (size_t)(v0 + pt) * D + 256 + g * 64 + fq * 4;
#pragma unroll
          for (int db = 0; db < 4; ++db) { const u32x2 w = uw[pb][db];
              const float y0 = gelu_tanh(bf_lo(w.x)) * (acc[db][pb][0] + bias[pb]), y1 = gelu_tanh(bf_hi(w.x)) * (acc[db][pb][1] + bias[pb]);
              const float y2 = gelu_tanh(bf_lo(w.y)) * (acc[db][pb][2] + bias[pb]), y3 = gelu_tanh(bf_hi(w.y)) * (acc[db][pb][3] + bias[pb]);
              u32x2 ov; ov.x = cvt_pk_bf16(y0, y1); ov.y = cvt_pk_bf16(y2, y3); *(u32x2*)(yp + db * 16) = ov; } } }
    __syncthreads();
}

__device__ void phase_mixers(const Params& p, int l, int hs, LAS unsigned char* lds, bool skip_ctx) {
    const int n_attn = part_nb(hs) * (skip_ctx ? 32 : 36), n_gmlp = (skip_ctx ? part_lat(hs) : part_rows(hs)) / 128;
#ifndef SKIP_ATTN
    for (int it = bid_opaque(); it < n_attn; it += gridDim.x) attn_item(p, l, hs, it);
#endif
    __builtin_amdgcn_sched_barrier(0);
#ifndef SKIP_GMLP
    { const int G = (int)gridDim.x; int n3 = n_attn - 2 * G; n3 = n3 < 0 ? 0 : n3 % G;
      for (int it = (bid_opaque() - n3 + G) % G; it < n_gmlp; it += G) gmlp_conv_item(p, l, hs, it, lds); }
#endif
}

#define XB_TMO      128
#define XB_XCNT(j)  (256  + 64 * (j))
#define XB_XSUB(j)  (1280 + 64 * (j))
#define XB_XGEN(j)  (2304 + 64 * (j))
#define XB_TOP      3328
#define XB_TOPGEN   3392
#define XCD_BAR_WORDS 3456
#define XB_SPIN_CAP (1u << 22)
__device__ __forceinline__ unsigned xb_ld(unsigned* p)              { return __hip_atomic_load(p, __ATOMIC_RELAXED, __HIP_MEMORY_SCOPE_AGENT); }
__device__ __forceinline__ unsigned xb_add(unsigned* p, unsigned v) { return __hip_atomic_fetch_add(p, v, __ATOMIC_RELAXED, __HIP_MEMORY_SCOPE_AGENT); }
__device__ __forceinline__ unsigned xb_xcc_id() { return (unsigned)__builtin_amdgcn_s_getreg((3 << 11) | 20) & 0xFu; }
#define XB_SPIN(cond, bar) do { unsigned _sp = 0; while (cond) { __builtin_amdgcn_s_sleep(1); \
    if ((++_sp & 255u) == 0u) { if (xb_ld(&(bar)[XB_TMO])) break; if (_sp > XB_SPIN_CAP) { atomicAdd(&(bar)[XB_TMO], 1u); break; } } } } while (0)
__device__ __forceinline__ void xcd_barrier_post(unsigned* bar) { if (threadIdx.x == 0) (void)xb_add(&bar[XB_XCNT(xb_xcc_id())], 1u); }
__device__ __forceinline__ void xcd_barrier_complete(unsigned* bar, unsigned x, unsigned& nloc, unsigned& nx) {
    const unsigned G = gridDim.x * gridDim.y * gridDim.z;
    unsigned sum, cnt, mine, sp = 0u;
    for (;;) {
        sum = 0u; cnt = 0u; mine = 0u;
#pragma unroll
        for (unsigned j = 0; j < 16; ++j) { const unsigned c = xb_ld(&bar[XB_XCNT(j)]); sum += c; cnt += (c > 0u) ? 1u : 0u; mine = (j == x) ? c : mine; }
        if (sum == G) break;
        __builtin_amdgcn_s_sleep(1);
        if ((++sp & 255u) == 0u) { if (xb_ld(&bar[XB_TMO])) break; if (sp > XB_SPIN_CAP) { atomicAdd(&bar[XB_TMO], 1u); break; } }
    }
    nloc = mine > 0u ? mine : 1u; nx = cnt > 0u ? cnt : 1u;
}
__device__ __forceinline__ void xcd_barrier(unsigned* bar, volatile LAS unsigned* st) {
    asm volatile("s_waitcnt vmcnt(0)" ::: "memory");
    __syncthreads();
    if (threadIdx.x == 0) {
        const unsigned x = xb_xcc_id();
        __builtin_amdgcn_s_waitcnt(0);
        unsigned nloc = st[0], nx = st[1];
        if (nloc == 0u) { xcd_barrier_complete(bar, x, nloc, nx); st[0] = nloc; st[1] = nx; }
        const unsigned old = xb_add(&bar[XB_XSUB(x)], 1u);
        const unsigned gen = old / nloc;
        if (old + 1u == (gen + 1u) * nloc) {
            __builtin_amdgcn_fence(__ATOMIC_RELEASE, "agent");
            asm volatile("s_waitcnt vmcnt(0)" ::: "memory");
            const unsigned og = xb_add(&bar[XB_TOP], 1u);
            const unsigned tg = og / nx;
            if (og + 1u == (tg + 1u) * nx) xb_add(&bar[XB_TOPGEN], 1u);
            else XB_SPIN(xb_ld(&bar[XB_TOPGEN]) == tg, bar);
            __builtin_amdgcn_fence(__ATOMIC_ACQUIRE, "agent");
            xb_add(&bar[XB_XGEN(x)], 1u);
            asm volatile("s_waitcnt vmcnt(0)" ::: "memory");
        } else {
            XB_SPIN(xb_ld(&bar[XB_XGEN(x)]) == gen, bar);
            __builtin_amdgcn_fence(__ATOMIC_ACQUIRE, "agent");
            asm volatile("s_waitcnt vmcnt(0)" ::: "memory");
        }
    }
    __syncthreads();
}

__device__ void run_phase(const Params& p, int ph, LAS unsigned char* lds) {
    if (ph == 0) {
#ifndef SKIP_SETUP
 phase_setup(p, lds);
#endif
 return; }
    const int q = ph - 1, l = q / 17, r = q % 17;
    const bf16_t* W = (const bf16_t*)(p.ws + WS_WT) + (size_t)l * W_LAYER;
    const float* MOD = (const float*)(p.ws + WS_MOD) + (size_t)l * 33 * (NMOD * D);
    bf16_t* HB = (bf16_t*)(p.ws + WS_H);
    const bool first = (l == 0 && r <= 2);
    const bool lastl = (l == NL - 1);
    bf16_t* A = (bf16_t*)(p.ws + WS_A); bf16_t* R1 = (bf16_t*)(p.ws + WS_R1);
    if (r == 0 || r == 3 || r == 14) {
#ifndef SKIP_NORM
 phase_norm(p, l, r == 0 ? 0 : (r == 3 ? 1 : 2), first, lastl && r == 14);
#endif
 return; }
    if (r == 1 || r == 15) {
        const int j = (r == 1) ? 0 : 1;
        const int sk = (lastl && j == 1) ? 1 : 0;
        pg8::Gemm g{A, D, W + (j ? W_FIN1 : W_FIN0), D, sk ? T_LAT : T_ALL, 2 * DFF, D, sk};
        pg8::EpiSwiglu E{R1};
#ifndef SKIP_UP
        pg8::gemm_phase(lds, g, E);
#endif
        return;
    }
    if (r == 2 || r == 16) {
        const int j = (r == 2) ? 0 : 1;
        const int sk = (lastl && j == 1) ? 1 : 0;
        pg8::Gemm g{R1, DFF, W + (j ? W_FOUT1 : W_FOUT0), DFF, sk ? T_LAT : T_ALL, D, DFF, sk};
        pg8::EpiResid E{p.in[I_X], p.in[I_CTX], HB, p.out, MOD, j ? 8 : 2, 0.5f, 0, first ? 0 : ((l == NL - 1 && r == 16) ? 2 : 1)};
#ifndef SKIP_DOWN
        pg8::gemm_phase(lds, g, E);
#endif
        return;
    }
    const int hs = (r - 4) / 5, rr = (r - 4) % 5;
    if (rr == 0) { pg8::Gemm g{A + (size_t)part_u0(hs) * D, D, W + W_WIN, D, part_rows(hs), PROJ, D, 0}; pg8::EpiBf16 E{R1, PROJ, p.in[I_BGATE] + (size_t)l * 3 * D, OFF_GATE};
#ifndef SKIP_PROJ
 pg8::gemm_phase(lds, g, E);
#endif
 return; }
    if (rr == 1) {
#ifndef SKIP_PREP
 phase_prep(p, l, hs, lds);
#endif
 return; }
    if (rr == 2) {
#ifndef SKIP_MIX
 phase_mixers(p, l, hs, lds, lastl);
#endif
 return; }
    if (rr == 3) { pg8::Gemm g{A + (size_t)part_u0(hs) * D, D, W + W_WB, D, lastl ? part_lat(hs) : part_rows(hs), D, D, 0}; pg8::EpiBranch E{R1};
#ifndef SKIP_BRANCH
 pg8::gemm_phase(lds, g, E);
#endif
 return; }
    { pg8::Gemm g{R1, PROJ, W + W_WO, D, lastl ? part_lat(hs) : part_rows(hs), D, D, 0}; pg8::EpiResid E{p.in[I_X], p.in[I_CTX], HB, p.out, MOD, 5, 1.0f, part_u0(hs) / 256, 1};
#ifndef SKIP_OUT
 pg8::gemm_phase(lds, g, E);
#endif
 }
}

__global__ __launch_bounds__(512, 2) void fwd_megakernel(Params p) {
    extern __shared__ __attribute__((aligned(16))) unsigned char shm[];
    LAS unsigned char* lds = (LAS unsigned char*)shm;
#if MK_SINGLE
    volatile LAS unsigned* bst = (volatile LAS unsigned*)(lds + LDS_BYTES - 16);
    if (threadIdx.x == 0) { bst[0] = 0u; bst[1] = 0u; }
    __syncthreads();
    xcd_barrier_post((unsigned*)(p.ws + WS_BAR));
#endif
    for (int ph = p.ph_lo; ph < p.ph_hi; ++ph) {
#if defined(__HIP_DEVICE_COMPILE__)
        const __attribute__((address_space(4))) char* kp = (const __attribute__((address_space(4))) char*)__builtin_amdgcn_kernarg_segment_ptr();
        asm volatile("" : "+s"(kp));
        const Params lp = *(const Params*)(const char*)kp;
#else
        const Params lp = p;
#endif
        run_phase(lp, ph, lds);
#if MK_SINGLE
        if (ph + 1 < lp.ph_hi) {
            if (ph == 0) cg::this_grid().sync();
            else xcd_barrier((unsigned*)(lp.ws + WS_BAR), (volatile LAS unsigned*)(lds + LDS_BYTES - 16));
        }
#endif
    }
}

extern "C" void kernel_launch(void* const* d_in, const int* in_sizes, int n_in, void* d_out, int out_size, void* d_ws, size_t ws_size, hipStream_t stream) {
    static int grid = 0;
    if (grid == 0) {
        if (n_in != N_IN || out_size != T_LAT * D || ws_size < WS_END) { fprintf(stderr, "kernel_launch: unexpected shapes (n_in %d out %d ws %zu need %zu)\n", n_in, out_size, ws_size, (size_t)WS_END); grid = -1; return; }
        int dev = 0, cus = 0, per_cu = 0;
        (void)hipGetDevice(&dev); (void)hipDeviceGetAttribute(&cus, hipDeviceAttributeMultiprocessorCount, dev);
        if (hipFuncSetAttribute((const void*)fwd_megakernel, hipFuncAttributeMaxDynamicSharedMemorySize, LDS_BYTES) != hipSuccess) { fprintf(stderr, "kernel_launch: hipFuncSetAttribute failed\n"); grid = -1; return; }
        if (hipOccupancyMaxActiveBlocksPerMultiprocessor(&per_cu, (const void*)fwd_megakernel, 512, LDS_BYTES) != hipSuccess || per_cu < 1) { fprintf(stderr, "kernel_launch: occupancy query gave %d\n", per_cu); per_cu = 1; }
        (void)hipGetLastError();
        grid = cus * per_cu;
    }
    if (grid < 0) return;
    Params p{};
    for (int i = 0; i < N_IN; ++i) p.in[i] = (const float*)d_in[i];
    p.out = (float*)d_out; p.ws = (unsigned char*)d_ws;
#if MK_SINGLE
    p.ph_lo = 0; p.ph_hi = N_PHASES;
    if (hipMemsetAsync((char*)d_ws + WS_BAR, 0, 16384, stream) != hipSuccess) { fprintf(stderr, "kernel_launch: memset of the barrier words failed\n"); return; }
    void* args[] = {&p};
    hipError_t e = hipLaunchCooperativeKernel((const void*)fwd_megakernel, dim3(grid), dim3(512), args, LDS_BYTES, stream);
    if (e != hipSuccess) fprintf(stderr, "cooperative launch failed: %s (grid %d)\n", hipGetErrorString(e), grid);
#else
    for (int ph = 0; ph < N_PHASES; ++ph) {
        p.ph_lo = ph; p.ph_hi = ph + 1;
        hipLaunchKernelGGL(fwd_megakernel, dim3(grid), dim3(512), LDS_BYTES, stream, p);
    }
#endif
}
```

```cpp
#include <hip/hip_runtime.h>
#include <hip/hip_cooperative_groups.h>
#include <cstdio>
namespace cg = cooperative_groups;

#ifndef MK_SINGLE
#define MK_SINGLE 1
#endif

#define LAS __attribute__((address_space(3)))
typedef unsigned short bf16_t;
typedef short bf16x8 __attribute__((ext_vector_type(8)));
typedef short bf16x4 __attribute__((ext_vector_type(4)));
typedef float f32x4 __attribute__((ext_vector_type(4)));
typedef unsigned u32x4 __attribute__((ext_vector_type(4)));
typedef unsigned u32x2 __attribute__((ext_vector_type(2)));
typedef float f32x2 __attribute__((ext_vector_type(2)));

constexpr int D = 1024, NB = 32, SEQ = 2048, NL = 4, CTXL = 256, DFF = 2816, PROJ = 5120, NMOD = 9;
constexpr int T_LAT = NB * SEQ, T_CTX = NB * CTXL, T_ALL = T_LAT + T_CTX;
constexpr int NB0 = 14, NB1 = NB - NB0;
constexpr int U1 = NB0 * (SEQ + CTXL);
constexpr int TH_MAX = NB1 * (SEQ + CTXL);
__host__ __device__ __forceinline__ constexpr int part_nb(int s) { return s ? NB1 : NB0; }
__host__ __device__ __forceinline__ constexpr int part_lat(int s) { return part_nb(s) * SEQ; }
__host__ __device__ __forceinline__ constexpr int part_rows(int s) { return part_nb(s) * (SEQ + CTXL); }
__host__ __device__ __forceinline__ constexpr int part_u0(int s) { return s ? U1 : 0; }
constexpr int OFF_CB = 0, OFF_CC = 256, OFF_CH = 512, OFF_GU = 768, OFF_GV = 1024, OFF_Q = 1280, OFF_K = 1792, OFF_V = 1920, OFF_GATE = 2048;
constexpr float EPS = 1e-6f;
constexpr float LOG2E = 1.4426950408889634f;

enum { I_X = 0, I_C, I_CTX, I_CCTX, I_WMOD, I_BMOD, I_NORMG, I_FFNIN, I_FFNOUT, I_WIN, I_BGATE, I_CONVW, I_LNG, I_LNB, I_GWS, I_GBS, I_QG, I_KG, I_SINK, I_WBC, I_WBG, I_WBA, I_WOUT, N_IN };

constexpr size_t W_FIN0 = 0, W_FIN1 = 5767168, W_FOUT0 = 11534336, W_FOUT1 = 14417920, W_WIN = 17301504, W_WB = 22544384, W_WO = 23592960, W_GWS = 24641536, W_LAYER = 24707072;
constexpr size_t WS_WT = 0;
constexpr size_t WS_MOD = WS_WT + NL * W_LAYER * 2;
constexpr size_t WS_ROPE = WS_MOD + (size_t)NL * 33 * 9216 * 4;
constexpr size_t WS_HC = WS_ROPE + 8192;
constexpr size_t WS_A = WS_HC + (size_t)T_CTX * D * 4;
constexpr size_t WS_R1 = WS_A + (size_t)T_ALL * D * 2;
constexpr size_t WS_VTL = WS_R1 + (size_t)TH_MAX * PROJ * 2;
constexpr size_t WS_VTC = WS_VTL + (size_t)NB1 * 2 * 64 * 2048 * 2;
constexpr size_t WS_BAR = WS_VTC + (size_t)NB1 * 2 * 64 * 256 * 2;
constexpr size_t WS_CNT = WS_BAR + 16384;
constexpr size_t WS_XS = WS_CNT + 32768;
constexpr size_t WS_H = WS_XS + (size_t)288 * 256 * 4 * 4;
constexpr size_t WS_END = WS_H + (size_t)T_ALL * D * 2;

constexpr int LDS_BYTES = 143360;
constexpr int N_PHASES = 1 + 17 * NL;

struct Params {
    const float* in[N_IN];
    float* out;
    unsigned char* ws;
    int ph_lo, ph_hi;
};

__device__ __forceinline__ unsigned cvt_pk_bf16(float lo, float hi) { unsigned r; asm volatile("v_cvt_pk_bf16_f32 %0, %1, %2" : "=v"(r) : "v"(lo), "v"(hi)); return r; }
__device__ __forceinline__ int tid_opaque() { int t = threadIdx.x; asm volatile("" : "+v"(t)); return t; }
__device__ __forceinline__ int bid_opaque() { int b = blockIdx.x; asm volatile("" : "+s"(b)); return b; }
__device__ __forceinline__ float bf_lo(unsigned w) { return __uint_as_float(w << 16); }
__device__ __forceinline__ float bf_hi(unsigned w) { return __uint_as_float(w & 0xffff0000u); }
__device__ __forceinline__ float fast_rcp(float x) { return __builtin_amdgcn_rcpf(x); }
__device__ __forceinline__ float fast_exp2(float x) { return __builtin_amdgcn_exp2f(x); }
__device__ __forceinline__ float sigmoidf_(float x) { return fast_rcp(1.0f + fast_exp2(-x * LOG2E)); }
__device__ __forceinline__ float siluf_(float x) { return x * sigmoidf_(x); }
__device__ __forceinline__ float gelu_tanh(float x) { const float z = 0.7978845608028654f * (x + 0.044715f * x * x * x); return x * sigmoidf_(2.0f * z); }
__device__ __forceinline__ float shx(float v, int m, int lane) { return __int_as_float(__builtin_amdgcn_ds_bpermute((lane ^ m) << 2, __float_as_int(v))); }
__device__ __forceinline__ float wave_sum(float v, int lane) {
    v += shx(v, 1, lane); v += shx(v, 2, lane); v += shx(v, 4, lane); v += shx(v, 8, lane); v += shx(v, 16, lane); v += shx(v, 32, lane); return v;
}
__device__ __forceinline__ void unpack8(const u32x4 w, float (&f)[8]) {
    f[0] = bf_lo(w.x); f[1] = bf_hi(w.x); f[2] = bf_lo(w.y); f[3] = bf_hi(w.y); f[4] = bf_lo(w.z); f[5] = bf_hi(w.z); f[6] = bf_lo(w.w); f[7] = bf_hi(w.w);
}
__device__ __forceinline__ u32x4 pack8(const float (&f)[8]) {
    u32x4 w; w.x = cvt_pk_bf16(f[0], f[1]); w.y = cvt_pk_bf16(f[2], f[3]); w.z = cvt_pk_bf16(f[4], f[5]); w.w = cvt_pk_bf16(f[6], f[7]); return w;
}

struct RowMap { size_t row0; int is_ctx; int modrow; };
__device__ __forceinline__ RowMap map_row(int u) {
    const int s = (u >= U1) ? 1 : 0, v = u - s * U1, latN = part_lat(s); RowMap r;
    if (v < latN) { r.row0 = (size_t)(s ? NB0 * SEQ : 0) + v; r.is_ctx = 0; r.modrow = (int)(r.row0 >> 11); }
    else { r.row0 = (size_t)(s ? NB0 * CTXL : 0) + (v - latN); r.is_ctx = 1; r.modrow = 32; }
    return r;
}

namespace pg8 {
constexpr int BM = 256, BK = 64, HALF = 128, HTB = HALF * BK * 2, STAGE_BYTES = 8 * HTB, NXCD = 8, WGM = 4;
__device__ __forceinline__ int lds_byte(int r, int c) { const int st = (r >> 4) * 2 + (c >> 5), rr = r & 15, cc = c & 31, ob = rr * 64 + cc * 2; return st * 1024 + (ob ^ (((ob >> 9) & 1) << 5)); }
__device__ __forceinline__ void stage_rc(int b, int& R, int& C) { const int st = b / 1024, sb = b % 1024, swz = sb ^ (((sb >> 9) & 1) << 5); R = (st >> 1) * 16 + swz / 64; C = (st & 1) * 32 + (swz % 64) / 2; }
__device__ __forceinline__ int perm32(int rho) { const int n = rho >> 4, i = rho & 15; return 8 * (i >> 2) + 4 * n + (i & 3); }

struct Unit { int pm, pn; };
struct Gemm { const bf16_t* A; int lda; const bf16_t* Bt; int ldb; int M, N, K; int skip_ctx; };

struct StaticOrder {
    int nM, nN, nwg, G, c, skip;
    __device__ void init(int M, int N, int G_, int c_, int skip_) { nM = M / BM; nN = N / BM; nwg = nM * nN; G = G_; c = c_; skip = skip_; }
    __device__ bool next(int i, Unit& u) const {
        const long L = (long)i * G + c; if (L >= nwg + 32) return false;
        if (nN == 4) {
            const int ch = (int)(L >> 5), p5 = (int)(L & 31), xcd = p5 & 7, qf = nM >> 3, rem = nM & 7;
            if (ch > qf || (ch == qf && xcd >= rem)) return false;
            u.pm = (xcd < rem ? xcd * (qf + 1) : rem * (qf + 1) + (xcd - rem) * qf) + ch; u.pn = p5 >> 3;
            if (skip && u.pm >= NB0 * 8) u.pm += NB0;
            return true;
        }
        if (L >= nwg) return false;
        int wgid = (int)L; { const int q = nwg / NXCD, r = nwg % NXCD, xcd = wgid % NXCD, off = wgid / NXCD; wgid = (xcd < r ? xcd * (q + 1) : r * (q + 1) + (xcd - r) * q) + off; }
        const int nig = WGM * nN, gid = wgid / nig, fm = gid * WGM, gsz = (nM - fm) < WGM ? (nM - fm) : WGM;
        u.pm = fm + ((wgid % nig) % gsz); u.pn = (wgid % nig) / gsz; if (skip && u.pm >= NB0 * 8) u.pm += NB0; return true;
    }
};

template <class Epi>
__device__ __forceinline__ void gemm_phase(LAS unsigned char* lds, const Gemm g, const Epi& E) {
    const int tid = tid_opaque(), wid = __builtin_amdgcn_readfirstlane(tid >> 6), lane = tid & 63, wr = wid >> 2, wc = wid & 3, fr = lane & 15, fq = lane >> 4;
    const int K = g.K, nt = K / BK;
    StaticOrder S; S.init(g.M, g.N, (int)gridDim.x, bid_opaque(), g.skip_ctx);
    unsigned voffA[2], voffB[2];
#pragma unroll
    for (int i = 0; i < 2; ++i) { int R, C; stage_rc(tid * 16 + i * 8192, R, C); const int Rb = Epi::PERM ? ((R & ~31) + perm32(R & 31)) : R;
        voffA[i] = (unsigned)(R * g.lda + C) * 2u; voffB[i] = (unsigned)(Rb * g.ldb + C) * 2u; }
    const size_t kstep = (size_t)(BK * 2);
    const size_t hstepA = (size_t)HALF * g.lda * 2, hstepB = (size_t)HALF * g.ldb * 2;
    const size_t tstepA = 2 * hstepA, tstepB = 2 * hstepB;
    const unsigned ldsw = (unsigned)wid * 1024u;
    const int aoff = lds_byte(wr * 64 + fr, fq * 8), boff = lds_byte(wc * 32 + fr, fq * 8);
#define PG8_SA(b, h) (((b) * 2 + (h)) * HTB)
#define PG8_SB(b, h) ((4 + (b) * 2 + (h)) * HTB)
#define PG8_STAGE(bufoff, gbase, voff) do { _Pragma("unroll") for (int _i = 0; _i < 2; ++_i) \
        __builtin_amdgcn_global_load_lds((const unsigned*)((const char*)(gbase) + (voff)[_i]), (LAS unsigned*)(lds + (bufoff) + ldsw + _i * 8192), 16, 0, 0); } while (0)
#define PG8_LDA(dst, b, h) do { _Pragma("unroll") for (int m = 0; m < 4; ++m) _Pragma("unroll") for (int k = 0; k < 2; ++k) dst[m][k] = *(const LAS bf16x8*)(lds + PG8_SA(b, h) + aoff + m * 2048 + k * 1024); } while (0)
#define PG8_LDB(dst, b, h) do { _Pragma("unroll") for (int n = 0; n < 2; ++n) _Pragma("unroll") for (int k = 0; k < 2; ++k) dst[n][k] = *(const LAS bf16x8*)(lds + PG8_SB(b, h) + boff + n * 2048 + k * 1024); } while (0)
#define PG8_MMA(ai, bj, At, Bt) do { __builtin_amdgcn_s_setprio(1); _Pragma("unroll") for (int m = 0; m < 4; ++m) _Pragma("unroll") for (int n = 0; n < 2; ++n) _Pragma("unroll") for (int k = 0; k < 2; ++k) \
        acc[ai][bj][m][n] = __builtin_amdgcn_mfma_f32_16x16x32_bf16(Bt[n][k], At[m][k], acc[ai][bj][m][n], 0, 0, 0); __builtin_amdgcn_s_setprio(0); } while (0)
#define PG8_WAIT_V(n) asm volatile("s_waitcnt vmcnt(" #n ")" ::: "memory")
#define PG8_WAIT_L(n) asm volatile("s_waitcnt lgkmcnt(" #n ")" ::: "memory")
#define PG8_BAR __builtin_amdgcn_s_barrier()
#define PG8_SCHED __builtin_amdgcn_sched_barrier(0)
#define PG8_KLOOP(TB, TE) for (int t = (TB); t < (TE); t += 2) { \
            const bool last = (t == nt - 2); \
            const char* a1 = cA + (size_t)(t + 1) * kstep; \
            const char* a2 = last ? nA : cA + (size_t)(t + 2) * kstep; const char* b2 = last ? nB : cB + (size_t)(t + 2) * kstep; \
            const char* a3 = a2 + kstep; const char* b3 = b2 + kstep; \
            PG8_LDB(B0, 0, 0); PG8_SCHED; PG8_LDA(At, 0, 0); PG8_STAGE(PG8_SA(1, 1), a1 + hstepA, voffA); \
            PG8_WAIT_L(8); PG8_BAR; PG8_WAIT_L(0); PG8_MMA(0, 0, At, B0); PG8_BAR; PG8_SCHED; \
            PG8_LDB(B1, 0, 1); PG8_STAGE(PG8_SB(0, 0), b2, voffB); \
            PG8_BAR; PG8_WAIT_L(0); PG8_MMA(0, 1, At, B1); PG8_BAR; \
            PG8_LDA(At, 0, 1); PG8_STAGE(PG8_SA(0, 0), a2, voffA); \
            PG8_BAR; PG8_WAIT_L(0); PG8_MMA(1, 0, At, B0); PG8_BAR; PG8_SCHED; \
            PG8_STAGE(PG8_SB(0, 1), b2 + hstepB, voffB); \
            PG8_WAIT_V(6); PG8_BAR; PG8_MMA(1, 1, At, B1); PG8_BAR; \
            PG8_LDB(B0, 1, 0); PG8_SCHED; PG8_LDA(At, 1, 0); PG8_STAGE(PG8_SA(0, 1), a2 + hstepA, voffA); \
            PG8_WAIT_L(8); PG8_BAR; PG8_WAIT_L(0); PG8_MMA(0, 0, At, B0); PG8_BAR; PG8_SCHED; \
            PG8_LDB(B1, 1, 1); PG8_STAGE(PG8_SB(1, 0), b3, voffB); \
            PG8_BAR; PG8_WAIT_L(0); PG8_MMA(0, 1, At, B1); PG8_BAR; \
            PG8_LDA(At, 1, 1); PG8_STAGE(PG8_SA(1, 0), a3, voffA); \
            PG8_BAR; PG8_WAIT_L(0); PG8_MMA(1, 0, At, B0); PG8_BAR; PG8_SCHED; \
            PG8_STAGE(PG8_SB(1, 1), b3 + hstepB, voffB); \
            PG8_WAIT_V(6); PG8_BAR; PG8_MMA(1, 1, At, B1); PG8_BAR; \
        }
    Unit cur, nxt; int ui = 0;
    if (!S.next(0, cur)) return;
    f32x4 acc[2][2][4][2];
#pragma unroll
    for (int a = 0; a < 2; ++a)
#pragma unroll
        for (int b = 0; b < 2; ++b)
#pragma unroll
            for (int m = 0; m < 4; ++m)
#pragma unroll
                for (int n = 0; n < 2; ++n) acc[a][b][m][n] = (f32x4){0.f, 0.f, 0.f, 0.f};
    bf16x8 At[4][2], B0[2][2], B1[2][2];
    const char* cA = (const char*)g.A + (size_t)cur.pm * tstepA; const char* cB = (const char*)g.Bt + (size_t)cur.pn * tstepB;
    PG8_STAGE(PG8_SB(0, 0), cB, voffB); PG8_STAGE(PG8_SA(0, 0), cA, voffA); PG8_STAGE(PG8_SB(0, 1), cB + hstepB, voffB); PG8_STAGE(PG8_SA(0, 1), cA + hstepA, voffA);
    if (wr == 1) PG8_BAR;
    PG8_WAIT_V(4); PG8_BAR;
    PG8_STAGE(PG8_SB(1, 0), cB + kstep, voffB); PG8_STAGE(PG8_SA(1, 0), cA + kstep, voffA); PG8_STAGE(PG8_SB(1, 1), cB + hstepB + kstep, voffB);
    PG8_WAIT_V(6); PG8_BAR;
    for (;;) {
        const bool has_next = S.next(ui + 1, nxt);
        const char* nA = has_next ? (const char*)g.A + (size_t)nxt.pm * tstepA : cA; const char* nB = has_next ? (const char*)g.Bt + (size_t)nxt.pn * tstepB : cB;
        if constexpr (Epi::MIDK) {
            PG8_KLOOP(0, 4)
            E.template mid<0>(acc, cur, wr, wc, fr, fq);
            PG8_KLOOP(4, 8)
            E.template mid<1>(acc, cur, wr, wc, fr, fq);
            PG8_KLOOP(8, nt)
        } else {
            PG8_KLOOP(0, nt)
        }
        E(acc, cur, wr, wc, fr, fq);
        if (!has_next) break;
#pragma unroll
        for (int a = 0; a < 2; ++a)
#pragma unroll
            for (int b = 0; b < 2; ++b)
#pragma unroll
                for (int m = 0; m < 4; ++m)
#pragma unroll
                    for (int n = 0; n < 2; ++n) acc[a][b][m][n] = (f32x4){0.f, 0.f, 0.f, 0.f};
        cur = nxt; cA = nA; cB = nB; ++ui;
    }
    PG8_WAIT_V(0);
    if (wr == 0) PG8_BAR;
    PG8_BAR;
#undef PG8_KLOOP
#undef PG8_SA
#undef PG8_SB
#undef PG8_STAGE
#undef PG8_LDA
#undef PG8_LDB
#undef PG8_MMA
#undef PG8_WAIT_V
#undef PG8_WAIT_L
#undef PG8_BAR
#undef PG8_SCHED
}

struct EpiSwiglu {
    static constexpr bool PERM = true, MIDK = false;
    bf16_t* O;
    __device__ __forceinline__ void operator()(const f32x4 (&acc)[2][2][4][2], const Unit& u, int wr, int wc, int fr, int fq) const {
        const int row0 = u.pm * BM + wr * 64 + fr, col0 = u.pn * 128 + wc * 32 + 8 * fq;
#pragma unroll
        for (int ai = 0; ai < 2; ++ai)
#pragma unroll
            for (int m = 0; m < 4; ++m) {
                float h[8];
#pragma unroll
                for (int n = 0; n < 2; ++n)
#pragma unroll
                    for (int j = 0; j < 4; j += 2) {
                        const f32x2 a2 = (f32x2){acc[ai][0][m][n][j], acc[ai][0][m][n][j + 1]}, u2 = (f32x2){acc[ai][1][m][n][j], acc[ai][1][m][n][j + 1]};
                        const f32x2 t2 = a2 * (-LOG2E);
                        f32x2 d2 = (f32x2){fast_exp2(t2[0]), fast_exp2(t2[1])}; d2 = d2 + 1.0f;
                        const f32x2 r2 = (f32x2){fast_rcp(d2[0]), fast_rcp(d2[1])};
                        const f32x2 h2 = (a2 * u2) * r2;
                        h[n * 4 + j] = h2[0]; h[n * 4 + j + 1] = h2[1]; }
                *(u32x4*)(O + (size_t)(row0 + ai * HALF + m * 16) * DFF + col0) = pack8(h);
            }
    }
};
struct EpiBf16 {
    static constexpr bool PERM = true, MIDK = false;
    bf16_t* O; int ldc; const float* bias; int bias_col0;
    __device__ __forceinline__ void operator()(const f32x4 (&acc)[2][2][4][2], const Unit& u, int wr, int wc, int fr, int fq) const {
        const int row0 = u.pm * BM + wr * 64 + fr, col0 = u.pn * BM + wc * 32 + 8 * fq;
        const bool hb = (u.pn * BM >= bias_col0);
        f32x4 bv[2][2];
#pragma unroll
        for (int bj = 0; bj < 2; ++bj)
#pragma unroll
            for (int n = 0; n < 2; ++n) bv[bj][n] = hb ? *(const f32x4*)(bias + (col0 - bias_col0) + bj * HALF + 4 * n) : (f32x4){0.f, 0.f, 0.f, 0.f};
#pragma unroll
        for (int ai = 0; ai < 2; ++ai)
#pragma unroll
            for (int m = 0; m < 4; ++m) { bf16_t* rowp = O + (size_t)(row0 + ai * HALF + m * 16) * ldc + col0;
#pragma unroll
                for (int bj = 0; bj < 2; ++bj) { f32x4 v0 = acc[ai][bj][m][0] + bv[bj][0], v1 = acc[ai][bj][m][1] + bv[bj][1];
                    if (hb) {
#pragma unroll
                        for (int j = 0; j < 4; j += 2) {
                            const f32x2 c0 = (f32x2){fminf(fmaxf(v0[j], -30.f), 30.f), fminf(fmaxf(v0[j + 1], -30.f), 30.f)} * (-LOG2E);
                            const f32x2 c1 = (f32x2){fminf(fmaxf(v1[j], -30.f), 30.f), fminf(fmaxf(v1[j + 1], -30.f), 30.f)} * (-LOG2E);
                            const f32x2 e0 = (f32x2){fast_exp2(c0[0]), fast_exp2(c0[1])} + 1.0f, e1 = (f32x2){fast_exp2(c1[0]), fast_exp2(c1[1])} + 1.0f;
                            v0[j] = e0[0]; v0[j + 1] = e0[1]; v1[j] = e1[0]; v1[j + 1] = e1[1]; } }
                    u32x4 w; w.x = cvt_pk_bf16(v0[0], v0[1]); w.y = cvt_pk_bf16(v0[2], v0[3]); w.z = cvt_pk_bf16(v1[0], v1[1]); w.w = cvt_pk_bf16(v1[2], v1[3]);
                    *(u32x4*)(rowp + bj * HALF) = w; } }
    }
};
template <int MODE_, bool FUSE_> struct EpiResid {
    static constexpr bool PERM = true, MIDK = false;
    const float* x_lat; const float* x_ctx; bf16_t* hbuf; float* out; const float* mod; int gate_idx; float gscale; int tile0; int mode;
    int nj; const float* ng; const float* nmod; bf16_t* Aout; float* xs; unsigned* cnt; LAS unsigned char* lds;
    template <int MODE> __device__ __forceinline__ void body(f32x4 (&acc)[2][2][4][2], const Unit& u, int, int, int, int) const {
        const int t_ = tid_opaque(); const int wr = t_ >> 8, wc = (t_ >> 6) & 3, fr = t_ & 15, fq = (t_ >> 4) & 3;
        const int urow0 = (tile0 + u.pm) * BM;
        const RowMap rm = map_row(urow0);
        const float* gp = mod + (size_t)rm.modrow * (NMOD * D) + gate_idx * D;
        int rloc = wr * 64 + fr, col0 = u.pn * BM + wc * 32 + 8 * fq;
        asm volatile("" : "+v"(rloc), "+v"(col0));
        const unsigned loff = (unsigned)rloc * D + (unsigned)col0;
        const char* hbase = (const char*)(hbuf + (size_t)urow0 * D);
        const char* obase = (const char*)(out + rm.row0 * D);
        const bool st_ok = (MODE != 2) || !rm.is_ctx;
        constexpr int MG = 4;
#pragma unroll
        for (int bj = 0; bj < 2; ++bj) {
            const f32x4 g0 = *(const f32x4*)(gp + col0 + bj * HALF) * gscale, g1 = *(const f32x4*)(gp + col0 + bj * HALF + 4) * gscale;
#pragma unroll
            for (int ai = 0; ai < 2; ++ai)
#pragma unroll
                for (int mg = 0; mg < 4; mg += MG) {
                    u32x4 xw[MG];
#pragma unroll
                    for (int mm = 0; mm < MG; ++mm) xw[mm] = *(const u32x4*)(hbase + (size_t)(loff + (unsigned)((ai * HALF + (mg + mm) * 16) * D + bj * HALF)) * 2u);
                    __builtin_amdgcn_sched_barrier(0);
#pragma unroll
                    for (int mm = 0; mm < MG; ++mm) { const int m = mg + mm; const unsigned eo = loff + (unsigned)((ai * HALF + m * 16) * D + bj * HALF);
                        const u32x4 w = xw[mm];
                        const f32x4 x0 = (f32x4){bf_lo(w.x), bf_hi(w.x), bf_lo(w.y), bf_hi(w.y)}, x1 = (f32x4){bf_lo(w.z), bf_hi(w.z), bf_lo(w.w), bf_hi(w.w)};
                        const f32x4 y0 = x0 + g0 * acc[ai][bj][m][0], y1 = x1 + g1 * acc[ai][bj][m][1];
                        if constexpr (MODE == 2) { if (st_ok) { *(f32x4*)(obase + (size_t)eo * 4u) = y0; *(f32x4*)(obase + (size_t)eo * 4u + 16) = y1; } }
                        else { if constexpr (!FUSE_) { u32x4 o; o.x = cvt_pk_bf16(y0[0], y0[1]); o.y = cvt_pk_bf16(y0[2], y0[3]); o.z = cvt_pk_bf16(y1[0], y1[1]); o.w = cvt_pk_bf16(y1[2], y1[3]); *(u32x4*)((char*)hbase + (size_t)eo * 2u) = o; }
                               acc[ai][bj][m][0] = y0; acc[ai][bj][m][1] = y1; }
                    }
                    __builtin_amdgcn_sched_barrier(0);
                }
        }
        if constexpr (MODE != 2) {
            if (!FUSE_) return;
            const int lane = fq * 16 + fr, T = tile0 + u.pm;
            LAS float* Pt = (LAS float*)(lds + STAGE_BYTES);
            LAS float* St = Pt + 1024;
#pragma unroll
            for (int ai = 0; ai < 2; ++ai)
#pragma unroll
                for (int m = 0; m < 4; ++m) { float sq = 0.f;
#pragma unroll
                    for (int bj = 0; bj < 2; ++bj)
#pragma unroll
                        for (int n = 0; n < 2; ++n) { const f32x4 v = acc[ai][bj][m][n]; sq += (v[0] * v[0] + v[1] * v[1]) + (v[2] * v[2] + v[3] * v[3]); }
                    sq += shx(sq, 16, lane); sq += shx(sq, 32, lane);
                    if (fq == 0) Pt[(ai * HALF + rloc + m * 16) * 4 + wc] = sq; }
            asm volatile("s_waitcnt lgkmcnt(0)" ::: "memory"); __builtin_amdgcn_s_barrier(); asm volatile("" ::: "memory");
            const int idx = wc * 32 + (lane & 31), row = (idx >> 6) * HALF + wr * 64 + (idx & 63);
            float* slot = xs + ((size_t)T * BM + row) * 4;
            if (lane < 32) { const f32x4 p4 = *(const LAS f32x4*)(Pt + row * 4);
                __hip_atomic_store(slot + u.pn, (p4[0] + p4[1]) + (p4[2] + p4[3]), __ATOMIC_RELAXED, __HIP_MEMORY_SCOPE_AGENT); }
            asm volatile("s_waitcnt vmcnt(0)" ::: "memory");
            unsigned* cw = cnt + T * 2 + wr;
            if (lane == 0) __hip_atomic_fetch_add(cw, 1u, __ATOMIC_RELAXED, __HIP_MEMORY_SCOPE_AGENT);
            unsigned loff2 = loff; asm volatile("" : "+v"(loff2));
#pragma unroll
            for (int bj = 0; bj < 2; ++bj)
#pragma unroll
                for (int ai = 0; ai < 2; ++ai)
#pragma unroll
                    for (int m = 0; m < 4; ++m) { const f32x4 y0 = acc[ai][bj][m][0], y1 = acc[ai][bj][m][1];
                        u32x4 o; o.x = cvt_pk_bf16(y0[0], y0[1]); o.y = cvt_pk_bf16(y0[2], y0[3]); o.z = cvt_pk_bf16(y1[0], y1[1]); o.w = cvt_pk_bf16(y1[2], y1[3]);
                        *(u32x4*)((char*)hbase + (size_t)(loff2 + (unsigned)((ai * HALF + m * 16) * D + bj * HALF)) * 2u) = o; }
            if (wc == 0) { unsigned spins = 0;
                while ((unsigned)__builtin_amdgcn_readfirstlane(__hip_atomic_load(cw, __ATOMIC_RELAXED, __HIP_MEMORY_SCOPE_AGENT)) < 16u) { __builtin_amdgcn_s_sleep(1); if (++spins > (1u << 19)) break; } }
            asm volatile("s_waitcnt vmcnt(0) lgkmcnt(0)" ::: "memory"); __builtin_amdgcn_s_barrier(); asm volatile("" ::: "memory");
            if (lane < 32) { float q = 0.f;
#pragma unroll
                for (int t = 0; t < 4; ++t) q += __hip_atomic_load(slot + t, __ATOMIC_RELAXED, __HIP_MEMORY_SCOPE_AGENT);
                St[row] = rsqrtf(q * (1.0f / D) + EPS); }
            asm volatile("s_waitcnt vmcnt(0) lgkmcnt(0)" ::: "memory"); __builtin_amdgcn_s_barrier(); asm volatile("" ::: "memory");
            const float* sh = nmod + (size_t)rm.modrow * (NMOD * D) + (3 * nj) * D; const float* scp = sh + D;
            char* abase = (char*)(Aout + (size_t)urow0 * D); unsigned loff3 = loff; asm volatile("" : "+v"(loff3));
#pragma unroll
            for (int bj = 0; bj < 2; ++bj) { const int cc = col0 + bj * HALF;
                const f32x4 gm0 = *(const f32x4*)(ng + cc) * (*(const f32x4*)(scp + cc) + 1.0f), gm1 = *(const f32x4*)(ng + cc + 4) * (*(const f32x4*)(scp + cc + 4) + 1.0f);
                const f32x4 s0 = *(const f32x4*)(sh + cc), s1 = *(const f32x4*)(sh + cc + 4);
#pragma unroll
                for (int ai = 0; ai < 2; ++ai)
#pragma unroll
                    for (int m = 0; m < 4; ++m) { const float rstd = St[ai * HALF + rloc + m * 16];
                        const f32x4 y0 = acc[ai][bj][m][0] * rstd * gm0 + s0, y1 = acc[ai][bj][m][1] * rstd * gm1 + s1;
                        u32x4 w; w.x = cvt_pk_bf16(y0[0], y0[1]); w.y = cvt_pk_bf16(y0[2], y0[3]); w.z = cvt_pk_bf16(y1[0], y1[1]); w.w = cvt_pk_bf16(y1[2], y1[3]);
                        *(u32x4*)(abase + (size_t)(loff3 + (unsigned)((ai * HALF + m * 16) * D + bj * HALF)) * 2u) = w; } }
        }
    }
    __device__ __forceinline__ void operator()(f32x4 (&acc)[2][2][4][2], const Unit& u, int wr, int wc, int fr, int fq) const {
        body<MODE_>(acc, u, wr, wc, fr, fq);
    }
};
struct EpiBranch {
    static constexpr bool PERM = true, MIDK = true;
    bf16_t* P;
    __device__ __forceinline__ u32x4 ld_raw(unsigned off) const { return *(const u32x4*)((const char*)P + (size_t)off * 2u); }
    __device__ __forceinline__ void to_e(const u32x4 w, float (&e)[8]) const { unpack8(w, e); }
    template <int WHICH> __device__ __forceinline__ void mid(f32x4 (&acc)[2][2][4][2], const Unit& u, int wr, int wc, int fr, int fq) const {
        unsigned base = (unsigned)(u.pm * BM + wr * 64 + fr) * PROJ + (unsigned)(u.pn * BM + wc * 32 + 8 * fq) + OFF_GATE + WHICH * D;
        asm volatile("" : "+v"(base));
#pragma unroll
        for (int ai = 0; ai < 2; ++ai)
#pragma unroll
            for (int mp = 0; mp < 2; ++mp) {
                u32x4 wa[2][2], wb[2][2];
#pragma unroll
                for (int mm = 0; mm < 2; ++mm)
#pragma unroll
                    for (int bj = 0; bj < 2; ++bj) { const unsigned o = base + (unsigned)(ai * HALF + (mp * 2 + mm) * 16) * PROJ + bj * HALF; wa[mm][bj] = ld_raw(o); wb[mm][bj] = ld_raw(o + D); }
                __builtin_amdgcn_sched_barrier(0);
#pragma unroll
                for (int mm = 0; mm < 2; ++mm)
#pragma unroll
                    for (int bj = 0; bj < 2; ++bj) { float ea[8], eb[8]; to_e(wa[mm][bj], ea); to_e(wb[mm][bj], eb);
#pragma unroll
                        for (int n = 0; n < 2; ++n)
#pragma unroll
                            for (int j = 0; j < 4; j += 2) { const f32x2 r2 = (f32x2){fast_rcp(ea[n * 4 + j]), fast_rcp(ea[n * 4 + j + 1])}, b2 = (f32x2){eb[n * 4 + j], eb[n * 4 + j + 1]};
                                const f32x2 v2 = (f32x2){acc[ai][bj][mp * 2 + mm][n][j], acc[ai][bj][mp * 2 + mm][n][j + 1]} * (b2 * r2);
                                acc[ai][bj][mp * 2 + mm][n][j] = v2[0]; acc[ai][bj][mp * 2 + mm][n][j + 1] = v2[1]; } }
                __builtin_amdgcn_sched_barrier(0);
            }
    }
    __device__ __forceinline__ void operator()(const f32x4 (&acc)[2][2][4][2], const Unit& u, int wr, int wc, int fr, int fq) const {
        unsigned base = (unsigned)(u.pm * BM + wr * 64 + fr) * PROJ + (unsigned)(u.pn * BM + wc * 32 + 8 * fq);
        asm volatile("" : "+v"(base));
#pragma unroll
        for (int ai = 0; ai < 2; ++ai) {
            u32x4 w2[4][2];
#pragma unroll
            for (int m = 0; m < 4; ++m)
#pragma unroll
                for (int bj = 0; bj < 2; ++bj) w2[m][bj] = ld_raw(base + (unsigned)(ai * HALF + m * 16) * PROJ + bj * HALF + OFF_GATE + 2 * D);
            __builtin_amdgcn_sched_barrier(0);
#pragma unroll
            for (int m = 0; m < 4; ++m)
#pragma unroll
                for (int bj = 0; bj < 2; ++bj) { const unsigned o = base + (unsigned)(ai * HALF + m * 16) * PROJ + bj * HALF;
                    float e2[8], ov[8]; to_e(w2[m][bj], e2);
#pragma unroll
                    for (int n = 0; n < 2; ++n)
#pragma unroll
                        for (int j = 0; j < 4; ++j) ov[n * 4 + j] = acc[ai][bj][m][n][j] * fast_rcp(e2[n * 4 + j]);
                    *(u32x4*)((char*)P + (size_t)o * 2u) = pack8(ov); }
            __builtin_amdgcn_sched_barrier(0);
        }
    }
};
}

__device__ __forceinline__ void tr_job(LAS float* tl, const float* src, int ld_src, int K, int Nout, bf16_t* dst, int ld_dst, int dkofs, int mode) {
    const int tid = tid_opaque();
    const int nkt = K / 64, ntl = nkt * (Nout / 64), G = gridDim.x;
    const int ln = tid & 63, lk = tid >> 6, sk2 = (tid & 31) * 2, sn = tid >> 5;
    float r[8];
    int t = bid_opaque();
    auto src_ptr = [&](int tt) -> const float* {
        const int kt = tt % nkt, n0 = (tt / nkt) * 64; int c0 = n0;
        if (mode == 1) { const int pn = n0 >> 8, rr = n0 & 255; c0 = (rr < 128) ? pn * 128 + rr : DFF + pn * 128 + (rr - 128); }
        return src + (size_t)(kt * 64 + lk) * ld_src + c0 + ln; };
    if (t < ntl) { const float* sp = src_ptr(t);
#pragma unroll
        for (int i = 0; i < 8; ++i) r[i] = sp[(size_t)(8 * i) * ld_src]; }
    for (; t < ntl; t += G) {
#pragma unroll
        for (int i = 0; i < 8; ++i) tl[(lk + 8 * i) * 65 + ln] = r[i];
        __syncthreads();
        if (t + G < ntl) { const float* sp = src_ptr(t + G);
#pragma unroll
            for (int i = 0; i < 8; ++i) r[i] = sp[(size_t)(8 * i) * ld_src]; }
        { const int kt = t % nkt, n0 = (t / nkt) * 64;
#pragma unroll
          for (int i = 0; i < 4; ++i) { const int n = sn + 16 * i; *(unsigned*)(dst + (size_t)(n0 + n) * ld_dst + dkofs + kt * 64 + sk2) = cvt_pk_bf16(tl[sk2 * 65 + n], tl[(sk2 + 1) * 65 + n]); } }
        __syncthreads();
    }
}

__device__ void phase_setup(const Params& p, LAS unsigned char* lds) {
    const int tid = tid_opaque(), wid = tid >> 6, lane = tid & 63;
    bf16_t* WT = (bf16_t*)(p.ws + WS_WT);
    LAS float* tl = (LAS float*)lds;
    for (int l = 0; l < NL; ++l) {
        bf16_t* W = WT + (size_t)l * W_LAYER;
        for (int j = 0; j < 2; ++j) {
            tr_job(tl, p.in[I_FFNIN] + ((size_t)l * 2 + j) * D * (2 * DFF), 2 * DFF, D, 2 * DFF, W + (j ? W_FIN1 : W_FIN0), D, 0, 1);
            tr_job(tl, p.in[I_FFNOUT] + ((size_t)l * 2 + j) * DFF * D, D, DFF, D, W + (j ? W_FOUT1 : W_FOUT0), DFF, 0, 0);
        }
        tr_job(tl, p.in[I_WIN] + (size_t)l * D * PROJ, PROJ, D, PROJ, W + W_WIN, D, 0, 0);
        tr_job(tl, p.in[I_WBC] + (size_t)l * 256 * D, D, 256, D, W + W_WB, D, 0, 0);
        tr_job(tl, p.in[I_WBG] + (size_t)l * 256 * D, D, 256, D, W + W_WB, D, 256, 0);
        tr_job(tl, p.in[I_WBA] + (size_t)l * 512 * D, D, 512, D, W + W_WB, D, 512, 0);
        tr_job(tl, p.in[I_WOUT] + (size_t)l * D * D, D, D, D, W + W_WO, D, 0, 0);
        for (int i = bid_opaque() * 512 + tid; i < 65536 / 2; i += gridDim.x * 512) {
            const float2 v = *(const float2*)(p.in[I_GWS] + (size_t)l * 65536 + 2 * i);
            *(unsigned*)(W + W_GWS + 2 * i) = cvt_pk_bf16(v.x, v.y);
        }
    }
    { const int gi = bid_opaque() * 512 + tid;
      if (gi < 1024) { const int pos = gi >> 4, i = gi & 15;
        const int i4 = i & 3, i16 = i >> 2;
        float inv = (i4 == 0) ? 1.0f : (i4 == 1) ? 0.5623413251903491f : (i4 == 2) ? 0.31622776601683794f : 0.1778279410038923f;
        inv *= (i16 == 0) ? 1.0f : (i16 == 1) ? 0.1f : (i16 == 2) ? 0.01f : 0.001f;
        const float a = (float)pos * inv;
        const float kq = __builtin_rintf(a * 0.6366197723675814f);
        float r = __builtin_fmaf(-kq, 1.5707963705062866f, a); r = __builtin_fmaf(kq, 4.371139000186241e-8f, r);
        const float r2 = r * r;
        const float sn = r * (1.0f + r2 * (-1.0f / 6 + r2 * (1.0f / 120 + r2 * (-1.0f / 5040 + r2 * (1.0f / 362880)))));
        const float cs = 1.0f + r2 * (-0.5f + r2 * (1.0f / 24 + r2 * (-1.0f / 720 + r2 * (1.0f / 40320 + r2 * (-1.0f / 3628800)))));
        const int q = ((int)kq) & 3;
        const float c = (q == 0) ? cs : (q == 1) ? -sn : (q == 2) ? -cs : sn;
        const float s = (q == 0) ? sn : (q == 1) ? cs : (q == 2) ? -sn : -cs;
        float2* rt = (float2*)(p.ws + WS_ROPE); rt[gi] = make_float2(c, s); } }
    if (bid_opaque() < NL * 36) {
        LAS float* sc = (LAS float*)lds;
        __syncthreads();
        for (int i = tid; i < 33 * D; i += 512) { const int r = i >> 10, k = i & 1023; const float v = (r < 32) ? p.in[I_C][r * D + k] : p.in[I_CCTX][k]; sc[i] = siluf_(v); }
        __syncthreads();
        float* MOD = (float*)(p.ws + WS_MOD);
        for (int it = bid_opaque(); it < NL * 36; it += gridDim.x) {
            const int l = it / 36, cgp = it % 36, n0 = cgp * 256 + lane * 4;
            const float* wp = p.in[I_WMOD] + (size_t)l * D * (NMOD * D) + n0;
            f32x4 a[5];
#pragma unroll
            for (int i = 0; i < 5; ++i) a[i] = (f32x4){0.f, 0.f, 0.f, 0.f};
            for (int k = 0; k < D; k += 16) {
                f32x4 w[16];
#pragma unroll
                for (int kk = 0; kk < 16; ++kk) w[kk] = *(const f32x4*)(wp + (size_t)(k + kk) * (NMOD * D));
#pragma unroll
                for (int i = 0; i < 5; ++i) { const int r = (i < 4) ? wid + 8 * i : 32;
#pragma unroll
                    for (int k4 = 0; k4 < 4; ++k4) { const f32x4 s4 = *(const LAS f32x4*)(sc + r * D + k + 4 * k4);
                        a[i] += s4[0] * w[4 * k4] + s4[1] * w[4 * k4 + 1] + s4[2] * w[4 * k4 + 2] + s4[3] * w[4 * k4 + 3]; } }
            }
            const f32x4 bv = *(const f32x4*)(p.in[I_BMOD] + (size_t)l * (NMOD * D) + n0);
#pragma unroll
            for (int i = 0; i < 5; ++i) { const int r = (i < 4) ? wid + 8 * i : 32; if (i < 4 || wid == 0) *(f32x4*)(MOD + ((size_t)l * 33 + r) * (NMOD * D) + n0) = a[i] + bv; }
        }
        __syncthreads();
    }
}

__device__ void phase_norm(const Params& p, int l, int j, bool from_inputs, bool skip_ctx) {
    const int tid = tid_opaque(), wid = tid >> 6, lane = tid & 63;
    bf16_t* A = (bf16_t*)(p.ws + WS_A);
    const bf16_t* hbuf = (const bf16_t*)(p.ws + WS_H);
    const float* MOD = (const float*)(p.ws + WS_MOD) + (size_t)l * 33 * (NMOD * D);
    const float* ng = p.in[I_NORMG] + ((size_t)l * 3 + j) * D;
    constexpr int NR = 4;
    for (int u = (bid_opaque() * 8 + wid) * NR; u < T_ALL; u += gridDim.x * 8 * NR) {
        const RowMap rm = map_row(u);
        if (skip_ctx && rm.is_ctx) continue;
        const float* sh = MOD + (size_t)rm.modrow * (NMOD * D) + (3 * j) * D; const float* sc = sh + D;
        f32x4 v[NR][4]; float ss[NR];
        if (from_inputs) { const float* x = (rm.is_ctx ? p.in[I_CTX] : p.in[I_X]) + rm.row0 * D; bf16_t* hw = (bf16_t*)(p.ws + WS_H) + (size_t)u * D;
#pragma unroll
            for (int rr = 0; rr < NR; ++rr)
#pragma unroll
                for (int i = 0; i < 4; ++i) { v[rr][i] = *(const f32x4*)(x + rr * D + i * 256 + lane * 4);
                    u32x2 w; w.x = cvt_pk_bf16(v[rr][i][0], v[rr][i][1]); w.y = cvt_pk_bf16(v[rr][i][2], v[rr][i][3]); *(u32x2*)(hw + rr * D + i * 256 + lane * 4) = w; }
        } else { const bf16_t* x = hbuf + (size_t)u * D;
#pragma unroll
            for (int rr = 0; rr < NR; ++rr)
#pragma unroll
                for (int i = 0; i < 4; ++i) { const u32x2 w = *(const u32x2*)(x + rr * D + i * 256 + lane * 4); v[rr][i] = (f32x4){bf_lo(w.x), bf_hi(w.x), bf_lo(w.y), bf_hi(w.y)}; }
        }
        f32x4 gm[4], s0[4];
#pragma unroll
        for (int i = 0; i < 4; ++i) { const int k = i * 256 + lane * 4; gm[i] = *(const f32x4*)(ng + k) * (*(const f32x4*)(sc + k) + 1.0f); s0[i] = *(const f32x4*)(sh + k); }
#pragma unroll
        for (int rr = 0; rr < NR; ++rr) { ss[rr] = 0.f;
#pragma unroll
            for (int i = 0; i < 4; ++i) ss[rr] += v[rr][i][0] * v[rr][i][0] + v[rr][i][1] * v[rr][i][1] + v[rr][i][2] * v[rr][i][2] + v[rr][i][3] * v[rr][i][3]; }
#pragma unroll
        for (int st = 1; st < 64; st <<= 1)
#pragma unroll
            for (int rr = 0; rr < NR; ++rr) ss[rr] += shx(ss[rr], st, lane);
#pragma unroll
        for (int rr = 0; rr < NR; ++rr) { const float rstd = rsqrtf(ss[rr] * (1.0f / D) + EPS);
#pragma unroll
            for (int i = 0; i < 4; ++i) { const int k = i * 256 + lane * 4;
                const f32x4 y = v[rr][i] * rstd * gm[i] + s0[i];
                u32x2 w; w.x = cvt_pk_bf16(y[0], y[1]); w.y = cvt_pk_bf16(y[2], y[3]);
                *(u32x2*)(A + (size_t)(u + rr) * D + k) = w; } }
    }
}

__device__ void phase_prep(const Params& p, int l, int hs, LAS unsigned char* lds) {
    const int THp = part_rows(hs), latN = part_lat(hs);
    const int tid = tid_opaque(), wid = tid >> 6, lane = tid & 63;
    bf16_t* P = (bf16_t*)(p.ws + WS_R1);
    bf16_t* VTL = (bf16_t*)(p.ws + WS_VTL); bf16_t* VTC = (bf16_t*)(p.ws + WS_VTC);
    const float* qg = p.in[I_QG] + l * 64; const float* kg = p.in[I_KG] + l * 64;
    LAS bf16_t* Vs = (LAS bf16_t*)lds;
    const LAS f32x2* rts = (const LAS f32x2*)(lds + 20480);
    __syncthreads();
    *(LAS u32x4*)(lds + 20480 + tid * 16) = *(const u32x4*)(p.ws + WS_ROPE + tid * 16);
    __syncthreads();
    const int c = lane & 7, seg = c >> 2, hf = (c >> 1) & 1, i0 = (c & 1) * 8;
    float gq[8], gk[8];
#pragma unroll
    for (int e = 0; e < 8; ++e) { gq[e] = qg[8 * c + e]; gk[e] = kg[8 * c + e]; }
    for (int it = bid_opaque(); it < THp / 64; it += gridDim.x) {
        const int v0 = it * 64; const bool lat = v0 < latN;
        const int prow = (v0 & (SEQ - 1)) >> 6;
        bf16_t* rowb = P + (size_t)(v0 + wid * 8) * PROJ;
        const int qoff = OFF_Q + (lane >> 3) * 64 + 8 * c, koff = OFF_K + ((lane >> 3) & 1) * 64 + 8 * c;
        u32x4 qr[8], kr[8]; unsigned vr[8];
#pragma unroll
        for (int i = 0; i < 8; ++i) { const bf16_t* rp = rowb + (size_t)i * PROJ; qr[i] = *(const u32x4*)(rp + qoff); kr[i] = *(const u32x4*)(rp + koff); vr[i] = *(const unsigned*)(rp + OFF_V + 2 * lane); }
#pragma unroll
        for (int i = 0; i < 8; ++i) {
            const int rl = wid * 8 + i;
            bf16_t* rowp = rowb + (size_t)i * PROJ;
            const int pp = seg ? rl : prow;
            float cs[8], sn[8];
#pragma unroll
            for (int e = 0; e < 8; ++e) { const f32x2 t2 = rts[pp * 16 + i0 + e]; cs[e] = lat ? t2[0] : 1.0f; sn[e] = lat ? t2[1] : 0.0f; }
            { float x[8]; unpack8(qr[i], x);
              float ss = 0.f;
#pragma unroll
              for (int e = 0; e < 8; ++e) ss += x[e] * x[e];
              ss += shx(ss, 1, lane); ss += shx(ss, 2, lane); ss += shx(ss, 4, lane);
              const float rstd = rsqrtf(ss * (1.0f / 64) + EPS); float o[8];
#pragma unroll
              for (int e = 0; e < 8; ++e) { const float y = x[e] * rstd * gq[e]; const float yp = shx(y, 2, lane);
                  o[e] = (hf ? (y * cs[e] + yp * sn[e]) : (y * cs[e] - yp * sn[e])) * (0.125f * LOG2E); }
              *(u32x4*)(rowp + qoff) = pack8(o); }
            { float x[8]; unpack8(kr[i], x);
              float ss = 0.f;
#pragma unroll
              for (int e = 0; e < 8; ++e) ss += x[e] * x[e];
              ss += shx(ss, 1, lane); ss += shx(ss, 2, lane); ss += shx(ss, 4, lane);
              const float rstd = rsqrtf(ss * (1.0f / 64) + EPS); float o[8];
#pragma unroll
              for (int e = 0; e < 8; ++e) { const float y = x[e] * rstd * gk[e]; const float yp = shx(y, 2, lane);
                  o[e] = hf ? (y * cs[e] + yp * sn[e]) : (y * cs[e] - yp * sn[e]); }
              if (lane < 16) *(u32x4*)(rowp + koff) = pack8(o); }
            { const unsigned w = vr[i];
              Vs[(2 * lane) * 72 + rl] = (bf16_t)(w & 0xffffu); Vs[(2 * lane + 1) * 72 + rl] = (bf16_t)(w >> 16); }
        }
        __syncthreads();
        { const int hd = tid >> 2, ch = tid & 3;
          bf16_t* dst;
          if (lat) { const int bl = v0 >> 11, pos0 = v0 & (SEQ - 1); dst = VTL + ((size_t)bl * 128 + hd) * SEQ + pos0 + ch * 16; }
          else { const int cv = v0 - latN, bl = cv >> 8, pos0 = cv & 255; dst = VTC + ((size_t)bl * 128 + hd) * CTXL + pos0 + ch * 16; }
          const u32x4 a = *(const LAS u32x4*)(Vs + hd * 72 + ch * 16), b = *(const LAS u32x4*)(Vs + hd * 72 + ch * 16 + 8);
          *(u32x4*)dst = a; *(u32x4*)(dst + 8) = b; }
        __syncthreads();
    }
}

struct KeySeg { const bf16_t* K; const bf16_t* Vt; int vstride; int ntiles; int mask; };

__device__ __forceinline__ void attn_item(const Params& p, int l, int hs, int idx) {
    const int tid = tid_opaque(), wid = __builtin_amdgcn_readfirstlane(tid >> 6), lane = tid & 63, fr = lane & 15, fq = lane >> 4;
    const bf16_t* P = (const bf16_t*)(p.ws + WS_R1);
    const bf16_t* VTL = (const bf16_t*)(p.ws + WS_VTL); const bf16_t* VTC = (const bf16_t*)(p.ws + WS_VTC);
    bf16_t* Y = (bf16_t*)(p.ws + WS_A) + (size_t)part_u0(hs) * D;
    const int latN = part_lat(hs), nli = part_nb(hs) * 32;
    int bl, qb, hk; bool lat;
    if (idx < nli) { lat = true; bl = idx >> 5; qb = (idx >> 1) & 15; hk = idx & 1; }
    else { const int j = idx - nli; lat = false; bl = j >> 2; qb = (j >> 1) & 1; hk = j & 1; }
    const int g = wid >> 1, r0 = (wid & 1) * 64, head = hk * 4 + g;
    const int qrow0 = lat ? bl * SEQ + qb * 128 : latN + bl * CTXL + qb * 128;
    const int crow0 = latN + bl * CTXL;
    bf16x8 qf[4][2];
    { const bf16_t* qp = P + (size_t)(qrow0 + r0 + fr) * PROJ + OFF_Q + head * 64 + fq * 8;
#pragma unroll
      for (int nq = 0; nq < 4; ++nq)
#pragma unroll
          for (int ks = 0; ks < 2; ++ks) qf[nq][ks] = *(const bf16x8*)(qp + (size_t)nq * 16 * PROJ + ks * 32); }
    f32x4 o[4][4];
#pragma unroll
    for (int a = 0; a < 4; ++a)
#pragma unroll
        for (int b = 0; b < 4; ++b) o[a][b] = (f32x4){0.f, 0.f, 0.f, 0.f};
    const float snk = p.in[I_SINK][l * 8 + head] * LOG2E;
    float mrun[4], lrun[4];
#pragma unroll
    for (int nq = 0; nq < 4; ++nq) { mrun[nq] = snk; lrun[nq] = (fq == 0) ? 1.0f : 0.0f; }

    int lo = 0, nb = 0;
    if (lat) { lo = (qb == 0) ? 4 : (r0 >> 5); const int hi = (qb == 15) ? 8 : (r0 == 0 ? 10 : 12); nb = hi - lo; }
    const int ntot = nb + 8;
    const char* kband = (const char*)(P + (ptrdiff_t)(bl * SEQ + (qb - 1) * 128 + lo * 32) * PROJ + OFF_K + hk * 64);
    const char* kctx = (const char*)(P + (size_t)crow0 * PROJ + OFF_K + hk * 64);
    const char* vband = (const char*)(VTL + ((size_t)bl * 2 + hk) * 64 * SEQ + (ptrdiff_t)((qb - 1) * 128 + lo * 32));
    const char* vctx = (const char*)(VTC + ((size_t)bl * 2 + hk) * 64 * CTXL);
    const unsigned klane = (unsigned)(fr * PROJ + fq * 8) * 2u, vlane_b = (unsigned)(fr * SEQ + fq * 4) * 2u, vlane_c = (unsigned)(fr * CTXL + fq * 4) * 2u;
#define ATT_LOAD(i_, KF, VLO, VHI) do { const int _i = (i_); \
        if (_i < nb) { const char* _kp = kband + (size_t)_i * (32 * PROJ * 2); const char* _vp = vband + _i * 64; \
            _Pragma("unroll") for (int kb = 0; kb < 2; ++kb) _Pragma("unroll") for (int ks = 0; ks < 2; ++ks) KF[kb][ks] = *(const bf16x8*)(_kp + kb * (16 * PROJ * 2) + ks * 64 + klane); \
            _Pragma("unroll") for (int db = 0; db < 4; ++db) { VLO[db] = *(const bf16x4*)(_vp + db * (16 * SEQ * 2) + vlane_b); VHI[db] = *(const bf16x4*)(_vp + db * (16 * SEQ * 2) + 32 + vlane_b); } \
        } else { const char* _kp = kctx + (size_t)(_i - nb) * (32 * PROJ * 2); const char* _vp = vctx + (_i - nb) * 64; \
            _Pragma("unroll") for (int kb = 0; kb < 2; ++kb) _Pragma("unroll") for (int ks = 0; ks < 2; ++ks) KF[kb][ks] = *(const bf16x8*)(_kp + kb * (16 * PROJ * 2) + ks * 64 + klane); \
            _Pragma("unroll") for (int db = 0; db < 4; ++db) { VLO[db] = *(const bf16x4*)(_vp + db * (16 * CTXL * 2) + vlane_c); VHI[db] = *(const bf16x4*)(_vp + db * (16 * CTXL * 2) + 32 + vlane_c); } } } while (0)
#define ATT_COMPUTE(i_, KF, VLO, VHI) do { const int _ci = (i_); const int bt = lo + _ci; const bool mask = (_ci < nb) && (bt < 4 || bt >= 8); \
        f32x4 s[2][4]; \
        _Pragma("unroll") for (int kb = 0; kb < 2; ++kb) _Pragma("unroll") for (int nq = 0; nq < 4; ++nq) { \
            s[kb][nq] = __builtin_amdgcn_mfma_f32_16x16x32_bf16(KF[kb][0], qf[nq][0], (f32x4){0.f, 0.f, 0.f, 0.f}, 0, 0, 0); \
            s[kb][nq] = __builtin_amdgcn_mfma_f32_16x16x32_bf16(KF[kb][1], qf[nq][1], s[kb][nq], 0, 0, 0); } \
        if (mask) { \
            _Pragma("unroll") for (int kb = 0; kb < 2; ++kb) _Pragma("unroll") for (int nq = 0; nq < 4; ++nq) _Pragma("unroll") for (int j = 0; j < 4; ++j) { \
                const int dlt = (bt * 32 - 128 + kb * 16 + fq * 4 + j) - (r0 + nq * 16 + fr); if (dlt > 128 || dlt < -128) s[kb][nq][j] = -1e30f; } } \
        bf16x8 pf[4]; \
        _Pragma("unroll") for (int nq = 0; nq < 4; ++nq) { \
            float mx = fmaxf(fmaxf(fmaxf(s[0][nq][0], s[0][nq][1]), fmaxf(s[0][nq][2], s[0][nq][3])), fmaxf(fmaxf(s[1][nq][0], s[1][nq][1]), fmaxf(s[1][nq][2], s[1][nq][3]))); \
            mx = fmaxf(mx, shx(mx, 16, lane)); mx = fmaxf(mx, shx(mx, 32, lane)); \
            const float mn = fmaxf(mrun[nq], mx), alpha = fast_exp2(mrun[nq] - mn); mrun[nq] = mn; \
            float pv[8]; f32x2 ps2 = (f32x2){0.f, 0.f}; const f32x2 mn2 = (f32x2){mn, mn}; \
            _Pragma("unroll") for (int kb = 0; kb < 2; ++kb) _Pragma("unroll") for (int j = 0; j < 4; j += 2) { \
                const f32x2 d2 = (f32x2){s[kb][nq][j], s[kb][nq][j + 1]} - mn2; const f32x2 e2 = (f32x2){fast_exp2(d2[0]), fast_exp2(d2[1])}; \
                pv[kb * 4 + j] = e2[0]; pv[kb * 4 + j + 1] = e2[1]; ps2 = ps2 + e2; } \
            lrun[nq] = lrun[nq] * alpha + (ps2[0] + ps2[1]); \
            const u32x4 w = pack8(pv); pf[nq] = *(const bf16x8*)&w; \
            _Pragma("unroll") for (int db = 0; db < 4; ++db) o[db][nq] *= alpha; } \
        _Pragma("unroll") for (int db = 0; db < 4; ++db) { const bf16x8 vf = (bf16x8){VLO[db][0], VLO[db][1], VLO[db][2], VLO[db][3], VHI[db][0], VHI[db][1], VHI[db][2], VHI[db][3]}; \
            _Pragma("unroll") for (int nq = 0; nq < 4; ++nq) o[db][nq] = __builtin_amdgcn_mfma_f32_16x16x32_bf16(vf, pf[nq], o[db][nq], 0, 0, 0); } } while (0)
    bf16x8 kfa[2][2], kfb[2][2]; bf16x4 vla[4], vha[4], vlb[4], vhb[4];
    ATT_LOAD(0, kfa, vla, vha);
    for (int i = 0; i < ntot; i += 2) {
        const int i1 = (i + 1 < ntot) ? i + 1 : i;
        ATT_LOAD(i1, kfb, vlb, vhb);
        ATT_COMPUTE(i, kfa, vla, vha);
        const int i2 = (i + 2 < ntot) ? i + 2 : i;
        ATT_LOAD(i2, kfa, vla, vha);
        if (i + 1 < ntot) ATT_COMPUTE(i + 1, kfb, vlb, vhb);
    }
#undef ATT_LOAD
#undef ATT_COMPUTE
#pragma unroll
    for (int nq = 0; nq < 4; ++nq) {
        float lt = lrun[nq]; lt += shx(lt, 16, lane); lt += shx(lt, 32, lane);
        const float inv = 1.0f / lt;
        bf16_t* yp = Y + (size_t)(qrow0 + r0 + nq * 16 + fr) * D + 512 + head * 64 + fq * 4;
#pragma unroll
        for (int db = 0; db < 4; ++db) { u32x2 w; w.x = cvt_pk_bf16(o[db][nq][0] * inv, o[db][nq][1] * inv); w.y = cvt_pk_bf16(o[db][nq][2] * inv, o[db][nq][3] * inv);
            *(u32x2*)(yp + db * 16) = w; }
    }
}

__device__ __forceinline__ void gmlp_conv_item(const Params& p, int l, int hs, int chunk, LAS unsigned char* lds) {
    const int tid = tid_opaque(), wid = tid >> 6, lane = tid & 63, fr = lane & 15, fq = lane >> 4;
    const bf16_t* P = (const bf16_t*)(p.ws + WS_R1);
    bf16_t* Y = (bf16_t*)(p.ws + WS_A) + (size_t)part_u0(hs) * D;
    const int v0 = chunk * 128, latN = part_lat(hs);
    LAS bf16_t* vT = (LAS bf16_t*)lds;
    { const float* cw = p.in[I_CONVW] + (size_t)l * 3 * 256;
      const bool lat = v0 < latN;
#pragma unroll 2
      for (int i = 0; i < 8; ++i) {
          const int id = i * 512 + tid, pt = id >> 5, cc = (id & 31) * 8, v = v0 + pt;
          const int pos = lat ? (v & (SEQ - 1)) : ((v - latN) & (CTXL - 1)), n = lat ? SEQ : CTXL;
          const bf16_t* rp = P + (size_t)v * PROJ + cc;
          float bv[8], c1[8], h1[8], acc[8];
          unpack8(*(const u32x4*)(rp + OFF_CB), bv); unpack8(*(const u32x4*)(rp + OFF_CC), c1); unpack8(*(const u32x4*)(rp + OFF_CH), h1);
          { const f32x4 wa = *(const f32x4*)(cw + 256 + cc), wb = *(const f32x4*)(cw + 256 + cc + 4);
#pragma unroll
            for (int e = 0; e < 8; ++e) acc[e] = c1[e] * h1[e] * (e < 4 ? wa[e & 3] : wb[e & 3]); }
          if (pos > 0) { float c0[8], h0[8]; unpack8(*(const u32x4*)(rp - PROJ + OFF_CC), c0); unpack8(*(const u32x4*)(rp - PROJ + OFF_CH), h0);
              const f32x4 wa = *(const f32x4*)(cw + cc), wb = *(const f32x4*)(cw + cc + 4);
#pragma unroll
              for (int e = 0; e < 8; ++e) acc[e] += c0[e] * h0[e] * (e < 4 ? wa[e & 3] : wb[e & 3]); }
          if (pos < n - 1) { float c2[8], h2[8]; unpack8(*(const u32x4*)(rp + PROJ + OFF_CC), c2); unpack8(*(const u32x4*)(rp + PROJ + OFF_CH), h2);
              const f32x4 wa = *(const f32x4*)(cw + 512 + cc), wb = *(const f32x4*)(cw + 512 + cc + 4);
#pragma unroll
              for (int e = 0; e < 8; ++e) acc[e] += c2[e] * h2[e] * (e < 4 ? wa[e & 3] : wb[e & 3]); }
#pragma unroll
          for (int e = 0; e < 8; ++e) acc[e] *= bv[e];
          *(u32x4*)(Y + (size_t)v * D + cc) = pack8(acc);
      } }
    { const float* lg = p.in[I_LNG] + l * 256 + 4 * lane; const float* lb = p.in[I_LNB] + l * 256 + 4 * lane;
      const f32x4 g4 = *(const f32x4*)lg, b4 = *(const f32x4*)lb;
#pragma unroll
      for (int hb = 0; hb < 2; ++hb) {
          u32x2 w[8]; float x[8][4], sm[8], qv[8];
#pragma unroll
          for (int i = 0; i < 8; ++i) w[i] = *(const u32x2*)(P + (size_t)(v0 + wid * 16 + hb * 8 + i) * PROJ + OFF_GV + 4 * lane);
#pragma unroll
          for (int i = 0; i < 8; ++i) { x[i][0] = gelu_tanh(bf_lo(w[i].x)); x[i][1] = gelu_tanh(bf_hi(w[i].x)); x[i][2] = gelu_tanh(bf_lo(w[i].y)); x[i][3] = gelu_tanh(bf_hi(w[i].y));
              sm[i] = (x[i][0] + x[i][1]) + (x[i][2] + x[i][3]); }
#pragma unroll
          for (int st = 1; st < 64; st <<= 1)
#pragma unroll
              for (int i = 0; i < 8; ++i) sm[i] += shx(sm[i], st, lane);
#pragma unroll
          for (int i = 0; i < 8; ++i) { const float mu = sm[i] * (1.0f / 256); float q = 0.f;
#pragma unroll
              for (int e = 0; e < 4; ++e) { x[i][e] -= mu; q += x[i][e] * x[i][e]; }
              qv[i] = q; }
#pragma unroll
          for (int st = 1; st < 64; st <<= 1)
#pragma unroll
              for (int i = 0; i < 8; ++i) qv[i] += shx(qv[i], st, lane);
#pragma unroll
          for (int i = 0; i < 8; ++i) { const float rstd = rsqrtf(qv[i] * (1.0f / 256) + EPS); const int pt = wid * 16 + hb * 8 + i;
#pragma unroll
              for (int e = 0; e < 4; ++e) { const float y = x[i][e] * rstd * g4[e] + b4[e]; vT[(4 * lane + e) * 136 + pt] = (bf16_t)(cvt_pk_bf16(y, 0.f) & 0xffffu); } }
      } }
    __syncthreads();
    { const int g = wid >> 1, ph = wid & 1;
      const bf16_t* wsb = (const bf16_t*)(p.ws + WS_WT) + (size_t)l * W_LAYER + W_GWS + (size_t)g * 128 * 128;
      f32x4 acc[4][4];
#pragma unroll
      for (int a = 0; a < 4; ++a)
#pragma unroll
          for (int b = 0; b < 4; ++b) acc[a][b] = (f32x4){0.f, 0.f, 0.f, 0.f};
#pragma unroll
      for (int kk = 0; kk < 4; ++kk) {
          bf16x8 af[4], bfr[4];
#pragma unroll
          for (int db = 0; db < 4; ++db) af[db] = *(const LAS bf16x8*)(vT + (g * 64 + db * 16 + fr) * 136 + kk * 32 + fq * 8);
#pragma unroll
          for (int pb = 0; pb < 4; ++pb) bfr[pb] = *(const bf16x8*)(wsb + (size_t)((ph * 4 + pb) * 16 + fr) * 128 + kk * 32 + fq * 8);
#pragma unroll
          for (int db = 0; db < 4; ++db)
#pragma unroll
              for (int pb = 0; pb < 4; ++pb) acc[db][pb] = __builtin_amdgcn_mfma_f32_16x16x32_bf16(af[db], bfr[pb], acc[db][pb], 0, 0, 0);
      }
      const float* bs = p.in[I_GBS] + (size_t)l * 512 + g * 128;
      u32x2 uw[4][4]; float bias[4];
#pragma unroll
      for (int pb = 0; pb < 4; ++pb) { const int pt = (ph * 4 + pb) * 16 + fr; bias[pb] = bs[pt];
          const bf16_t* up = P + (size_t)(v0 + pt) * PROJ + OFF_GU + g * 64 + fq * 4;
#pragma unroll
          for (int db = 0; db < 4; ++db) uw[pb][db] = *(const u32x2*)(up + db * 16); }
#pragma unroll
      for (int pb = 0; pb < 4; ++pb) { const int pt = (ph * 4 + pb) * 16 + fr;
          bf16_t* yp = Y + (size_t)(v0 + pt) * D + 256 + g * 64 + fq * 4;
#pragma unroll
          for (int db = 0; db < 4; ++db) { const u32x2 w = uw[pb][db];
              const float y0 = gelu_tanh(bf_lo(w.x)) * (acc[db][pb][0] + bias[pb]), y1 = gelu_tanh(bf_hi(w.x)) * (acc[db][pb][1] + bias[pb]);
              const float y2 = gelu_tanh(bf_lo(w.y)) * (acc[db][pb][2] + bias[pb]), y3 = gelu_tanh(bf_hi(w.y)) * (acc[db][pb][3] + bias[pb]);
              u32x2 ov; ov.x = cvt_pk_bf16(y0, y1); ov.y = cvt_pk_bf16(y2, y3); *(u32x2*)(yp + db * 16) = ov; } } }
    __syncthreads();
}

__device__ void phase_mixers(const Params& p, int l, int hs, LAS unsigned char* lds, bool skip_ctx) {
    const int n_attn = part_nb(hs) * (skip_ctx ? 32 : 36), n_gmlp = (skip_ctx ? part_lat(hs) : part_rows(hs)) / 128;
#ifndef SKIP_ATTN
    for (int it = bid_opaque(); it < n_attn; it += gridDim.x) attn_item(p, l, hs, it);
#endif
    __builtin_amdgcn_sched_barrier(0);
#ifndef SKIP_GMLP
    { const int G = (int)gridDim.x; int n3 = n_attn - 2 * G; n3 = n3 < 0 ? 0 : n3 % G;
      for (int it = (bid_opaque() - n3 + G) % G; it < n_gmlp; it += G) gmlp_conv_item(p, l, hs, it, lds); }
#endif
}

#define XB_TMO      128
#define XB_XCNT(j)  (256  + 64 * (j))
#define XB_XSUB(j)  (1280 + 64 * (j))
#define XB_XGEN(j)  (2304 + 64 * (j))
#define XB_TOP      3328
#define XB_TOPGEN   3392
#define XCD_BAR_WORDS 3456
#define XB_SPIN_CAP (1u << 22)
__device__ __forceinline__ unsigned xb_ld(unsigned* p)              { return __hip_atomic_load(p, __ATOMIC_RELAXED, __HIP_MEMORY_SCOPE_AGENT); }
__device__ __forceinline__ unsigned xb_add(unsigned* p, unsigned v) { return __hip_atomic_fetch_add(p, v, __ATOMIC_RELAXED, __HIP_MEMORY_SCOPE_AGENT); }
__device__ __forceinline__ unsigned xb_xcc_id() { return (unsigned)__builtin_amdgcn_s_getreg((3 << 11) | 20) & 0xFu; }
#define XB_SPIN(cond, bar) do { unsigned _sp = 0; while (cond) { __builtin_amdgcn_s_sleep(1); \
    if ((++_sp & 255u) == 0u) { if (xb_ld(&(bar)[XB_TMO])) break; if (_sp > XB_SPIN_CAP) { atomicAdd(&(bar)[XB_TMO], 1u); break; } } } } while (0)
__device__ __forceinline__ void xcd_barrier_post(unsigned* bar) { if (threadIdx.x == 0) (void)xb_add(&bar[XB_XCNT(xb_xcc_id())], 1u); }
__device__ __forceinline__ void xcd_barrier_complete(unsigned* bar, unsigned x, unsigned& nloc, unsigned& nx) {
    const unsigned G = gridDim.x * gridDim.y * gridDim.z;
    unsigned sum, cnt, mine, sp = 0u;
    for (;;) {
        sum = 0u; cnt = 0u; mine = 0u;
#pragma unroll
        for (unsigned j = 0; j < 16; ++j) { const unsigned c = xb_ld(&bar[XB_XCNT(j)]); sum += c; cnt += (c > 0u) ? 1u : 0u; mine = (j == x) ? c : mine; }
        if (sum == G) break;
        __builtin_amdgcn_s_sleep(1);
        if ((++sp & 255u) == 0u) { if (xb_ld(&bar[XB_TMO])) break; if (sp > XB_SPIN_CAP) { atomicAdd(&bar[XB_TMO], 1u); break; } }
    }
    nloc = mine > 0u ? mine : 1u; nx = cnt > 0u ? cnt : 1u;
}
__device__ __forceinline__ void xcd_barrier(unsigned* bar, volatile LAS unsigned* st) {
    asm volatile("s_waitcnt vmcnt(0)" ::: "memory");
    __syncthreads();
    if (threadIdx.x == 0) {
        const unsigned x = xb_xcc_id();
        __builtin_amdgcn_s_waitcnt(0);
        unsigned nloc = st[0], nx = st[1];
        if (nloc == 0u) { xcd_barrier_complete(bar, x, nloc, nx); st[0] = nloc; st[1] = nx; }
        const unsigned old = xb_add(&bar[XB_XSUB(x)], 1u);
        const unsigned gen = old / nloc;
        if (old + 1u == (gen + 1u) * nloc) {
            __builtin_amdgcn_fence(__ATOMIC_RELEASE, "agent");
            asm volatile("s_waitcnt vmcnt(0)" ::: "memory");
            const unsigned og = xb_add(&bar[XB_TOP], 1u);
            const unsigned tg = og / nx;
            if (og + 1u == (tg + 1u) * nx) xb_add(&bar[XB_TOPGEN], 1u);
            else XB_SPIN(xb_ld(&bar[XB_TOPGEN]) == tg, bar);
            __builtin_amdgcn_fence(__ATOMIC_ACQUIRE, "agent");
            xb_add(&bar[XB_XGEN(x)], 1u);
            asm volatile("s_waitcnt vmcnt(0)" ::: "memory");
        } else {
            XB_SPIN(xb_ld(&bar[XB_XGEN(x)]) == gen, bar);
            __builtin_amdgcn_fence(__ATOMIC_ACQUIRE, "agent");
            asm volatile("s_waitcnt vmcnt(0)" ::: "memory");
        }
    }
    __syncthreads();
}

__device__ void run_phase(const Params& p, int ph, LAS unsigned char* lds) {
    if (ph == 0) {
#ifndef SKIP_SETUP
 phase_setup(p, lds);
#endif
 return; }
    const int q = ph - 1, l = q / 17, r = q % 17;
    const bf16_t* W = (const bf16_t*)(p.ws + WS_WT) + (size_t)l * W_LAYER;
    const float* MOD = (const float*)(p.ws + WS_MOD) + (size_t)l * 33 * (NMOD * D);
    bf16_t* HB = (bf16_t*)(p.ws + WS_H);
    const bool first = (l == 0 && r <= 2);
    const bool lastl = (l == NL - 1);
    bf16_t* A = (bf16_t*)(p.ws + WS_A); bf16_t* R1 = (bf16_t*)(p.ws + WS_R1);
    if (r == 0 || r == 3 || r == 14) {
#ifndef SKIP_NORM
 if (l == 0 && r == 0) phase_norm(p, l, 0, true, false);
#endif
 return; }
    if (r == 1 || r == 15) {
        const int j = (r == 1) ? 0 : 1;
        const int sk = (lastl && j == 1) ? 1 : 0;
        pg8::Gemm g{A, D, W + (j ? W_FIN1 : W_FIN0), D, sk ? T_LAT : T_ALL, 2 * DFF, D, sk};
        pg8::EpiSwiglu E{R1};
#ifndef SKIP_UP
        pg8::gemm_phase(lds, g, E);
#endif
        return;
    }
    if (r == 2 || r == 16) {
        const int j = (r == 2) ? 0 : 1;
        const int sk = (lastl && j == 1) ? 1 : 0;
        pg8::Gemm g{R1, DFF, W + (j ? W_FOUT1 : W_FOUT0), DFF, sk ? T_LAT : T_ALL, D, DFF, sk};
        const int nj = (r == 2) ? 1 : (lastl ? -1 : 0), ln = (r == 2) ? l : l + 1;
        const bool fin = (lastl && r == 16);
        const float* ngp = p.in[I_NORMG] + ((size_t)(nj < 0 ? 0 : ln) * 3 + (nj < 0 ? 0 : nj)) * D; const float* nmp = (const float*)(p.ws + WS_MOD) + (size_t)(nj < 0 ? 0 : ln) * 33 * (NMOD * D);
        unsigned* cntp = (unsigned*)(p.ws + WS_CNT) + (size_t)(l * 3 + (r == 2 ? 0 : 2)) * 576;
#ifndef SKIP_DOWN
        if (fin) { pg8::EpiResid<2, false> E{p.in[I_X], p.in[I_CTX], HB, p.out, MOD, 8, 0.5f, 0, 2, -1, ngp, nmp, A, (float*)(p.ws + WS_XS), cntp, lds}; pg8::gemm_phase(lds, g, E); }
        else { pg8::EpiResid<1, true> E{p.in[I_X], p.in[I_CTX], HB, p.out, MOD, j ? 8 : 2, 0.5f, 0, 1, nj, ngp, nmp, A, (float*)(p.ws + WS_XS), cntp, lds}; pg8::gemm_phase(lds, g, E); }
#endif
        return;
    }
    const int hs = (r - 4) / 5, rr = (r - 4) % 5;
    if (rr == 0) { pg8::Gemm g{A + (size_t)part_u0(hs) * D, D, W + W_WIN, D, part_rows(hs), PROJ, D, 0}; pg8::EpiBf16 E{R1, PROJ, p.in[I_BGATE] + (size_t)l * 3 * D, OFF_GATE};
#ifndef SKIP_PROJ
 pg8::gemm_phase(lds, g, E);
#endif
 return; }
    if (rr == 1) {
#ifndef SKIP_PREP
 phase_prep(p, l, hs, lds);
#endif
 return; }
    if (rr == 2) {
#ifndef SKIP_MIX
 phase_mixers(p, l, hs, lds, lastl);
#endif
 return; }
    if (rr == 3) { pg8::Gemm g{A + (size_t)part_u0(hs) * D, D, W + W_WB, D, lastl ? part_lat(hs) : part_rows(hs), D, D, 0}; pg8::EpiBranch E{R1};
#ifndef SKIP_BRANCH
 pg8::gemm_phase(lds, g, E);
#endif
 return; }
    { pg8::Gemm g{R1, PROJ, W + W_WO, D, lastl ? part_lat(hs) : part_rows(hs), D, D, 0}; pg8::EpiResid<1, true> E{p.in[I_X], p.in[I_CTX], HB, p.out, MOD, 5, 1.0f, part_u0(hs) / 256, 1,
                        2, p.in[I_NORMG] + ((size_t)l * 3 + 2) * D, MOD, A, (float*)(p.ws + WS_XS), (unsigned*)(p.ws + WS_CNT) + (size_t)(l * 3 + 1) * 576, lds};
#ifndef SKIP_OUT
 pg8::gemm_phase(lds, g, E);
#endif
 }
}

__global__ __launch_bounds__(512, 2) void fwd_megakernel(Params p) {
    extern __shared__ __attribute__((aligned(16))) unsigned char shm[];
    LAS unsigned char* lds = (LAS unsigned char*)shm;
#if MK_SINGLE
    volatile LAS unsigned* bst = (volatile LAS unsigned*)(lds + LDS_BYTES - 16);
    if (threadIdx.x == 0) { bst[0] = 0u; bst[1] = 0u; }
    __syncthreads();
    xcd_barrier_post((unsigned*)(p.ws + WS_BAR));
#endif
    for (int ph = p.ph_lo; ph < p.ph_hi; ++ph) {
#if defined(__HIP_DEVICE_COMPILE__)
        const __attribute__((address_space(4))) char* kp = (const __attribute__((address_space(4))) char*)__builtin_amdgcn_kernarg_segment_ptr();
        asm volatile("" : "+s"(kp));
        const Params lp = *(const Params*)(const char*)kp;
#else
        const Params lp = p;
#endif
        run_phase(lp, ph, lds);
#if MK_SINGLE
        const int r_ = (ph - 1) % 17;
        if (ph + 1 < lp.ph_hi && !(ph > 1 && (r_ == 0 || r_ == 3 || r_ == 14))) {
            if (ph == 0) cg::this_grid().sync();
            else xcd_barrier((unsigned*)(lp.ws + WS_BAR), (volatile LAS unsigned*)(lds + LDS_BYTES - 16));
        }
#endif
    }
}

extern "C" void kernel_launch(void* const* d_in, const int* in_sizes, int n_in, void* d_out, int out_size, void* d_ws, size_t ws_size, hipStream_t stream) {
    static int grid = 0;
    if (grid == 0) {
        if (n_in != N_IN || out_size != T_LAT * D || ws_size < WS_END) { fprintf(stderr, "kernel_launch: unexpected shapes (n_in %d out %d ws %zu need %zu)\n", n_in, out_size, ws_size, (size_t)WS_END); grid = -1; return; }
        int dev = 0, cus = 0, per_cu = 0;
        (void)hipGetDevice(&dev); (void)hipDeviceGetAttribute(&cus, hipDeviceAttributeMultiprocessorCount, dev);
        if (hipFuncSetAttribute((const void*)fwd_megakernel, hipFuncAttributeMaxDynamicSharedMemorySize, LDS_BYTES) != hipSuccess) { fprintf(stderr, "kernel_launch: hipFuncSetAttribute failed\n"); grid = -1; return; }
        if (hipOccupancyMaxActiveBlocksPerMultiprocessor(&per_cu, (const void*)fwd_megakernel, 512, LDS_BYTES) != hipSuccess || per_cu < 1) { fprintf(stderr, "kernel_launch: occupancy query gave %d\n", per_cu); per_cu = 1; }
        (void)hipGetLastError();
        grid = cus * per_cu;
    }
    if (grid < 0) return;
    Params p{};
    for (int i = 0; i < N_IN; ++i) p.in[i] = (const float*)d_in[i];
    p.out = (float*)d_out; p.ws = (unsigned char*)d_ws;
#if MK_SINGLE
    p.ph_lo = 0; p.ph_hi = N_PHASES;
    if (hipMemsetAsync((char*)d_ws + WS_BAR, 0, 16384 + 32768, stream) != hipSuccess) { fprintf(stderr, "kernel_launch: memset of the barrier words failed\n"); return; }
    void* args[] = {&p};
    hipError_t e = hipLaunchCooperativeKernel((const void*)fwd_megakernel, dim3(grid), dim3(512), args, LDS_BYTES, stream);
    if (e != hipSuccess) fprintf(stderr, "cooperative launch failed: %s (grid %d)\n", hipGetErrorString(e), grid);
#else
    for (int ph = 0; ph < N_PHASES; ++ph) {
        p.ph_lo = ph; p.ph_hi = ph + 1;
        hipLaunchKernelGGL(fwd_megakernel, dim3(grid), dim3(512), LDS_BYTES, stream, p);
    }
#endif
}
```

```cpp
#include <hip/hip_runtime.h>
#include <hip/hip_cooperative_groups.h>
#include <cstdio>
namespace cg = cooperative_groups;

#ifndef MK_SINGLE
#define MK_SINGLE 1
#endif

#define LAS __attribute__((address_space(3)))
typedef unsigned short bf16_t;
typedef short bf16x8 __attribute__((ext_vector_type(8)));
typedef short bf16x4 __attribute__((ext_vector_type(4)));
typedef float f32x4 __attribute__((ext_vector_type(4)));
typedef unsigned u32x4 __attribute__((ext_vector_type(4)));
typedef unsigned u32x2 __attribute__((ext_vector_type(2)));
typedef float f32x2 __attribute__((ext_vector_type(2)));

constexpr int D = 1024, NB = 32, SEQ = 2048, NL = 4, CTXL = 256, DFF = 2816, PROJ = 5120, NMOD = 9;
constexpr int T_LAT = NB * SEQ, T_CTX = NB * CTXL, T_ALL = T_LAT + T_CTX;
constexpr int NB0 = 14, NB1 = NB - NB0;
constexpr int U1 = NB0 * (SEQ + CTXL);
constexpr int TH_MAX = NB1 * (SEQ + CTXL);
__host__ __device__ __forceinline__ constexpr int part_nb(int s) { return s ? NB1 : NB0; }
__host__ __device__ __forceinline__ constexpr int part_lat(int s) { return part_nb(s) * SEQ; }
__host__ __device__ __forceinline__ constexpr int part_rows(int s) { return part_nb(s) * (SEQ + CTXL); }
__host__ __device__ __forceinline__ constexpr int part_u0(int s) { return s ? U1 : 0; }
constexpr int OFF_CB = 0, OFF_CC = 256, OFF_CH = 512, OFF_GU = 768, OFF_GV = 1024, OFF_Q = 1280, OFF_K = 1792, OFF_V = 1920, OFF_GATE = 2048;
constexpr float EPS = 1e-6f;
constexpr float LOG2E = 1.4426950408889634f;

enum { I_X = 0, I_C, I_CTX, I_CCTX, I_WMOD, I_BMOD, I_NORMG, I_FFNIN, I_FFNOUT, I_WIN, I_BGATE, I_CONVW, I_LNG, I_LNB, I_GWS, I_GBS, I_QG, I_KG, I_SINK, I_WBC, I_WBG, I_WBA, I_WOUT, N_IN };

constexpr size_t W_FIN0 = 0, W_FIN1 = 5767168, W_FOUT0 = 11534336, W_FOUT1 = 14417920, W_WIN = 17301504, W_WB = 22544384, W_WO = 23592960, W_GWS = 24641536, W_LAYER = 24707072;
constexpr size_t WS_WT = 0;
constexpr size_t WS_MOD = WS_WT + NL * W_LAYER * 2;
constexpr size_t WS_ROPE = WS_MOD + (size_t)NL * 33 * 9216 * 4;
constexpr size_t WS_HC = WS_ROPE + 8192;
constexpr size_t WS_A = WS_HC + (size_t)T_CTX * D * 4;
constexpr size_t WS_R1 = WS_A + (size_t)T_ALL * D * 2;
constexpr size_t WS_VTL = WS_R1 + (size_t)TH_MAX * PROJ * 2;
constexpr size_t WS_VTC = WS_VTL + (size_t)NB1 * 2 * 64 * 2048 * 2;
constexpr size_t WS_BAR = WS_VTC + (size_t)NB1 * 2 * 64 * 256 * 2;
constexpr size_t WS_CNT = WS_BAR + 16384;
constexpr size_t WS_XS = WS_CNT + 32768;
constexpr size_t WS_H = WS_XS + (size_t)288 * 256 * 4 * 4;
constexpr size_t WS_END = WS_H + (size_t)T_ALL * D * 2;

constexpr int LDS_BYTES = 143360;
constexpr int N_PHASES = 1 + 17 * NL;

struct Params {
    const float* in[N_IN];
    float* out;
    unsigned char* ws;
    int ph_lo, ph_hi;
};

__device__ __forceinline__ unsigned cvt_pk_bf16(float lo, float hi) { unsigned r; asm volatile("v_cvt_pk_bf16_f32 %0, %1, %2" : "=v"(r) : "v"(lo), "v"(hi)); return r; }
__device__ __forceinline__ int tid_opaque() { int t = threadIdx.x; asm volatile("" : "+v"(t)); return t; }
__device__ __forceinline__ int bid_opaque() { int b = blockIdx.x; asm volatile("" : "+s"(b)); return b; }
__device__ __forceinline__ float bf_lo(unsigned w) { return __uint_as_float(w << 16); }
__device__ __forceinline__ float bf_hi(unsigned w) { return __uint_as_float(w & 0xffff0000u); }
__device__ __forceinline__ float fast_rcp(float x) { return __builtin_amdgcn_rcpf(x); }
__device__ __forceinline__ float fast_exp2(float x) { return __builtin_amdgcn_exp2f(x); }
__device__ __forceinline__ float sigmoidf_(float x) { return fast_rcp(1.0f + fast_exp2(-x * LOG2E)); }
__device__ __forceinline__ float siluf_(float x) { return x * sigmoidf_(x); }
__device__ __forceinline__ float gelu_tanh(float x) { const float z = 0.7978845608028654f * (x + 0.044715f * x * x * x); return x * sigmoidf_(2.0f * z); }
__device__ __forceinline__ float shx(float v, int m, int lane) { return __int_as_float(__builtin_amdgcn_ds_bpermute((lane ^ m) << 2, __float_as_int(v))); }
__device__ __forceinline__ float wave_sum(float v, int lane) {
    v += shx(v, 1, lane); v += shx(v, 2, lane); v += shx(v, 4, lane); v += shx(v, 8, lane); v += shx(v, 16, lane); v += shx(v, 32, lane); return v;
}
__device__ __forceinline__ void unpack8(const u32x4 w, float (&f)[8]) {
    f[0] = bf_lo(w.x); f[1] = bf_hi(w.x); f[2] = bf_lo(w.y); f[3] = bf_hi(w.y); f[4] = bf_lo(w.z); f[5] = bf_hi(w.z); f[6] = bf_lo(w.w); f[7] = bf_hi(w.w);
}
__device__ __forceinline__ u32x4 pack8(const float (&f)[8]) {
    u32x4 w; w.x = cvt_pk_bf16(f[0], f[1]); w.y = cvt_pk_bf16(f[2], f[3]); w.z = cvt_pk_bf16(f[4], f[5]); w.w = cvt_pk_bf16(f[6], f[7]); return w;
}

struct RowMap { size_t row0; int is_ctx; int modrow; };
__device__ __forceinline__ RowMap map_row(int u) {
    const int s = (u >= U1) ? 1 : 0, v = u - s * U1, latN = part_lat(s); RowMap r;
    if (v < latN) { r.row0 = (size_t)(s ? NB0 * SEQ : 0) + v; r.is_ctx = 0; r.modrow = (int)(r.row0 >> 11); }
    else { r.row0 = (size_t)(s ? NB0 * CTXL : 0) + (v - latN); r.is_ctx = 1; r.modrow = 32; }
    return r;
}

namespace pg8 {
constexpr int BM = 256, BK = 64, HALF = 128, HTB = HALF * BK * 2, STAGE_BYTES = 8 * HTB, NXCD = 8, WGM = 4;
__device__ __forceinline__ int lds_byte(int r, int c) { const int st = (r >> 4) * 2 + (c >> 5), rr = r & 15, cc = c & 31, ob = rr * 64 + cc * 2; return st * 1024 + (ob ^ (((ob >> 9) & 1) << 5)); }
__device__ __forceinline__ void stage_rc(int b, int& R, int& C) { const int st = b / 1024, sb = b % 1024, swz = sb ^ (((sb >> 9) & 1) << 5); R = (st >> 1) * 16 + swz / 64; C = (st & 1) * 32 + (swz % 64) / 2; }
__device__ __forceinline__ int perm32(int rho) { const int n = rho >> 4, i = rho & 15; return 8 * (i >> 2) + 4 * n + (i & 3); }

struct Unit { int pm, pn; };
struct Gemm { const bf16_t* A; int lda; const bf16_t* Bt; int ldb; int M, N, K; int skip_ctx; int rev; };

struct StaticOrder {
    int nM, nN, nwg, G, c, skip, rev;
    __device__ void init(int M, int N, int G_, int c_, int skip_, int rev_) { nM = M / BM; nN = N / BM; nwg = nM * nN; G = G_; c = c_; skip = skip_; rev = rev_; }
    __device__ bool next(int i, Unit& u) const {
        const long L = (long)i * G + c; if (L >= nwg + 32) return false;
        if (nN == 4) {
            const int ch = (int)(L >> 5), p5 = (int)(L & 31), xcd = p5 & 7, qf = nM >> 3, rem = nM & 7;
            if (ch > qf || (ch == qf && xcd >= rem)) return false;
            const int cntx = qf + (xcd < rem ? 1 : 0);
            u.pm = (xcd < rem ? xcd * (qf + 1) : rem * (qf + 1) + (xcd - rem) * qf) + (rev ? cntx - 1 - ch : ch); u.pn = p5 >> 3;
            if (skip && u.pm >= NB0 * 8) u.pm += NB0;
            return true;
        }
        if (L >= nwg) return false;
        int wgid = (int)L; { const int q = nwg / NXCD, r = nwg % NXCD, xcd = wgid % NXCD, off = wgid / NXCD; wgid = (xcd < r ? xcd * (q + 1) : r * (q + 1) + (xcd - r) * q) + off; }
        const int nig = WGM * nN, gid = wgid / nig, fm = gid * WGM, gsz = (nM - fm) < WGM ? (nM - fm) : WGM;
        u.pm = fm + ((wgid % nig) % gsz); u.pn = (wgid % nig) / gsz; if (skip && u.pm >= NB0 * 8) u.pm += NB0; return true;
    }
};

template <class Epi>
__device__ __forceinline__ void gemm_phase(LAS unsigned char* lds, const Gemm g, const Epi& E) {
    const int tid = tid_opaque(), wid = __builtin_amdgcn_readfirstlane(tid >> 6), lane = tid & 63, wr = wid >> 2, wc = wid & 3, fr = lane & 15, fq = lane >> 4;
    const int K = g.K, nt = K / BK;
    StaticOrder S; S.init(g.M, g.N, (int)gridDim.x, bid_opaque(), g.skip_ctx, g.rev);
    unsigned voffA[2], voffB[2];
#pragma unroll
    for (int i = 0; i < 2; ++i) { int R, C; stage_rc(tid * 16 + i * 8192, R, C); const int Rb = Epi::PERM ? ((R & ~31) + perm32(R & 31)) : R;
        voffA[i] = (unsigned)(R * g.lda + C) * 2u; voffB[i] = (unsigned)(Rb * g.ldb + C) * 2u; }
    const size_t kstep = (size_t)(BK * 2);
    const size_t hstepA = (size_t)HALF * g.lda * 2, hstepB = (size_t)HALF * g.ldb * 2;
    const size_t tstepA = 2 * hstepA, tstepB = 2 * hstepB;
    const unsigned ldsw = (unsigned)wid * 1024u;
    const int aoff = lds_byte(wr * 64 + fr, fq * 8), boff = lds_byte(wc * 32 + fr, fq * 8);
#define PG8_SA(b, h) (((b) * 2 + (h)) * HTB)
#define PG8_SB(b, h) ((4 + (b) * 2 + (h)) * HTB)
#define PG8_STAGE(bufoff, gbase, voff) do { _Pragma("unroll") for (int _i = 0; _i < 2; ++_i) \
        __builtin_amdgcn_global_load_lds((const unsigned*)((const char*)(gbase) + (voff)[_i]), (LAS unsigned*)(lds + (bufoff) + ldsw + _i * 8192), 16, 0, 0); } while (0)
#define PG8_LDA(dst, b, h) do { _Pragma("unroll") for (int m = 0; m < 4; ++m) _Pragma("unroll") for (int k = 0; k < 2; ++k) dst[m][k] = *(const LAS bf16x8*)(lds + PG8_SA(b, h) + aoff + m * 2048 + k * 1024); } while (0)
#define PG8_LDB(dst, b, h) do { _Pragma("unroll") for (int n = 0; n < 2; ++n) _Pragma("unroll") for (int k = 0; k < 2; ++k) dst[n][k] = *(const LAS bf16x8*)(lds + PG8_SB(b, h) + boff + n * 2048 + k * 1024); } while (0)
#define PG8_MMA(ai, bj, At, Bt) do { __builtin_amdgcn_s_setprio(1); _Pragma("unroll") for (int m = 0; m < 4; ++m) _Pragma("unroll") for (int n = 0; n < 2; ++n) _Pragma("unroll") for (int k = 0; k < 2; ++k) \
        acc[ai][bj][m][n] = __builtin_amdgcn_mfma_f32_16x16x32_bf16(Bt[n][k], At[m][k], acc[ai][bj][m][n], 0, 0, 0); __builtin_amdgcn_s_setprio(0); } while (0)
#define PG8_WAIT_V(n) asm volatile("s_waitcnt vmcnt(" #n ")" ::: "memory")
#define PG8_WAIT_L(n) asm volatile("s_waitcnt lgkmcnt(" #n ")" ::: "memory")
#define PG8_BAR __builtin_amdgcn_s_barrier()
#define PG8_SCHED __builtin_amdgcn_sched_barrier(0)
#define PG8_KLOOP(TB, TE) for (int t = (TB); t < (TE); t += 2) { \
            const bool last = (t == nt - 2); \
            const char* a1 = cA + (size_t)(t + 1) * kstep; \
            const char* a2 = last ? nA : cA + (size_t)(t + 2) * kstep; const char* b2 = last ? nB : cB + (size_t)(t + 2) * kstep; \
            const char* a3 = a2 + kstep; const char* b3 = b2 + kstep; \
            PG8_LDB(B0, 0, 0); PG8_SCHED; PG8_LDA(At, 0, 0); PG8_STAGE(PG8_SA(1, 1), a1 + hstepA, voffA); \
            PG8_WAIT_L(8); PG8_BAR; PG8_WAIT_L(0); PG8_MMA(0, 0, At, B0); PG8_BAR; PG8_SCHED; \
            PG8_LDB(B1, 0, 1); PG8_STAGE(PG8_SB(0, 0), b2, voffB); \
            PG8_BAR; PG8_WAIT_L(0); PG8_MMA(0, 1, At, B1); PG8_BAR; \
            PG8_LDA(At, 0, 1); PG8_STAGE(PG8_SA(0, 0), a2, voffA); \
            PG8_BAR; PG8_WAIT_L(0); PG8_MMA(1, 0, At, B0); PG8_BAR; PG8_SCHED; \
            PG8_STAGE(PG8_SB(0, 1), b2 + hstepB, voffB); \
            PG8_WAIT_V(6); PG8_BAR; PG8_MMA(1, 1, At, B1); PG8_BAR; \
            PG8_LDB(B0, 1, 0); PG8_SCHED; PG8_LDA(At, 1, 0); PG8_STAGE(PG8_SA(0, 1), a2 + hstepA, voffA); \
            PG8_WAIT_L(8); PG8_BAR; PG8_WAIT_L(0); PG8_MMA(0, 0, At, B0); PG8_BAR; PG8_SCHED; \
            PG8_LDB(B1, 1, 1); PG8_STAGE(PG8_SB(1, 0), b3, voffB); \
            PG8_BAR; PG8_WAIT_L(0); PG8_MMA(0, 1, At, B1); PG8_BAR; \
            PG8_LDA(At, 1, 1); PG8_STAGE(PG8_SA(1, 0), a3, voffA); \
            PG8_BAR; PG8_WAIT_L(0); PG8_MMA(1, 0, At, B0); PG8_BAR; PG8_SCHED; \
            PG8_STAGE(PG8_SB(1, 1), b3 + hstepB, voffB); \
            PG8_WAIT_V(6); PG8_BAR; PG8_MMA(1, 1, At, B1); PG8_BAR; \
        }
    Unit cur, nxt; int ui = 0;
    if (!S.next(0, cur)) return;
    f32x4 acc[2][2][4][2];
#pragma unroll
    for (int a = 0; a < 2; ++a)
#pragma unroll
        for (int b = 0; b < 2; ++b)
#pragma unroll
            for (int m = 0; m < 4; ++m)
#pragma unroll
                for (int n = 0; n < 2; ++n) acc[a][b][m][n] = (f32x4){0.f, 0.f, 0.f, 0.f};
    bf16x8 At[4][2], B0[2][2], B1[2][2];
    const char* cA = (const char*)g.A + (size_t)cur.pm * tstepA; const char* cB = (const char*)g.Bt + (size_t)cur.pn * tstepB;
    PG8_STAGE(PG8_SB(0, 0), cB, voffB); PG8_STAGE(PG8_SA(0, 0), cA, voffA); PG8_STAGE(PG8_SB(0, 1), cB + hstepB, voffB); PG8_STAGE(PG8_SA(0, 1), cA + hstepA, voffA);
    if (wr == 1) PG8_BAR;
    PG8_WAIT_V(4); PG8_BAR;
    PG8_STAGE(PG8_SB(1, 0), cB + kstep, voffB); PG8_STAGE(PG8_SA(1, 0), cA + kstep, voffA); PG8_STAGE(PG8_SB(1, 1), cB + hstepB + kstep, voffB);
    PG8_WAIT_V(6); PG8_BAR;
    for (;;) {
        const bool has_next = S.next(ui + 1, nxt);
        const char* nA = has_next ? (const char*)g.A + (size_t)nxt.pm * tstepA : cA; const char* nB = has_next ? (const char*)g.Bt + (size_t)nxt.pn * tstepB : cB;
        if constexpr (Epi::MIDK) {
            PG8_KLOOP(0, 4)
            E.template mid<0>(acc, cur, wr, wc, fr, fq);
            PG8_KLOOP(4, 8)
            E.template mid<1>(acc, cur, wr, wc, fr, fq);
            PG8_KLOOP(8, nt)
        } else {
            PG8_KLOOP(0, nt)
        }
        E(acc, cur, wr, wc, fr, fq);
        if (!has_next) break;
#pragma unroll
        for (int a = 0; a < 2; ++a)
#pragma unroll
            for (int b = 0; b < 2; ++b)
#pragma unroll
                for (int m = 0; m < 4; ++m)
#pragma unroll
                    for (int n = 0; n < 2; ++n) acc[a][b][m][n] = (f32x4){0.f, 0.f, 0.f, 0.f};
        cur = nxt; cA = nA; cB = nB; ++ui;
    }
    PG8_WAIT_V(0);
    if (wr == 0) PG8_BAR;
    PG8_BAR;
#undef PG8_KLOOP
#undef PG8_SA
#undef PG8_SB
#undef PG8_STAGE
#undef PG8_LDA
#undef PG8_LDB
#undef PG8_MMA
#undef PG8_WAIT_V
#undef PG8_WAIT_L
#undef PG8_BAR
#undef PG8_SCHED
}

struct EpiSwiglu {
    static constexpr bool PERM = true, MIDK = false;
    bf16_t* O;
    __device__ __forceinline__ void operator()(const f32x4 (&acc)[2][2][4][2], const Unit& u, int wr, int wc, int fr, int fq) const {
        const int row0 = u.pm * BM + wr * 64 + fr, col0 = u.pn * 128 + wc * 32 + 8 * fq;
#pragma unroll
        for (int ai = 0; ai < 2; ++ai)
#pragma unroll
            for (int m = 0; m < 4; ++m) {
                float h[8];
#pragma unroll
                for (int n = 0; n < 2; ++n)
#pragma unroll
                    for (int j = 0; j < 4; j += 2) {
                        const f32x2 a2 = (f32x2){acc[ai][0][m][n][j], acc[ai][0][m][n][j + 1]}, u2 = (f32x2){acc[ai][1][m][n][j], acc[ai][1][m][n][j + 1]};
                        const f32x2 t2 = a2 * (-LOG2E);
                        f32x2 d2 = (f32x2){fast_exp2(t2[0]), fast_exp2(t2[1])}; d2 = d2 + 1.0f;
                        const f32x2 r2 = (f32x2){fast_rcp(d2[0]), fast_rcp(d2[1])};
                        const f32x2 h2 = (a2 * u2) * r2;
                        h[n * 4 + j] = h2[0]; h[n * 4 + j + 1] = h2[1]; }
                *(u32x4*)(O + (size_t)(row0 + ai * HALF + m * 16) * DFF + col0) = pack8(h);
            }
    }
};
struct EpiBf16 {
    static constexpr bool PERM = true, MIDK = false;
    bf16_t* O; int ldc; const float* bias; int bias_col0;
    __device__ __forceinline__ void operator()(const f32x4 (&acc)[2][2][4][2], const Unit& u, int wr, int wc, int fr, int fq) const {
        const int row0 = u.pm * BM + wr * 64 + fr, col0 = u.pn * BM + wc * 32 + 8 * fq;
        const bool hb = (u.pn * BM >= bias_col0);
        f32x4 bv[2][2];
#pragma unroll
        for (int bj = 0; bj < 2; ++bj)
#pragma unroll
            for (int n = 0; n < 2; ++n) bv[bj][n] = hb ? *(const f32x4*)(bias + (col0 - bias_col0) + bj * HALF + 4 * n) : (f32x4){0.f, 0.f, 0.f, 0.f};
#pragma unroll
        for (int ai = 0; ai < 2; ++ai)
#pragma unroll
            for (int m = 0; m < 4; ++m) { bf16_t* rowp = O + (size_t)(row0 + ai * HALF + m * 16) * ldc + col0;
#pragma unroll
                for (int bj = 0; bj < 2; ++bj) { f32x4 v0 = acc[ai][bj][m][0] + bv[bj][0], v1 = acc[ai][bj][m][1] + bv[bj][1];
                    if (hb) {
#pragma unroll
                        for (int j = 0; j < 4; j += 2) {
                            const f32x2 c0 = (f32x2){fminf(fmaxf(v0[j], -30.f), 30.f), fminf(fmaxf(v0[j + 1], -30.f), 30.f)} * (-LOG2E);
                            const f32x2 c1 = (f32x2){fminf(fmaxf(v1[j], -30.f), 30.f), fminf(fmaxf(v1[j + 1], -30.f), 30.f)} * (-LOG2E);
                            const f32x2 e0 = (f32x2){fast_exp2(c0[0]), fast_exp2(c0[1])} + 1.0f, e1 = (f32x2){fast_exp2(c1[0]), fast_exp2(c1[1])} + 1.0f;
                            v0[j] = e0[0]; v0[j + 1] = e0[1]; v1[j] = e1[0]; v1[j + 1] = e1[1]; } }
                    u32x4 w; w.x = cvt_pk_bf16(v0[0], v0[1]); w.y = cvt_pk_bf16(v0[2], v0[3]); w.z = cvt_pk_bf16(v1[0], v1[1]); w.w = cvt_pk_bf16(v1[2], v1[3]);
                    *(u32x4*)(rowp + bj * HALF) = w; } }
    }
};
template <int MODE_, bool FUSE_> struct EpiResid {
    static constexpr bool PERM = true, MIDK = false;
    const float* x_lat; const float* x_ctx; bf16_t* hbuf; float* out; const float* mod; int gate_idx; float gscale; int tile0; int mode;
    int nj; const float* ng; const float* nmod; bf16_t* Aout; float* xs; unsigned* cnt; LAS unsigned char* lds;
    template <int MODE> __device__ __forceinline__ void body(f32x4 (&acc)[2][2][4][2], const Unit& u, int, int, int, int) const {
        const int t_ = tid_opaque(); const int wr = t_ >> 8, wc = (t_ >> 6) & 3, fr = t_ & 15, fq = (t_ >> 4) & 3;
        const int urow0 = (tile0 + u.pm) * BM;
        const RowMap rm = map_row(urow0);
        const float* gp = mod + (size_t)rm.modrow * (NMOD * D) + gate_idx * D;
        int rloc = wr * 64 + fr, col0 = u.pn * BM + wc * 32 + 8 * fq;
        asm volatile("" : "+v"(rloc), "+v"(col0));
        const unsigned loff = (unsigned)rloc * D + (unsigned)col0;
        const char* hbase = (const char*)(hbuf + (size_t)urow0 * D);
        const char* obase = (const char*)(out + rm.row0 * D);
        const bool st_ok = (MODE != 2) || !rm.is_ctx;
        constexpr int MG = 4;
#pragma unroll
        for (int bj = 0; bj < 2; ++bj) {
            const f32x4 g0 = *(const f32x4*)(gp + col0 + bj * HALF) * gscale, g1 = *(const f32x4*)(gp + col0 + bj * HALF + 4) * gscale;
#pragma unroll
            for (int ai = 0; ai < 2; ++ai)
#pragma unroll
                for (int mg = 0; mg < 4; mg += MG) {
                    u32x4 xw[MG];
#pragma unroll
                    for (int mm = 0; mm < MG; ++mm) xw[mm] = *(const u32x4*)(hbase + (size_t)(loff + (unsigned)((ai * HALF + (mg + mm) * 16) * D + bj * HALF)) * 2u);
                    __builtin_amdgcn_sched_barrier(0);
#pragma unroll
                    for (int mm = 0; mm < MG; ++mm) { const int m = mg + mm; const unsigned eo = loff + (unsigned)((ai * HALF + m * 16) * D + bj * HALF);
                        const u32x4 w = xw[mm];
                        const f32x4 x0 = (f32x4){bf_lo(w.x), bf_hi(w.x), bf_lo(w.y), bf_hi(w.y)}, x1 = (f32x4){bf_lo(w.z), bf_hi(w.z), bf_lo(w.w), bf_hi(w.w)};
                        const f32x4 y0 = x0 + g0 * acc[ai][bj][m][0], y1 = x1 + g1 * acc[ai][bj][m][1];
                        if constexpr (MODE == 2) { if (st_ok) { *(f32x4*)(obase + (size_t)eo * 4u) = y0; *(f32x4*)(obase + (size_t)eo * 4u + 16) = y1; } }
                        else { if constexpr (!FUSE_) { u32x4 o; o.x = cvt_pk_bf16(y0[0], y0[1]); o.y = cvt_pk_bf16(y0[2], y0[3]); o.z = cvt_pk_bf16(y1[0], y1[1]); o.w = cvt_pk_bf16(y1[2], y1[3]); *(u32x4*)((char*)hbase + (size_t)eo * 2u) = o; }
                               acc[ai][bj][m][0] = y0; acc[ai][bj][m][1] = y1; }
                    }
                    __builtin_amdgcn_sched_barrier(0);
                }
        }
        if constexpr (MODE != 2) {
            if (!FUSE_) return;
            const int lane = fq * 16 + fr, T = tile0 + u.pm;
            LAS float* Pt = (LAS float*)(lds + STAGE_BYTES);
            LAS float* St = Pt + 1024;
#pragma unroll
            for (int ai = 0; ai < 2; ++ai)
#pragma unroll
                for (int m = 0; m < 4; ++m) { float sq = 0.f;
#pragma unroll
                    for (int bj = 0; bj < 2; ++bj)
#pragma unroll
                        for (int n = 0; n < 2; ++n) { const f32x4 v = acc[ai][bj][m][n]; sq += (v[0] * v[0] + v[1] * v[1]) + (v[2] * v[2] + v[3] * v[3]); }
                    sq += shx(sq, 16, lane); sq += shx(sq, 32, lane);
                    if (fq == 0) Pt[(ai * HALF + rloc + m * 16) * 4 + wc] = sq; }
            asm volatile("s_waitcnt lgkmcnt(0)" ::: "memory"); __builtin_amdgcn_s_barrier(); asm volatile("" ::: "memory");
            const int idx = wc * 32 + (lane & 31), row = (idx >> 6) * HALF + wr * 64 + (idx & 63);
            float* slot = xs + ((size_t)T * BM + row) * 4;
            if (lane < 32) { const f32x4 p4 = *(const LAS f32x4*)(Pt + row * 4);
                __hip_atomic_store(slot + u.pn, (p4[0] + p4[1]) + (p4[2] + p4[3]), __ATOMIC_RELAXED, __HIP_MEMORY_SCOPE_AGENT); }
            asm volatile("s_waitcnt vmcnt(0)" ::: "memory");
            unsigned* cw = cnt + T * 2 + wr;
            if (lane == 0) __hip_atomic_fetch_add(cw, 1u, __ATOMIC_RELAXED, __HIP_MEMORY_SCOPE_AGENT);
            unsigned loff2 = loff; asm volatile("" : "+v"(loff2));
#pragma unroll
            for (int bj = 0; bj < 2; ++bj)
#pragma unroll
                for (int ai = 0; ai < 2; ++ai)
#pragma unroll
                    for (int m = 0; m < 4; ++m) { const f32x4 y0 = acc[ai][bj][m][0], y1 = acc[ai][bj][m][1];
                        u32x4 o; o.x = cvt_pk_bf16(y0[0], y0[1]); o.y = cvt_pk_bf16(y0[2], y0[3]); o.z = cvt_pk_bf16(y1[0], y1[1]); o.w = cvt_pk_bf16(y1[2], y1[3]);
                        *(u32x4*)((char*)hbase + (size_t)(loff2 + (unsigned)((ai * HALF + m * 16) * D + bj * HALF)) * 2u) = o; }
            if (wc == 0) { unsigned spins = 0;
                while ((unsigned)__builtin_amdgcn_readfirstlane(__hip_atomic_load(cw, __ATOMIC_RELAXED, __HIP_MEMORY_SCOPE_AGENT)) < 16u) { __builtin_amdgcn_s_sleep(1); if (++spins > (1u << 19)) break; } }
            asm volatile("s_waitcnt vmcnt(0) lgkmcnt(0)" ::: "memory"); __builtin_amdgcn_s_barrier(); asm volatile("" ::: "memory");
            if (lane < 32) { float q = 0.f;
#pragma unroll
                for (int t = 0; t < 4; ++t) q += __hip_atomic_load(slot + t, __ATOMIC_RELAXED, __HIP_MEMORY_SCOPE_AGENT);
                St[row] = rsqrtf(q * (1.0f / D) + EPS); }
            asm volatile("s_waitcnt vmcnt(0) lgkmcnt(0)" ::: "memory"); __builtin_amdgcn_s_barrier(); asm volatile("" ::: "memory");
            const float* sh = nmod + (size_t)rm.modrow * (NMOD * D) + (3 * nj) * D; const float* scp = sh + D;
            char* abase = (char*)(Aout + (size_t)urow0 * D); unsigned loff3 = loff; asm volatile("" : "+v"(loff3));
#pragma unroll
            for (int bj = 0; bj < 2; ++bj) { const int cc = col0 + bj * HALF;
                const f32x4 gm0 = *(const f32x4*)(ng + cc) * (*(const f32x4*)(scp + cc) + 1.0f), gm1 = *(const f32x4*)(ng + cc + 4) * (*(const f32x4*)(scp + cc + 4) + 1.0f);
                const f32x4 s0 = *(const f32x4*)(sh + cc), s1 = *(const f32x4*)(sh + cc + 4);
#pragma unroll
                for (int ai = 0; ai < 2; ++ai)
#pragma unroll
                    for (int m = 0; m < 4; ++m) { const float rstd = St[ai * HALF + rloc + m * 16];
                        const f32x4 y0 = acc[ai][bj][m][0] * rstd * gm0 + s0, y1 = acc[ai][bj][m][1] * rstd * gm1 + s1;
                        u32x4 w; w.x = cvt_pk_bf16(y0[0], y0[1]); w.y = cvt_pk_bf16(y0[2], y0[3]); w.z = cvt_pk_bf16(y1[0], y1[1]); w.w = cvt_pk_bf16(y1[2], y1[3]);
                        *(u32x4*)(abase + (size_t)(loff3 + (unsigned)((ai * HALF + m * 16) * D + bj * HALF)) * 2u) = w; } }
        }
    }
    __device__ __forceinline__ void operator()(f32x4 (&acc)[2][2][4][2], const Unit& u, int wr, int wc, int fr, int fq) const {
        body<MODE_>(acc, u, wr, wc, fr, fq);
    }
};
struct EpiBranch {
    static constexpr bool PERM = true, MIDK = true;
    bf16_t* P;
    __device__ __forceinline__ u32x4 ld_raw(unsigned off) const { return *(const u32x4*)((const char*)P + (size_t)off * 2u); }
    __device__ __forceinline__ void to_e(const u32x4 w, float (&e)[8]) const { unpack8(w, e); }
    template <int WHICH> __device__ __forceinline__ void mid(f32x4 (&acc)[2][2][4][2], const Unit& u, int wr, int wc, int fr, int fq) const {
        unsigned base = (unsigned)(u.pm * BM + wr * 64 + fr) * PROJ + (unsigned)(u.pn * BM + wc * 32 + 8 * fq) + OFF_GATE + WHICH * D;
        asm volatile("" : "+v"(base));
#pragma unroll
        for (int ai = 0; ai < 2; ++ai)
#pragma unroll
            for (int mp = 0; mp < 2; ++mp) {
                u32x4 wa[2][2], wb[2][2];
#pragma unroll
                for (int mm = 0; mm < 2; ++mm)
#pragma unroll
                    for (int bj = 0; bj < 2; ++bj) { const unsigned o = base + (unsigned)(ai * HALF + (mp * 2 + mm) * 16) * PROJ + bj * HALF; wa[mm][bj] = ld_raw(o); wb[mm][bj] = ld_raw(o + D); }
                __builtin_amdgcn_sched_barrier(0);
#pragma unroll
                for (int mm = 0; mm < 2; ++mm)
#pragma unroll
                    for (int bj = 0; bj < 2; ++bj) { float ea[8], eb[8]; to_e(wa[mm][bj], ea); to_e(wb[mm][bj], eb);
#pragma unroll
                        for (int n = 0; n < 2; ++n)
#pragma unroll
                            for (int j = 0; j < 4; j += 2) { const f32x2 r2 = (f32x2){fast_rcp(ea[n * 4 + j]), fast_rcp(ea[n * 4 + j + 1])}, b2 = (f32x2){eb[n * 4 + j], eb[n * 4 + j + 1]};
                                const f32x2 v2 = (f32x2){acc[ai][bj][mp * 2 + mm][n][j], acc[ai][bj][mp * 2 + mm][n][j + 1]} * (b2 * r2);
                                acc[ai][bj][mp * 2 + mm][n][j] = v2[0]; acc[ai][bj][mp * 2 + mm][n][j + 1] = v2[1]; } }
                __builtin_amdgcn_sched_barrier(0);
            }
    }
    __device__ __forceinline__ void operator()(const f32x4 (&acc)[2][2][4][2], const Unit& u, int wr, int wc, int fr, int fq) const {
        unsigned base = (unsigned)(u.pm * BM + wr * 64 + fr) * PROJ + (unsigned)(u.pn * BM + wc * 32 + 8 * fq);
        asm volatile("" : "+v"(base));
#pragma unroll
        for (int ai = 0; ai < 2; ++ai) {
            u32x4 w2[4][2];
#pragma unroll
            for (int m = 0; m < 4; ++m)
#pragma unroll
                for (int bj = 0; bj < 2; ++bj) w2[m][bj] = ld_raw(base + (unsigned)(ai * HALF + m * 16) * PROJ + bj * HALF + OFF_GATE + 2 * D);
            __builtin_amdgcn_sched_barrier(0);
#pragma unroll
            for (int m = 0; m < 4; ++m)
#pragma unroll
                for (int bj = 0; bj < 2; ++bj) { const unsigned o = base + (unsigned)(ai * HALF + m * 16) * PROJ + bj * HALF;
                    float e2[8], ov[8]; to_e(w2[m][bj], e2);
#pragma unroll
                    for (int n = 0; n < 2; ++n)
#pragma unroll
                        for (int j = 0; j < 4; ++j) ov[n * 4 + j] = acc[ai][bj][m][n][j] * fast_rcp(e2[n * 4 + j]);
                    *(u32x4*)((char*)P + (size_t)o * 2u) = pack8(ov); }
            __builtin_amdgcn_sched_barrier(0);
        }
    }
};
}

__device__ __forceinline__ void tr_job(LAS float* tl, const float* src, int ld_src, int K, int Nout, bf16_t* dst, int ld_dst, int dkofs, int mode) {
    const int tid = tid_opaque();
    const int nkt = K / 64, ntl = nkt * (Nout / 64), G = gridDim.x;
    const int ln = tid & 63, lk = tid >> 6, sk2 = (tid & 31) * 2, sn = tid >> 5;
    float r[8];
    int t = bid_opaque();
    auto src_ptr = [&](int tt) -> const float* {
        const int kt = tt % nkt, n0 = (tt / nkt) * 64; int c0 = n0;
        if (mode == 1) { const int pn = n0 >> 8, rr = n0 & 255; c0 = (rr < 128) ? pn * 128 + rr : DFF + pn * 128 + (rr - 128); }
        return src + (size_t)(kt * 64 + lk) * ld_src + c0 + ln; };
    if (t < ntl) { const float* sp = src_ptr(t);
#pragma unroll
        for (int i = 0; i < 8; ++i) r[i] = sp[(size_t)(8 * i) * ld_src]; }
    for (; t < ntl; t += G) {
#pragma unroll
        for (int i = 0; i < 8; ++i) tl[(lk + 8 * i) * 65 + ln] = r[i];
        __syncthreads();
        if (t + G < ntl) { const float* sp = src_ptr(t + G);
#pragma unroll
            for (int i = 0; i < 8; ++i) r[i] = sp[(size_t)(8 * i) * ld_src]; }
        { const int kt = t % nkt, n0 = (t / nkt) * 64;
#pragma unroll
          for (int i = 0; i < 4; ++i) { const int n = sn + 16 * i; *(unsigned*)(dst + (size_t)(n0 + n) * ld_dst + dkofs + kt * 64 + sk2) = cvt_pk_bf16(tl[sk2 * 65 + n], tl[(sk2 + 1) * 65 + n]); } }
        __syncthreads();
    }
}

__device__ void phase_setup(const Params& p, LAS unsigned char* lds) {
    const int tid = tid_opaque(), wid = tid >> 6, lane = tid & 63;
    bf16_t* WT = (bf16_t*)(p.ws + WS_WT);
    LAS float* tl = (LAS float*)lds;
    for (int l = 0; l < NL; ++l) {
        bf16_t* W = WT + (size_t)l * W_LAYER;
        for (int j = 0; j < 2; ++j) {
            tr_job(tl, p.in[I_FFNIN] + ((size_t)l * 2 + j) * D * (2 * DFF), 2 * DFF, D, 2 * DFF, W + (j ? W_FIN1 : W_FIN0), D, 0, 1);
            tr_job(tl, p.in[I_FFNOUT] + ((size_t)l * 2 + j) * DFF * D, D, DFF, D, W + (j ? W_FOUT1 : W_FOUT0), DFF, 0, 0);
        }
        tr_job(tl, p.in[I_WIN] + (size_t)l * D * PROJ, PROJ, D, PROJ, W + W_WIN, D, 0, 0);
        tr_job(tl, p.in[I_WBC] + (size_t)l * 256 * D, D, 256, D, W + W_WB, D, 0, 0);
        tr_job(tl, p.in[I_WBG] + (size_t)l * 256 * D, D, 256, D, W + W_WB, D, 256, 0);
        tr_job(tl, p.in[I_WBA] + (size_t)l * 512 * D, D, 512, D, W + W_WB, D, 512, 0);
        tr_job(tl, p.in[I_WOUT] + (size_t)l * D * D, D, D, D, W + W_WO, D, 0, 0);
        for (int i = bid_opaque() * 512 + tid; i < 65536 / 2; i += gridDim.x * 512) {
            const float2 v = *(const float2*)(p.in[I_GWS] + (size_t)l * 65536 + 2 * i);
            *(unsigned*)(W + W_GWS + 2 * i) = cvt_pk_bf16(v.x, v.y);
        }
    }
    { const int gi = bid_opaque() * 512 + tid;
      if (gi < 1024) { const int pos = gi >> 4, i = gi & 15;
        const int i4 = i & 3, i16 = i >> 2;
        float inv = (i4 == 0) ? 1.0f : (i4 == 1) ? 0.5623413251903491f : (i4 == 2) ? 0.31622776601683794f : 0.1778279410038923f;
        inv *= (i16 == 0) ? 1.0f : (i16 == 1) ? 0.1f : (i16 == 2) ? 0.01f : 0.001f;
        const float a = (float)pos * inv;
        const float kq = __builtin_rintf(a * 0.6366197723675814f);
        float r = __builtin_fmaf(-kq, 1.5707963705062866f, a); r = __builtin_fmaf(kq, 4.371139000186241e-8f, r);
        const float r2 = r * r;
        const float sn = r * (1.0f + r2 * (-1.0f / 6 + r2 * (1.0f / 120 + r2 * (-1.0f / 5040 + r2 * (1.0f / 362880)))));
        const float cs = 1.0f + r2 * (-0.5f + r2 * (1.0f / 24 + r2 * (-1.0f / 720 + r2 * (1.0f / 40320 + r2 * (-1.0f / 3628800)))));
        const int q = ((int)kq) & 3;
        const float c = (q == 0) ? cs : (q == 1) ? -sn : (q == 2) ? -cs : sn;
        const float s = (q == 0) ? sn : (q == 1) ? cs : (q == 2) ? -sn : -cs;
        float2* rt = (float2*)(p.ws + WS_ROPE); rt[gi] = make_float2(c, s); } }
    if (bid_opaque() < NL * 36) {
        LAS float* sc = (LAS float*)lds;
        __syncthreads();
        for (int i = tid; i < 33 * D; i += 512) { const int r = i >> 10, k = i & 1023; const float v = (r < 32) ? p.in[I_C][r * D + k] : p.in[I_CCTX][k]; sc[i] = siluf_(v); }
        __syncthreads();
        float* MOD = (float*)(p.ws + WS_MOD);
        for (int it = bid_opaque(); it < NL * 36; it += gridDim.x) {
            const int l = it / 36, cgp = it % 36, n0 = cgp * 256 + lane * 4;
            const float* wp = p.in[I_WMOD] + (size_t)l * D * (NMOD * D) + n0;
            f32x4 a[5];
#pragma unroll
            for (int i = 0; i < 5; ++i) a[i] = (f32x4){0.f, 0.f, 0.f, 0.f};
            for (int k = 0; k < D; k += 16) {
                f32x4 w[16];
#pragma unroll
                for (int kk = 0; kk < 16; ++kk) w[kk] = *(const f32x4*)(wp + (size_t)(k + kk) * (NMOD * D));
#pragma unroll
                for (int i = 0; i < 5; ++i) { const int r = (i < 4) ? wid + 8 * i : 32;
#pragma unroll
                    for (int k4 = 0; k4 < 4; ++k4) { const f32x4 s4 = *(const LAS f32x4*)(sc + r * D + k + 4 * k4);
                        a[i] += s4[0] * w[4 * k4] + s4[1] * w[4 * k4 + 1] + s4[2] * w[4 * k4 + 2] + s4[3] * w[4 * k4 + 3]; } }
            }
            const f32x4 bv = *(const f32x4*)(p.in[I_BMOD] + (size_t)l * (NMOD * D) + n0);
#pragma unroll
            for (int i = 0; i < 5; ++i) { const int r = (i < 4) ? wid + 8 * i : 32; if (i < 4 || wid == 0) *(f32x4*)(MOD + ((size_t)l * 33 + r) * (NMOD * D) + n0) = a[i] + bv; }
        }
        __syncthreads();
    }
}

__device__ void phase_norm(const Params& p, int l, int j, bool from_inputs, bool skip_ctx) {
    const int tid = tid_opaque(), wid = tid >> 6, lane = tid & 63;
    bf16_t* A = (bf16_t*)(p.ws + WS_A);
    const bf16_t* hbuf = (const bf16_t*)(p.ws + WS_H);
    const float* MOD = (const float*)(p.ws + WS_MOD) + (size_t)l * 33 * (NMOD * D);
    const float* ng = p.in[I_NORMG] + ((size_t)l * 3 + j) * D;
    constexpr int NR = 4;
    for (int u = (bid_opaque() * 8 + wid) * NR; u < T_ALL; u += gridDim.x * 8 * NR) {
        const RowMap rm = map_row(u);
        if (skip_ctx && rm.is_ctx) continue;
        const float* sh = MOD + (size_t)rm.modrow * (NMOD * D) + (3 * j) * D; const float* sc = sh + D;
        f32x4 v[NR][4]; float ss[NR];
        if (from_inputs) { const float* x = (rm.is_ctx ? p.in[I_CTX] : p.in[I_X]) + rm.row0 * D; bf16_t* hw = (bf16_t*)(p.ws + WS_H) + (size_t)u * D;
#pragma unroll
            for (int rr = 0; rr < NR; ++rr)
#pragma unroll
                for (int i = 0; i < 4; ++i) { v[rr][i] = *(const f32x4*)(x + rr * D + i * 256 + lane * 4);
                    u32x2 w; w.x = cvt_pk_bf16(v[rr][i][0], v[rr][i][1]); w.y = cvt_pk_bf16(v[rr][i][2], v[rr][i][3]); *(u32x2*)(hw + rr * D + i * 256 + lane * 4) = w; }
        } else { const bf16_t* x = hbuf + (size_t)u * D;
#pragma unroll
            for (int rr = 0; rr < NR; ++rr)
#pragma unroll
                for (int i = 0; i < 4; ++i) { const u32x2 w = *(const u32x2*)(x + rr * D + i * 256 + lane * 4); v[rr][i] = (f32x4){bf_lo(w.x), bf_hi(w.x), bf_lo(w.y), bf_hi(w.y)}; }
        }
        f32x4 gm[4], s0[4];
#pragma unroll
        for (int i = 0; i < 4; ++i) { const int k = i * 256 + lane * 4; gm[i] = *(const f32x4*)(ng + k) * (*(const f32x4*)(sc + k) + 1.0f); s0[i] = *(const f32x4*)(sh + k); }
#pragma unroll
        for (int rr = 0; rr < NR; ++rr) { ss[rr] = 0.f;
#pragma unroll
            for (int i = 0; i < 4; ++i) ss[rr] += v[rr][i][0] * v[rr][i][0] + v[rr][i][1] * v[rr][i][1] + v[rr][i][2] * v[rr][i][2] + v[rr][i][3] * v[rr][i][3]; }
#pragma unroll
        for (int st = 1; st < 64; st <<= 1)
#pragma unroll
            for (int rr = 0; rr < NR; ++rr) ss[rr] += shx(ss[rr], st, lane);
#pragma unroll
        for (int rr = 0; rr < NR; ++rr) { const float rstd = rsqrtf(ss[rr] * (1.0f / D) + EPS);
#pragma unroll
            for (int i = 0; i < 4; ++i) { const int k = i * 256 + lane * 4;
                const f32x4 y = v[rr][i] * rstd * gm[i] + s0[i];
                u32x2 w; w.x = cvt_pk_bf16(y[0], y[1]); w.y = cvt_pk_bf16(y[2], y[3]);
                *(u32x2*)(A + (size_t)(u + rr) * D + k) = w; } }
    }
}

__device__ void phase_prep(const Params& p, int l, int hs, LAS unsigned char* lds) {
    const int THp = part_rows(hs), latN = part_lat(hs);
    const int tid = tid_opaque(), wid = tid >> 6, lane = tid & 63;
    bf16_t* P = (bf16_t*)(p.ws + WS_R1);
    bf16_t* VTL = (bf16_t*)(p.ws + WS_VTL); bf16_t* VTC = (bf16_t*)(p.ws + WS_VTC);
    const float* qg = p.in[I_QG] + l * 64; const float* kg = p.in[I_KG] + l * 64;
    LAS bf16_t* Vs = (LAS bf16_t*)lds;
    const LAS f32x2* rts = (const LAS f32x2*)(lds + 20480);
    __syncthreads();
    *(LAS u32x4*)(lds + 20480 + tid * 16) = *(const u32x4*)(p.ws + WS_ROPE + tid * 16);
    __syncthreads();
    const int c = lane & 7, seg = c >> 2, hf = (c >> 1) & 1, i0 = (c & 1) * 8;
    float gq[8], gk[8];
#pragma unroll
    for (int e = 0; e < 8; ++e) { gq[e] = qg[8 * c + e]; gk[e] = kg[8 * c + e]; }
    for (int it = bid_opaque(); it < THp / 64; it += gridDim.x) {
        const int v0 = it * 64; const bool lat = v0 < latN;
        const int prow = (v0 & (SEQ - 1)) >> 6;
        bf16_t* rowb = P + (size_t)(v0 + wid * 8) * PROJ;
        const int qoff = OFF_Q + (lane >> 3) * 64 + 8 * c, koff = OFF_K + ((lane >> 3) & 1) * 64 + 8 * c;
        u32x4 qr[8], kr[8]; unsigned vr[8];
#pragma unroll
        for (int i = 0; i < 8; ++i) { const bf16_t* rp = rowb + (size_t)i * PROJ; qr[i] = *(const u32x4*)(rp + qoff); kr[i] = *(const u32x4*)(rp + koff); vr[i] = *(const unsigned*)(rp + OFF_V + 2 * lane); }
#pragma unroll
        for (int i = 0; i < 8; ++i) {
            const int rl = wid * 8 + i;
            bf16_t* rowp = rowb + (size_t)i * PROJ;
            const int pp = seg ? rl : prow;
            float cs[8], sn[8];
#pragma unroll
            for (int e = 0; e < 8; ++e) { const f32x2 t2 = rts[pp * 16 + i0 + e]; cs[e] = lat ? t2[0] : 1.0f; sn[e] = lat ? t2[1] : 0.0f; }
            { float x[8]; unpack8(qr[i], x);
              float ss = 0.f;
#pragma unroll
              for (int e = 0; e < 8; ++e) ss += x[e] * x[e];
              ss += shx(ss, 1, lane); ss += shx(ss, 2, lane); ss += shx(ss, 4, lane);
              const float rstd = rsqrtf(ss * (1.0f / 64) + EPS); float o[8];
#pragma unroll
              for (int e = 0; e < 8; ++e) { const float y = x[e] * rstd * gq[e]; const float yp = shx(y, 2, lane);
                  o[e] = (hf ? (y * cs[e] + yp * sn[e]) : (y * cs[e] - yp * sn[e])) * (0.125f * LOG2E); }
              *(u32x4*)(rowp + qoff) = pack8(o); }
            { float x[8]; unpack8(kr[i], x);
              float ss = 0.f;
#pragma unroll
              for (int e = 0; e < 8; ++e) ss += x[e] * x[e];
              ss += shx(ss, 1, lane); ss += shx(ss, 2, lane); ss += shx(ss, 4, lane);
              const float rstd = rsqrtf(ss * (1.0f / 64) + EPS); float o[8];
#pragma unroll
              for (int e = 0; e < 8; ++e) { const float y = x[e] * rstd * gk[e]; const float yp = shx(y, 2, lane);
                  o[e] = hf ? (y * cs[e] + yp * sn[e]) : (y * cs[e] - yp * sn[e]); }
              if (lane < 16) *(u32x4*)(rowp + koff) = pack8(o); }
            { const unsigned w = vr[i];
              Vs[(2 * lane) * 72 + rl] = (bf16_t)(w & 0xffffu); Vs[(2 * lane + 1) * 72 + rl] = (bf16_t)(w >> 16); }
        }
        __syncthreads();
        { const int hd = tid >> 2, ch = tid & 3;
          bf16_t* dst;
          if (lat) { const int bl = v0 >> 11, pos0 = v0 & (SEQ - 1); dst = VTL + ((size_t)bl * 128 + hd) * SEQ + pos0 + ch * 16; }
          else { const int cv = v0 - latN, bl = cv >> 8, pos0 = cv & 255; dst = VTC + ((size_t)bl * 128 + hd) * CTXL + pos0 + ch * 16; }
          const u32x4 a = *(const LAS u32x4*)(Vs + hd * 72 + ch * 16), b = *(const LAS u32x4*)(Vs + hd * 72 + ch * 16 + 8);
          *(u32x4*)dst = a; *(u32x4*)(dst + 8) = b; }
        __syncthreads();
    }
}

struct KeySeg { const bf16_t* K; const bf16_t* Vt; int vstride; int ntiles; int mask; };

__device__ __forceinline__ void attn_item(const Params& p, int l, int hs, int idx) {
    const int tid = tid_opaque(), wid = __builtin_amdgcn_readfirstlane(tid >> 6), lane = tid & 63, fr = lane & 15, fq = lane >> 4;
    const bf16_t* P = (const bf16_t*)(p.ws + WS_R1);
    const bf16_t* VTL = (const bf16_t*)(p.ws + WS_VTL); const bf16_t* VTC = (const bf16_t*)(p.ws + WS_VTC);
    bf16_t* Y = (bf16_t*)(p.ws + WS_A) + (size_t)part_u0(hs) * D;
    const int latN = part_lat(hs), nli = part_nb(hs) * 32;
    int bl, qb, hk; bool lat;
    if (idx < nli) { lat = true; bl = idx >> 5; qb = (idx >> 1) & 15; hk = idx & 1; }
    else { const int j = idx - nli; lat = false; bl = j >> 2; qb = (j >> 1) & 1; hk = j & 1; }
    const int g = wid >> 1, r0 = (wid & 1) * 64, head = hk * 4 + g;
    const int qrow0 = lat ? bl * SEQ + qb * 128 : latN + bl * CTXL + qb * 128;
    const int crow0 = latN + bl * CTXL;
    bf16x8 qf[4][2];
    { const bf16_t* qp = P + (size_t)(qrow0 + r0 + fr) * PROJ + OFF_Q + head * 64 + fq * 8;
#pragma unroll
      for (int nq = 0; nq < 4; ++nq)
#pragma unroll
          for (int ks = 0; ks < 2; ++ks) qf[nq][ks] = *(const bf16x8*)(qp + (size_t)nq * 16 * PROJ + ks * 32); }
    f32x4 o[4][4];
#pragma unroll
    for (int a = 0; a < 4; ++a)
#pragma unroll
        for (int b = 0; b < 4; ++b) o[a][b] = (f32x4){0.f, 0.f, 0.f, 0.f};
    const float snk = p.in[I_SINK][l * 8 + head] * LOG2E;
    float mrun[4], lrun[4];
#pragma unroll
    for (int nq = 0; nq < 4; ++nq) { mrun[nq] = snk; lrun[nq] = (fq == 0) ? 1.0f : 0.0f; }

    int lo = 0, nb = 0;
    if (lat) { lo = (qb == 0) ? 4 : (r0 >> 5); const int hi = (qb == 15) ? 8 : (r0 == 0 ? 10 : 12); nb = hi - lo; }
    const int ntot = nb + 8;
    const char* kband = (const char*)(P + (ptrdiff_t)(bl * SEQ + (qb - 1) * 128 + lo * 32) * PROJ + OFF_K + hk * 64);
    const char* kctx = (const char*)(P + (size_t)crow0 * PROJ + OFF_K + hk * 64);
    const char* vband = (const char*)(VTL + ((size_t)bl * 2 + hk) * 64 * SEQ + (ptrdiff_t)((qb - 1) * 128 + lo * 32));
    const char* vctx = (const char*)(VTC + ((size_t)bl * 2 + hk) * 64 * CTXL);
    const unsigned klane = (unsigned)(fr * PROJ + fq * 8) * 2u, vlane_b = (unsigned)(fr * SEQ + fq * 4) * 2u, vlane_c = (unsigned)(fr * CTXL + fq * 4) * 2u;
#define ATT_LOAD(i_, KF, VLO, VHI) do { const int _i = (i_); \
        if (_i < nb) { const char* _kp = kband + (size_t)_i * (32 * PROJ * 2); const char* _vp = vband + _i * 64; \
            _Pragma("unroll") for (int kb = 0; kb < 2; ++kb) _Pragma("unroll") for (int ks = 0; ks < 2; ++ks) KF[kb][ks] = *(const bf16x8*)(_kp + kb * (16 * PROJ * 2) + ks * 64 + klane); \
            _Pragma("unroll") for (int db = 0; db < 4; ++db) { VLO[db] = *(const bf16x4*)(_vp + db * (16 * SEQ * 2) + vlane_b); VHI[db] = *(const bf16x4*)(_vp + db * (16 * SEQ * 2) + 32 + vlane_b); } \
        } else { const char* _kp = kctx + (size_t)(_i - nb) * (32 * PROJ * 2); const char* _vp = vctx + (_i - nb) * 64; \
            _Pragma("unroll") for (int kb = 0; kb < 2; ++kb) _Pragma("unroll") for (int ks = 0; ks < 2; ++ks) KF[kb][ks] = *(const bf16x8*)(_kp + kb * (16 * PROJ * 2) + ks * 64 + klane); \
            _Pragma("unroll") for (int db = 0; db < 4; ++db) { VLO[db] = *(const bf16x4*)(_vp + db * (16 * CTXL * 2) + vlane_c); VHI[db] = *(const bf16x4*)(_vp + db * (16 * CTXL * 2) + 32 + vlane_c); } } } while (0)
#define ATT_COMPUTE(i_, KF, VLO, VHI) do { const int _ci = (i_); const int bt = lo + _ci; const bool mask = (_ci < nb) && (bt < 4 || bt >= 8); \
        f32x4 s[2][4]; \
        _Pragma("unroll") for (int kb = 0; kb < 2; ++kb) _Pragma("unroll") for (int nq = 0; nq < 4; ++nq) { \
            s[kb][nq] = __builtin_amdgcn_mfma_f32_16x16x32_bf16(KF[kb][0], qf[nq][0], (f32x4){0.f, 0.f, 0.f, 0.f}, 0, 0, 0); \
            s[kb][nq] = __builtin_amdgcn_mfma_f32_16x16x32_bf16(KF[kb][1], qf[nq][1], s[kb][nq], 0, 0, 0); } \
        if (mask) { \
            _Pragma("unroll") for (int kb = 0; kb < 2; ++kb) _Pragma("unroll") for (int nq = 0; nq < 4; ++nq) _Pragma("unroll") for (int j = 0; j < 4; ++j) { \
                const int dlt = (bt * 32 - 128 + kb * 16 + fq * 4 + j) - (r0 + nq * 16 + fr); if (dlt > 128 || dlt < -128) s[kb][nq][j] = -1e30f; } } \
        bf16x8 pf[4]; \
        _Pragma("unroll") for (int nq = 0; nq < 4; ++nq) { \
            float mx = fmaxf(fmaxf(fmaxf(s[0][nq][0], s[0][nq][1]), fmaxf(s[0][nq][2], s[0][nq][3])), fmaxf(fmaxf(s[1][nq][0], s[1][nq][1]), fmaxf(s[1][nq][2], s[1][nq][3]))); \
            mx = fmaxf(mx, shx(mx, 16, lane)); mx = fmaxf(mx, shx(mx, 32, lane)); \
            const float mn = fmaxf(mrun[nq], mx), alpha = fast_exp2(mrun[nq] - mn); mrun[nq] = mn; \
            float pv[8]; f32x2 ps2 = (f32x2){0.f, 0.f}; const f32x2 mn2 = (f32x2){mn, mn}; \
            _Pragma("unroll") for (int kb = 0; kb < 2; ++kb) _Pragma("unroll") for (int j = 0; j < 4; j += 2) { \
                const f32x2 d2 = (f32x2){s[kb][nq][j], s[kb][nq][j + 1]} - mn2; const f32x2 e2 = (f32x2){fast_exp2(d2[0]), fast_exp2(d2[1])}; \
                pv[kb * 4 + j] = e2[0]; pv[kb * 4 + j + 1] = e2[1]; ps2 = ps2 + e2; } \
            lrun[nq] = lrun[nq] * alpha + (ps2[0] + ps2[1]); \
            const u32x4 w = pack8(pv); pf[nq] = *(const bf16x8*)&w; \
            _Pragma("unroll") for (int db = 0; db < 4; ++db) o[db][nq] *= alpha; } \
        _Pragma("unroll") for (int db = 0; db < 4; ++db) { const bf16x8 vf = (bf16x8){VLO[db][0], VLO[db][1], VLO[db][2], VLO[db][3], VHI[db][0], VHI[db][1], VHI[db][2], VHI[db][3]}; \
            _Pragma("unroll") for (int nq = 0; nq < 4; ++nq) o[db][nq] = __builtin_amdgcn_mfma_f32_16x16x32_bf16(vf, pf[nq], o[db][nq], 0, 0, 0); } } while (0)
    bf16x8 kfa[2][2], kfb[2][2]; bf16x4 vla[4], vha[4], vlb[4], vhb[4];
    ATT_LOAD(0, kfa, vla, vha);
    for (int i = 0; i < ntot; i += 2) {
        const int i1 = (i + 1 < ntot) ? i + 1 : i;
        ATT_LOAD(i1, kfb, vlb, vhb);
        ATT_COMPUTE(i, kfa, vla, vha);
        const int i2 = (i + 2 < ntot) ? i + 2 : i;
        ATT_LOAD(i2, kfa, vla, vha);
        if (i + 1 < ntot) ATT_COMPUTE(i + 1, kfb, vlb, vhb);
    }
#undef ATT_LOAD
#undef ATT_COMPUTE
#pragma unroll
    for (int nq = 0; nq < 4; ++nq) {
        float lt = lrun[nq]; lt += shx(lt, 16, lane); lt += shx(lt, 32, lane);
        const float inv = 1.0f / lt;
        bf16_t* yp = Y + (size_t)(qrow0 + r0 + nq * 16 + fr) * D + 512 + head * 64 + fq * 4;
#pragma unroll
        for (int db = 0; db < 4; ++db) { u32x2 w; w.x = cvt_pk_bf16(o[db][nq][0] * inv, o[db][nq][1] * inv); w.y = cvt_pk_bf16(o[db][nq][2] * inv, o[db][nq][3] * inv);
            *(u32x2*)(yp + db * 16) = w; }
    }
}

__device__ __forceinline__ void gmlp_conv_item(const Params& p, int l, int hs, int chunk, LAS unsigned char* lds) {
    const int tid = tid_opaque(), wid = tid >> 6, lane = tid & 63, fr = lane & 15, fq = lane >> 4;
    const bf16_t* P = (const bf16_t*)(p.ws + WS_R1);
    bf16_t* Y = (bf16_t*)(p.ws + WS_A) + (size_t)part_u0(hs) * D;
    const int v0 = chunk * 128, latN = part_lat(hs);
    LAS bf16_t* vT = (LAS bf16_t*)lds;
    { const float* cw = p.in[I_CONVW] + (size_t)l * 3 * 256;
      const bool lat = v0 < latN;
#pragma unroll 2
      for (int i = 0; i < 8; ++i) {
          const int id = i * 512 + tid, pt = id >> 5, cc = (id & 31) * 8, v = v0 + pt;
          const int pos = lat ? (v & (SEQ - 1)) : ((v - latN) & (CTXL - 1)), n = lat ? SEQ : CTXL;
          const bf16_t* rp = P + (size_t)v * PROJ + cc;
          float bv[8], c1[8], h1[8], acc[8];
          unpack8(*(const u32x4*)(rp + OFF_CB), bv); unpack8(*(const u32x4*)(rp + OFF_CC), c1); unpack8(*(const u32x4*)(rp + OFF_CH), h1);
          { const f32x4 wa = *(const f32x4*)(cw + 256 + cc), wb = *(const f32x4*)(cw + 256 + cc + 4);
#pragma unroll
            for (int e = 0; e < 8; ++e) acc[e] = c1[e] * h1[e] * (e < 4 ? wa[e & 3] : wb[e & 3]); }
          if (pos > 0) { float c0[8], h0[8]; unpack8(*(const u32x4*)(rp - PROJ + OFF_CC), c0); unpack8(*(const u32x4*)(rp - PROJ + OFF_CH), h0);
              const f32x4 wa = *(const f32x4*)(cw + cc), wb = *(const f32x4*)(cw + cc + 4);
#pragma unroll
              for (int e = 0; e < 8; ++e) acc[e] += c0[e] * h0[e] * (e < 4 ? wa[e & 3] : wb[e & 3]); }
          if (pos < n - 1) { float c2[8], h2[8]; unpack8(*(const u32x4*)(rp + PROJ + OFF_CC), c2); unpack8(*(const u32x4*)(rp + PROJ + OFF_CH), h2);
              const f32x4 wa = *(const f32x4*)(cw + 512 + cc), wb = *(const f32x4*)(cw + 512 + cc + 4);
#pragma unroll
              for (int e = 0; e < 8; ++e) acc[e] += c2[e] * h2[e] * (e < 4 ? wa[e & 3] : wb[e & 3]); }
#pragma unroll
          for (int e = 0; e < 8; ++e) acc[e] *= bv[e];
          *(u32x4*)(Y + (size_t)v * D + cc) = pack8(acc);
      } }
    { const float* lg = p.in[I_LNG] + l * 256 + 4 * lane; const float* lb = p.in[I_LNB] + l * 256 + 4 * lane;
      const f32x4 g4 = *(const f32x4*)lg, b4 = *(const f32x4*)lb;
#pragma unroll
      for (int hb = 0; hb < 2; ++hb) {
          u32x2 w[8]; float x[8][4], sm[8], qv[8];
#pragma unroll
          for (int i = 0; i < 8; ++i) w[i] = *(const u32x2*)(P + (size_t)(v0 + wid * 16 + hb * 8 + i) * PROJ + OFF_GV + 4 * lane);
#pragma unroll
          for (int i = 0; i < 8; ++i) { x[i][0] = gelu_tanh(bf_lo(w[i].x)); x[i][1] = gelu_tanh(bf_hi(w[i].x)); x[i][2] = gelu_tanh(bf_lo(w[i].y)); x[i][3] = gelu_tanh(bf_hi(w[i].y));
              sm[i] = (x[i][0] + x[i][1]) + (x[i][2] + x[i][3]); }
#pragma unroll
          for (int st = 1; st < 64; st <<= 1)
#pragma unroll
              for (int i = 0; i < 8; ++i) sm[i] += shx(sm[i], st, lane);
#pragma unroll
          for (int i = 0; i < 8; ++i) { const float mu = sm[i] * (1.0f / 256); float q = 0.f;
#pragma unroll
              for (int e = 0; e < 4; ++e) { x[i][e] -= mu; q += x[i][e] * x[i][e]; }
              qv[i] = q; }
#pragma unroll
          for (int st = 1; st < 64; st <<= 1)
#pragma unroll
              for (int i = 0; i < 8; ++i) qv[i] += shx(qv[i], st, lane);
#pragma unroll
          for (int i = 0; i < 8; ++i) { const float rstd = rsqrtf(qv[i] * (1.0f / 256) + EPS); const int pt = wid * 16 + hb * 8 + i;
#pragma unroll
              for (int e = 0; e < 4; ++e) { const float y = x[i][e] * rstd * g4[e] + b4[e]; vT[(4 * lane + e) * 136 + pt] = (bf16_t)(cvt_pk_bf16(y, 0.f) & 0xffffu); } }
      } }
    __syncthreads();
    { const int g = wid >> 1, ph = wid & 1;
      const bf16_t* wsb = (const bf16_t*)(p.ws + WS_WT) + (size_t)l * W_LAYER + W_GWS + (size_t)g * 128 * 128;
      f32x4 acc[4][4];
#pragma unroll
      for (int a = 0; a < 4; ++a)
#pragma unroll
          for (int b = 0; b < 4; ++b) acc[a][b] = (f32x4){0.f, 0.f, 0.f, 0.f};
#pragma unroll
      for (int kk = 0; kk < 4; ++kk) {
          bf16x8 af[4], bfr[4];
#pragma unroll
          for (int db = 0; db < 4; ++db) af[db] = *(const LAS bf16x8*)(vT + (g * 64 + db * 16 + fr) * 136 + kk * 32 + fq * 8);
#pragma unroll
          for (int pb = 0; pb < 4; ++pb) bfr[pb] = *(const bf16x8*)(wsb + (size_t)((ph * 4 + pb) * 16 + fr) * 128 + kk * 32 + fq * 8);
#pragma unroll
          for (int db = 0; db < 4; ++db)
#pragma unroll
              for (int pb = 0; pb < 4; ++pb) acc[db][pb] = __builtin_amdgcn_mfma_f32_16x16x32_bf16(af[db], bfr[pb], acc[db][pb], 0, 0, 0);
      }
      const float* bs = p.in[I_GBS] + (size_t)l * 512 + g * 128;
      u32x2 uw[4][4]; float bias[4];
#pragma unroll
      for (int pb = 0; pb < 4; ++pb) { const int pt = (ph * 4 + pb) * 16 + fr; bias[pb] = bs[pt];
          const bf16_t* up = P + (size_t)(v0 + pt) * PROJ + OFF_GU + g * 64 + fq * 4;
#pragma unroll
          for (int db = 0; db < 4; ++db) uw[pb][db] = *(const u32x2*)(up + db * 16); }
#pragma unroll
      for (int pb = 0; pb < 4; ++pb) { const int pt = (ph * 4 + pb) * 16 + fr;
          bf16_t* yp = Y + (size_t)(v0 + pt) * D + 256 + g * 64 + fq * 4;
#pragma unroll
          for (int db = 0; db < 4; ++db) { const u32x2 w = uw[pb][db];
              const float y0 = gelu_tanh(bf_lo(w.x)) * (acc[db][pb][0] + bias[pb]), y1 = gelu_tanh(bf_hi(w.x)) * (acc[db][pb][1] + bias[pb]);
              const float y2 = gelu_tanh(bf_lo(w.y)) * (acc[db][pb][2] + bias[pb]), y3 = gelu_tanh(bf_hi(w.y)) * (acc[db][pb][3] + bias[pb]);
              u32x2 ov; ov.x = cvt_pk_bf16(y0, y1); ov.y = cvt_pk_bf16(y2, y3); *(u32x2*)(yp + db * 16) = ov; } } }
    __syncthreads();
}

__device__ void phase_mixers(const Params& p, int l, int hs, LAS unsigned char* lds, bool skip_ctx) {
    const int n_attn = part_nb(hs) * (skip_ctx ? 32 : 36), n_gmlp = (skip_ctx ? part_lat(hs) : part_rows(hs)) / 128;
#ifndef SKIP_ATTN
    for (int it = bid_opaque(); it < n_attn; it += gridDim.x) attn_item(p, l, hs, it);
#endif
    __builtin_amdgcn_sched_barrier(0);
#ifndef SKIP_GMLP
    { const int G = (int)gridDim.x; int n3 = n_attn - 2 * G; n3 = n3 < 0 ? 0 : n3 % G;
      for (int it = (bid_opaque() - n3 + G) % G; it < n_gmlp; it += G) gmlp_conv_item(p, l, hs, it, lds); }
#endif
}

#define XB_TMO      128
#define XB_XCNT(j)  (256  + 64 * (j))
#define XB_XSUB(j)  (1280 + 64 * (j))
#define XB_XGEN(j)  (2304 + 64 * (j))
#define XB_TOP      3328
#define XB_TOPGEN   3392
#define XCD_BAR_WORDS 3456
#define XB_SPIN_CAP (1u << 22)
__device__ __forceinline__ unsigned xb_ld(unsigned* p)              { return __hip_atomic_load(p, __ATOMIC_RELAXED, __HIP_MEMORY_SCOPE_AGENT); }
__device__ __forceinline__ unsigned xb_add(unsigned* p, unsigned v) { return __hip_atomic_fetch_add(p, v, __ATOMIC_RELAXED, __HIP_MEMORY_SCOPE_AGENT); }
__device__ __forceinline__ unsigned xb_xcc_id() { return (unsigned)__builtin_amdgcn_s_getreg((3 << 11) | 20) & 0xFu; }
#define XB_SPIN(cond, bar) do { unsigned _sp = 0; while (cond) { __builtin_amdgcn_s_sleep(1); \
    if ((++_sp & 255u) == 0u) { if (xb_ld(&(bar)[XB_TMO])) break; if (_sp > XB_SPIN_CAP) { atomicAdd(&(bar)[XB_TMO], 1u); break; } } } } while (0)
__device__ __forceinline__ void xcd_barrier_post(unsigned* bar) { if (threadIdx.x == 0) (void)xb_add(&bar[XB_XCNT(xb_xcc_id())], 1u); }
__device__ __forceinline__ void xcd_barrier_complete(unsigned* bar, unsigned x, unsigned& nloc, unsigned& nx) {
    const unsigned G = gridDim.x * gridDim.y * gridDim.z;
    unsigned sum, cnt, mine, sp = 0u;
    for (;;) {
        sum = 0u; cnt = 0u; mine = 0u;
#pragma unroll
        for (unsigned j = 0; j < 16; ++j) { const unsigned c = xb_ld(&bar[XB_XCNT(j)]); sum += c; cnt += (c > 0u) ? 1u : 0u; mine = (j == x) ? c : mine; }
        if (sum == G) break;
        __builtin_amdgcn_s_sleep(1);
        if ((++sp & 255u) == 0u) { if (xb_ld(&bar[XB_TMO])) break; if (sp > XB_SPIN_CAP) { atomicAdd(&bar[XB_TMO], 1u); break; } }
    }
    nloc = mine > 0u ? mine : 1u; nx = cnt > 0u ? cnt : 1u;
}
__device__ __forceinline__ void xcd_barrier(unsigned* bar, volatile LAS unsigned* st) {
    asm volatile("s_waitcnt vmcnt(0)" ::: "memory");
    __syncthreads();
    if (threadIdx.x == 0) {
        const unsigned x = xb_xcc_id();
        __builtin_amdgcn_s_waitcnt(0);
        unsigned nloc = st[0], nx = st[1];
        if (nloc == 0u) { xcd_barrier_complete(bar, x, nloc, nx); st[0] = nloc; st[1] = nx; }
        const unsigned old = xb_add(&bar[XB_XSUB(x)], 1u);
        const unsigned gen = old / nloc;
        if (old + 1u == (gen + 1u) * nloc) {
            __builtin_amdgcn_fence(__ATOMIC_RELEASE, "agent");
            asm volatile("s_waitcnt vmcnt(0)" ::: "memory");
            const unsigned og = xb_add(&bar[XB_TOP], 1u);
            const unsigned tg = og / nx;
            if (og + 1u == (tg + 1u) * nx) xb_add(&bar[XB_TOPGEN], 1u);
            else XB_SPIN(xb_ld(&bar[XB_TOPGEN]) == tg, bar);
            __builtin_amdgcn_fence(__ATOMIC_ACQUIRE, "agent");
            xb_add(&bar[XB_XGEN(x)], 1u);
            asm volatile("s_waitcnt vmcnt(0)" ::: "memory");
        } else {
            XB_SPIN(xb_ld(&bar[XB_XGEN(x)]) == gen, bar);
            __builtin_amdgcn_fence(__ATOMIC_ACQUIRE, "agent");
            asm volatile("s_waitcnt vmcnt(0)" ::: "memory");
        }
    }
    __syncthreads();
}

__device__ void run_phase(const Params& p, int ph, LAS unsigned char* lds) {
    if (ph == 0) {
#ifndef SKIP_SETUP
 phase_setup(p, lds);
#endif
 return; }
    const int q = ph - 1, l = q / 17, r = q % 17;
    const bf16_t* W = (const bf16_t*)(p.ws + WS_WT) + (size_t)l * W_LAYER;
    const float* MOD = (const float*)(p.ws + WS_MOD) + (size_t)l * 33 * (NMOD * D);
    bf16_t* HB = (bf16_t*)(p.ws + WS_H);
    const bool first = (l == 0 && r <= 2);
    const bool lastl = (l == NL - 1);
    bf16_t* A = (bf16_t*)(p.ws + WS_A); bf16_t* R1 = (bf16_t*)(p.ws + WS_R1);
    if (r == 0 || r == 3 || r == 14) {
#ifndef SKIP_NORM
 if (l == 0 && r == 0) phase_norm(p, l, 0, true, false);
#endif
 return; }
    if (r == 1 || r == 15) {
        const int j = (r == 1) ? 0 : 1;
        const int sk = (lastl && j == 1) ? 1 : 0;
        pg8::Gemm g{A, D, W + (j ? W_FIN1 : W_FIN0), D, sk ? T_LAT : T_ALL, 2 * DFF, D, sk, 0};
        pg8::EpiSwiglu E{R1};
#ifndef SKIP_UP
        pg8::gemm_phase(lds, g, E);
#endif
        return;
    }
    if (r == 2 || r == 16) {
        const int j = (r == 2) ? 0 : 1;
        const int sk = (lastl && j == 1) ? 1 : 0;
        pg8::Gemm g{R1, DFF, W + (j ? W_FOUT1 : W_FOUT0), DFF, sk ? T_LAT : T_ALL, D, DFF, sk, 1};
        const int nj = (r == 2) ? 1 : (lastl ? -1 : 0), ln = (r == 2) ? l : l + 1;
        const bool fin = (lastl && r == 16);
        const float* ngp = p.in[I_NORMG] + ((size_t)(nj < 0 ? 0 : ln) * 3 + (nj < 0 ? 0 : nj)) * D; const float* nmp = (const float*)(p.ws + WS_MOD) + (size_t)(nj < 0 ? 0 : ln) * 33 * (NMOD * D);
        unsigned* cntp = (unsigned*)(p.ws + WS_CNT) + (size_t)(l * 3 + (r == 2 ? 0 : 2)) * 576;
#ifndef SKIP_DOWN
        if (fin) { pg8::EpiResid<2, false> E{p.in[I_X], p.in[I_CTX], HB, p.out, MOD, 8, 0.5f, 0, 2, -1, ngp, nmp, A, (float*)(p.ws + WS_XS), cntp, lds}; pg8::gemm_phase(lds, g, E); }
        else { pg8::EpiResid<1, true> E{p.in[I_X], p.in[I_CTX], HB, p.out, MOD, j ? 8 : 2, 0.5f, 0, 1, nj, ngp, nmp, A, (float*)(p.ws + WS_XS), cntp, lds}; pg8::gemm_phase(lds, g, E); }
#endif
        return;
    }
    const int hs = (r - 4) / 5, rr = (r - 4) % 5;
    if (rr == 0) { pg8::Gemm g{A + (size_t)part_u0(hs) * D, D, W + W_WIN, D, part_rows(hs), PROJ, D, 0, 0}; pg8::EpiBf16 E{R1, PROJ, p.in[I_BGATE] + (size_t)l * 3 * D, OFF_GATE};
#ifndef SKIP_PROJ
 pg8::gemm_phase(lds, g, E);
#endif
 return; }
    if (rr == 1) {
#ifndef SKIP_PREP
 phase_prep(p, l, hs, lds);
#endif
 return; }
    if (rr == 2) {
#ifndef SKIP_MIX
 phase_mixers(p, l, hs, lds, lastl);
#endif
 return; }
    if (rr == 3) { pg8::Gemm g{A + (size_t)part_u0(hs) * D, D, W + W_WB, D, lastl ? part_lat(hs) : part_rows(hs), D, D, 0, 1}; pg8::EpiBranch E{R1};
#ifndef SKIP_BRANCH
 pg8::gemm_phase(lds, g, E);
#endif
 return; }
    { pg8::Gemm g{R1, PROJ, W + W_WO, D, lastl ? part_lat(hs) : part_rows(hs), D, D, 0, 0}; pg8::EpiResid<1, true> E{p.in[I_X], p.in[I_CTX], HB, p.out, MOD, 5, 1.0f, part_u0(hs) / 256, 1,
                        2, p.in[I_NORMG] + ((size_t)l * 3 + 2) * D, MOD, A, (float*)(p.ws + WS_XS), (unsigned*)(p.ws + WS_CNT) + (size_t)(l * 3 + 1) * 576, lds};
#ifndef SKIP_OUT
 pg8::gemm_phase(lds, g, E);
#endif
 }
}

__global__ __launch_bounds__(512, 2) void fwd_megakernel(Params p) {
    extern __shared__ __attribute__((aligned(16))) unsigned char shm[];
    LAS unsigned char* lds = (LAS unsigned char*)shm;
#if MK_SINGLE
    volatile LAS unsigned* bst = (volatile LAS unsigned*)(lds + LDS_BYTES - 16);
    if (threadIdx.x == 0) { bst[0] = 0u; bst[1] = 0u; }
    __syncthreads();
    xcd_barrier_post((unsigned*)(p.ws + WS_BAR));
#endif
    for (int ph = p.ph_lo; ph < p.ph_hi; ++ph) {
#if defined(__HIP_DEVICE_COMPILE__)
        const __attribute__((address_space(4))) char* kp = (const __attribute__((address_space(4))) char*)__builtin_amdgcn_kernarg_segment_ptr();
        asm volatile("" : "+s"(kp));
        const Params lp = *(const Params*)(const char*)kp;
#else
        const Params lp = p;
#endif
        run_phase(lp, ph, lds);
#if MK_SINGLE
        const int r_ = (ph - 1) % 17;
        if (ph + 1 < lp.ph_hi && !(ph > 1 && (r_ == 0 || r_ == 3 || r_ == 14))) {
            if (ph == 0) cg::this_grid().sync();
            else xcd_barrier((unsigned*)(lp.ws + WS_BAR), (volatile LAS unsigned*)(lds + LDS_BYTES - 16));
        }
#endif
    }
}

extern "C" void kernel_launch(void* const* d_in, const int* in_sizes, int n_in, void* d_out, int out_size, void* d_ws, size_t ws_size, hipStream_t stream) {
    static int grid = 0;
    if (grid == 0) {
        if (n_in != N_IN || out_size != T_LAT * D || ws_size < WS_END) { fprintf(stderr, "kernel_launch: unexpected shapes (n_in %d out %d ws %zu need %zu)\n", n_in, out_size, ws_size, (size_t)WS_END); grid = -1; return; }
        int dev = 0, cus = 0, per_cu = 0;
        (void)hipGetDevice(&dev); (void)hipDeviceGetAttribute(&cus, hipDeviceAttributeMultiprocessorCount, dev);
        if (hipFuncSetAttribute((const void*)fwd_megakernel, hipFuncAttributeMaxDynamicSharedMemorySize, LDS_BYTES) != hipSuccess) { fprintf(stderr, "kernel_launch: hipFuncSetAttribute failed\n"); grid = -1; return; }
        if (hipOccupancyMaxActiveBlocksPerMultiprocessor(&per_cu, (const void*)fwd_megakernel, 512, LDS_BYTES) != hipSuccess || per_cu < 1) { fprintf(stderr, "kernel_launch: occupancy query gave %d\n", per_cu); per_cu = 1; }
        (void)hipGetLastError();
        grid = cus * per_cu;
    }
    if (grid < 0) return;
    Params p{};
    for (int i = 0; i < N_IN; ++i) p.in[i] = (const float*)d_in[i];
    p.out = (float*)d_out; p.ws = (unsigned char*)d_ws;
#if MK_SINGLE
    p.ph_lo = 0; p.ph_hi = N_PHASES;
    if (hipMemsetAsync((char*)d_ws + WS_BAR, 0, 16384 + 32768, stream) != hipSuccess) { fprintf(stderr, "kernel_launch: memset of the barrier words failed\n"); return; }
    void* args[] = {&p};
    hipError_t e = hipLaunchCooperativeKernel((const void*)fwd_megakernel, dim3(grid), dim3(512), args, LDS_BYTES, stream);
    if (e != hipSuccess) fprintf(stderr, "cooperative launch failed: %s (grid %d)\n", hipGetErrorString(e), grid);
#else
    for (int ph = 0; ph < N_PHASES; ++ph) {
        p.ph_lo = ph; p.ph_hi = ph + 1;
        hipLaunchKernelGGL(fwd_megakernel, dim3(grid), dim3(512), LDS_BYTES, stream, p);
    }
#endif
}
```

```cpp
#include <hip/hip_runtime.h>
#include <hip/hip_cooperative_groups.h>
#include <cstdio>
namespace cg = cooperative_groups;

#ifndef MK_SINGLE
#define MK_SINGLE 1
#endif

#define LAS __attribute__((address_space(3)))
typedef unsigned short bf16_t;
typedef short bf16x8 __attribute__((ext_vector_type(8)));
typedef short bf16x4 __attribute__((ext_vector_type(4)));
typedef float f32x4 __attribute__((ext_vector_type(4)));
typedef unsigned u32x4 __attribute__((ext_vector_type(4)));
typedef unsigned u32x2 __attribute__((ext_vector_type(2)));
typedef float f32x2 __attribute__((ext_vector_type(2)));

constexpr int D = 1024, NB = 32, SEQ = 2048, NL = 4, CTXL = 256, DFF = 2816, PROJ = 5120, NMOD = 9;
constexpr int T_LAT = NB * SEQ, T_CTX = NB * CTXL, T_ALL = T_LAT + T_CTX;
constexpr int NB0 = 14, NB1 = NB - NB0;
constexpr int U1 = NB0 * (SEQ + CTXL);
constexpr int TH_MAX = NB1 * (SEQ + CTXL);
__host__ __device__ __forceinline__ constexpr int part_nb(int s) { return s ? NB1 : NB0; }
__host__ __device__ __forceinline__ constexpr int part_lat(int s) { return part_nb(s) * SEQ; }
__host__ __device__ __forceinline__ constexpr int part_rows(int s) { return part_nb(s) * (SEQ + CTXL); }
__host__ __device__ __forceinline__ constexpr int part_u0(int s) { return s ? U1 : 0; }
constexpr int OFF_CB = 0, OFF_CC = 256, OFF_CH = 512, OFF_GU = 768, OFF_GV = 1024, OFF_Q = 1280, OFF_K = 1792, OFF_V = 1920, OFF_GATE = 2048;
constexpr float EPS = 1e-6f;
constexpr float LOG2E = 1.4426950408889634f;

enum { I_X = 0, I_C, I_CTX, I_CCTX, I_WMOD, I_BMOD, I_NORMG, I_FFNIN, I_FFNOUT, I_WIN, I_BGATE, I_CONVW, I_LNG, I_LNB, I_GWS, I_GBS, I_QG, I_KG, I_SINK, I_WBC, I_WBG, I_WBA, I_WOUT, N_IN };

constexpr size_t W_FIN0 = 0, W_FIN1 = 5767168, W_FOUT0 = 11534336, W_FOUT1 = 14417920, W_WIN = 17301504, W_WB = 22544384, W_WO = 23592960, W_GWS = 24641536, W_LAYER = 24707072;
constexpr size_t WS_WT = 0;
constexpr size_t WS_MOD = WS_WT + NL * W_LAYER * 2;
constexpr size_t WS_ROPE = WS_MOD + (size_t)NL * 33 * 9216 * 4;
constexpr size_t WS_HC = WS_ROPE + 8192;
constexpr size_t WS_A = WS_HC + (size_t)T_CTX * D * 4;
constexpr size_t WS_R1 = WS_A + (size_t)T_ALL * D * 2;
constexpr size_t WS_VTL = WS_R1 + (size_t)TH_MAX * PROJ * 2;
constexpr size_t WS_VTC = WS_VTL + (size_t)NB1 * 2 * 64 * 2048 * 2;
constexpr size_t WS_BAR = WS_VTC + (size_t)NB1 * 2 * 64 * 256 * 2;
constexpr size_t WS_CNT = WS_BAR + 16384;
constexpr size_t WS_XS = WS_CNT + 32768;
constexpr size_t WS_H = WS_XS + (size_t)288 * 256 * 4 * 4;
constexpr size_t WS_END = WS_H + (size_t)T_ALL * D * 2;

constexpr int LDS_BYTES = 143360;
constexpr int N_PHASES = 1 + 17 * NL;

struct Params {
    const float* in[N_IN];
    float* out;
    unsigned char* ws;
    int ph_lo, ph_hi;
};

__device__ __forceinline__ unsigned cvt_pk_bf16(float lo, float hi) { unsigned r; asm volatile("v_cvt_pk_bf16_f32 %0, %1, %2" : "=v"(r) : "v"(lo), "v"(hi)); return r; }
__device__ __forceinline__ int tid_opaque() { int t = threadIdx.x; asm volatile("" : "+v"(t)); return t; }
__device__ __forceinline__ int bid_opaque() { int b = blockIdx.x; asm volatile("" : "+s"(b)); return b; }
__device__ __forceinline__ float bf_lo(unsigned w) { return __uint_as_float(w << 16); }
__device__ __forceinline__ float bf_hi(unsigned w) { return __uint_as_float(w & 0xffff0000u); }
__device__ __forceinline__ float fast_rcp(float x) { return __builtin_amdgcn_rcpf(x); }
__device__ __forceinline__ float fast_exp2(float x) { return __builtin_amdgcn_exp2f(x); }
__device__ __forceinline__ float sigmoidf_(float x) { return fast_rcp(1.0f + fast_exp2(-x * LOG2E)); }
__device__ __forceinline__ float siluf_(float x) { return x * sigmoidf_(x); }
__device__ __forceinline__ float gelu_tanh(float x) { const float z = 0.7978845608028654f * (x + 0.044715f * x * x * x); return x * sigmoidf_(2.0f * z); }
__device__ __forceinline__ float shx(float v, int m, int lane) { return __int_as_float(__builtin_amdgcn_ds_bpermute((lane ^ m) << 2, __float_as_int(v))); }
__device__ __forceinline__ float wave_sum(float v, int lane) {
    v += shx(v, 1, lane); v += shx(v, 2, lane); v += shx(v, 4, lane); v += shx(v, 8, lane); v += shx(v, 16, lane); v += shx(v, 32, lane); return v;
}
__device__ __forceinline__ void unpack8(const u32x4 w, float (&f)[8]) {
    f[0] = bf_lo(w.x); f[1] = bf_hi(w.x); f[2] = bf_lo(w.y); f[3] = bf_hi(w.y); f[4] = bf_lo(w.z); f[5] = bf_hi(w.z); f[6] = bf_lo(w.w); f[7] = bf_hi(w.w);
}
__device__ __forceinline__ u32x4 pack8(const float (&f)[8]) {
    u32x4 w; w.x = cvt_pk_bf16(f[0], f[1]); w.y = cvt_pk_bf16(f[2], f[3]); w.z = cvt_pk_bf16(f[4], f[5]); w.w = cvt_pk_bf16(f[6], f[7]); return w;
}

struct RowMap { size_t row0; int is_ctx; int modrow; };
__device__ __forceinline__ RowMap map_row(int u) {
    const int s = (u >= U1) ? 1 : 0, v = u - s * U1, latN = part_lat(s); RowMap r;
    if (v < latN) { r.row0 = (size_t)(s ? NB0 * SEQ : 0) + v; r.is_ctx = 0; r.modrow = (int)(r.row0 >> 11); }
    else { r.row0 = (size_t)(s ? NB0 * CTXL : 0) + (v - latN); r.is_ctx = 1; r.modrow = 32; }
    return r;
}

namespace pg8 {
constexpr int BM = 256, BK = 64, HALF = 128, HTB = HALF * BK * 2, STAGE_BYTES = 8 * HTB, NXCD = 8, WGM = 4;
__device__ __forceinline__ int lds_byte(int r, int c) { const int st = (r >> 4) * 2 + (c >> 5), rr = r & 15, cc = c & 31, ob = rr * 64 + cc * 2; return st * 1024 + (ob ^ (((ob >> 9) & 1) << 5)); }
__device__ __forceinline__ void stage_rc(int b, int& R, int& C) { const int st = b / 1024, sb = b % 1024, swz = sb ^ (((sb >> 9) & 1) << 5); R = (st >> 1) * 16 + swz / 64; C = (st & 1) * 32 + (swz % 64) / 2; }
__device__ __forceinline__ int perm32(int rho) { const int n = rho >> 4, i = rho & 15; return 8 * (i >> 2) + 4 * n + (i & 3); }

struct Unit { int pm, pn; };
struct Gemm { const bf16_t* A; int lda; const bf16_t* Bt; int ldb; int M, N, K; int skip_ctx; int rev; };

struct StaticOrder {
    int nM, nN, nwg, G, c, skip, rev;
    __device__ void init(int M, int N, int G_, int c_, int skip_, int rev_) { nM = M / BM; nN = N / BM; nwg = nM * nN; G = G_; c = c_; skip = skip_; rev = rev_;
        if (nN != 4 && rev > 0) nwg = rev * nN + (nM - rev); }
    __device__ bool next(int i, Unit& u) const {
        const long L = (long)i * G + c; if (L >= nwg + 32) return false;
        if (nN == 4) {
            const int ch = (int)(L >> 5), p5 = (int)(L & 31), xcd = p5 & 7, qf = nM >> 3, rem = nM & 7;
            if (ch > qf || (ch == qf && xcd >= rem)) return false;
            const int cntx = qf + (xcd < rem ? 1 : 0);
            u.pm = (xcd < rem ? xcd * (qf + 1) : rem * (qf + 1) + (xcd - rem) * qf) + (rev ? cntx - 1 - ch : ch); u.pn = p5 >> 3;
            if (skip && u.pm >= NB0 * 8) u.pm += NB0;
            return true;
        }
        if (L >= nwg) return false;
        int wgid = (int)L; { const int q = nwg / NXCD, r = nwg % NXCD, xcd = wgid % NXCD, off = wgid / NXCD; wgid = (xcd < r ? xcd * (q + 1) : r * (q + 1) + (xcd - r) * q) + off; }
        if (rev > 0 && wgid >= rev * nN) { u.pm = rev + (wgid - rev * nN); u.pn = 7; return true; }
        const int nMw = rev > 0 ? rev : nM;
        const int nig = WGM * nN, gid = wgid / nig, fm = gid * WGM, gsz = (nMw - fm) < WGM ? (nMw - fm) : WGM;
        u.pm = fm + ((wgid % nig) % gsz); u.pn = (wgid % nig) / gsz; if (skip && u.pm >= NB0 * 8) u.pm += NB0; return true;
    }
};

template <class Epi>
__device__ __forceinline__ void gemm_phase(LAS unsigned char* lds, const Gemm g, const Epi& E) {
    const int tid = tid_opaque(), wid = __builtin_amdgcn_readfirstlane(tid >> 6), lane = tid & 63, wr = wid >> 2, wc = wid & 3, fr = lane & 15, fq = lane >> 4;
    const int K = g.K, nt = K / BK;
    StaticOrder S; S.init(g.M, g.N, (int)gridDim.x, bid_opaque(), g.skip_ctx, g.rev);
    unsigned voffA[2], voffB[2];
#pragma unroll
    for (int i = 0; i < 2; ++i) { int R, C; stage_rc(tid * 16 + i * 8192, R, C); const int Rb = Epi::PERM ? ((R & ~31) + perm32(R & 31)) : R;
        voffA[i] = (unsigned)(R * g.lda + C) * 2u; voffB[i] = (unsigned)(Rb * g.ldb + C) * 2u; }
    const size_t kstep = (size_t)(BK * 2);
    const size_t hstepA = (size_t)HALF * g.lda * 2, hstepB = (size_t)HALF * g.ldb * 2;
    const size_t tstepA = 2 * hstepA, tstepB = 2 * hstepB;
    const unsigned ldsw = (unsigned)wid * 1024u;
    const int aoff = lds_byte(wr * 64 + fr, fq * 8), boff = lds_byte(wc * 32 + fr, fq * 8);
#define PG8_SA(b, h) (((b) * 2 + (h)) * HTB)
#define PG8_SB(b, h) ((4 + (b) * 2 + (h)) * HTB)
#define PG8_STAGE(bufoff, gbase, voff) do { _Pragma("unroll") for (int _i = 0; _i < 2; ++_i) \
        __builtin_amdgcn_global_load_lds((const unsigned*)((const char*)(gbase) + (voff)[_i]), (LAS unsigned*)(lds + (bufoff) + ldsw + _i * 8192), 16, 0, 0); } while (0)
#define PG8_LDA(dst, b, h) do { _Pragma("unroll") for (int m = 0; m < 4; ++m) _Pragma("unroll") for (int k = 0; k < 2; ++k) dst[m][k] = *(const LAS bf16x8*)(lds + PG8_SA(b, h) + aoff + m * 2048 + k * 1024); } while (0)
#define PG8_LDB(dst, b, h) do { _Pragma("unroll") for (int n = 0; n < 2; ++n) _Pragma("unroll") for (int k = 0; k < 2; ++k) dst[n][k] = *(const LAS bf16x8*)(lds + PG8_SB(b, h) + boff + n * 2048 + k * 1024); } while (0)
#define PG8_MMA(ai, bj, At, Bt) do { __builtin_amdgcn_s_setprio(1); _Pragma("unroll") for (int m = 0; m < 4; ++m) _Pragma("unroll") for (int n = 0; n < 2; ++n) _Pragma("unroll") for (int k = 0; k < 2; ++k) \
        acc[ai][bj][m][n] = __builtin_amdgcn_mfma_f32_16x16x32_bf16(Bt[n][k], At[m][k], acc[ai][bj][m][n], 0, 0, 0); __builtin_amdgcn_s_setprio(0); } while (0)
#define PG8_WAIT_V(n) asm volatile("s_waitcnt vmcnt(" #n ")" ::: "memory")
#define PG8_WAIT_L(n) asm volatile("s_waitcnt lgkmcnt(" #n ")" ::: "memory")
#define PG8_BAR __builtin_amdgcn_s_barrier()
#define PG8_SCHED __builtin_amdgcn_sched_barrier(0)
#define PG8_KLOOP(TB, TE) for (int t = (TB); t < (TE); t += 2) { \
            const bool last = (t == nt - 2); \
            const char* a1 = cA + (size_t)(t + 1) * kstep; \
            const char* a2 = last ? nA : cA + (size_t)(t + 2) * kstep; const char* b2 = last ? nB : cB + (size_t)(t + 2) * kstep; \
            const char* a3 = a2 + kstep; const char* b3 = b2 + kstep; \
            PG8_LDB(B0, 0, 0); PG8_SCHED; PG8_LDA(At, 0, 0); PG8_STAGE(PG8_SA(1, 1), a1 + hstepA, voffA); \
            PG8_WAIT_L(8); PG8_BAR; PG8_WAIT_L(0); PG8_MMA(0, 0, At, B0); PG8_BAR; PG8_SCHED; \
            PG8_LDB(B1, 0, 1); PG8_STAGE(PG8_SB(0, 0), b2, voffB); \
            PG8_BAR; PG8_WAIT_L(0); PG8_MMA(0, 1, At, B1); PG8_BAR; \
            PG8_LDA(At, 0, 1); PG8_STAGE(PG8_SA(0, 0), a2, voffA); \
            PG8_BAR; PG8_WAIT_L(0); PG8_MMA(1, 0, At, B0); PG8_BAR; PG8_SCHED; \
            PG8_STAGE(PG8_SB(0, 1), b2 + hstepB, voffB); \
            PG8_WAIT_V(6); PG8_BAR; PG8_MMA(1, 1, At, B1); PG8_BAR; \
            PG8_LDB(B0, 1, 0); PG8_SCHED; PG8_LDA(At, 1, 0); PG8_STAGE(PG8_SA(0, 1), a2 + hstepA, voffA); \
            PG8_WAIT_L(8); PG8_BAR; PG8_WAIT_L(0); PG8_MMA(0, 0, At, B0); PG8_BAR; PG8_SCHED; \
            PG8_LDB(B1, 1, 1); PG8_STAGE(PG8_SB(1, 0), b3, voffB); \
            PG8_BAR; PG8_WAIT_L(0); PG8_MMA(0, 1, At, B1); PG8_BAR; \
            PG8_LDA(At, 1, 1); PG8_STAGE(PG8_SA(1, 0), a3, voffA); \
            PG8_BAR; PG8_WAIT_L(0); PG8_MMA(1, 0, At, B0); PG8_BAR; PG8_SCHED; \
            PG8_STAGE(PG8_SB(1, 1), b3 + hstepB, voffB); \
            PG8_WAIT_V(6); PG8_BAR; PG8_MMA(1, 1, At, B1); PG8_BAR; \
        }
    Unit cur, nxt; int ui = 0;
    if (!S.next(0, cur)) return;
    f32x4 acc[2][2][4][2];
#pragma unroll
    for (int a = 0; a < 2; ++a)
#pragma unroll
        for (int b = 0; b < 2; ++b)
#pragma unroll
            for (int m = 0; m < 4; ++m)
#pragma unroll
                for (int n = 0; n < 2; ++n) acc[a][b][m][n] = (f32x4){0.f, 0.f, 0.f, 0.f};
    bf16x8 At[4][2], B0[2][2], B1[2][2];
    const char* cA = (const char*)g.A + (size_t)cur.pm * tstepA; const char* cB = (const char*)g.Bt + (size_t)cur.pn * tstepB;
    PG8_STAGE(PG8_SB(0, 0), cB, voffB); PG8_STAGE(PG8_SA(0, 0), cA, voffA); PG8_STAGE(PG8_SB(0, 1), cB + hstepB, voffB); PG8_STAGE(PG8_SA(0, 1), cA + hstepA, voffA);
    if (wr == 1) PG8_BAR;
    PG8_WAIT_V(4); PG8_BAR;
    PG8_STAGE(PG8_SB(1, 0), cB + kstep, voffB); PG8_STAGE(PG8_SA(1, 0), cA + kstep, voffA); PG8_STAGE(PG8_SB(1, 1), cB + hstepB + kstep, voffB);
    PG8_WAIT_V(6); PG8_BAR;
    for (;;) {
        const bool has_next = S.next(ui + 1, nxt);
        const char* nA = has_next ? (const char*)g.A + (size_t)nxt.pm * tstepA : cA; const char* nB = has_next ? (const char*)g.Bt + (size_t)nxt.pn * tstepB : cB;
        if constexpr (Epi::MIDK) {
            PG8_KLOOP(0, 4)
            E.template mid<0>(acc, cur, wr, wc, fr, fq);
            PG8_KLOOP(4, 8)
            E.template mid<1>(acc, cur, wr, wc, fr, fq);
            PG8_KLOOP(8, nt)
        } else {
            PG8_KLOOP(0, nt)
        }
        E(acc, cur, wr, wc, fr, fq);
        if (!has_next) break;
#pragma unroll
        for (int a = 0; a < 2; ++a)
#pragma unroll
            for (int b = 0; b < 2; ++b)
#pragma unroll
                for (int m = 0; m < 4; ++m)
#pragma unroll
                    for (int n = 0; n < 2; ++n) acc[a][b][m][n] = (f32x4){0.f, 0.f, 0.f, 0.f};
        cur = nxt; cA = nA; cB = nB; ++ui;
    }
    PG8_WAIT_V(0);
    if (wr == 0) PG8_BAR;
    PG8_BAR;
#undef PG8_KLOOP
#undef PG8_SA
#undef PG8_SB
#undef PG8_STAGE
#undef PG8_LDA
#undef PG8_LDB
#undef PG8_MMA
#undef PG8_WAIT_V
#undef PG8_WAIT_L
#undef PG8_BAR
#undef PG8_SCHED
}

struct EpiSwiglu {
    static constexpr bool PERM = true, MIDK = false;
    bf16_t* O;
    __device__ __forceinline__ void operator()(const f32x4 (&acc)[2][2][4][2], const Unit& u, int wr, int wc, int fr, int fq) const {
        const int row0 = u.pm * BM + wr * 64 + fr, col0 = u.pn * 128 + wc * 32 + 8 * fq;
#pragma unroll
        for (int ai = 0; ai < 2; ++ai)
#pragma unroll
            for (int m = 0; m < 4; ++m) {
                float h[8];
#pragma unroll
                for (int n = 0; n < 2; ++n)
#pragma unroll
                    for (int j = 0; j < 4; j += 2) {
                        const f32x2 a2 = (f32x2){acc[ai][0][m][n][j], acc[ai][0][m][n][j + 1]}, u2 = (f32x2){acc[ai][1][m][n][j], acc[ai][1][m][n][j + 1]};
                        const f32x2 t2 = a2 * (-LOG2E);
                        f32x2 d2 = (f32x2){fast_exp2(t2[0]), fast_exp2(t2[1])}; d2 = d2 + 1.0f;
                        const f32x2 r2 = (f32x2){fast_rcp(d2[0]), fast_rcp(d2[1])};
                        const f32x2 h2 = (a2 * u2) * r2;
                        h[n * 4 + j] = h2[0]; h[n * 4 + j + 1] = h2[1]; }
                *(u32x4*)(O + (size_t)(row0 + ai * HALF + m * 16) * DFF + col0) = pack8(h);
            }
    }
};
struct EpiBf16 {
    static constexpr bool PERM = true, MIDK = false;
    bf16_t* O; int ldc; const float* bias; int bias_col0;
    __device__ __forceinline__ void operator()(const f32x4 (&acc)[2][2][4][2], const Unit& u, int wr, int wc, int fr, int fq) const {
        const int row0 = u.pm * BM + wr * 64 + fr, col0 = u.pn * BM + wc * 32 + 8 * fq;
        const bool hb = (u.pn * BM >= bias_col0);
        f32x4 bv[2][2];
#pragma unroll
        for (int bj = 0; bj < 2; ++bj)
#pragma unroll
            for (int n = 0; n < 2; ++n) bv[bj][n] = hb ? *(const f32x4*)(bias + (col0 - bias_col0) + bj * HALF + 4 * n) : (f32x4){0.f, 0.f, 0.f, 0.f};
#pragma unroll
        for (int ai = 0; ai < 2; ++ai)
#pragma unroll
            for (int m = 0; m < 4; ++m) { bf16_t* rowp = O + (size_t)(row0 + ai * HALF + m * 16) * ldc + col0;
#pragma unroll
                for (int bj = 0; bj < 2; ++bj) { f32x4 v0 = acc[ai][bj][m][0] + bv[bj][0], v1 = acc[ai][bj][m][1] + bv[bj][1];
                    if (hb) {
#pragma unroll
                        for (int j = 0; j < 4; j += 2) {
                            const f32x2 c0 = (f32x2){fminf(fmaxf(v0[j], -30.f), 30.f), fminf(fmaxf(v0[j + 1], -30.f), 30.f)} * (-LOG2E);
                            const f32x2 c1 = (f32x2){fminf(fmaxf(v1[j], -30.f), 30.f), fminf(fmaxf(v1[j + 1], -30.f), 30.f)} * (-LOG2E);
                            const f32x2 e0 = (f32x2){fast_exp2(c0[0]), fast_exp2(c0[1])} + 1.0f, e1 = (f32x2){fast_exp2(c1[0]), fast_exp2(c1[1])} + 1.0f;
                            v0[j] = e0[0]; v0[j + 1] = e0[1]; v1[j] = e1[0]; v1[j + 1] = e1[1]; } }
                    u32x4 w; w.x = cvt_pk_bf16(v0[0], v0[1]); w.y = cvt_pk_bf16(v0[2], v0[3]); w.z = cvt_pk_bf16(v1[0], v1[1]); w.w = cvt_pk_bf16(v1[2], v1[3]);
                    *(u32x4*)(rowp + bj * HALF) = w; } }
    }
};
template <int MODE_, bool FUSE_> struct EpiResid {
    static constexpr bool PERM = true, MIDK = false;
    const float* x_lat; const float* x_ctx; bf16_t* hbuf; float* out; const float* mod; int gate_idx; float gscale; int tile0; int mode;
    int nj; const float* ng; const float* nmod; bf16_t* Aout; float* xs; unsigned* cnt; LAS unsigned char* lds;
    template <int MODE> __device__ __forceinline__ void body(f32x4 (&acc)[2][2][4][2], const Unit& u, int, int, int, int) const {
        const int t_ = tid_opaque(); const int wr = t_ >> 8, wc = (t_ >> 6) & 3, fr = t_ & 15, fq = (t_ >> 4) & 3;
        const int urow0 = (tile0 + u.pm) * BM;
        const RowMap rm = map_row(urow0);
        const float* gp = mod + (size_t)rm.modrow * (NMOD * D) + gate_idx * D;
        int rloc = wr * 64 + fr, col0 = u.pn * BM + wc * 32 + 8 * fq;
        asm volatile("" : "+v"(rloc), "+v"(col0));
        const unsigned loff = (unsigned)rloc * D + (unsigned)col0;
        const char* hbase = (const char*)(hbuf + (size_t)urow0 * D);
        const char* obase = (const char*)(out + rm.row0 * D);
        const bool st_ok = (MODE != 2) || !rm.is_ctx;
        constexpr int MG = 4;
#pragma unroll
        for (int bj = 0; bj < 2; ++bj) {
            const f32x4 g0 = *(const f32x4*)(gp + col0 + bj * HALF) * gscale, g1 = *(const f32x4*)(gp + col0 + bj * HALF + 4) * gscale;
#pragma unroll
            for (int ai = 0; ai < 2; ++ai)
#pragma unroll
                for (int mg = 0; mg < 4; mg += MG) {
                    u32x4 xw[MG];
#pragma unroll
                    for (int mm = 0; mm < MG; ++mm) xw[mm] = *(const u32x4*)(hbase + (size_t)(loff + (unsigned)((ai * HALF + (mg + mm) * 16) * D + bj * HALF)) * 2u);
                    __builtin_amdgcn_sched_barrier(0);
#pragma unroll
                    for (int mm = 0; mm < MG; ++mm) { const int m = mg + mm; const unsigned eo = loff + (unsigned)((ai * HALF + m * 16) * D + bj * HALF);
                        const u32x4 w = xw[mm];
                        const f32x4 x0 = (f32x4){bf_lo(w.x), bf_hi(w.x), bf_lo(w.y), bf_hi(w.y)}, x1 = (f32x4){bf_lo(w.z), bf_hi(w.z), bf_lo(w.w), bf_hi(w.w)};
                        const f32x4 y0 = x0 + g0 * acc[ai][bj][m][0], y1 = x1 + g1 * acc[ai][bj][m][1];
                        if constexpr (MODE == 2) { if (st_ok) { *(f32x4*)(obase + (size_t)eo * 4u) = y0; *(f32x4*)(obase + (size_t)eo * 4u + 16) = y1; } }
                        else { if constexpr (!FUSE_) { u32x4 o; o.x = cvt_pk_bf16(y0[0], y0[1]); o.y = cvt_pk_bf16(y0[2], y0[3]); o.z = cvt_pk_bf16(y1[0], y1[1]); o.w = cvt_pk_bf16(y1[2], y1[3]); *(u32x4*)((char*)hbase + (size_t)eo * 2u) = o; }
                               acc[ai][bj][m][0] = y0; acc[ai][bj][m][1] = y1; }
                    }
                    __builtin_amdgcn_sched_barrier(0);
                }
        }
        if constexpr (MODE != 2) {
            if (!FUSE_) return;
            const int lane = fq * 16 + fr, T = tile0 + u.pm;
            LAS float* Pt = (LAS float*)(lds + STAGE_BYTES);
            LAS float* St = Pt + 1024;
#pragma unroll
            for (int ai = 0; ai < 2; ++ai)
#pragma unroll
                for (int m = 0; m < 4; ++m) { float sq = 0.f;
#pragma unroll
                    for (int bj = 0; bj < 2; ++bj)
#pragma unroll
                        for (int n = 0; n < 2; ++n) { const f32x4 v = acc[ai][bj][m][n]; sq += (v[0] * v[0] + v[1] * v[1]) + (v[2] * v[2] + v[3] * v[3]); }
                    sq += shx(sq, 16, lane); sq += shx(sq, 32, lane);
                    if (fq == 0) Pt[(ai * HALF + rloc + m * 16) * 4 + wc] = sq; }
            asm volatile("s_waitcnt lgkmcnt(0)" ::: "memory"); __builtin_amdgcn_s_barrier(); asm volatile("" ::: "memory");
            const int idx = wc * 32 + (lane & 31), row = (idx >> 6) * HALF + wr * 64 + (idx & 63);
            float* slot = xs + ((size_t)T * BM + row) * 4;
            if (lane < 32) { const f32x4 p4 = *(const LAS f32x4*)(Pt + row * 4);
                __hip_atomic_store(slot + u.pn, (p4[0] + p4[1]) + (p4[2] + p4[3]), __ATOMIC_RELAXED, __HIP_MEMORY_SCOPE_AGENT); }
            asm volatile("s_waitcnt vmcnt(0)" ::: "memory");
            unsigned* cw = cnt + T * 2 + wr;
            if (lane == 0) __hip_atomic_fetch_add(cw, 1u, __ATOMIC_RELAXED, __HIP_MEMORY_SCOPE_AGENT);
            unsigned loff2 = loff; asm volatile("" : "+v"(loff2));
#pragma unroll
            for (int bj = 0; bj < 2; ++bj)
#pragma unroll
                for (int ai = 0; ai < 2; ++ai)
#pragma unroll
                    for (int m = 0; m < 4; ++m) { const f32x4 y0 = acc[ai][bj][m][0], y1 = acc[ai][bj][m][1];
                        u32x4 o; o.x = cvt_pk_bf16(y0[0], y0[1]); o.y = cvt_pk_bf16(y0[2], y0[3]); o.z = cvt_pk_bf16(y1[0], y1[1]); o.w = cvt_pk_bf16(y1[2], y1[3]);
                        *(u32x4*)((char*)hbase + (size_t)(loff2 + (unsigned)((ai * HALF + m * 16) * D + bj * HALF)) * 2u) = o; }
            if (wc == 0) { unsigned spins = 0;
                while ((unsigned)__builtin_amdgcn_readfirstlane(__hip_atomic_load(cw, __ATOMIC_RELAXED, __HIP_MEMORY_SCOPE_AGENT)) < 16u) { __builtin_amdgcn_s_sleep(1); if (++spins > (1u << 19)) break; } }
            asm volatile("s_waitcnt vmcnt(0) lgkmcnt(0)" ::: "memory"); __builtin_amdgcn_s_barrier(); asm volatile("" ::: "memory");
            if (lane < 32) { float q = 0.f;
#pragma unroll
                for (int t = 0; t < 4; ++t) q += __hip_atomic_load(slot + t, __ATOMIC_RELAXED, __HIP_MEMORY_SCOPE_AGENT);
                St[row] = rsqrtf(q * (1.0f / D) + EPS); }
            asm volatile("s_waitcnt vmcnt(0) lgkmcnt(0)" ::: "memory"); __builtin_amdgcn_s_barrier(); asm volatile("" ::: "memory");
            const float* sh = nmod + (size_t)rm.modrow * (NMOD * D) + (3 * nj) * D; const float* scp = sh + D;
            char* abase = (char*)(Aout + (size_t)urow0 * D); unsigned loff3 = loff; asm volatile("" : "+v"(loff3));
#pragma unroll
            for (int bj = 0; bj < 2; ++bj) { const int cc = col0 + bj * HALF;
                const f32x4 gm0 = *(const f32x4*)(ng + cc) * (*(const f32x4*)(scp + cc) + 1.0f), gm1 = *(const f32x4*)(ng + cc + 4) * (*(const f32x4*)(scp + cc + 4) + 1.0f);
                const f32x4 s0 = *(const f32x4*)(sh + cc), s1 = *(const f32x4*)(sh + cc + 4);
#pragma unroll
                for (int ai = 0; ai < 2; ++ai)
#pragma unroll
                    for (int m = 0; m < 4; ++m) { const float rstd = St[ai * HALF + rloc + m * 16];
                        const f32x4 y0 = acc[ai][bj][m][0] * rstd * gm0 + s0, y1 = acc[ai][bj][m][1] * rstd * gm1 + s1;
                        u32x4 w; w.x = cvt_pk_bf16(y0[0], y0[1]); w.y = cvt_pk_bf16(y0[2], y0[3]); w.z = cvt_pk_bf16(y1[0], y1[1]); w.w = cvt_pk_bf16(y1[2], y1[3]);
                        *(u32x4*)(abase + (size_t)(loff3 + (unsigned)((ai * HALF + m * 16) * D + bj * HALF)) * 2u) = w; } }
        }
    }
    __device__ __forceinline__ void operator()(f32x4 (&acc)[2][2][4][2], const Unit& u, int wr, int wc, int fr, int fq) const {
        body<MODE_>(acc, u, wr, wc, fr, fq);
    }
};
struct EpiBranch {
    static constexpr bool PERM = true, MIDK = true;
    bf16_t* P;
    __device__ __forceinline__ u32x4 ld_raw(unsigned off) const { return *(const u32x4*)((const char*)P + (size_t)off * 2u); }
    __device__ __forceinline__ void to_e(const u32x4 w, float (&e)[8]) const { unpack8(w, e); }
    template <int WHICH> __device__ __forceinline__ void mid(f32x4 (&acc)[2][2][4][2], const Unit& u, int wr, int wc, int fr, int fq) const {
        unsigned base = (unsigned)(u.pm * BM + wr * 64 + fr) * PROJ + (unsigned)(u.pn * BM + wc * 32 + 8 * fq) + OFF_GATE + WHICH * D;
        asm volatile("" : "+v"(base));
#pragma unroll
        for (int ai = 0; ai < 2; ++ai)
#pragma unroll
            for (int mp = 0; mp < 2; ++mp) {
                u32x4 wa[2][2], wb[2][2];
#pragma unroll
                for (int mm = 0; mm < 2; ++mm)
#pragma unroll
                    for (int bj = 0; bj < 2; ++bj) { const unsigned o = base + (unsigned)(ai * HALF + (mp * 2 + mm) * 16) * PROJ + bj * HALF; wa[mm][bj] = ld_raw(o); wb[mm][bj] = ld_raw(o + D); }
                __builtin_amdgcn_sched_barrier(0);
#pragma unroll
                for (int mm = 0; mm < 2; ++mm)
#pragma unroll
                    for (int bj = 0; bj < 2; ++bj) { float ea[8], eb[8]; to_e(wa[mm][bj], ea); to_e(wb[mm][bj], eb);
#pragma unroll
                        for (int n = 0; n < 2; ++n)
#pragma unroll
                            for (int j = 0; j < 4; j += 2) { const f32x2 r2 = (f32x2){fast_rcp(ea[n * 4 + j]), fast_rcp(ea[n * 4 + j + 1])}, b2 = (f32x2){eb[n * 4 + j], eb[n * 4 + j + 1]};
                                const f32x2 v2 = (f32x2){acc[ai][bj][mp * 2 + mm][n][j], acc[ai][bj][mp * 2 + mm][n][j + 1]} * (b2 * r2);
                                acc[ai][bj][mp * 2 + mm][n][j] = v2[0]; acc[ai][bj][mp * 2 + mm][n][j + 1] = v2[1]; } }
                __builtin_amdgcn_sched_barrier(0);
            }
    }
    __device__ __forceinline__ void operator()(const f32x4 (&acc)[2][2][4][2], const Unit& u, int wr, int wc, int fr, int fq) const {
        unsigned base = (unsigned)(u.pm * BM + wr * 64 + fr) * PROJ + (unsigned)(u.pn * BM + wc * 32 + 8 * fq);
        asm volatile("" : "+v"(base));
#pragma unroll
        for (int ai = 0; ai < 2; ++ai) {
            u32x4 w2[4][2];
#pragma unroll
            for (int m = 0; m < 4; ++m)
#pragma unroll
                for (int bj = 0; bj < 2; ++bj) w2[m][bj] = ld_raw(base + (unsigned)(ai * HALF + m * 16) * PROJ + bj * HALF + OFF_GATE + 2 * D);
            __builtin_amdgcn_sched_barrier(0);
#pragma unroll
            for (int m = 0; m < 4; ++m)
#pragma unroll
                for (int bj = 0; bj < 2; ++bj) { const unsigned o = base + (unsigned)(ai * HALF + m * 16) * PROJ + bj * HALF;
                    float e2[8], ov[8]; to_e(w2[m][bj], e2);
#pragma unroll
                    for (int n = 0; n < 2; ++n)
#pragma unroll
                        for (int j = 0; j < 4; ++j) ov[n * 4 + j] = acc[ai][bj][m][n][j] * fast_rcp(e2[n * 4 + j]);
                    *(u32x4*)((char*)P + (size_t)o * 2u) = pack8(ov); }
            __builtin_amdgcn_sched_barrier(0);
        }
    }
};
}

__device__ __forceinline__ void tr_job(LAS float* tl, const float* src, int ld_src, int K, int Nout, bf16_t* dst, int ld_dst, int dkofs, int mode) {
    const int tid = tid_opaque();
    const int nkt = K / 64, ntl = nkt * (Nout / 64), G = gridDim.x;
    const int ln = tid & 63, lk = tid >> 6, sk2 = (tid & 31) * 2, sn = tid >> 5;
    float r[8];
    int t = bid_opaque();
    auto src_ptr = [&](int tt) -> const float* {
        const int kt = tt % nkt, n0 = (tt / nkt) * 64; int c0 = n0;
        if (mode == 1) { const int pn = n0 >> 8, rr = n0 & 255; c0 = (rr < 128) ? pn * 128 + rr : DFF + pn * 128 + (rr - 128); }
        return src + (size_t)(kt * 64 + lk) * ld_src + c0 + ln; };
    if (t < ntl) { const float* sp = src_ptr(t);
#pragma unroll
        for (int i = 0; i < 8; ++i) r[i] = sp[(size_t)(8 * i) * ld_src]; }
    for (; t < ntl; t += G) {
#pragma unroll
        for (int i = 0; i < 8; ++i) tl[(lk + 8 * i) * 65 + ln] = r[i];
        __syncthreads();
        if (t + G < ntl) { const float* sp = src_ptr(t + G);
#pragma unroll
            for (int i = 0; i < 8; ++i) r[i] = sp[(size_t)(8 * i) * ld_src]; }
        { const int kt = t % nkt, n0 = (t / nkt) * 64;
#pragma unroll
          for (int i = 0; i < 4; ++i) { const int n = sn + 16 * i; *(unsigned*)(dst + (size_t)(n0 + n) * ld_dst + dkofs + kt * 64 + sk2) = cvt_pk_bf16(tl[sk2 * 65 + n], tl[(sk2 + 1) * 65 + n]); } }
        __syncthreads();
    }
}

__device__ void phase_setup(const Params& p, LAS unsigned char* lds) {
    const int tid = tid_opaque(), wid = tid >> 6, lane = tid & 63;
    bf16_t* WT = (bf16_t*)(p.ws + WS_WT);
    LAS float* tl = (LAS float*)lds;
    for (int l = 0; l < NL; ++l) {
        bf16_t* W = WT + (size_t)l * W_LAYER;
        for (int j = 0; j < 2; ++j) {
            tr_job(tl, p.in[I_FFNIN] + ((size_t)l * 2 + j) * D * (2 * DFF), 2 * DFF, D, 2 * DFF, W + (j ? W_FIN1 : W_FIN0), D, 0, 1);
            tr_job(tl, p.in[I_FFNOUT] + ((size_t)l * 2 + j) * DFF * D, D, DFF, D, W + (j ? W_FOUT1 : W_FOUT0), DFF, 0, 0);
        }
        tr_job(tl, p.in[I_WIN] + (size_t)l * D * PROJ, PROJ, D, PROJ, W + W_WIN, D, 0, 0);
        tr_job(tl, p.in[I_WBC] + (size_t)l * 256 * D, D, 256, D, W + W_WB, D, 0, 0);
        tr_job(tl, p.in[I_WBG] + (size_t)l * 256 * D, D, 256, D, W + W_WB, D, 256, 0);
        tr_job(tl, p.in[I_WBA] + (size_t)l * 512 * D, D, 512, D, W + W_WB, D, 512, 0);
        tr_job(tl, p.in[I_WOUT] + (size_t)l * D * D, D, D, D, W + W_WO, D, 0, 0);
        for (int i = bid_opaque() * 512 + tid; i < 65536 / 2; i += gridDim.x * 512) {
            const float2 v = *(const float2*)(p.in[I_GWS] + (size_t)l * 65536 + 2 * i);
            *(unsigned*)(W + W_GWS + 2 * i) = cvt_pk_bf16(v.x, v.y);
        }
    }
    { const int gi = bid_opaque() * 512 + tid;
      if (gi < 1024) { const int pos = gi >> 4, i = gi & 15;
        const int i4 = i & 3, i16 = i >> 2;
        float inv = (i4 == 0) ? 1.0f : (i4 == 1) ? 0.5623413251903491f : (i4 == 2) ? 0.31622776601683794f : 0.1778279410038923f;
        inv *= (i16 == 0) ? 1.0f : (i16 == 1) ? 0.1f : (i16 == 2) ? 0.01f : 0.001f;
        const float a = (float)pos * inv;
        const float kq = __builtin_rintf(a * 0.6366197723675814f);
        float r = __builtin_fmaf(-kq, 1.5707963705062866f, a); r = __builtin_fmaf(kq, 4.371139000186241e-8f, r);
        const float r2 = r * r;
        const float sn = r * (1.0f + r2 * (-1.0f / 6 + r2 * (1.0f / 120 + r2 * (-1.0f / 5040 + r2 * (1.0f / 362880)))));
        const float cs = 1.0f + r2 * (-0.5f + r2 * (1.0f / 24 + r2 * (-1.0f / 720 + r2 * (1.0f / 40320 + r2 * (-1.0f / 3628800)))));
        const int q = ((int)kq) & 3;
        const float c = (q == 0) ? cs : (q == 1) ? -sn : (q == 2) ? -cs : sn;
        const float s = (q == 0) ? sn : (q == 1) ? cs : (q == 2) ? -sn : -cs;
        float2* rt = (float2*)(p.ws + WS_ROPE); rt[gi] = make_float2(c, s); } }
    if (bid_opaque() < NL * 36) {
        LAS float* sc = (LAS float*)lds;
        __syncthreads();
        for (int i = tid; i < 33 * D; i += 512) { const int r = i >> 10, k = i & 1023; const float v = (r < 32) ? p.in[I_C][r * D + k] : p.in[I_CCTX][k]; sc[i] = siluf_(v); }
        __syncthreads();
        float* MOD = (float*)(p.ws + WS_MOD);
        for (int it = bid_opaque(); it < NL * 36; it += gridDim.x) {
            const int l = it / 36, cgp = it % 36, n0 = cgp * 256 + lane * 4;
            const float* wp = p.in[I_WMOD] + (size_t)l * D * (NMOD * D) + n0;
            f32x4 a[5];
#pragma unroll
            for (int i = 0; i < 5; ++i) a[i] = (f32x4){0.f, 0.f, 0.f, 0.f};
            for (int k = 0; k < D; k += 16) {
                f32x4 w[16];
#pragma unroll
                for (int kk = 0; kk < 16; ++kk) w[kk] = *(const f32x4*)(wp + (size_t)(k + kk) * (NMOD * D));
#pragma unroll
                for (int i = 0; i < 5; ++i) { const int r = (i < 4) ? wid + 8 * i : 32;
#pragma unroll
                    for (int k4 = 0; k4 < 4; ++k4) { const f32x4 s4 = *(const LAS f32x4*)(sc + r * D + k + 4 * k4);
                        a[i] += s4[0] * w[4 * k4] + s4[1] * w[4 * k4 + 1] + s4[2] * w[4 * k4 + 2] + s4[3] * w[4 * k4 + 3]; } }
            }
            const f32x4 bv = *(const f32x4*)(p.in[I_BMOD] + (size_t)l * (NMOD * D) + n0);
#pragma unroll
            for (int i = 0; i < 5; ++i) { const int r = (i < 4) ? wid + 8 * i : 32; if (i < 4 || wid == 0) *(f32x4*)(MOD + ((size_t)l * 33 + r) * (NMOD * D) + n0) = a[i] + bv; }
        }
        __syncthreads();
    }
}

__device__ void phase_norm(const Params& p, int l, int j, bool from_inputs, bool skip_ctx) {
    const int tid = tid_opaque(), wid = tid >> 6, lane = tid & 63;
    bf16_t* A = (bf16_t*)(p.ws + WS_A);
    const bf16_t* hbuf = (const bf16_t*)(p.ws + WS_H);
    const float* MOD = (const float*)(p.ws + WS_MOD) + (size_t)l * 33 * (NMOD * D);
    const float* ng = p.in[I_NORMG] + ((size_t)l * 3 + j) * D;
    constexpr int NR = 4;
    for (int u = (bid_opaque() * 8 + wid) * NR; u < T_ALL; u += gridDim.x * 8 * NR) {
        const RowMap rm = map_row(u);
        if (skip_ctx && rm.is_ctx) continue;
        const float* sh = MOD + (size_t)rm.modrow * (NMOD * D) + (3 * j) * D; const float* sc = sh + D;
        f32x4 v[NR][4]; float ss[NR];
        if (from_inputs) { const float* x = (rm.is_ctx ? p.in[I_CTX] : p.in[I_X]) + rm.row0 * D; bf16_t* hw = (bf16_t*)(p.ws + WS_H) + (size_t)u * D;
#pragma unroll
            for (int rr = 0; rr < NR; ++rr)
#pragma unroll
                for (int i = 0; i < 4; ++i) { v[rr][i] = *(const f32x4*)(x + rr * D + i * 256 + lane * 4);
                    u32x2 w; w.x = cvt_pk_bf16(v[rr][i][0], v[rr][i][1]); w.y = cvt_pk_bf16(v[rr][i][2], v[rr][i][3]); *(u32x2*)(hw + rr * D + i * 256 + lane * 4) = w; }
        } else { const bf16_t* x = hbuf + (size_t)u * D;
#pragma unroll
            for (int rr = 0; rr < NR; ++rr)
#pragma unroll
                for (int i = 0; i < 4; ++i) { const u32x2 w = *(const u32x2*)(x + rr * D + i * 256 + lane * 4); v[rr][i] = (f32x4){bf_lo(w.x), bf_hi(w.x), bf_lo(w.y), bf_hi(w.y)}; }
        }
        f32x4 gm[4], s0[4];
#pragma unroll
        for (int i = 0; i < 4; ++i) { const int k = i * 256 + lane * 4; gm[i] = *(const f32x4*)(ng + k) * (*(const f32x4*)(sc + k) + 1.0f); s0[i] = *(const f32x4*)(sh + k); }
#pragma unroll
        for (int rr = 0; rr < NR; ++rr) { ss[rr] = 0.f;
#pragma unroll
            for (int i = 0; i < 4; ++i) ss[rr] += v[rr][i][0] * v[rr][i][0] + v[rr][i][1] * v[rr][i][1] + v[rr][i][2] * v[rr][i][2] + v[rr][i][3] * v[rr][i][3]; }
#pragma unroll
        for (int st = 1; st < 64; st <<= 1)
#pragma unroll
            for (int rr = 0; rr < NR; ++rr) ss[rr] += shx(ss[rr], st, lane);
#pragma unroll
        for (int rr = 0; rr < NR; ++rr) { const float rstd = rsqrtf(ss[rr] * (1.0f / D) + EPS);
#pragma unroll
            for (int i = 0; i < 4; ++i) { const int k = i * 256 + lane * 4;
                const f32x4 y = v[rr][i] * rstd * gm[i] + s0[i];
                u32x2 w; w.x = cvt_pk_bf16(y[0], y[1]); w.y = cvt_pk_bf16(y[2], y[3]);
                *(u32x2*)(A + (size_t)(u + rr) * D + k) = w; } }
    }
}

__device__ void phase_prep(const Params& p, int l, int hs, LAS unsigned char* lds) {
    const int THp = part_rows(hs), latN = part_lat(hs);
    const int tid = tid_opaque(), wid = tid >> 6, lane = tid & 63;
    bf16_t* P = (bf16_t*)(p.ws + WS_R1);
    bf16_t* VTL = (bf16_t*)(p.ws + WS_VTL); bf16_t* VTC = (bf16_t*)(p.ws + WS_VTC);
    const float* qg = p.in[I_QG] + l * 64; const float* kg = p.in[I_KG] + l * 64;
    LAS bf16_t* Vs = (LAS bf16_t*)lds;
    const LAS f32x2* rts = (const LAS f32x2*)(lds + 20480);
    __syncthreads();
    *(LAS u32x4*)(lds + 20480 + tid * 16) = *(const u32x4*)(p.ws + WS_ROPE + tid * 16);
    __syncthreads();
    const int c = lane & 7, seg = c >> 2, hf = (c >> 1) & 1, i0 = (c & 1) * 8;
    float gq[8], gk[8];
#pragma unroll
    for (int e = 0; e < 8; ++e) { gq[e] = qg[8 * c + e]; gk[e] = kg[8 * c + e]; }
    for (int it = bid_opaque(); it < THp / 64; it += gridDim.x) {
        const int v0 = it * 64; const bool lat = v0 < latN;
        const int prow = (v0 & (SEQ - 1)) >> 6;
        bf16_t* rowb = P + (size_t)(v0 + wid * 8) * PROJ;
        const int qoff = OFF_Q + (lane >> 3) * 64 + 8 * c, koff = OFF_K + ((lane >> 3) & 1) * 64 + 8 * c;
        u32x4 qr[8], kr[8]; unsigned vr[8];
#pragma unroll
        for (int i = 0; i < 8; ++i) { const bf16_t* rp = rowb + (size_t)i * PROJ; qr[i] = *(const u32x4*)(rp + qoff); kr[i] = *(const u32x4*)(rp + koff); vr[i] = *(const unsigned*)(rp + OFF_V + 2 * lane); }
#pragma unroll
        for (int i = 0; i < 8; ++i) {
            const int rl = wid * 8 + i;
            bf16_t* rowp = rowb + (size_t)i * PROJ;
            const int pp = seg ? rl : prow;
            float cs[8], sn[8];
#pragma unroll
            for (int e = 0; e < 8; ++e) { const f32x2 t2 = rts[pp * 16 + i0 + e]; cs[e] = lat ? t2[0] : 1.0f; sn[e] = lat ? t2[1] : 0.0f; }
            { float x[8]; unpack8(qr[i], x);
              float ss = 0.f;
#pragma unroll
              for (int e = 0; e < 8; ++e) ss += x[e] * x[e];
              ss += shx(ss, 1, lane); ss += shx(ss, 2, lane); ss += shx(ss, 4, lane);
              const float rstd = rsqrtf(ss * (1.0f / 64) + EPS); float o[8];
#pragma unroll
              for (int e = 0; e < 8; ++e) { const float y = x[e] * rstd * gq[e]; const float yp = shx(y, 2, lane);
                  o[e] = (hf ? (y * cs[e] + yp * sn[e]) : (y * cs[e] - yp * sn[e])) * (0.125f * LOG2E); }
              *(u32x4*)(rowp + qoff) = pack8(o); }
            { float x[8]; unpack8(kr[i], x);
              float ss = 0.f;
#pragma unroll
              for (int e = 0; e < 8; ++e) ss += x[e] * x[e];
              ss += shx(ss, 1, lane); ss += shx(ss, 2, lane); ss += shx(ss, 4, lane);
              const float rstd = rsqrtf(ss * (1.0f / 64) + EPS); float o[8];
#pragma unroll
              for (int e = 0; e < 8; ++e) { const float y = x[e] * rstd * gk[e]; const float yp = shx(y, 2, lane);
                  o[e] = hf ? (y * cs[e] + yp * sn[e]) : (y * cs[e] - yp * sn[e]); }
              if (lane < 16) *(u32x4*)(rowp + koff) = pack8(o); }
            { const unsigned w = vr[i];
              Vs[(2 * lane) * 72 + rl] = (bf16_t)(w & 0xffffu); Vs[(2 * lane + 1) * 72 + rl] = (bf16_t)(w >> 16); }
        }
        __syncthreads();
        { const int hd = tid >> 2, ch = tid & 3;
          bf16_t* dst;
          if (lat) { const int bl = v0 >> 11, pos0 = v0 & (SEQ - 1); dst = VTL + ((size_t)bl * 128 + hd) * SEQ + pos0 + ch * 16; }
          else { const int cv = v0 - latN, bl = cv >> 8, pos0 = cv & 255; dst = VTC + ((size_t)bl * 128 + hd) * CTXL + pos0 + ch * 16; }
          const u32x4 a = *(const LAS u32x4*)(Vs + hd * 72 + ch * 16), b = *(const LAS u32x4*)(Vs + hd * 72 + ch * 16 + 8);
          *(u32x4*)dst = a; *(u32x4*)(dst + 8) = b; }
        __syncthreads();
    }
}

struct KeySeg { const bf16_t* K; const bf16_t* Vt; int vstride; int ntiles; int mask; };

__device__ __forceinline__ void attn_item(const Params& p, int l, int hs, int idx) {
    const int tid = tid_opaque(), wid = __builtin_amdgcn_readfirstlane(tid >> 6), lane = tid & 63, fr = lane & 15, fq = lane >> 4;
    const bf16_t* P = (const bf16_t*)(p.ws + WS_R1);
    const bf16_t* VTL = (const bf16_t*)(p.ws + WS_VTL); const bf16_t* VTC = (const bf16_t*)(p.ws + WS_VTC);
    bf16_t* Y = (bf16_t*)(p.ws + WS_A) + (size_t)part_u0(hs) * D;
    const int latN = part_lat(hs), nli = part_nb(hs) * 32;
    int bl, qb, hk; bool lat;
    if (idx < nli) { lat = true; bl = idx >> 5; qb = (idx >> 1) & 15; hk = idx & 1; }
    else { const int j = idx - nli; lat = false; bl = j >> 2; qb = (j >> 1) & 1; hk = j & 1; }
    const int g = wid >> 1, r0 = (wid & 1) * 64, head = hk * 4 + g;
    const int qrow0 = lat ? bl * SEQ + qb * 128 : latN + bl * CTXL + qb * 128;
    const int crow0 = latN + bl * CTXL;
    bf16x8 qf[4][2];
    { const bf16_t* qp = P + (size_t)(qrow0 + r0 + fr) * PROJ + OFF_Q + head * 64 + fq * 8;
#pragma unroll
      for (int nq = 0; nq < 4; ++nq)
#pragma unroll
          for (int ks = 0; ks < 2; ++ks) qf[nq][ks] = *(const bf16x8*)(qp + (size_t)nq * 16 * PROJ + ks * 32); }
    f32x4 o[4][4];
#pragma unroll
    for (int a = 0; a < 4; ++a)
#pragma unroll
        for (int b = 0; b < 4; ++b) o[a][b] = (f32x4){0.f, 0.f, 0.f, 0.f};
    const float snk = p.in[I_SINK][l * 8 + head] * LOG2E;
    float mrun[4], lrun[4];
#pragma unroll
    for (int nq = 0; nq < 4; ++nq) { mrun[nq] = snk; lrun[nq] = (fq == 0) ? 1.0f : 0.0f; }

    int lo = 0, nb = 0;
    if (lat) { lo = (qb == 0) ? 4 : (r0 >> 5); const int hi = (qb == 15) ? 8 : (r0 == 0 ? 10 : 12); nb = hi - lo; }
    const int ntot = nb + 8;
    const char* kband = (const char*)(P + (ptrdiff_t)(bl * SEQ + (qb - 1) * 128 + lo * 32) * PROJ + OFF_K + hk * 64);
    const char* kctx = (const char*)(P + (size_t)crow0 * PROJ + OFF_K + hk * 64);
    const char* vband = (const char*)(VTL + ((size_t)bl * 2 + hk) * 64 * SEQ + (ptrdiff_t)((qb - 1) * 128 + lo * 32));
    const char* vctx = (const char*)(VTC + ((size_t)bl * 2 + hk) * 64 * CTXL);
    const unsigned klane = (unsigned)(fr * PROJ + fq * 8) * 2u, vlane_b = (unsigned)(fr * SEQ + fq * 4) * 2u, vlane_c = (unsigned)(fr * CTXL + fq * 4) * 2u;
#define ATT_LOAD(i_, KF, VLO, VHI) do { const int _i = (i_); \
        if (_i < nb) { const char* _kp = kband + (size_t)_i * (32 * PROJ * 2); const char* _vp = vband + _i * 64; \
            _Pragma("unroll") for (int kb = 0; kb < 2; ++kb) _Pragma("unroll") for (int ks = 0; ks < 2; ++ks) KF[kb][ks] = *(const bf16x8*)(_kp + kb * (16 * PROJ * 2) + ks * 64 + klane); \
            _Pragma("unroll") for (int db = 0; db < 4; ++db) { VLO[db] = *(const bf16x4*)(_vp + db * (16 * SEQ * 2) + vlane_b); VHI[db] = *(const bf16x4*)(_vp + db * (16 * SEQ * 2) + 32 + vlane_b); } \
        } else { const char* _kp = kctx + (size_t)(_i - nb) * (32 * PROJ * 2); const char* _vp = vctx + (_i - nb) * 64; \
            _Pragma("unroll") for (int kb = 0; kb < 2; ++kb) _Pragma("unroll") for (int ks = 0; ks < 2; ++ks) KF[kb][ks] = *(const bf16x8*)(_kp + kb * (16 * PROJ * 2) + ks * 64 + klane); \
            _Pragma("unroll") for (int db = 0; db < 4; ++db) { VLO[db] = *(const bf16x4*)(_vp + db * (16 * CTXL * 2) + vlane_c); VHI[db] = *(const bf16x4*)(_vp + db * (16 * CTXL * 2) + 32 + vlane_c); } } } while (0)
#define ATT_COMPUTE(i_, KF, VLO, VHI) do { const int _ci = (i_); const int bt = lo + _ci; const bool mask = (_ci < nb) && (bt < 4 || bt >= 8); \
        f32x4 s[2][4]; \
        _Pragma("unroll") for (int kb = 0; kb < 2; ++kb) _Pragma("unroll") for (int nq = 0; nq < 4; ++nq) { \
            s[kb][nq] = __builtin_amdgcn_mfma_f32_16x16x32_bf16(KF[kb][0], qf[nq][0], (f32x4){0.f, 0.f, 0.f, 0.f}, 0, 0, 0); \
            s[kb][nq] = __builtin_amdgcn_mfma_f32_16x16x32_bf16(KF[kb][1], qf[nq][1], s[kb][nq], 0, 0, 0); } \
        if (mask) { \
            _Pragma("unroll") for (int kb = 0; kb < 2; ++kb) _Pragma("unroll") for (int nq = 0; nq < 4; ++nq) _Pragma("unroll") for (int j = 0; j < 4; ++j) { \
                const int dlt = (bt * 32 - 128 + kb * 16 + fq * 4 + j) - (r0 + nq * 16 + fr); if (dlt > 128 || dlt < -128) s[kb][nq][j] = -1e30f; } } \
        bf16x8 pf[4]; \
        _Pragma("unroll") for (int nq = 0; nq < 4; ++nq) { \
            float mx = fmaxf(fmaxf(fmaxf(s[0][nq][0], s[0][nq][1]), fmaxf(s[0][nq][2], s[0][nq][3])), fmaxf(fmaxf(s[1][nq][0], s[1][nq][1]), fmaxf(s[1][nq][2], s[1][nq][3]))); \
            mx = fmaxf(mx, shx(mx, 16, lane)); mx = fmaxf(mx, shx(mx, 32, lane)); \
            const float mn = fmaxf(mrun[nq], mx), alpha = fast_exp2(mrun[nq] - mn); mrun[nq] = mn; \
            float pv[8]; f32x2 ps2 = (f32x2){0.f, 0.f}; const f32x2 mn2 = (f32x2){mn, mn}; \
            _Pragma("unroll") for (int kb = 0; kb < 2; ++kb) _Pragma("unroll") for (int j = 0; j < 4; j += 2) { \
                const f32x2 d2 = (f32x2){s[kb][nq][j], s[kb][nq][j + 1]} - mn2; const f32x2 e2 = (f32x2){fast_exp2(d2[0]), fast_exp2(d2[1])}; \
                pv[kb * 4 + j] = e2[0]; pv[kb * 4 + j + 1] = e2[1]; ps2 = ps2 + e2; } \
            lrun[nq] = lrun[nq] * alpha + (ps2[0] + ps2[1]); \
            const u32x4 w = pack8(pv); pf[nq] = *(const bf16x8*)&w; \
            _Pragma("unroll") for (int db = 0; db < 4; ++db) o[db][nq] *= alpha; } \
        _Pragma("unroll") for (int db = 0; db < 4; ++db) { const bf16x8 vf = (bf16x8){VLO[db][0], VLO[db][1], VLO[db][2], VLO[db][3], VHI[db][0], VHI[db][1], VHI[db][2], VHI[db][3]}; \
            _Pragma("unroll") for (int nq = 0; nq < 4; ++nq) o[db][nq] = __builtin_amdgcn_mfma_f32_16x16x32_bf16(vf, pf[nq], o[db][nq], 0, 0, 0); } } while (0)
    bf16x8 kfa[2][2], kfb[2][2]; bf16x4 vla[4], vha[4], vlb[4], vhb[4];
    ATT_LOAD(0, kfa, vla, vha);
    for (int i = 0; i < ntot; i += 2) {
        const int i1 = (i + 1 < ntot) ? i + 1 : i;
        ATT_LOAD(i1, kfb, vlb, vhb);
        ATT_COMPUTE(i, kfa, vla, vha);
        const int i2 = (i + 2 < ntot) ? i + 2 : i;
        ATT_LOAD(i2, kfa, vla, vha);
        if (i + 1 < ntot) ATT_COMPUTE(i + 1, kfb, vlb, vhb);
    }
#undef ATT_LOAD
#undef ATT_COMPUTE
#pragma unroll
    for (int nq = 0; nq < 4; ++nq) {
        float lt = lrun[nq]; lt += shx(lt, 16, lane); lt += shx(lt, 32, lane);
        const float inv = 1.0f / lt;
        bf16_t* yp = Y + (size_t)(qrow0 + r0 + nq * 16 + fr) * D + 512 + head * 64 + fq * 4;
#pragma unroll
        for (int db = 0; db < 4; ++db) { u32x2 w; w.x = cvt_pk_bf16(o[db][nq][0] * inv, o[db][nq][1] * inv); w.y = cvt_pk_bf16(o[db][nq][2] * inv, o[db][nq][3] * inv);
            *(u32x2*)(yp + db * 16) = w; }
    }
}

__device__ __forceinline__ void gmlp_conv_item(const Params& p, int l, int hs, int chunk, LAS unsigned char* lds) {
    const int tid = tid_opaque(), wid = tid >> 6, lane = tid & 63, fr = lane & 15, fq = lane >> 4;
    const bf16_t* P = (const bf16_t*)(p.ws + WS_R1);
    bf16_t* Y = (bf16_t*)(p.ws + WS_A) + (size_t)part_u0(hs) * D;
    const int v0 = chunk * 128, latN = part_lat(hs);
    LAS bf16_t* vT = (LAS bf16_t*)lds;
    { const float* cw = p.in[I_CONVW] + (size_t)l * 3 * 256;
      const bool lat = v0 < latN;
#pragma unroll 2
      for (int i = 0; i < 8; ++i) {
          const int id = i * 512 + tid, pt = id >> 5, cc = (id & 31) * 8, v = v0 + pt;
          const int pos = lat ? (v & (SEQ - 1)) : ((v - latN) & (CTXL - 1)), n = lat ? SEQ : CTXL;
          const bf16_t* rp = P + (size_t)v * PROJ + cc;
          float bv[8], c1[8], h1[8], acc[8];
          unpack8(*(const u32x4*)(rp + OFF_CB), bv); unpack8(*(const u32x4*)(rp + OFF_CC), c1); unpack8(*(const u32x4*)(rp + OFF_CH), h1);
          { const f32x4 wa = *(const f32x4*)(cw + 256 + cc), wb = *(const f32x4*)(cw + 256 + cc + 4);
#pragma unroll
            for (int e = 0; e < 8; ++e) acc[e] = c1[e] * h1[e] * (e < 4 ? wa[e & 3] : wb[e & 3]); }
          if (pos > 0) { float c0[8], h0[8]; unpack8(*(const u32x4*)(rp - PROJ + OFF_CC), c0); unpack8(*(const u32x4*)(rp - PROJ + OFF_CH), h0);
              const f32x4 wa = *(const f32x4*)(cw + cc), wb = *(const f32x4*)(cw + cc + 4);
#pragma unroll
              for (int e = 0; e < 8; ++e) acc[e] += c0[e] * h0[e] * (e < 4 ? wa[e & 3] : wb[e & 3]); }
          if (pos < n - 1) { float c2[8], h2[8]; unpack8(*(const u32x4*)(rp + PROJ + OFF_CC), c2); unpack8(*(const u32x4*)(rp + PROJ + OFF_CH), h2);
              const f32x4 wa = *(const f32x4*)(cw + 512 + cc), wb = *(const f32x4*)(cw + 512 + cc + 4);
#pragma unroll
              for (int e = 0; e < 8; ++e) acc[e] += c2[e] * h2[e] * (e < 4 ? wa[e & 3] : wb[e & 3]); }
#pragma unroll
          for (int e = 0; e < 8; ++e) acc[e] *= bv[e];
          *(u32x4*)(Y + (size_t)v * D + cc) = pack8(acc);
      } }
    { const float* lg = p.in[I_LNG] + l * 256 + 4 * lane; const float* lb = p.in[I_LNB] + l * 256 + 4 * lane;
      const f32x4 g4 = *(const f32x4*)lg, b4 = *(const f32x4*)lb;
#pragma unroll
      for (int hb = 0; hb < 2; ++hb) {
          u32x2 w[8]; float x[8][4], sm[8], qv[8];
#pragma unroll
          for (int i = 0; i < 8; ++i) w[i] = *(const u32x2*)(P + (size_t)(v0 + wid * 16 + hb * 8 + i) * PROJ + OFF_GV + 4 * lane);
#pragma unroll
          for (int i = 0; i < 8; ++i) { x[i][0] = gelu_tanh(bf_lo(w[i].x)); x[i][1] = gelu_tanh(bf_hi(w[i].x)); x[i][2] = gelu_tanh(bf_lo(w[i].y)); x[i][3] = gelu_tanh(bf_hi(w[i].y));
              sm[i] = (x[i][0] + x[i][1]) + (x[i][2] + x[i][3]); }
#pragma unroll
          for (int st = 1; st < 64; st <<= 1)
#pragma unroll
              for (int i = 0; i < 8; ++i) sm[i] += shx(sm[i], st, lane);
#pragma unroll
          for (int i = 0; i < 8; ++i) { const float mu = sm[i] * (1.0f / 256); float q = 0.f;
#pragma unroll
              for (int e = 0; e < 4; ++e) { x[i][e] -= mu; q += x[i][e] * x[i][e]; }
              qv[i] = q; }
#pragma unroll
          for (int st = 1; st < 64; st <<= 1)
#pragma unroll
              for (int i = 0; i < 8; ++i) qv[i] += shx(qv[i], st, lane);
#pragma unroll
          for (int i = 0; i < 8; ++i) { const float rstd = rsqrtf(qv[i] * (1.0f / 256) + EPS); const int pt = wid * 16 + hb * 8 + i;
#pragma unroll
              for (int e = 0; e < 4; ++e) { const float y = x[i][e] * rstd * g4[e] + b4[e]; vT[(4 * lane + e) * 136 + pt] = (bf16_t)(cvt_pk_bf16(y, 0.f) & 0xffffu); } }
      } }
    __syncthreads();
    { const int g = wid >> 1, ph = wid & 1;
      const bf16_t* wsb = (const bf16_t*)(p.ws + WS_WT) + (size_t)l * W_LAYER + W_GWS + (size_t)g * 128 * 128;
      f32x4 acc[4][4];
#pragma unroll
      for (int a = 0; a < 4; ++a)
#pragma unroll
          for (int b = 0; b < 4; ++b) acc[a][b] = (f32x4){0.f, 0.f, 0.f, 0.f};
#pragma unroll
      for (int kk = 0; kk < 4; ++kk) {
          bf16x8 af[4], bfr[4];
#pragma unroll
          for (int db = 0; db < 4; ++db) af[db] = *(const LAS bf16x8*)(vT + (g * 64 + db * 16 + fr) * 136 + kk * 32 + fq * 8);
#pragma unroll
          for (int pb = 0; pb < 4; ++pb) bfr[pb] = *(const bf16x8*)(wsb + (size_t)((ph * 4 + pb) * 16 + fr) * 128 + kk * 32 + fq * 8);
#pragma unroll
          for (int db = 0; db < 4; ++db)
#pragma unroll
              for (int pb = 0; pb < 4; ++pb) acc[db][pb] = __builtin_amdgcn_mfma_f32_16x16x32_bf16(af[db], bfr[pb], acc[db][pb], 0, 0, 0);
      }
      const float* bs = p.in[I_GBS] + (size_t)l * 512 + g * 128;
      u32x2 uw[4][4]; float bias[4];
#pragma unroll
      for (int pb = 0; pb < 4; ++pb) { const int pt = (ph * 4 + pb) * 16 + fr; bias[pb] = bs[pt];
          const bf16_t* up = P + (size_t)(v0 + pt) * PROJ + OFF_GU + g * 64 + fq * 4;
#pragma unroll
          for (int db = 0; db < 4; ++db) uw[pb][db] = *(const u32x2*)(up + db * 16); }
#pragma unroll
      for (int pb = 0; pb < 4; ++pb) { const int pt = (ph * 4 + pb) * 16 + fr;
          bf16_t* yp = Y + (size_t)(v0 + pt) * D + 256 + g * 64 + fq * 4;
#pragma unroll
          for (int db = 0; db < 4; ++db) { const u32x2 w = uw[pb][db];
              const float y0 = gelu_tanh(bf_lo(w.x)) * (acc[db][pb][0] + bias[pb]), y1 = gelu_tanh(bf_hi(w.x)) * (acc[db][pb][1] + bias[pb]);
              const float y2 = gelu_tanh(bf_lo(w.y)) * (acc[db][pb][2] + bias[pb]), y3 = gelu_tanh(bf_hi(w.y)) * (acc[db][pb][3] + bias[pb]);
              u32x2 ov; ov.x = cvt_pk_bf16(y0, y1); ov.y = cvt_pk_bf16(y2, y3); *(u32x2*)(yp + db * 16) = ov; } } }
    __syncthreads();
}

__device__ void phase_mixers(const Params& p, int l, int hs, LAS unsigned char* lds, bool skip_ctx) {
    const int n_attn = part_nb(hs) * (skip_ctx ? 32 : 36), n_gmlp = (skip_ctx ? part_lat(hs) : part_rows(hs)) / 128;
#ifndef SKIP_ATTN
    for (int it = bid_opaque(); it < n_attn; it += gridDim.x) attn_item(p, l, hs, it);
#endif
    __builtin_amdgcn_sched_barrier(0);
#ifndef SKIP_GMLP
    { const int G = (int)gridDim.x; int n3 = n_attn - 2 * G; n3 = n3 < 0 ? 0 : n3 % G;
      for (int it = (bid_opaque() - n3 + G) % G; it < n_gmlp; it += G) gmlp_conv_item(p, l, hs, it, lds); }
#endif
}

#define XB_TMO      128
#define XB_XCNT(j)  (256  + 64 * (j))
#define XB_XSUB(j)  (1280 + 64 * (j))
#define XB_XGEN(j)  (2304 + 64 * (j))
#define XB_TOP      3328
#define XB_TOPGEN   3392
#define XCD_BAR_WORDS 3456
#define XB_SPIN_CAP (1u << 22)
__device__ __forceinline__ unsigned xb_ld(unsigned* p)              { return __hip_atomic_load(p, __ATOMIC_RELAXED, __HIP_MEMORY_SCOPE_AGENT); }
__device__ __forceinline__ unsigned xb_add(unsigned* p, unsigned v) { return __hip_atomic_fetch_add(p, v, __ATOMIC_RELAXED, __HIP_MEMORY_SCOPE_AGENT); }
__device__ __forceinline__ unsigned xb_xcc_id() { return (unsigned)__builtin_amdgcn_s_getreg((3 << 11) | 20) & 0xFu; }
#define XB_SPIN(cond, bar) do { unsigned _sp = 0; while (cond) { __builtin_amdgcn_s_sleep(1); \
    if ((++_sp & 255u) == 0u) { if (xb_ld(&(bar)[XB_TMO])) break; if (_sp > XB_SPIN_CAP) { atomicAdd(&(bar)[XB_TMO], 1u); break; } } } } while (0)
__device__ __forceinline__ void xcd_barrier_post(unsigned* bar) { if (threadIdx.x == 0) (void)xb_add(&bar[XB_XCNT(xb_xcc_id())], 1u); }
__device__ __forceinline__ void xcd_barrier_complete(unsigned* bar, unsigned x, unsigned& nloc, unsigned& nx) {
    const unsigned G = gridDim.x * gridDim.y * gridDim.z;
    unsigned sum, cnt, mine, sp = 0u;
    for (;;) {
        sum = 0u; cnt = 0u; mine = 0u;
#pragma unroll
        for (unsigned j = 0; j < 16; ++j) { const unsigned c = xb_ld(&bar[XB_XCNT(j)]); sum += c; cnt += (c > 0u) ? 1u : 0u; mine = (j == x) ? c : mine; }
        if (sum == G) break;
        __builtin_amdgcn_s_sleep(1);
        if ((++sp & 255u) == 0u) { if (xb_ld(&bar[XB_TMO])) break; if (sp > XB_SPIN_CAP) { atomicAdd(&bar[XB_TMO], 1u); break; } }
    }
    nloc = mine > 0u ? mine : 1u; nx = cnt > 0u ? cnt : 1u;
}
__device__ __forceinline__ void xcd_barrier(unsigned* bar, volatile LAS unsigned* st) {
    asm volatile("s_waitcnt vmcnt(0)" ::: "memory");
    __syncthreads();
    if (threadIdx.x == 0) {
        const unsigned x = xb_xcc_id();
        __builtin_amdgcn_s_waitcnt(0);
        unsigned nloc = st[0], nx = st[1];
        if (nloc == 0u) { xcd_barrier_complete(bar, x, nloc, nx); st[0] = nloc; st[1] = nx; }
        const unsigned old = xb_add(&bar[XB_XSUB(x)], 1u);
        const unsigned gen = old / nloc;
        if (old + 1u == (gen + 1u) * nloc) {
            __builtin_amdgcn_fence(__ATOMIC_RELEASE, "agent");
            asm volatile("s_waitcnt vmcnt(0)" ::: "memory");
            const unsigned og = xb_add(&bar[XB_TOP], 1u);
            const unsigned tg = og / nx;
            if (og + 1u == (tg + 1u) * nx) xb_add(&bar[XB_TOPGEN], 1u);
            else XB_SPIN(xb_ld(&bar[XB_TOPGEN]) == tg, bar);
            __builtin_amdgcn_fence(__ATOMIC_ACQUIRE, "agent");
            xb_add(&bar[XB_XGEN(x)], 1u);
            asm volatile("s_waitcnt vmcnt(0)" ::: "memory");
        } else {
            XB_SPIN(xb_ld(&bar[XB_XGEN(x)]) == gen, bar);
            __builtin_amdgcn_fence(__ATOMIC_ACQUIRE, "agent");
            asm volatile("s_waitcnt vmcnt(0)" ::: "memory");
        }
    }
    __syncthreads();
}

__device__ void run_phase(const Params& p, int ph, LAS unsigned char* lds) {
    if (ph == 0) {
#ifndef SKIP_SETUP
 phase_setup(p, lds);
#endif
 return; }
    const int q = ph - 1, l = q / 17, r = q % 17;
    const bf16_t* W = (const bf16_t*)(p.ws + WS_WT) + (size_t)l * W_LAYER;
    const float* MOD = (const float*)(p.ws + WS_MOD) + (size_t)l * 33 * (NMOD * D);
    bf16_t* HB = (bf16_t*)(p.ws + WS_H);
    const bool first = (l == 0 && r <= 2);
    const bool lastl = (l == NL - 1);
    bf16_t* A = (bf16_t*)(p.ws + WS_A); bf16_t* R1 = (bf16_t*)(p.ws + WS_R1);
    if (r == 0 || r == 3 || r == 14) {
#ifndef SKIP_NORM
 if (l == 0 && r == 0) phase_norm(p, l, 0, true, false);
#endif
 return; }
    if (r == 1 || r == 15) {
        const int j = (r == 1) ? 0 : 1;
        const int sk = (lastl && j == 1) ? 1 : 0;
        pg8::Gemm g{A, D, W + (j ? W_FIN1 : W_FIN0), D, sk ? T_LAT : T_ALL, 2 * DFF, D, sk, 0};
        pg8::EpiSwiglu E{R1};
#ifndef SKIP_UP
        pg8::gemm_phase(lds, g, E);
#endif
        return;
    }
    if (r == 2 || r == 16) {
        const int j = (r == 2) ? 0 : 1;
        const int sk = (lastl && j == 1) ? 1 : 0;
        pg8::Gemm g{R1, DFF, W + (j ? W_FOUT1 : W_FOUT0), DFF, sk ? T_LAT : T_ALL, D, DFF, sk, 1};
        const int nj = (r == 2) ? 1 : (lastl ? -1 : 0), ln = (r == 2) ? l : l + 1;
        const bool fin = (lastl && r == 16);
        const float* ngp = p.in[I_NORMG] + ((size_t)(nj < 0 ? 0 : ln) * 3 + (nj < 0 ? 0 : nj)) * D; const float* nmp = (const float*)(p.ws + WS_MOD) + (size_t)(nj < 0 ? 0 : ln) * 33 * (NMOD * D);
        unsigned* cntp = (unsigned*)(p.ws + WS_CNT) + (size_t)(l * 3 + (r == 2 ? 0 : 2)) * 576;
#ifndef SKIP_DOWN
        if (fin) { pg8::EpiResid<2, false> E{p.in[I_X], p.in[I_CTX], HB, p.out, MOD, 8, 0.5f, 0, 2, -1, ngp, nmp, A, (float*)(p.ws + WS_XS), cntp, lds}; pg8::gemm_phase(lds, g, E); }
        else { pg8::EpiResid<1, true> E{p.in[I_X], p.in[I_CTX], HB, p.out, MOD, j ? 8 : 2, 0.5f, 0, 1, nj, ngp, nmp, A, (float*)(p.ws + WS_XS), cntp, lds}; pg8::gemm_phase(lds, g, E); }
#endif
        return;
    }
    const int hs = (r - 4) / 5, rr = (r - 4) % 5;
    if (rr == 0) { pg8::Gemm g{A + (size_t)part_u0(hs) * D, D, W + W_WIN, D, part_rows(hs), PROJ, D, 0, lastl ? part_lat(hs) / 256 : 0}; pg8::EpiBf16 E{R1, PROJ, p.in[I_BGATE] + (size_t)l * 3 * D, OFF_GATE};
#ifndef SKIP_PROJ
 pg8::gemm_phase(lds, g, E);
#endif
 return; }
    if (rr == 1) {
#ifndef SKIP_PREP
 phase_prep(p, l, hs, lds);
#endif
 return; }
    if (rr == 2) {
#ifndef SKIP_MIX
 phase_mixers(p, l, hs, lds, lastl);
#endif
 return; }
    if (rr == 3) { pg8::Gemm g{A + (size_t)part_u0(hs) * D, D, W + W_WB, D, lastl ? part_lat(hs) : part_rows(hs), D, D, 0, 1}; pg8::EpiBranch E{R1};
#ifndef SKIP_BRANCH
 pg8::gemm_phase(lds, g, E);
#endif
 return; }
    { pg8::Gemm g{R1, PROJ, W + W_WO, D, lastl ? part_lat(hs) : part_rows(hs), D, D, 0, 0}; pg8::EpiResid<1, true> E{p.in[I_X], p.in[I_CTX], HB, p.out, MOD, 5, 1.0f, part_u0(hs) / 256, 1,
                        2, p.in[I_NORMG] + ((size_t)l * 3 + 2) * D, MOD, A, (float*)(p.ws + WS_XS), (unsigned*)(p.ws + WS_CNT) + (size_t)(l * 3 + 1) * 576, lds};
#ifndef SKIP_OUT
 pg8::gemm_phase(lds, g, E);
#endif
 }
}

__global__ __launch_bounds__(512, 2) void fwd_megakernel(Params p) {
    extern __shared__ __attribute__((aligned(16))) unsigned char shm[];
    LAS unsigned char* lds = (LAS unsigned char*)shm;
#if MK_SINGLE
    volatile LAS unsigned* bst = (volatile LAS unsigned*)(lds + LDS_BYTES - 16);
    if (threadIdx.x == 0) { bst[0] = 0u; bst[1] = 0u; }
    __syncthreads();
    xcd_barrier_post((unsigned*)(p.ws + WS_BAR));
#endif
    for (int ph = p.ph_lo; ph < p.ph_hi; ++ph) {
#if defined(__HIP_DEVICE_COMPILE__)
        const __attribute__((address_space(4))) char* kp = (const __attribute__((address_space(4))) char*)__builtin_amdgcn_kernarg_segment_ptr();
        asm volatile("" : "+s"(kp));
        const Params lp = *(const Params*)(const char*)kp;
#else
        const Params lp = p;
#endif
        run_phase(lp, ph, lds);
#if MK_SINGLE
        const int r_ = (ph - 1) % 17;
        if (ph + 1 < lp.ph_hi && !(ph > 1 && (r_ == 0 || r_ == 3 || r_ == 14))) {
            if (ph == 0) cg::this_grid().sync();
            else xcd_barrier((unsigned*)(lp.ws + WS_BAR), (volatile LAS unsigned*)(lds + LDS_BYTES - 16));
        }
#endif
    }
}

extern "C" void kernel_launch(void* const* d_in, const int* in_sizes, int n_in, void* d_out, int out_size, void* d_ws, size_t ws_size, hipStream_t stream) {
    static int grid = 0;
    if (grid == 0) {
        if (n_in != N_IN || out_size != T_LAT * D || ws_size < WS_END) { fprintf(stderr, "kernel_launch: unexpected shapes (n_in %d out %d ws %zu need %zu)\n", n_in, out_size, ws_size, (size_t)WS_END); grid = -1; return; }
        int dev = 0, cus = 0, per_cu = 0;
        (void)hipGetDevice(&dev); (void)hipDeviceGetAttribute(&cus, hipDeviceAttributeMultiprocessorCount, dev);
        if (hipFuncSetAttribute((const void*)fwd_megakernel, hipFuncAttributeMaxDynamicSharedMemorySize, LDS_BYTES) != hipSuccess) { fprintf(stderr, "kernel_launch: hipFuncSetAttribute failed\n"); grid = -1; return; }
        if (hipOccupancyMaxActiveBlocksPerMultiprocessor(&per_cu, (const void*)fwd_megakernel, 512, LDS_BYTES) != hipSuccess || per_cu < 1) { fprintf(stderr, "kernel_launch: occupancy query gave %d\n", per_cu); per_cu = 1; }
        (void)hipGetLastError();
        grid = cus * per_cu;
    }
    if (grid < 0) return;
    Params p{};
    for (int i = 0; i < N_IN; ++i) p.in[i] = (const float*)d_in[i];
    p.out = (float*)d_out; p.ws = (unsigned char*)d_ws;
#if MK_SINGLE
    p.ph_lo = 0; p.ph_hi = N_PHASES;
    if (hipMemsetAsync((char*)d_ws + WS_BAR, 0, 16384 + 32768, stream) != hipSuccess) { fprintf(stderr, "kernel_launch: memset of the barrier words failed\n"); return; }
    void* args[] = {&p};
    hipError_t e = hipLaunchCooperativeKernel((const void*)fwd_megakernel, dim3(grid), dim3(512), args, LDS_BYTES, stream);
    if (e != hipSuccess) fprintf(stderr, "cooperative launch failed: %s (grid %d)\n", hipGetErrorString(e), grid);
#else
    for (int ph = 0; ph < N_PHASES; ++ph) {
        p.ph_lo = ph; p.ph_hi = ph + 1;
        hipLaunchKernelGGL(fwd_megakernel, dim3(grid), dim3(512), LDS_BYTES, stream, p);
    }
#endif
}
```
